# Optimizing an MI355X kernel written in HIP

```python
import jax, jax.numpy as jnp
from jax import lax
import numpy as np

D_MODEL = 1024
BATCH = 32
SEQ = 2048
DEPTH = 4

N_A = DEPTH // 2
N_B = DEPTH - N_A
N_DENSE = (DEPTH + 1) // 2
N_MOE = DEPTH // 2

POOL_WINDOWS = (2, 4, 8, 16)
N_POOL_GROUPS = len(POOL_WINDOWS)
GW = D_MODEL // N_POOL_GROUPS

HEAD_DIM = 64
N_HEADS = D_MODEL // HEAD_DIM
Q_BLOCK = 128

D_FF = 2816
N_EXPERTS = 8
TOP_K = 2
D_FF_EXPERT = 3584
EXPERT_BLOCK = 128

RMS_EPS = 1e-6

kernel_name = "yoco_pool_stickbreak_moe_trunk"


def rmsnorm(x, g):
    xf = x.astype(jnp.float32)
    inv = lax.rsqrt(jnp.mean(xf * xf, axis=-1, keepdims=True) + RMS_EPS)
    return (xf * inv).astype(x.dtype) * g


def multiscale_pool(h, w_groups, scale):
    B, S, D = h.shape
    hf = h.astype(jnp.float32)
    cs = jnp.cumsum(hf, axis=1)
    t = jnp.arange(S)
    pooled = []
    for gi, w in enumerate(POOL_WINDOWS):
        sl = slice(gi * GW, (gi + 1) * GW)
        csg = cs[..., sl]
        lagged = jnp.pad(csg, ((0, 0), (w, 0), (0, 0)))[:, :S]
        count = jnp.minimum(t + 1, w).astype(jnp.float32)[None, :, None]
        pooled.append((csg - lagged) / count - hf[..., sl])
    p = jnp.stack(pooled, axis=2).astype(h.dtype)
    y = jnp.einsum('bsgc,gcd->bsgd', p, w_groups).reshape(B, S, D)
    return y * scale


def stick_breaking_attention(q, k, v):
    S = q.shape[2]
    scale = HEAD_DIM ** -0.5
    outs = []
    for i in range(S // Q_BLOCK):
        L = (i + 1) * Q_BLOCK
        qb = q[:, :, i * Q_BLOCK:L]
        kb = k[:, :, :L]
        vb = v[:, :, :L]
        z = jnp.einsum('bhqd,bhkd->bhqk', qb, kb).astype(jnp.float32) * scale
        qpos = i * Q_BLOCK + jnp.arange(Q_BLOCK)
        kpos = jnp.arange(L)
        causal = kpos[None, :] < qpos[:, None]
        log_beta = jax.nn.log_sigmoid(z)
        log_keep = jnp.where(causal, log_beta - z, 0.0)
        log_after = lax.cumsum(log_keep, axis=3, reverse=True) - log_keep
        a = jnp.where(causal, jnp.exp(log_beta + log_after), 0.0)
        outs.append(jnp.einsum('bhqk,bhkd->bhqd', a.astype(vb.dtype), vb))
    return jnp.concatenate(outs, axis=2)


def split_heads(t):
    B, S, _ = t.shape
    return t.reshape(B, S, N_HEADS, HEAD_DIM).transpose(0, 2, 1, 3)


def merge_heads(t):
    B, H, S, Dh = t.shape
    return t.transpose(0, 2, 1, 3).reshape(B, S, H * Dh)


def swiglu(h, w_in, w_out):
    g, u = jnp.split(h @ w_in, 2, axis=-1)
    return (jax.nn.silu(g) * u) @ w_out


def moe_swiglu(h, w_router, w_in, w_out):
    B, S, D = h.shape
    N = B * S
    NK = N * TOP_K
    hf = h.reshape(N, D)
    logits = hf.astype(jnp.float32) @ w_router.astype(jnp.float32)
    top_v, top_e = lax.top_k(logits, TOP_K)
    gates = jax.nn.softmax(top_v, axis=-1)
    flat_e = top_e.reshape(NK).astype(jnp.int32)
    flat_g = gates.reshape(NK).astype(h.dtype)
    flat_tok = jnp.arange(NK, dtype=jnp.int32) // TOP_K

    order = jnp.argsort(flat_e)
    sorted_e = flat_e[order]
    counts = jnp.bincount(flat_e, length=N_EXPERTS).astype(jnp.int32)
    padded = (counts + EXPERT_BLOCK - 1) // EXPERT_BLOCK * EXPERT_BLOCK
    pend = jnp.cumsum(padded)
    pstart = pend - padded
    cstart = jnp.cumsum(counts) - counts
    dest = pstart[sorted_e] + jnp.arange(NK, dtype=jnp.int32) - cstart[sorted_e]

    cap = NK + N_EXPERTS * EXPERT_BLOCK
    n_blk = cap // EXPERT_BLOCK
    tok_buf = jnp.zeros((cap,), jnp.int32).at[dest].set(flat_tok[order])
    gate_buf = jnp.zeros((cap,), h.dtype).at[dest].set(flat_g[order])
    blk_start = jnp.arange(n_blk, dtype=jnp.int32) * EXPERT_BLOCK
    blk_e = jnp.minimum(jnp.searchsorted(pend, blk_start, side='right'), N_EXPERTS - 1)

    xs = hf[tok_buf].reshape(n_blk, EXPERT_BLOCK, D)

    def expert_block(args):
        xb, e = args
        g, u = jnp.split(xb @ w_in[e], 2, axis=-1)
        return (jax.nn.silu(g) * u) @ w_out[e]

    ys = lax.map(expert_block, (xs, blk_e)).reshape(cap, D)
    y = jnp.zeros_like(hf).at[tok_buf].add(ys * gate_buf[:, None])
    return y.reshape(B, S, D)


def setup_inputs(seed: int = 0) -> dict:
    key = jax.random.key(seed)
    ks = jax.random.split(key, 16)
    f32 = jnp.float32

    def nrm(k, shape, fan_in):
        return jax.random.normal(k, shape, f32) * (fan_in ** -0.5)

    def gain(k, shape):
        return 1.0 + 0.02 * jax.random.normal(k, shape, f32)

    return {
        "x": jax.random.normal(ks[0], (BATCH, SEQ, D_MODEL), f32),
        "g_mix": gain(ks[1], (DEPTH, D_MODEL)),
        "g_ffn": gain(ks[2], (DEPTH, D_MODEL)),
        "pool_w": nrm(ks[3], (N_A, N_POOL_GROUPS, GW, GW), GW),
        "pool_scale": gain(ks[4], (N_A, D_MODEL)),
        "g_kv": gain(ks[5], (D_MODEL,)),
        "w_kv": nrm(ks[6], (D_MODEL, 2 * D_MODEL), D_MODEL),
        "w_q": nrm(ks[7], (N_B, D_MODEL, D_MODEL), D_MODEL),
        "w_o": nrm(ks[8], (N_B, D_MODEL, D_MODEL), D_MODEL),
        "ffn_in": nrm(ks[9], (N_DENSE, D_MODEL, 2 * D_FF), D_MODEL),
        "ffn_out": nrm(ks[10], (N_DENSE, D_FF, D_MODEL), D_FF),
        "w_router": nrm(ks[11], (N_MOE, D_MODEL, N_EXPERTS), D_MODEL),
        "moe_in": nrm(ks[12], (N_MOE, N_EXPERTS, D_MODEL, 2 * D_FF_EXPERT), D_MODEL),
        "moe_out": nrm(ks[13], (N_MOE, N_EXPERTS, D_FF_EXPERT, D_MODEL), D_FF_EXPERT),
        "g_final": gain(ks[14], (D_MODEL,)),
    }


def reference(x, g_mix, g_ffn, pool_w, pool_scale, g_kv, w_kv, w_q, w_o,
              ffn_in, ffn_out, w_router, moe_in, moe_out, g_final):
    k_sh = None
    v_sh = None
    for l in range(DEPTH):
        h = rmsnorm(x, g_mix[l])
        if l < N_A:
            x = x + multiscale_pool(h, pool_w[l], pool_scale[l])
        else:
            b = l - N_A
            q = split_heads(h @ w_q[b])
            o = stick_breaking_attention(q, k_sh, v_sh)
            x = x + merge_heads(o) @ w_o[b]
        h = rmsnorm(x, g_ffn[l])
        if l % 2 == 0:
            x = x + swiglu(h, ffn_in[l // 2], ffn_out[l // 2])
        else:
            x = x + moe_swiglu(h, w_router[l // 2], moe_in[l // 2], moe_out[l // 2])
        if l == N_A - 1:
            kv = rmsnorm(x, g_kv) @ w_kv
            k_part, v_part = jnp.split(kv, 2, axis=-1)
            k_sh = split_heads(k_part)
            v_sh = split_heads(v_part)
    return rmsnorm(x, g_final)
```

```cpp
#include <hip/hip_runtime.h>
#include <cstdio>
#include <cstdint>

#define LAS __attribute__((address_space(3)))
#define GAS __attribute__((address_space(1)))
typedef unsigned short bf16_t;
typedef short bf16x8 __attribute__((ext_vector_type(8)));
typedef float f32x2 __attribute__((ext_vector_type(2)));
typedef float f32x4 __attribute__((ext_vector_type(4)));
typedef float f32x16 __attribute__((ext_vector_type(16)));
typedef unsigned u32x2 __attribute__((ext_vector_type(2)));
typedef unsigned u32x4 __attribute__((ext_vector_type(4)));
typedef int i32x4 __attribute__((ext_vector_type(4)));
typedef __bf16 bf16x2_t __attribute__((ext_vector_type(2)));

constexpr int D = 1024, BATCH = 32, SEQ = 2048, M = BATCH * SEQ;
constexpr int DFF = 2816, DFFE = 3584, NE = 8, NH = 16;
constexpr int CAP = 2 * M + NE * 256;
constexpr int CHUNK_BLKS = 260;
constexpr float RMS_EPS = 1e-6f;
#ifndef FP8_MASK
#define FP8_MASK 14
#endif
#ifndef INT8_UP0
#define INT8_UP0 1
#endif
#ifndef INT8_PROJ
#define INT8_PROJ 1
#endif
constexpr float W8_UP = 64.f, W8_DN = 128.f, H8_SC = 8.f;
constexpr int NWAVES = 8, NTHREADS = 512;

constexpr size_t MiB = 1u << 20;
constexpr size_t WS_CTL = 0, CTL_ZERO_BYTES = 80 * 1024;
constexpr size_t WS_COLMAX2 = 65536;
constexpr size_t WS_WSCALE2 = 1 * MiB + 40960;
constexpr size_t WS_COLMAX = 32768;
constexpr size_t WS_WSCALE = 1 * MiB + 16384;
constexpr size_t WS_ASCALE = 3 * MiB + 786432;
constexpr size_t WS_TILECNT = 1 * MiB;
constexpr size_t WS_ROUTE_E = 1 * MiB + 65536;
constexpr size_t WS_ROUTE_G = 2 * MiB;
constexpr size_t WS_SLOT_OF = 2 * MiB + 524288;
constexpr size_t WS_GATE_SLOT = 3 * MiB;
constexpr size_t WS_WPOOL = 4 * MiB;
constexpr size_t WS_WK = 5 * MiB, WS_WV = 7 * MiB, WS_WQ = 9 * MiB, WS_WO = 13 * MiB;
constexpr size_t WS_WFI = 17 * MiB;
constexpr size_t WS_WFO = 39 * MiB;
constexpr size_t WS_WMI = 50 * MiB;
constexpr size_t WS_WMO = 274 * MiB;
constexpr size_t WS_XN = 386 * MiB;
constexpr size_t WS_K = 514 * MiB, WS_VT = 642 * MiB;
constexpr size_t WS_XS = 770 * MiB;
constexpr size_t WS_R = 1030 * MiB;
constexpr size_t WS_XS8 = 1485 * MiB;
constexpr size_t WS_DELTA = 1616 * MiB;
constexpr size_t WS_END = 1744 * MiB;
static_assert(WS_XS8 + (size_t)CAP * D <= WS_END, "xs8");
static_assert(WS_XS + (size_t)CAP * D * 2 <= WS_R, "xs");
static_assert(WS_R + (size_t)CHUNK_BLKS * 256 * DFFE * 2 <= WS_END, "moe hidden chunk");
static_assert(WS_R + (size_t)M * DFF * 2 <= WS_END, "dense hidden");
static_assert(WS_R + (size_t)CAP * DFFE <= WS_XS8, "fp8 moe hidden, one chunk");
static_assert(WS_WMO + (size_t)2 * 8 * 1024 * 3584 * 2 <= WS_XN, "weights");

constexpr int STAGE_BYTES_LDS = 131072;
constexpr int LCTL_OFF = STAGE_BYTES_LDS;
constexpr int LDS_BYTES = 147456;

__device__ __forceinline__ unsigned cvtpk(float lo, float hi) { f32x2 v = {lo, hi}; bf16x2_t b = __builtin_convertvector(v, bf16x2_t); return __builtin_bit_cast(unsigned, b); }
__device__ __forceinline__ unsigned pk4_fp8(float a, float b, float c, float d) { int w = __builtin_amdgcn_cvt_pk_fp8_f32(a, b, 0, false); w = __builtin_amdgcn_cvt_pk_fp8_f32(c, d, w, true); return (unsigned)w; }
__device__ __forceinline__ unsigned pk4_i8(float a, float b, float c, float d) {
    const int i0 = (int)__builtin_rintf(__builtin_amdgcn_fmed3f(a, -127.f, 127.f)), i1 = (int)__builtin_rintf(__builtin_amdgcn_fmed3f(b, -127.f, 127.f));
    const int i2 = (int)__builtin_rintf(__builtin_amdgcn_fmed3f(c, -127.f, 127.f)), i3 = (int)__builtin_rintf(__builtin_amdgcn_fmed3f(d, -127.f, 127.f));
    return (unsigned)(i0 & 255) | ((unsigned)(i1 & 255) << 8) | ((unsigned)(i2 & 255) << 16) | ((unsigned)i3 << 24); }
__device__ __forceinline__ float wave_max(float v) {
#pragma unroll
    for (int o = 1; o < 64; o <<= 1) v = fmaxf(v, __shfl_xor(v, o));
    return v;
}
__device__ __forceinline__ float bf_lo(unsigned w) { return __builtin_bit_cast(float, w << 16); }
__device__ __forceinline__ float bf_hi(unsigned w) { return __builtin_bit_cast(float, w & 0xffff0000u); }
__device__ __forceinline__ float wave_sum(float v) {
#pragma unroll
    for (int o = 1; o < 64; o <<= 1) v += __shfl_xor(v, o);
    return v;
}
#define LDS_WAIT() asm volatile("s_waitcnt lgkmcnt(0)" ::: "memory")
__device__ __forceinline__ int fresh_tid(int wave_s) { int w = wave_s, z = 0; asm volatile("" : "+s"(w), "+s"(z)); return w * 64 + (int)__builtin_amdgcn_mbcnt_hi(~0u, __builtin_amdgcn_mbcnt_lo(~0u, (unsigned)z)); }
#define RLX_AGENT __ATOMIC_RELAXED, __HIP_MEMORY_SCOPE_AGENT

#define XB_TMO      128
#define XB_XCNT(j)  (256  + 64 * (j))
#define XB_XSUB(j)  (1280 + 64 * (j))
#define XB_XGEN(j)  (2304 + 64 * (j))
#define XB_TOP      3328
#define XB_TOPGEN   3392
#define XCD_BAR_WORDS 3456
#define XB_SPIN_CAP (1u << 22)
__device__ __forceinline__ unsigned xb_ld(unsigned* p)              { return __hip_atomic_load(p, __ATOMIC_RELAXED, __HIP_MEMORY_SCOPE_AGENT); }
__device__ __forceinline__ unsigned xb_add(unsigned* p, unsigned v) { return __hip_atomic_fetch_add(p, v, __ATOMIC_RELAXED, __HIP_MEMORY_SCOPE_AGENT); }
__device__ __forceinline__ unsigned xb_xcc_id() { return (unsigned)__builtin_amdgcn_s_getreg((3 << 11) | 20) & 0xFu; }
#define XB_SPIN(cond, bar) do { unsigned _sp = 0; while (cond) { __builtin_amdgcn_s_sleep(1); \
    if ((++_sp & 255u) == 0u) { if (xb_ld(&(bar)[XB_TMO])) break; if (_sp > XB_SPIN_CAP) { atomicAdd(&(bar)[XB_TMO], 1u); break; } } } } while (0)
struct XcdBarrier { unsigned* bar; unsigned x; volatile LAS unsigned* st; };
__device__ __forceinline__ XcdBarrier xcd_barrier_post(unsigned* bar, volatile LAS unsigned* st) {
    XcdBarrier b; b.bar = bar; b.x = xb_xcc_id(); b.st = st;
    if (threadIdx.x == 0) (void)xb_add(&bar[XB_XCNT(b.x)], 1u);
    return b;
}
__device__ __forceinline__ void xcd_barrier_complete(unsigned* bar, unsigned x, unsigned& nloc, unsigned& nx) {
    const unsigned G = gridDim.x * gridDim.y * gridDim.z;
    unsigned sum, cnt, mine, sp = 0u;
    for (;;) {
        sum = 0u; cnt = 0u; mine = 0u;
#pragma unroll
        for (unsigned j = 0; j < 16; ++j) { const unsigned c = xb_ld(&bar[XB_XCNT(j)]); sum += c; cnt += (c > 0u) ? 1u : 0u; mine = (j == x) ? c : mine; }
        if (sum == G) break;
        __builtin_amdgcn_s_sleep(1);
        if ((++sp & 255u) == 0u) { if (xb_ld(&bar[XB_TMO])) break; if (sp > XB_SPIN_CAP) { atomicAdd(&bar[XB_TMO], 1u); break; } }
    }
    nloc = mine > 0u ? mine : 1u; nx = cnt > 0u ? cnt : 1u;
}
__device__ __forceinline__ void xcd_barrier(const XcdBarrier& b, int wave_s) {
    asm volatile("s_waitcnt vmcnt(0)" ::: "memory");
    __syncthreads();
    if (fresh_tid(wave_s) == 0) {
        unsigned* bar = b.bar;
        __builtin_amdgcn_s_waitcnt(0);
        unsigned nloc = b.st[0], nx = b.st[1];
        if (nloc == 0u) { xcd_barrier_complete(bar, b.x, nloc, nx); b.st[0] = nloc; b.st[1] = nx; }
        const unsigned old = xb_add(&bar[XB_XSUB(b.x)], 1u);
        const unsigned gen = old / nloc;
        if (old + 1u == (gen + 1u) * nloc) {
            __builtin_amdgcn_fence(__ATOMIC_RELEASE, "agent");
            asm volatile("s_waitcnt vmcnt(0)" ::: "memory");
            const unsigned og = xb_add(&bar[XB_TOP], 1u);
            const unsigned tg = og / nx;
            if (og + 1u == (tg + 1u) * nx) xb_add(&bar[XB_TOPGEN], 1u);
            else XB_SPIN(xb_ld(&bar[XB_TOPGEN]) == tg, bar);
            __builtin_amdgcn_fence(__ATOMIC_ACQUIRE, "agent");
            xb_add(&bar[XB_XGEN(b.x)], 1u);
            asm volatile("s_waitcnt vmcnt(0)" ::: "memory");
        } else {
            XB_SPIN(xb_ld(&bar[XB_XGEN(b.x)]) == gen, bar);
            __builtin_amdgcn_fence(__ATOMIC_ACQUIRE, "agent");
            asm volatile("s_waitcnt vmcnt(0)" ::: "memory");
        }
    }
    __syncthreads();
}

namespace pg8 {
constexpr int BM = 256, BK = 64, HALF = 128, HTB = HALF * BK * 2, NXCD = 8, WGM = 8;
__host__ __device__ __forceinline__ int lds_byte(int r, int c) { const int st = (r >> 4) * 2 + (c >> 5), rr = r & 15, cc = c & 31, ob = rr * 64 + cc * 2; return st * 1024 + (ob ^ (((ob >> 9) & 1) << 5)); }
__host__ __device__ __forceinline__ void stage_rc(int b, int& R, int& C) { const int st = b / 1024, sb = b % 1024, swz = sb ^ (((sb >> 9) & 1) << 5); R = (st >> 1) * 16 + swz / 64; C = (st & 1) * 32 + (swz % 64) / 2; }
__host__ __device__ __forceinline__ int perm32(int rho) { const int n = rho >> 4, i = rho & 15; return 8 * (i >> 2) + 4 * n + (i & 3); }

typedef int i32x8 __attribute__((ext_vector_type(8)));
__device__ __forceinline__ i32x8 cat8(bf16x8 lo, bf16x8 hi) { const i32x4 a = __builtin_bit_cast(i32x4, lo), b = __builtin_bit_cast(i32x4, hi); return __builtin_shufflevector(a, b, 0, 1, 2, 3, 4, 5, 6, 7); }
struct Unit { const char* A; const char* B; int pm, pn, aux; };
struct GemmK { int K, lda, ldb; };

__device__ __forceinline__ bool smap(long L, int nM, int nN, int& pm, int& pn) {
    const int nwg = nM * nN; if (L >= nwg) return false;
    int wgid = (int)L; { const int q = nwg / NXCD, r = nwg % NXCD, xcd = wgid % NXCD, off = wgid / NXCD; wgid = (xcd < r ? xcd * (q + 1) : r * (q + 1) + (xcd - r) * q) + off; }
    const int nig = WGM * nN, gid = wgid / nig, fm = gid * WGM, gsz = (nM - fm) < WGM ? (nM - fm) : WGM;
    pm = fm + ((wgid % nig) % gsz); pn = (wgid % nig) / gsz; return true;
}

template <class Epi, class Sched, bool ALIGN_EPI, int MODE = 0, bool GATHER = false>
__device__ __forceinline__ void gemm_phase(LAS unsigned char* lds, const GemmK g, const Sched& S, const Epi& E, int wave_s) {
    const int tid = fresh_tid(wave_s);
    const int wid = __builtin_amdgcn_readfirstlane(tid >> 6), lane = tid & 63, wr = wid >> 2, wc = wid & 3, fr = lane & 15, fq = lane >> 4;
    constexpr bool FP8 = (MODE == 1);
    const int K = g.K, nt = K / BK;
    unsigned voffA[2], voffB[2];
#pragma unroll
    for (int i = 0; i < 2; ++i) { int R, C; stage_rc(tid * 16 + i * 8192, R, C); const int Rb = Epi::PERM ? ((R & ~31) + perm32(R & 31)) : R;
        voffA[i] = (unsigned)(R * g.lda + C) * 2u; voffB[i] = (unsigned)(Rb * g.ldb + C) * 2u; }
    unsigned vG[2][2], vN[2][2];
    const size_t kstep = (size_t)(BK * 2);
    const size_t hstepA = (size_t)HALF * g.lda * 2, hstepB = (size_t)HALF * g.ldb * 2;
    const unsigned ldsw = (unsigned)wid * 1024u;
    const int aoff = lds_byte(wr * 64 + fr, fq * 8), boff = lds_byte(wc * 32 + fr, fq * 8);
#define PG8_SA(b, h) (((b) * 2 + (h)) * HTB)
#define PG8_SB(b, h) ((4 + (b) * 2 + (h)) * HTB)
#define PG8_STAGE(bufoff, gbase, voff) do { _Pragma("unroll") for (int _i = 0; _i < 2; ++_i) \
        __builtin_amdgcn_global_load_lds((const unsigned*)((const char*)(gbase) + (voff)[_i]), (LAS unsigned*)(lds + (bufoff) + ldsw + _i * 8192), 16, 0, 0); } while (0)
#define PG8_STAGE_A(bufoff, gbase, h, nx) do { if constexpr (GATHER) { unsigned _v[2] = { (nx) ? vN[h][0] : vG[h][0], (nx) ? vN[h][1] : vG[h][1] }; PG8_STAGE(bufoff, gbase, _v); } \
        else PG8_STAGE(bufoff, (gbase) + (h) * hstepA, voffA); } while (0)
#define PG8_LD8(p) __builtin_shufflevector(*(const LAS i32x4*)(p), *(const LAS i32x4*)((p) + 1024), 0, 1, 2, 3, 4, 5, 6, 7)
#define PG8_LDA(dst, b, h) do { if constexpr (FP8) { _Pragma("unroll") for (int m = 0; m < 4; ++m) dst##8[m] = PG8_LD8(lds + PG8_SA(b, h) + aoff + m * 2048); } \
        else { _Pragma("unroll") for (int m = 0; m < 4; ++m) _Pragma("unroll") for (int k = 0; k < 2; ++k) dst[m][k] = *(const LAS bf16x8*)(lds + PG8_SA(b, h) + aoff + m * 2048 + k * 1024); } } while (0)
#define PG8_LDB(dst, b, h) do { if constexpr (FP8) { _Pragma("unroll") for (int n = 0; n < 2; ++n) dst##8[n] = PG8_LD8(lds + PG8_SB(b, h) + boff + n * 2048); } \
        else { _Pragma("unroll") for (int n = 0; n < 2; ++n) _Pragma("unroll") for (int k = 0; k < 2; ++k) dst[n][k] = *(const LAS bf16x8*)(lds + PG8_SB(b, h) + boff + n * 2048 + k * 1024); } } while (0)
#define PG8_MMA(ai, bj, At, Bt) do { __builtin_amdgcn_s_setprio(1); _Pragma("unroll") for (int m = 0; m < 4; ++m) _Pragma("unroll") for (int n = 0; n < 2; ++n) { \
        if constexpr (FP8) asm volatile("v_mfma_f32_16x16x128_f8f6f4 %0, %1, %2, %0" : "+v"(acc[ai][bj][m][n]) : "v"(Bt##8[n]), "v"(At##8[m])); \
        else if constexpr (MODE == 2) { _Pragma("unroll") for (int k = 0; k < 2; ++k) acc[ai][bj][m][n] = __builtin_bit_cast(f32x4, __builtin_amdgcn_mfma_i32_16x16x64_i8(__builtin_bit_cast(i32x4, Bt[n][k]), __builtin_bit_cast(i32x4, At[m][k]), __builtin_bit_cast(i32x4, acc[ai][bj][m][n]), 0, 0, 0)); } \
        else { _Pragma("unroll") for (int k = 0; k < 2; ++k) acc[ai][bj][m][n] = __builtin_amdgcn_mfma_f32_16x16x32_bf16(Bt[n][k], At[m][k], acc[ai][bj][m][n], 0, 0, 0); } } \
        __builtin_amdgcn_s_setprio(0); } while (0)
#define PG8_WAIT_V(n) asm volatile("s_waitcnt vmcnt(" #n ")" ::: "memory")
#define PG8_WAIT_L(n) asm volatile("s_waitcnt lgkmcnt(" #n ")" ::: "memory")
#define PG8_BAR __builtin_amdgcn_s_barrier()
#define PG8_SCHED __builtin_amdgcn_sched_barrier(0)
    Unit cur, nxt; int ui = 0;
    if (!S.next(0, cur)) return;
    f32x4 acc[2][2][4][2];
#pragma unroll
    for (int a = 0; a < 2; ++a)
#pragma unroll
        for (int b = 0; b < 2; ++b)
#pragma unroll
            for (int m = 0; m < 4; ++m)
#pragma unroll
                for (int n = 0; n < 2; ++n) acc[a][b][m][n] = (f32x4){0.f, 0.f, 0.f, 0.f};
    bf16x8 At[4][2], B0[2][2], B1[2][2]; i32x8 At8[4], B08[2], B18[2];
    const char* cA = cur.A; const char* cB = cur.B;
    if constexpr (GATHER) {
#pragma unroll
        for (int i = 0; i < 2; ++i) { int R, C; stage_rc(tid * 16 + i * 8192, R, C);
#pragma unroll
            for (int h = 0; h < 2; ++h) { vG[h][i] = (unsigned)S.tos[(size_t)cur.aux * 256 + h * HALF + R] * (unsigned)(g.lda * 2) + (unsigned)C * 2u; vN[h][i] = vG[h][i]; } } }
    PG8_STAGE(PG8_SB(0, 0), cB, voffB); PG8_STAGE(PG8_SB(0, 1), cB + hstepB, voffB); PG8_STAGE_A(PG8_SA(0, 0), cA, 0, false); PG8_STAGE_A(PG8_SA(0, 1), cA, 1, false);
    if (wr == 1) PG8_BAR;
    PG8_WAIT_V(2); PG8_BAR;
    PG8_STAGE(PG8_SB(1, 0), cB + kstep, voffB); PG8_STAGE_A(PG8_SA(1, 0), cA + kstep, 0, false); PG8_STAGE(PG8_SB(1, 1), cB + hstepB + kstep, voffB);
    PG8_WAIT_V(6); PG8_BAR;
    for (;;) {
        const bool has_next = S.next(ui + 1, nxt);
        const char* nA = has_next ? nxt.A : cA; const char* nB = has_next ? nxt.B : cB;
        if constexpr (GATHER) { if (has_next && wid < 4) __builtin_amdgcn_global_load_lds((const unsigned*)(S.tos + (size_t)nxt.aux * 256 + wid * 64 + lane), (LAS unsigned*)(S.idxl + ((ui + 1) & 1) * 256 + wid * 64), 4, 0, 0); }
        for (int t = 0; t < nt; t += 2) {
            const bool last = (t == nt - 2);
            const char* a1 = cA + (size_t)(t + 1) * kstep;
            const char* a2 = last ? nA : cA + (size_t)(t + 2) * kstep; const char* b2 = last ? nB : cB + (size_t)(t + 2) * kstep;
            const char* a3 = a2 + kstep; const char* b3 = b2 + kstep;
            if constexpr (GATHER) { if (last) {
                    const LAS int* ib = S.idxl + ((ui + 1) & 1) * 256;
#pragma unroll
                    for (int i = 0; i < 2; ++i) { int R, C; stage_rc(tid * 16 + i * 8192, R, C);
#pragma unroll
                        for (int h = 0; h < 2; ++h) vN[h][i] = has_next ? (unsigned)ib[h * HALF + R] * (unsigned)(g.lda * 2) + (unsigned)C * 2u : vG[h][i]; } } }
            PG8_LDB(B0, 0, 0); PG8_LDB(B1, 0, 1); PG8_SCHED; PG8_LDA(At, 0, 0); PG8_STAGE_A(PG8_SA(1, 1), a1, 1, false);
            PG8_WAIT_V(8); PG8_WAIT_L(0); PG8_BAR; PG8_MMA(0, 0, At, B0); PG8_MMA(0, 1, At, B1); PG8_BAR; PG8_SCHED;
            PG8_LDA(At, 0, 1); PG8_STAGE(PG8_SB(0, 0), b2, voffB); PG8_STAGE(PG8_SB(0, 1), b2 + hstepB, voffB); PG8_STAGE_A(PG8_SA(0, 0), a2, 0, last);
            PG8_WAIT_V(8); PG8_WAIT_L(0); PG8_BAR; PG8_MMA(1, 0, At, B0); PG8_MMA(1, 1, At, B1); PG8_BAR; PG8_SCHED;
            PG8_LDB(B0, 1, 0); PG8_LDB(B1, 1, 1); PG8_SCHED; PG8_LDA(At, 1, 0); PG8_STAGE_A(PG8_SA(0, 1), a2, 1, last);
            PG8_WAIT_V(8); PG8_WAIT_L(0); PG8_BAR; PG8_MMA(0, 0, At, B0); PG8_MMA(0, 1, At, B1); PG8_BAR; PG8_SCHED;
            PG8_LDA(At, 1, 1); PG8_STAGE(PG8_SB(1, 0), b3, voffB); PG8_STAGE(PG8_SB(1, 1), b3 + hstepB, voffB); PG8_STAGE_A(PG8_SA(1, 0), a3, 0, last);
            PG8_WAIT_V(8); PG8_WAIT_L(0); PG8_BAR; PG8_MMA(1, 0, At, B0); PG8_MMA(1, 1, At, B1); PG8_BAR; PG8_SCHED;
        }
        if constexpr (ALIGN_EPI) { if (wr == 0) PG8_BAR; }
        if constexpr (FP8) asm volatile("s_nop 15\n\ts_nop 15" ::: "memory");
        E(acc, cur, wr, wc, fr, fq);
        if (!has_next) break;
#pragma unroll
        for (int a = 0; a < 2; ++a)
#pragma unroll
            for (int b = 0; b < 2; ++b)
#pragma unroll
                for (int m = 0; m < 4; ++m)
#pragma unroll
                    for (int n = 0; n < 2; ++n) acc[a][b][m][n] = (f32x4){0.f, 0.f, 0.f, 0.f};
        cur = nxt; cA = nA; cB = nB; ++ui;
        if constexpr (GATHER) {
#pragma unroll
            for (int h = 0; h < 2; ++h) { vG[h][0] = vN[h][0]; vG[h][1] = vN[h][1]; } }
        if constexpr (ALIGN_EPI) { if (wr == 1) PG8_BAR; }
    }
    PG8_WAIT_V(0);
    if constexpr (!ALIGN_EPI) { if (wr == 0) PG8_BAR; }
    PG8_BAR;
#undef PG8_SA
#undef PG8_SB
#undef PG8_STAGE
#undef PG8_STAGE_A
#undef PG8_LDA
#undef PG8_LDB
#undef PG8_MMA
#undef PG8_WAIT_V
#undef PG8_WAIT_L
#undef PG8_BAR
#undef PG8_SCHED
}

struct DenseOrder {
    int nM, nN, G, c; const char* A; const char* B; size_t at, bt;
    __device__ __forceinline__ bool next(int i, Unit& u) const { int pm, pn; if (!smap((long)i * G + c, nM, nN, pm, pn)) return false;
        u.A = A + (size_t)pm * at; u.B = B + (size_t)pn * bt; u.pm = pm; u.pn = pn; u.aux = 0; return true; }
};
struct PoolOrder {
    int G, c; const char* P; const char* W;
    __device__ __forceinline__ bool next(int i, Unit& u) const { int pm, pn; if (!smap((long)i * G + c, M / 256, 4, pm, pn)) return false;
        u.A = P + (size_t)pm * (256 * 1024 * 2) + (size_t)pn * 512; u.B = W + (size_t)pn * (256 * 256 * 2); u.pm = pm; u.pn = pn; u.aux = 0; return true; }
};
struct ProjOrder {
    int njobs, G, c; const char* ws; size_t qoff, tb;
    __device__ __forceinline__ bool next(int i, Unit& u) const {
        const long L = (long)i * G + c; if (L >= (long)njobs * 1024) return false;
        const int job = (int)(L >> 10), l = (int)(L & 1023); const int kind = (njobs == 1) ? 1 : job;
        const size_t woff = WS_WK + (size_t)(kind == 1) * (WS_WQ + qoff - WS_WK) + (size_t)(kind == 2) * (WS_WV - WS_WK);
        int pm, pn;
        if (kind == 2) { smap(l, 4, 256, pm, pn); u.A = ws + woff + (size_t)pm * tb; u.B = ws + WS_XN + (size_t)pn * tb; }
        else { smap(l, 256, 4, pm, pn); u.A = ws + WS_XN + (size_t)pm * tb; u.B = ws + woff + (size_t)pn * tb; }
        u.pm = pm; u.pn = pn; u.aux = kind; return true; }
};
struct MoeOrder {
    int nM, nN, G, c, blk0, a_rel; const char* A; const char* B; size_t at, bt, be; const LAS int* pend;
    __device__ __forceinline__ bool next(int i, Unit& u) const { int pm, pn; if (!smap((long)i * G + c, nM, nN, pm, pn)) return false;
        const int b = blk0 + pm; int e = 0;
#pragma unroll
        for (int j = 0; j < 7; ++j) e += (b >= pend[j]) ? 1 : 0;
        e = __builtin_amdgcn_readfirstlane(e);
        u.A = A + (size_t)(a_rel ? pm : b) * at; u.B = B + (size_t)e * be + (size_t)pn * bt; u.pm = a_rel ? b : pm; u.pn = pn; u.aux = 0; return true; }
};

struct MoeGatherOrder {
    int nM, nN, G, c, blk0; const char* A; const char* B; size_t bt, be; const LAS int* pend; const int* tos; LAS int* idxl;
    __device__ __forceinline__ bool next(int i, Unit& u) const { int pm, pn; if (!smap((long)i * G + c, nM, nN, pm, pn)) return false;
        const int b = blk0 + pm; int e = 0;
#pragma unroll
        for (int j = 0; j < 7; ++j) e += (b >= pend[j]) ? 1 : 0;
        e = __builtin_amdgcn_readfirstlane(e);
        u.A = A; u.B = B + (size_t)e * be + (size_t)pn * bt; u.pm = pm; u.pn = pn; u.aux = b; return true; }
};
struct EpiPool {
    static constexpr bool PERM = false;
    const float* xin; float* out; const float* scale; float mul;
    __device__ __forceinline__ void operator()(const f32x4 (&acc)[2][2][4][2], const Unit& u, int wr, int wc, int fr, int fq) const {
        const int row0 = u.pm * BM + wr * 64 + fr, col0 = u.pn * BM + wc * 32 + 4 * fq;
        f32x4 sv[2][2];
#pragma unroll
        for (int bj = 0; bj < 2; ++bj)
#pragma unroll
            for (int n = 0; n < 2; ++n) sv[bj][n] = *(const f32x4*)(scale + col0 + bj * HALF + n * 16) * mul;
#pragma unroll
        for (int ai = 0; ai < 2; ++ai)
#pragma unroll
            for (int m = 0; m < 4; ++m) { const size_t off = (size_t)(row0 + ai * HALF + m * 16) * D + col0;
#pragma unroll
                for (int bj = 0; bj < 2; ++bj)
#pragma unroll
                    for (int n = 0; n < 2; ++n) { const f32x4 xv = *(const f32x4*)(xin + off + bj * HALF + n * 16); *(f32x4*)(out + off + bj * HALF + n * 16) = xv + sv[bj][n] * acc[ai][bj][m][n]; }
                asm volatile("" ::: "memory"); }
    }
};
struct EpiDelta {
    static constexpr bool PERM = true;
    bf16_t* DL; const float* scale;
    __device__ __forceinline__ void operator()(const f32x4 (&acc)[2][2][4][2], const Unit& u, int wr, int wc, int fr, int fq) const {
        const int row0 = u.pm * BM + wr * 64 + fr, col0 = u.pn * BM + wc * 32 + 8 * fq;
        f32x4 sv[2][2];
#pragma unroll
        for (int bj = 0; bj < 2; ++bj) { sv[bj][0] = scale ? *(const f32x4*)(scale + col0 + bj * HALF) : (f32x4){1.f, 1.f, 1.f, 1.f}; sv[bj][1] = scale ? *(const f32x4*)(scale + col0 + bj * HALF + 4) : (f32x4){1.f, 1.f, 1.f, 1.f}; }
#pragma unroll
        for (int ai = 0; ai < 2; ++ai)
#pragma unroll
            for (int m = 0; m < 4; ++m) { bf16_t* rowp = DL + (size_t)(row0 + ai * HALF + m * 16) * D + col0;
#pragma unroll
                for (int bj = 0; bj < 2; ++bj) { const f32x4 v0 = acc[ai][bj][m][0] * sv[bj][0], v1 = acc[ai][bj][m][1] * sv[bj][1];
                    u32x4 w; w.x = cvtpk(v0[0], v0[1]); w.y = cvtpk(v0[2], v0[3]); w.z = cvtpk(v1[0], v1[1]); w.w = cvtpk(v1[2], v1[3]);
                    *(u32x4*)(rowp + bj * HALF) = w; } }
    }
};
struct EpiResidD {
    static constexpr bool PERM = true;
    const float* xsrc; float* out; const bf16_t* DL; float mul;
    __device__ __forceinline__ void operator()(const f32x4 (&acc)[2][2][4][2], const Unit& u, int wr, int wc, int fr, int fq) const {
        const int row0 = u.pm * BM + wr * 64 + fr, col0 = u.pn * BM + wc * 32 + 8 * fq;
#pragma unroll
        for (int ai = 0; ai < 2; ++ai)
#pragma unroll
            for (int m = 0; m < 4; ++m) { const size_t off0 = (size_t)(row0 + ai * HALF + m * 16) * D + col0;
#pragma unroll
                for (int bj = 0; bj < 2; ++bj) { const size_t off = off0 + bj * HALF; const f32x4 x0 = *(const f32x4*)(xsrc + off), x1 = *(const f32x4*)(xsrc + off + 4); const u32x4 d = *(const u32x4*)(DL + off);
                    const f32x4 d0 = {bf_lo(d.x), bf_hi(d.x), bf_lo(d.y), bf_hi(d.y)}, d1 = {bf_lo(d.z), bf_hi(d.z), bf_lo(d.w), bf_hi(d.w)};
                    *(f32x4*)(out + off) = x0 + d0 + acc[ai][bj][m][0] * mul; *(f32x4*)(out + off + 4) = x1 + d1 + acc[ai][bj][m][1] * mul; }
                asm volatile("" ::: "memory"); }
    }
};
struct EpiResid {
    static constexpr bool PERM = false;
    float* x; float mul;
    __device__ __forceinline__ void operator()(const f32x4 (&acc)[2][2][4][2], const Unit& u, int wr, int wc, int fr, int fq) const {
        const int row0 = u.pm * BM + wr * 64 + fr, col0 = u.pn * BM + wc * 32 + 4 * fq;
#pragma unroll
        for (int ai = 0; ai < 2; ++ai)
#pragma unroll
            for (int m = 0; m < 4; ++m) { float* p = x + (size_t)(row0 + ai * HALF + m * 16) * D + col0;
#pragma unroll
                for (int bj = 0; bj < 2; ++bj)
#pragma unroll
                    for (int n = 0; n < 2; ++n) { const f32x4 xv = *(const f32x4*)(p + bj * HALF + n * 16); *(f32x4*)(p + bj * HALF + n * 16) = xv + acc[ai][bj][m][n] * mul; }
                asm volatile("" ::: "memory"); }
    }
};
__device__ __forceinline__ f32x2 swiglu2(f32x2 g, f32x2 u, float c1  , float kinv  ) {
    const f32x2 t = g * c1; f32x2 e; e.x = __builtin_amdgcn_exp2f(t.x); e.y = __builtin_amdgcn_exp2f(t.y);
    const f32x2 d = e * kinv + kinv; f32x2 r; r.x = __builtin_amdgcn_rcpf(d.x); r.y = __builtin_amdgcn_rcpf(d.y);
    return (g * u) * r;
}
__device__ __forceinline__ float silu_mul(float g, float u) { return g * u * __builtin_amdgcn_rcpf(1.0f + __builtin_amdgcn_exp2f(-1.4426950408889634f * g)); }
struct EpiSwiglu {
    static constexpr bool PERM = true;
    bf16_t* H; int ldc;
    __device__ __forceinline__ void operator()(const f32x4 (&acc)[2][2][4][2], const Unit& u, int wr, int wc, int fr, int fq) const {
        const int row0 = u.pm * BM + wr * 64 + fr, col0 = u.pn * HALF + wc * 32 + 8 * fq;
#pragma unroll
        for (int ai = 0; ai < 2; ++ai)
#pragma unroll
            for (int m = 0; m < 4; ++m) { bf16_t* rowp = H + (size_t)(row0 + ai * HALF + m * 16) * ldc + col0;
                const f32x4 g0 = acc[ai][0][m][0], g1 = acc[ai][0][m][1], u0 = acc[ai][1][m][0], u1 = acc[ai][1][m][1];
                const f32x2 h0 = swiglu2((f32x2){g0[0], g0[1]}, (f32x2){u0[0], u0[1]}, -1.4426950408889634f, 1.0f), h1 = swiglu2((f32x2){g0[2], g0[3]}, (f32x2){u0[2], u0[3]}, -1.4426950408889634f, 1.0f);
                const f32x2 h2 = swiglu2((f32x2){g1[0], g1[1]}, (f32x2){u1[0], u1[1]}, -1.4426950408889634f, 1.0f), h3 = swiglu2((f32x2){g1[2], g1[3]}, (f32x2){u1[2], u1[3]}, -1.4426950408889634f, 1.0f);
                u32x4 w; w.x = cvtpk(h0.x, h0.y); w.y = cvtpk(h1.x, h1.y); w.z = cvtpk(h2.x, h2.y); w.w = cvtpk(h3.x, h3.y);
                *(u32x4*)rowp = w; }
    }
};
struct EpiSwigluI8 {
    static constexpr bool PERM = true;
    bf16_t* H; int ldc; const float* ascale; const float* wscale;
    __device__ __forceinline__ void operator()(const f32x4 (&acc)[2][2][4][2], const Unit& u, int wr, int wc, int fr, int fq) const {
        const int row0 = u.pm * BM + wr * 64 + fr, col0 = u.pn * HALF + wc * 32 + 8 * fq;
        const float* wsp = wscale + u.pn * BM + wc * 32 + 8 * fq;
        const f32x4 sg0 = *(const f32x4*)wsp, sg1 = *(const f32x4*)(wsp + 4), su0 = *(const f32x4*)(wsp + HALF), su1 = *(const f32x4*)(wsp + HALF + 4);
#pragma unroll
        for (int ai = 0; ai < 2; ++ai)
#pragma unroll
            for (int m = 0; m < 4; ++m) { const int row = row0 + ai * HALF + m * 16; bf16_t* rowp = H + (size_t)row * ldc + col0; const float sa = ascale[row];
                const i32x4 ig0 = __builtin_bit_cast(i32x4, acc[ai][0][m][0]), ig1 = __builtin_bit_cast(i32x4, acc[ai][0][m][1]), iu0 = __builtin_bit_cast(i32x4, acc[ai][1][m][0]), iu1 = __builtin_bit_cast(i32x4, acc[ai][1][m][1]);
                const f32x4 g0 = __builtin_convertvector(ig0, f32x4) * (sg0 * sa), g1 = __builtin_convertvector(ig1, f32x4) * (sg1 * sa), u0 = __builtin_convertvector(iu0, f32x4) * (su0 * sa), u1 = __builtin_convertvector(iu1, f32x4) * (su1 * sa);
                const f32x2 h0 = swiglu2((f32x2){g0[0], g0[1]}, (f32x2){u0[0], u0[1]}, -1.4426950408889634f, 1.0f), h1 = swiglu2((f32x2){g0[2], g0[3]}, (f32x2){u0[2], u0[3]}, -1.4426950408889634f, 1.0f);
                const f32x2 h2 = swiglu2((f32x2){g1[0], g1[1]}, (f32x2){u1[0], u1[1]}, -1.4426950408889634f, 1.0f), h3 = swiglu2((f32x2){g1[2], g1[3]}, (f32x2){u1[2], u1[3]}, -1.4426950408889634f, 1.0f);
                u32x4 w; w.x = cvtpk(h0.x, h0.y); w.y = cvtpk(h1.x, h1.y); w.z = cvtpk(h2.x, h2.y); w.w = cvtpk(h3.x, h3.y);
                *(u32x4*)rowp = w; }
    }
};
struct EpiSwiglu8 {
    static constexpr bool PERM = true;
    unsigned char* H; int ldc; float gsc;
    __device__ __forceinline__ void operator()(const f32x4 (&acc)[2][2][4][2], const Unit& u, int wr, int wc, int fr, int fq) const {
        const int row0 = u.pm * BM + wr * 64 + fr, col0 = u.pn * HALF + wc * 32 + 8 * fq;
#pragma unroll
        for (int ai = 0; ai < 2; ++ai)
#pragma unroll
            for (int m = 0; m < 4; ++m) { unsigned char* rowp = H + (size_t)(row0 + ai * HALF + m * 16) * ldc + col0;
                const f32x4 g0 = acc[ai][0][m][0], g1 = acc[ai][0][m][1], u0 = acc[ai][1][m][0], u1 = acc[ai][1][m][1];
                const float c1 = -1.4426950408889634f * gsc, kinv = 1.0f / (gsc * gsc * H8_SC);
                const f32x2 h0 = swiglu2((f32x2){g0[0], g0[1]}, (f32x2){u0[0], u0[1]}, c1, kinv), h1 = swiglu2((f32x2){g0[2], g0[3]}, (f32x2){u0[2], u0[3]}, c1, kinv);
                const f32x2 h2 = swiglu2((f32x2){g1[0], g1[1]}, (f32x2){u1[0], u1[1]}, c1, kinv), h3 = swiglu2((f32x2){g1[2], g1[3]}, (f32x2){u1[2], u1[3]}, c1, kinv);
#define CL8(v) __builtin_amdgcn_fmed3f((v), -448.f, 448.f)
                u32x2 w; w.x = pk4_fp8(CL8(h0.x), CL8(h0.y), CL8(h1.x), CL8(h1.y)); w.y = pk4_fp8(CL8(h2.x), CL8(h2.y), CL8(h3.x), CL8(h3.y));
#undef CL8
                *(u32x2*)rowp = w; }
    }
};
struct EpiProj {
    static constexpr bool PERM = true;
    bf16_t *Kb, *Qb, *Vt;
    __device__ __forceinline__ void operator()(const f32x4 (&acc)[2][2][4][2], const Unit& u, int wr, int wc, int fr, int fq) const {
        bf16_t* base = (u.aux == 0) ? Kb : (u.aux == 1 ? Qb : Vt); const size_t ldc = (u.aux == 2) ? (size_t)M : (size_t)D;
        const int row0 = u.pm * BM + wr * 64 + fr, col0 = u.pn * BM + wc * 32 + 8 * fq;
#pragma unroll
        for (int ai = 0; ai < 2; ++ai)
#pragma unroll
            for (int m = 0; m < 4; ++m) { bf16_t* rowp = base + (size_t)(row0 + ai * HALF + m * 16) * ldc + col0;
#pragma unroll
                for (int bj = 0; bj < 2; ++bj) { const f32x4 v0 = acc[ai][bj][m][0], v1 = acc[ai][bj][m][1];
                    u32x4 w; w.x = cvtpk(v0[0], v0[1]); w.y = cvtpk(v0[2], v0[3]); w.z = cvtpk(v1[0], v1[1]); w.w = cvtpk(v1[2], v1[3]);
                    if (u.aux == 2) { bf16_t* p16 = rowp + bj * HALF - (fq & 1) * 8 + (fq & 1) * 4;
                        *(u32x2*)p16 = (u32x2){w.x, w.y}; *(u32x2*)(p16 + 8) = (u32x2){w.z, w.w}; }
                    else *(u32x4*)(rowp + bj * HALF) = w; } }
    }
};
struct EpiProjI8 {
    static constexpr bool PERM = true;
    bf16_t *Kb, *Qb, *Vt; const float* ascale; const float* wsc  ; int qsel;
    __device__ __forceinline__ void operator()(const f32x4 (&acc)[2][2][4][2], const Unit& u, int wr, int wc, int fr, int fq) const {
        bf16_t* base = (u.aux == 0) ? Kb : (u.aux == 1 ? Qb : Vt); const size_t ldc = (u.aux == 2) ? (size_t)M : (size_t)D;
        const float* rs; const float* cs; if (u.aux == 2) { rs = wsc + 1024; cs = ascale; } else { rs = ascale; cs = wsc + u.aux * (2048 + qsel * 1024); }
        const int row0 = u.pm * BM + wr * 64 + fr, col0 = u.pn * BM + wc * 32 + 8 * fq;
        f32x4 cv[2][2];
#pragma unroll
        for (int bj = 0; bj < 2; ++bj) { cv[bj][0] = *(const f32x4*)(cs + col0 + bj * HALF); cv[bj][1] = *(const f32x4*)(cs + col0 + bj * HALF + 4); }
#pragma unroll
        for (int ai = 0; ai < 2; ++ai)
#pragma unroll
            for (int m = 0; m < 4; ++m) { const int row = row0 + ai * HALF + m * 16; bf16_t* rowp = base + (size_t)row * ldc + col0; const float rv = rs[row];
#pragma unroll
                for (int bj = 0; bj < 2; ++bj) { const f32x4 v0 = __builtin_convertvector(__builtin_bit_cast(i32x4, acc[ai][bj][m][0]), f32x4) * (cv[bj][0] * rv), v1 = __builtin_convertvector(__builtin_bit_cast(i32x4, acc[ai][bj][m][1]), f32x4) * (cv[bj][1] * rv);
                    u32x4 w; w.x = cvtpk(v0[0], v0[1]); w.y = cvtpk(v0[2], v0[3]); w.z = cvtpk(v1[0], v1[1]); w.w = cvtpk(v1[2], v1[3]);
                    if (u.aux == 2) { bf16_t* p16 = rowp + bj * HALF - (fq & 1) * 8 + (fq & 1) * 4;
                        *(u32x2*)p16 = (u32x2){w.x, w.y}; *(u32x2*)(p16 + 8) = (u32x2){w.z, w.w}; }
                    else *(u32x4*)(rowp + bj * HALF) = w; } }
    }
};
struct EpiMoeDown {
    static constexpr bool PERM = true;
    bf16_t* Y; const float* gate; float osc;
    __device__ __forceinline__ void operator()(const f32x4 (&acc)[2][2][4][2], const Unit& u, int wr, int wc, int fr, int fq) const {
        const int row0 = u.pm * BM + wr * 64 + fr, col0 = u.pn * BM + wc * 32 + 8 * fq;
#pragma unroll
        for (int ai = 0; ai < 2; ++ai)
#pragma unroll
            for (int m = 0; m < 4; ++m) { const int row = row0 + ai * HALF + m * 16; const float gt = gate[row] * osc; bf16_t* rowp = Y + (size_t)row * D + col0;
#pragma unroll
                for (int bj = 0; bj < 2; ++bj) { const f32x4 v0 = acc[ai][bj][m][0] * gt, v1 = acc[ai][bj][m][1] * gt;
                    u32x4 w; w.x = cvtpk(v0[0], v0[1]); w.y = cvtpk(v0[2], v0[3]); w.z = cvtpk(v1[0], v1[1]); w.w = cvtpk(v1[2], v1[3]);
                    *(u32x4*)(rowp + bj * HALF) = w; } }
    }
};
}

__device__ __forceinline__ void tr_load(float (&tv)[32], const float* W, int ldw, int k0, int n0, int lane) {
    const GAS float* wp = (const GAS float*)W + (size_t)(k0 + (lane >> 5)) * ldw + n0 + (lane & 31);
#pragma unroll
    for (int i = 0; i < 32; ++i) tv[i] = wp[(size_t)(2 * i) * ldw];
}
__device__ __forceinline__ void tr_put(const float (&tv)[32], int k0, const float* gain, float mul, int mode  , unsigned char* WT, int ldk, int drow0, LAS float* scr, int lane,
                                       const unsigned* colmax = nullptr  , int n0 = 0, float* wscale = nullptr  ) {
#pragma unroll
    for (int i = 0; i < 32; ++i) { const int kk = 2 * i + (lane >> 5); const float gv = gain ? gain[k0 + kk] * mul : mul; scr[kk * 33 + (lane & 31)] = tv[i] * gv; }
    LDS_WAIT(); asm volatile("" ::: "memory");
    const int c = lane & 7;
#pragma unroll
    for (int j = 0; j < 4; ++j) { const int n = (lane >> 3) + 8 * j; const LAS float* sp = scr + (8 * c) * 33 + n;
        const float e0 = sp[0 * 33], e1 = sp[1 * 33], e2 = sp[2 * 33], e3 = sp[3 * 33], e4 = sp[4 * 33], e5 = sp[5 * 33], e6 = sp[6 * 33], e7 = sp[7 * 33];
        if (mode == 2) { const float mx = __builtin_bit_cast(float, __hip_atomic_load(colmax + n0 + n, RLX_AGENT)); const float q = mx > 0.f ? 127.0f / mx : 0.f;
            u32x2 o; o.x = pk4_i8(e0 * q, e1 * q, e2 * q, e3 * q); o.y = pk4_i8(e4 * q, e5 * q, e6 * q, e7 * q); *(GAS u32x2*)(WT + (size_t)(drow0 + n) * ldk + k0 + 8 * c) = o;
            if (k0 == 0 && c == 0) wscale[drow0 + n] = mx * (1.0f / 127.0f); }
        else if (mode == 1) { u32x2 o; o.x = pk4_fp8(e0, e1, e2, e3); o.y = pk4_fp8(e4, e5, e6, e7); *(GAS u32x2*)(WT + (size_t)(drow0 + n) * ldk + k0 + 8 * c) = o; }
        else { u32x4 o; o.x = cvtpk(e0, e1); o.y = cvtpk(e2, e3); o.z = cvtpk(e4, e5); o.w = cvtpk(e6, e7); *(GAS u32x4*)(WT + ((size_t)(drow0 + n) * ldk + k0 + 8 * c) * 2) = o; } }
    LDS_WAIT(); asm volatile("" ::: "memory");
}
__device__ __forceinline__ void tr_mat(const float* W, int ldw, int K, int N, const float* gain, float mul, int mode, bool gu, unsigned char* WT, LAS float* scr, int first, int NGW, int lane,
                                       const unsigned* colmax = nullptr, float* wscale = nullptr) {
    const int nblk = N / 32, nitems = (K / 64) * nblk, F = N / 2;
    float tv[32], tn[32];
    int it = first; if (it >= nitems) return;
    tr_load(tv, W, ldw, (it / nblk) * 64, (it % nblk) * 32, lane);
    for (; it < nitems; it += NGW) {
        const int nx = it + NGW; if (nx < nitems) tr_load(tn, W, ldw, (nx / nblk) * 64, (nx % nblk) * 32, lane);
        const int kb = it / nblk, n0 = (it % nblk) * 32; int drow0 = n0;
        if (gu) { const int isup = n0 >= F, j = isup ? n0 - F : n0; drow0 = (j >> 7) * 256 + (isup ? 128 : 0) + (j & 127); }
        tr_put(tv, kb * 64, gain, mul, mode, WT, K, drow0, scr, lane, colmax, n0, wscale);
#pragma unroll
        for (int i = 0; i < 32; ++i) tv[i] = tn[i];
    }
}

struct Args { const float* in[15]; float* out; unsigned char* ws; };
template <int OFF> __device__ __forceinline__ unsigned long long karg() { unsigned long long v; auto ka = __builtin_amdgcn_kernarg_segment_ptr();
    asm volatile("s_load_dwordx2 %0, %1, %2\n\ts_waitcnt lgkmcnt(0)" : "=s"(v) : "s"(ka), "n"(OFF) : "memory"); return v; }
#define ARG_IN(k) ((const float*)(const GAS float*)karg<8 * (k)>())
#define ARG_OUT() ((float*)(GAS float*)karg<120>())
#define ARG_WS() ((unsigned char*)(GAS unsigned char*)karg<128>())

template <int W>
__device__ __forceinline__ void pool_chan(const float* xp  , int s0, const LAS float* inv  , bf16_t* pp  ) {
    f32x2 hist[W]; f32x2 S = {0.f, 0.f};
#pragma unroll
    for (int j = 0; j < W; ++j) hist[j] = (f32x2){0.f, 0.f};
    if (s0 > 0) {
#pragma unroll
        for (int j = 1; j < W; ++j) { const int t = j - W; const f32x2 v = *(const f32x2*)(xp + (ptrdiff_t)t * D) * inv[15 + t]; hist[j] = v; S += v; }
    }
    for (int tb = 0; tb < 256; tb += 16) {
        f32x2 v[16];
#pragma unroll
        for (int j = 0; j < 16; ++j) v[j] = *(const f32x2*)(xp + (size_t)(tb + j) * D);
#pragma unroll
        for (int j = 0; j < 16; ++j) { const int t = tb + j; const f32x2 xv = v[j] * inv[15 + t]; S += xv - hist[j % W]; hist[j % W] = xv;
            const int pos = s0 + t + 1; const float rc = (pos >= W) ? (1.0f / W) : (1.0f / (float)pos);
            const f32x2 p = S * rc - xv; *(unsigned*)(pp + (size_t)t * D) = cvtpk(p.x, p.y); }
    }
}
__device__ __forceinline__ void pool_prep_phase(const float* x, bf16_t* P, LAS unsigned char* lds, int G, int wave_s) {
    const int tid = fresh_tid(wave_s); const int lane = tid & 63, wave = __builtin_amdgcn_readfirstlane(tid >> 6);
    LAS float* inv = (LAS float*)lds;
    for (int tile = blockIdx.x; tile < M / 256; tile += G) {
        const int r0 = tile * 256, s0 = r0 % SEQ;
        const int start = (s0 > 0) ? -15 : 0;
        for (int rr = start + wave; rr < 256; rr += NWAVES) {
            const GAS f32x4* xr = (const GAS f32x4*)(x + (size_t)(r0 + rr) * D) + lane; float s = 0.f;
#pragma unroll
            for (int j = 0; j < 4; ++j) { const f32x4 v = xr[64 * j]; s += (v.x * v.x + v.y * v.y) + (v.z * v.z + v.w * v.w); }
            s = wave_sum(s);
            if (lane == 0) inv[15 + rr] = 1.0f / sqrtf(s * (1.0f / D) + RMS_EPS);
        }
        __syncthreads();
        const int c = 2 * tid; const float* xp = x + (size_t)r0 * D + c; bf16_t* pp = P + (size_t)r0 * D + c;
        const int grp = wave >> 1;
        if (grp == 0) pool_chan<2>(xp, s0, inv, pp);
        else if (grp == 1) pool_chan<4>(xp, s0, inv, pp);
        else if (grp == 2) pool_chan<8>(xp, s0, inv, pp);
        else pool_chan<16>(xp, s0, inv, pp);
        __syncthreads();
    }
}

template <bool COMBINE, bool ROUTER, bool FINAL, int OUTK = 0, bool DELTA = false>
__device__ __forceinline__ void norm_phase(float* x, bf16_t* XN, const bf16_t* YS, const int* slot_of, const float* gvec  , const float* wr  ,
                                           int* route_e, float* route_g, int* tilecnt, LAS unsigned char* lds, LAS int* cnt_l, int G, int wave_s, float* ascale = nullptr, const bf16_t* DL = nullptr, const float* xin = nullptr  ) {
    const int tid = fresh_tid(wave_s); const int lane = tid & 63, wave = __builtin_amdgcn_readfirstlane(tid >> 6);
    const float* xs = xin ? xin : (const float*)x;
    LAS float* wl = (LAS float*)lds;
    if (ROUTER) {
        for (int i = tid; i < 8 * 1024; i += NTHREADS) { const int c = i >> 3, e = i & 7; wl[e * 1024 + c] = wr[i] * gvec[c]; }
        __syncthreads();
    }
    f32x4 gf[4];
    if (FINAL) {
#pragma unroll
        for (int j = 0; j < 4; ++j) gf[j] = *((const f32x4*)gvec + lane + 64 * j);
    }
    for (int tile = blockIdx.x; tile < M / 256; tile += G) {
        const int rb = tile * 256 + wave * 32;
        f32x4 vnx[4]; u32x2 yan[4], ybn[4], dnx[4]; int sl0 = 0, sl1 = 0;
        { const GAS f32x4* xr0 = (const GAS f32x4*)(xs + (size_t)rb * D) + lane;
#pragma unroll
          for (int j = 0; j < 4; ++j) vnx[j] = xr0[64 * j];
          if (DELTA) { const GAS u32x2* d0 = (const GAS u32x2*)(DL + (size_t)rb * D) + lane;
#pragma unroll
              for (int j = 0; j < 4; ++j) dnx[j] = d0[64 * j]; }
          if (COMBINE) { const int a0 = __builtin_amdgcn_readfirstlane(__hip_atomic_load(slot_of + 2 * rb, RLX_AGENT)), a1 = __builtin_amdgcn_readfirstlane(__hip_atomic_load(slot_of + 2 * rb + 1, RLX_AGENT));
              const GAS u32x2* y0 = (const GAS u32x2*)(YS + (size_t)a0 * D) + lane; const GAS u32x2* y1 = (const GAS u32x2*)(YS + (size_t)a1 * D) + lane;
#pragma unroll
              for (int j = 0; j < 4; ++j) { yan[j] = y0[64 * j]; ybn[j] = y1[64 * j]; }
              sl0 = __builtin_amdgcn_readfirstlane(__hip_atomic_load(slot_of + 2 * (rb + 1), RLX_AGENT)); sl1 = __builtin_amdgcn_readfirstlane(__hip_atomic_load(slot_of + 2 * (rb + 1) + 1, RLX_AGENT)); } }
        for (int i = 0; i < 32; ++i) {
            const int r = rb + i;
            GAS f32x4* xr = (GAS f32x4*)(x + (size_t)r * D) + lane;
            f32x4 v[4]; u32x2 ya[4], yb[4];
#pragma unroll
            for (int j = 0; j < 4; ++j) { v[j] = vnx[j]; if (COMBINE) { ya[j] = yan[j]; yb[j] = ybn[j]; }
                if (DELTA) { const u32x2 d = dnx[j]; v[j].x += bf_lo(d.x); v[j].y += bf_hi(d.x); v[j].z += bf_lo(d.y); v[j].w += bf_hi(d.y); } }
            if (i + 1 < 32) { const GAS f32x4* xn_ = (const GAS f32x4*)(xs + (size_t)(r + 1) * D) + lane;
#pragma unroll
                for (int j = 0; j < 4; ++j) vnx[j] = xn_[64 * j];
                if (DELTA) { const GAS u32x2* d1 = (const GAS u32x2*)(DL + (size_t)(r + 1) * D) + lane;
#pragma unroll
                    for (int j = 0; j < 4; ++j) dnx[j] = d1[64 * j]; }
                if (COMBINE) { const GAS u32x2* y0 = (const GAS u32x2*)(YS + (size_t)sl0 * D) + lane; const GAS u32x2* y1 = (const GAS u32x2*)(YS + (size_t)sl1 * D) + lane;
#pragma unroll
                    for (int j = 0; j < 4; ++j) { yan[j] = y0[64 * j]; ybn[j] = y1[64 * j]; }
                    if (i + 2 < 32) { sl0 = __builtin_amdgcn_readfirstlane(__hip_atomic_load(slot_of + 2 * (r + 2), RLX_AGENT)); sl1 = __builtin_amdgcn_readfirstlane(__hip_atomic_load(slot_of + 2 * (r + 2) + 1, RLX_AGENT)); } } }
            if (COMBINE) {
#pragma unroll
                for (int j = 0; j < 4; ++j) { const u32x2 a = ya[j], b = yb[j];
                    v[j].x += bf_lo(a.x) + bf_lo(b.x); v[j].y += bf_hi(a.x) + bf_hi(b.x); v[j].z += bf_lo(a.y) + bf_lo(b.y); v[j].w += bf_hi(a.y) + bf_hi(b.y); }
                if (!FINAL) {
#pragma unroll
                    for (int j = 0; j < 4; ++j) xr[64 * j] = v[j];
                }
            }
            float s = 0.f;
#pragma unroll
            for (int j = 0; j < 4; ++j) s += (v[j].x * v[j].x + v[j].y * v[j].y) + (v[j].z * v[j].z + v[j].w * v[j].w);
            const float inv = 1.0f / sqrtf(wave_sum(s) * (1.0f / D) + RMS_EPS);
#pragma unroll
            for (int j = 0; j < 4; ++j) v[j] = v[j] * inv;
            if (FINAL) {
#pragma unroll
                for (int j = 0; j < 4; ++j) xr[64 * j] = v[j] * gf[j];
            } else if (OUTK == 2) {
                float mx = 0.f;
#pragma unroll
                for (int j = 0; j < 4; ++j) mx = fmaxf(fmaxf(mx, fmaxf(fabsf(v[j].x), fabsf(v[j].y))), fmaxf(fabsf(v[j].z), fabsf(v[j].w)));
                mx = wave_max(mx); const float q = mx > 0.f ? 127.0f / mx : 0.f;
                GAS unsigned* o = (GAS unsigned*)((unsigned char*)XN + (size_t)r * D) + lane;
#pragma unroll
                for (int j = 0; j < 4; ++j) o[64 * j] = pk4_i8(v[j].x * q, v[j].y * q, v[j].z * q, v[j].w * q);
                if (lane == 0) ascale[r] = mx * (1.0f / 127.0f);
            } else if (OUTK == 1) {
                GAS unsigned* o = (GAS unsigned*)((unsigned char*)XN + (size_t)r * D) + lane;
#pragma unroll
                for (int j = 0; j < 4; ++j) o[64 * j] = pk4_fp8(v[j].x, v[j].y, v[j].z, v[j].w);
            } else {
                GAS u32x2* o = (GAS u32x2*)(XN + (size_t)r * D) + lane;
#pragma unroll
                for (int j = 0; j < 4; ++j) { u32x2 w; w.x = cvtpk(v[j].x, v[j].y); w.y = cvtpk(v[j].z, v[j].w); o[64 * j] = w; }
            }
            if (ROUTER) {
                float lg[8];
#pragma unroll
                for (int e = 0; e < 8; ++e) { float a = 0.f;
#pragma unroll
                    for (int j = 0; j < 4; ++j) { const f32x4 w = *((const LAS f32x4*)(wl + e * 1024) + lane + 64 * j); a += (v[j].x * w.x + v[j].y * w.y) + (v[j].z * w.z + v[j].w * w.w); }
                    lg[e] = wave_sum(a); }
                int e0 = 0; float v0 = lg[0];
#pragma unroll
                for (int e = 1; e < 8; ++e) if (lg[e] > v0) { v0 = lg[e]; e0 = e; }
                int e1 = -1; float v1 = -3.0e38f;
#pragma unroll
                for (int e = 0; e < 8; ++e) if (e != e0 && lg[e] > v1) { v1 = lg[e]; e1 = e; }
                const float ex = __expf(v1 - v0), g0 = 1.0f / (1.0f + ex), g1 = ex * g0;
                if (lane == 0) { route_e[r] = e0 | (e1 << 8); route_g[2 * r] = g0; route_g[2 * r + 1] = g1; atomicAdd((int*)(cnt_l + e0), 1); atomicAdd((int*)(cnt_l + e1), 1); }
            }
        }
        if (ROUTER) {
            __syncthreads();
            if (tid < 8) { tilecnt[tile * 8 + tid] = cnt_l[tid]; cnt_l[tid] = 0; }
            __syncthreads();
        }
    }
}

template <bool FP8>
__device__ __forceinline__ void dispatch_phase(const int* tilecnt, const int* route_e, const float* route_g, int* slot_of, float* gate_slot, const bf16_t* XN, bf16_t* XS  ,
                                               LAS unsigned char* lds, LAS int* pend, int G, int wave_s) {
    const int tid = fresh_tid(wave_s); const int lane = tid & 63, wave = __builtin_amdgcn_readfirstlane(tid >> 6);
    LAS int* lc = (LAS int*)lds;
    LAS int* tot_l = (LAS int*)(lds + 8192);
    LAS int* pst_l = (LAS int*)(lds + 8192 + 32);
    LAS int* base_l = (LAS int*)(lds + 8192 + 64);
    LAS int* slot_l = (LAS int*)(lds + 8192 + 128);
    if (tid < 256) { const i32x4 a = *((const i32x4*)tilecnt + 2 * tid), b = *((const i32x4*)tilecnt + 2 * tid + 1); *((LAS i32x4*)lc + 2 * tid) = a; *((LAS i32x4*)lc + 2 * tid + 1) = b; }
    __syncthreads();
    if (tid < 8) { int t = 0; for (int i = 0; i < 256; ++i) t += lc[i * 8 + tid]; tot_l[tid] = t; }
    __syncthreads();
    if (tid == 0) { int ps = 0; for (int e = 0; e < 8; ++e) { const int padded = (tot_l[e] + 255) & ~255; pst_l[e] = ps; ps += padded; pend[e] = ps >> 8; } }
    __syncthreads();
    if (FP8 && blockIdx.x < 8) { const int e = blockIdx.x, t0 = pst_l[e] + tot_l[e], npad = ((tot_l[e] + 255) & ~255) - tot_l[e];
        for (int i = tid; i < npad; i += NTHREADS) ((int*)XS)[t0 + i] = 0; }
    for (int tile = blockIdx.x; tile < M / 256; tile += G) {
        const int r0 = tile * 256;
        if (tid < 8) { int pre = 0; for (int i = 0; i < tile; ++i) pre += lc[i * 8 + tid]; base_l[tid] = pst_l[tid] + pre; }
        __syncthreads();
        if (wave == 0) {
            int run[8];
#pragma unroll
            for (int e = 0; e < 8; ++e) run[e] = 0;
            for (int ch = 0; ch < 8; ++ch) {
                const int i = ch * 64 + lane, tok = r0 + (i >> 1), k = i & 1;
                const int ew = __hip_atomic_load(route_e + tok, RLX_AGENT); const int e = (ew >> (8 * k)) & 0xff;
                int slot = 0;
#pragma unroll
                for (int ee = 0; ee < 8; ++ee) { const unsigned long long mask = __ballot(e == ee);
                    if (e == ee) slot = base_l[ee] + run[ee] + __popcll(mask & ((1ull << lane) - 1ull));
                    run[ee] += __popcll(mask); }
                slot_l[i] = slot; slot_of[2 * tok + k] = slot; gate_slot[slot] = __hip_atomic_load(route_g + 2 * tok + k, RLX_AGENT); if (FP8) ((int*)XS)[slot] = tok;
            }
        }
        __syncthreads();
        if constexpr (!FP8) {
        for (int ii = 0; ii < 64; ii += 4) {
            u32x4 a[4][2];
#pragma unroll
            for (int q = 0; q < 4; ++q) { const int i = wave * 64 + ii + q; const GAS u32x4* src = (const GAS u32x4*)(XN + (size_t)(r0 + (i >> 1)) * D) + lane; a[q][0] = src[0]; a[q][1] = src[64]; }
#pragma unroll
            for (int q = 0; q < 4; ++q) { const int i = wave * 64 + ii + q; GAS u32x4* dst = (GAS u32x4*)(XS + (size_t)slot_l[i] * D) + lane; dst[0] = a[q][0]; dst[64] = a[q][1]; }
        }
        }
        __syncthreads();
    }
}

#define ATT_LOAD(KF, VF, kt_) do { const int k0_ = (kt_) * 32; \
        const GAS u32x4* kp_ = (const GAS u32x4*)(Kb + (rowbase + k0_ + n) * D + h * 64 + 8 * hh); \
        _Pragma("unroll") for (int s_ = 0; s_ < 4; ++s_) KF[s_] = __builtin_bit_cast(bf16x8, kp_[2 * s_]); \
        _Pragma("unroll") for (int dt_ = 0; dt_ < 2; ++dt_) { const GAS u32x4* vp_ = (const GAS u32x4*)(Vt + (size_t)(h * 64 + dt_ * 32 + n) * M + rowbase + k0_ + 8 * hh); \
            _Pragma("unroll") for (int s_ = 0; s_ < 2; ++s_) VF[dt_][s_] = __builtin_bit_cast(bf16x8, vp_[2 * s_]); } } while (0)
constexpr float ATT_STOP = 9.0e-14f;
__device__ __forceinline__ void att_tile(const bf16x8 (&kf)[4], const bf16x8 (&vf)[2][2], const bf16x8 (&qf)[4], f32x16& o0, f32x16& o1, float& carry, bool diag, int n, int hh) {
    f32x16 sc;
#pragma unroll
    for (int r = 0; r < 16; ++r) sc[r] = 0.f;
#pragma unroll
    for (int s = 0; s < 4; ++s) sc = __builtin_amdgcn_mfma_f32_32x32x16_bf16(kf[s], qf[s], sc, 0, 0, 0);
    float be[16], kp[16];
#pragma unroll
    for (int r = 0; r < 16; ++r) { const float zl = sc[r]; const float e = __builtin_amdgcn_exp2f(-fabsf(zl)); const float rr = __builtin_amdgcn_rcpf(1.0f + e), er = e * rr;
        float bt_ = zl >= 0.f ? rr : er, kp_ = zl >= 0.f ? er : rr;
        if (diag) { const int key = (r & 3) + 8 * (r >> 2) + 4 * hh; if (key >= n) { bt_ = 0.f; kp_ = 1.f; } }
        be[r] = bt_; kp[r] = kp_; }
    float T[4], Pp[4], p2[4], p1[4], p0[4];
#pragma unroll
    for (int g = 0; g < 4; ++g) { p2[g] = kp[4 * g + 3]; p1[g] = p2[g] * kp[4 * g + 2]; p0[g] = p1[g] * kp[4 * g + 1]; T[g] = p0[g] * kp[4 * g]; }
#pragma unroll
    for (int g = 0; g < 4; ++g) Pp[g] = __shfl_xor(T[g], 32);
    float off[4];
    { const float own2 = T[3], own1 = T[3] * T[2], own0 = own1 * T[1];
      const float pe2 = Pp[3], pe1 = Pp[3] * Pp[2], pe0 = pe1 * Pp[1];
      if (hh == 0) { off[0] = own0 * pe0 * Pp[0]; off[1] = own1 * pe1 * Pp[1]; off[2] = own2 * pe2 * Pp[2]; off[3] = Pp[3]; }
      else         { off[0] = own0 * pe0;         off[1] = own1 * pe1;         off[2] = own2 * pe2;         off[3] = 1.f; } }
    float a[16];
#pragma unroll
    for (int g = 0; g < 4; ++g) { const float base = carry * off[g];
        a[4 * g + 0] = be[4 * g + 0] * (base * p0[g]); a[4 * g + 1] = be[4 * g + 1] * (base * p1[g]); a[4 * g + 2] = be[4 * g + 2] * (base * p2[g]); a[4 * g + 3] = be[4 * g + 3] * base; }
    carry *= ((T[0] * T[1]) * (T[2] * T[3])) * ((Pp[0] * Pp[1]) * (Pp[2] * Pp[3]));
    bf16x8 pb[2];
#pragma unroll
    for (int s = 0; s < 2; ++s) { u32x4 w; w.x = cvtpk(a[8 * s + 0], a[8 * s + 1]); w.y = cvtpk(a[8 * s + 2], a[8 * s + 3]); w.z = cvtpk(a[8 * s + 4], a[8 * s + 5]); w.w = cvtpk(a[8 * s + 6], a[8 * s + 7]); pb[s] = __builtin_bit_cast(bf16x8, w); }
#pragma unroll
    for (int s = 0; s < 2; ++s) { o0 = __builtin_amdgcn_mfma_f32_32x32x16_bf16(vf[0][s], pb[s], o0, 0, 0, 0); o1 = __builtin_amdgcn_mfma_f32_32x32x16_bf16(vf[1][s], pb[s], o1, 0, 0, 0); }
}
constexpr int ATT_KROW = 144, ATT_VROW = 784, ATT_V_OFF = 384 * ATT_KROW;
static_assert(ATT_V_OFF + 64 * ATT_VROW <= STAGE_BYTES_LDS, "attention LDS image");
__device__ __forceinline__ void attn_phase(const bf16_t* Q, const bf16_t* Kb, const bf16_t* Vt, bf16_t* O, LAS unsigned char* lds, int vcu, int G, int wave_s) {
    const int tid = fresh_tid(wave_s); const int lane = tid & 63, wave = __builtin_amdgcn_readfirstlane(tid >> 6);
    const int n = lane & 31, hh = lane >> 5;
    const int NU = BATCH * NH * (SEQ / 256), per = (NU + G - 1) / G;
    const int u_lo = vcu * per, u_hi = (u_lo + per < NU) ? u_lo + per : NU;
    u32x4 pk[6], pv[6];
#define ATT_FETCH(uu) do { const int bh_ = (uu) >> 3, qb_ = (uu) & 7, h_ = bh_ & 15, b_ = bh_ >> 4; const int kw0_ = qb_ > 0 ? qb_ * 256 - 128 : 0, nk_ = qb_ * 256 + 256 - kw0_; \
        const size_t rb_ = (size_t)b_ * SEQ; \
        _Pragma("unroll") for (int i_ = 0; i_ < 6; ++i_) { const int p_ = tid + i_ * NTHREADS; const int kr_ = p_ >> 3, kc_ = p_ & 7; \
            if (kr_ < nk_) pk[i_] = *(const GAS u32x4*)(Kb + (rb_ + kw0_ + kr_) * D + h_ * 64 + kc_ * 8); \
            const int vd_ = p_ / 48, vc_ = p_ - vd_ * 48; \
            if (vc_ * 8 < nk_) pv[i_] = *(const GAS u32x4*)(Vt + (size_t)(h_ * 64 + vd_) * M + rb_ + kw0_ + vc_ * 8); } } while (0)
#define ATT_PUT(uu) do { const int qb_ = (uu) & 7; const int kw0_ = qb_ > 0 ? qb_ * 256 - 128 : 0, nk_ = qb_ * 256 + 256 - kw0_; \
        _Pragma("unroll") for (int i_ = 0; i_ < 6; ++i_) { const int p_ = tid + i_ * NTHREADS; const int kr_ = p_ >> 3, kc_ = p_ & 7; \
            if (kr_ < nk_) *(LAS u32x4*)(lds + kr_ * ATT_KROW + kc_ * 16) = pk[i_]; \
            const int vd_ = p_ / 48, vc_ = p_ - vd_ * 48; \
            if (vc_ * 8 < nk_) *(LAS u32x4*)(lds + ATT_V_OFF + vd_ * ATT_VROW + vc_ * 16) = pv[i_]; } } while (0)
#define ATT_TILE_LD(KF, VF, kt_) do { const int k0_ = (kt_) * 32; if (k0_ >= kw0) { const int ko_ = k0_ - kw0; \
            _Pragma("unroll") for (int s_ = 0; s_ < 4; ++s_) KF[s_] = *(const LAS bf16x8*)(lds + (ko_ + n) * ATT_KROW + 32 * s_ + 16 * hh); \
            _Pragma("unroll") for (int dt_ = 0; dt_ < 2; ++dt_) _Pragma("unroll") for (int s_ = 0; s_ < 2; ++s_) VF[dt_][s_] = *(const LAS bf16x8*)(lds + ATT_V_OFF + (dt_ * 32 + n) * ATT_VROW + (ko_ + 16 * s_ + 8 * hh) * 2); } \
        else { ATT_LOAD(KF, VF, kt_); } } while (0)
    if (u_lo < u_hi) ATT_FETCH(u_lo);
    for (int u = u_lo; u < u_hi; ++u) {
        const int bh = u >> 3, qb = u & 7, h = bh & 15, b = bh >> 4;
        const size_t rowbase = (size_t)b * SEQ; const int kw0 = qb > 0 ? qb * 256 - 128 : 0;
        const int qt = qb * 8 + wave, q0 = qt * 32;
        bf16x8 qf[4];
        { const GAS u32x4* qp = (const GAS u32x4*)(Q + (rowbase + q0 + n) * D + h * 64 + 8 * hh);
#pragma unroll
          for (int s = 0; s < 4; ++s) qf[s] = __builtin_bit_cast(bf16x8, qp[2 * s]); }
        ATT_PUT(u);
        __syncthreads();
        if (u + 1 < u_hi) ATT_FETCH(u + 1);
        f32x16 o0, o1;
#pragma unroll
        for (int r = 0; r < 16; ++r) { o0[r] = 0.f; o1[r] = 0.f; }
        float carry = 1.f;
        bf16x8 kf[4], vf[2][2];
        for (int kt = qt; kt >= 0; --kt) {
            ATT_TILE_LD(kf, vf, kt);
            att_tile(kf, vf, qf, o0, o1, carry, kt == qt, n, hh);
            if (__all(carry < ATT_STOP)) break;
        }
        bf16_t* op = O + (rowbase + q0 + n) * D + h * 64 + 4 * hh;
#pragma unroll
        for (int g = 0; g < 4; ++g) { u32x2 w0, w1; w0.x = cvtpk(o0[4 * g], o0[4 * g + 1]); w0.y = cvtpk(o0[4 * g + 2], o0[4 * g + 3]); w1.x = cvtpk(o1[4 * g], o1[4 * g + 1]); w1.y = cvtpk(o1[4 * g + 2], o1[4 * g + 3]);
            *(u32x2*)(op + 8 * g) = w0; *(u32x2*)(op + 32 + 8 * g) = w1; }
        __syncthreads();
    }
#undef ATT_FETCH
#undef ATT_PUT
#undef ATT_TILE_LD
}

#define WSP(T, off) ((T*)(ws + (off)))
#ifndef PROBE_DUP
#define PROBE_DUP 0
#endif
#define DUP(k) ((PROBE_DUP >> (k)) & 1)
template <int l>
__device__ __forceinline__ void layer_body(LAS unsigned char* lds, const XcdBarrier& bar, LAS int* pend, LAS int* cnt_l, int G, int bx, int vcu, int NGW, int wave_s) {
#define SITE_POOLPREP() { { unsigned char* ws = ARG_WS(); const float* xsrc = (l == 0) ? ARG_IN(0) : (const float*)ARG_OUT(); pool_prep_phase(xsrc, WSP(bf16_t, WS_R), lds, G, wave_s); \
              if constexpr (l == 0 && (INT8_UP0 != 0 || INT8_PROJ != 0)) {     \
                  const int t_ = fresh_tid(wave_s); const int wv_ = __builtin_amdgcn_readfirstlane(t_ >> 6); LAS float* sc_ = (LAS float*)(lds + wv_ * 16384); const int g_ = vcu * NWAVES + wv_; int base_ = 0; \
                  for (int j_ = 0; j_ < 5; ++j_) { if ((j_ == 0 && !I8) || (j_ > 0 && !INT8_PROJ)) continue; \
                      const float* W_; const float* gn_; int ldw_, N_; float mul_ = 1.0f; bool gu_ = false; size_t dst_; const unsigned* cm_; float* wsc_; \
                      if (j_ == 0) { W_ = ARG_IN(9); gn_ = ARG_IN(2); ldw_ = 2 * DFF; N_ = 2 * DFF; gu_ = true; dst_ = WS_WFI; cm_ = WSP(unsigned, WS_COLMAX); wsc_ = WSP(float, WS_WSCALE); } \
                      else if (j_ < 3) { W_ = ARG_IN(6) + (j_ - 1) * 1024; gn_ = ARG_IN(5); ldw_ = 2048; N_ = 1024; dst_ = (j_ == 1) ? WS_WK : WS_WV; cm_ = WSP(unsigned, WS_COLMAX2) + (j_ - 1) * 1024; wsc_ = WSP(float, WS_WSCALE2) + (j_ - 1) * 1024; } \
                      else { const int b_ = j_ - 3; W_ = ARG_IN(7) + (size_t)b_ * D * D; gn_ = ARG_IN(1) + (2 + b_) * D; ldw_ = 1024; N_ = 1024; mul_ = 0.125f * 1.4426950408889634f; dst_ = WS_WQ + (size_t)b_ * D * D * 2; cm_ = WSP(unsigned, WS_COLMAX2) + (2 + b_) * 1024; wsc_ = WSP(float, WS_WSCALE2) + (2 + b_) * 1024; } \
                      int first_ = (g_ - base_) % NGW; if (first_ < 0) first_ += NGW; \
                      tr_mat(W_, ldw_, D, N_, gn_, mul_, 2, gu_, ws + dst_, sc_, first_, NGW, t_ & 63, cm_, wsc_); base_ = (base_ + (D / 64) * (N_ / 32)) % NGW; } } } xcd_barrier(bar, wave_s); }
#define SITE_POOLGEMM(MUL) { { unsigned char* ws = ARG_WS(); \
              pg8::GemmK g{256, 1024, 256}; pg8::PoolOrder S{G, bx, (const char*)WSP(bf16_t, WS_R), (const char*)(WSP(bf16_t, WS_WPOOL) + (size_t)l * 4 * 65536)}; \
              pg8::EpiDelta E{WSP(bf16_t, WS_DELTA), ARG_IN(4) + l * D}; \
              pg8::gemm_phase<pg8::EpiDelta, pg8::PoolOrder, true>(lds, g, S, E, wave_s); } xcd_barrier(bar, wave_s); }
#define SITE_PROJ() { { unsigned char* ws = ARG_WS(); \
              if constexpr (INT8_PROJ != 0) { pg8::GemmK g{512, 512, 512}; pg8::ProjOrder S{(l == 2) ? 3 : 1, G, bx, (const char*)ws, (size_t)(l - 2) * D * D * 2, (size_t)256 * 1024}; \
                pg8::EpiProjI8 E{WSP(bf16_t, WS_K), WSP(bf16_t, WS_R), WSP(bf16_t, WS_VT), WSP(float, WS_ASCALE), WSP(float, WS_WSCALE2), l - 2}; \
                pg8::gemm_phase<pg8::EpiProjI8, pg8::ProjOrder, true, 2>(lds, g, S, E, wave_s); } \
              else { pg8::GemmK g{1024, 1024, 1024}; pg8::ProjOrder S{(l == 2) ? 3 : 1, G, bx, (const char*)ws, (size_t)(l - 2) * D * D * 2, (size_t)256 * 1024 * 2}; \
                pg8::EpiProj E{WSP(bf16_t, WS_K), WSP(bf16_t, WS_R), WSP(bf16_t, WS_VT)}; \
                pg8::gemm_phase<pg8::EpiProj, pg8::ProjOrder, true>(lds, g, S, E, wave_s); } } xcd_barrier(bar, wave_s); }
#define SITE_ATTN() { { unsigned char* ws = ARG_WS(); attn_phase(WSP(bf16_t, WS_R), WSP(bf16_t, WS_K), WSP(bf16_t, WS_VT), WSP(bf16_t, WS_R) + (size_t)M * D, lds, vcu, G, wave_s); } xcd_barrier(bar, wave_s); }
#define SITE_OPROJ(MUL) { { unsigned char* ws = ARG_WS(); \
              pg8::GemmK g{1024, 1024, 1024}; pg8::DenseOrder S{M / 256, 4, G, bx, (const char*)(WSP(bf16_t, WS_R) + (size_t)M * D), (const char*)(WSP(bf16_t, WS_WO) + (size_t)(l - 2) * D * D), (size_t)256 * 1024 * 2, (size_t)256 * 1024 * 2}; \
              pg8::EpiDelta E{WSP(bf16_t, WS_DELTA), nullptr}; \
              pg8::gemm_phase<pg8::EpiDelta, pg8::DenseOrder, true>(lds, g, S, E, wave_s); } xcd_barrier(bar, wave_s); }
#define SITE_NORMX(OUTK_, DELTA_) { { unsigned char* ws = ARG_WS(); norm_phase<false, false, false, OUTK_, DELTA_>(ARG_OUT(), WSP(bf16_t, WS_XN), nullptr, nullptr, nullptr, nullptr, nullptr, nullptr, nullptr, lds, cnt_l, G, wave_s, WSP(float, WS_ASCALE), \
              (DELTA_) ? WSP(bf16_t, WS_DELTA) : (bf16_t*)nullptr, ((DELTA_) && l == 0) ? ARG_IN(0) : (const float*)nullptr); } xcd_barrier(bar, wave_s); }
#define SITE_NORMI8() { { unsigned char* ws = ARG_WS(); norm_phase<false, false, false, 2>(ARG_OUT(), WSP(bf16_t, WS_XN), nullptr, nullptr, nullptr, nullptr, nullptr, nullptr, nullptr, lds, cnt_l, G, wave_s, WSP(float, WS_ASCALE)); } xcd_barrier(bar, wave_s); }
#define SITE_NORM8() { { unsigned char* ws = ARG_WS(); norm_phase<false, false, false, 1>(ARG_OUT(), WSP(bf16_t, WS_XN), nullptr, nullptr, nullptr, nullptr, nullptr, nullptr, nullptr, lds, cnt_l, G, wave_s); } xcd_barrier(bar, wave_s); }
#define SITE_NORM() { { unsigned char* ws = ARG_WS(); norm_phase<false, false, false>(ARG_OUT(), WSP(bf16_t, WS_XN), nullptr, nullptr, nullptr, nullptr, nullptr, nullptr, nullptr, lds, cnt_l, G, wave_s); } xcd_barrier(bar, wave_s); }
#define SITE_DUP() { { unsigned char* ws = ARG_WS(); \
              if constexpr (I8) { pg8::GemmK g{512, 512, 512}; pg8::DenseOrder S{M / 256, DFF / 128, G, bx, (const char*)WSP(unsigned char, WS_XN), (const char*)WSP(unsigned char, WS_WFI), (size_t)256 * 1024, (size_t)256 * 1024}; \
                pg8::EpiSwigluI8 E{WSP(bf16_t, WS_R), DFF, WSP(float, WS_ASCALE), WSP(float, WS_WSCALE)}; \
                pg8::gemm_phase<pg8::EpiSwigluI8, pg8::DenseOrder, true, 2>(lds, g, S, E, wave_s); } \
              else if constexpr (F8) { pg8::GemmK g{512, 512, 512}; pg8::DenseOrder S{M / 256, DFF / 128, G, bx, (const char*)WSP(unsigned char, WS_XN), (const char*)(WSP(unsigned char, WS_WFI) + (size_t)(l >> 1) * 2 * DFF * D * 2), (size_t)256 * 1024, (size_t)256 * 1024}; \
                pg8::EpiSwiglu8 E{WSP(unsigned char, WS_R), DFF, 1.0f / W8_UP}; \
                pg8::gemm_phase<pg8::EpiSwiglu8, pg8::DenseOrder, true, 1>(lds, g, S, E, wave_s); } \
              else { pg8::GemmK g{1024, 1024, 1024}; pg8::DenseOrder S{M / 256, DFF / 128, G, bx, (const char*)WSP(bf16_t, WS_XN), (const char*)(WSP(bf16_t, WS_WFI) + (size_t)(l >> 1) * 2 * DFF * D), (size_t)256 * 1024 * 2, (size_t)256 * 1024 * 2}; \
                pg8::EpiSwiglu E{WSP(bf16_t, WS_R), DFF}; \
                pg8::gemm_phase<pg8::EpiSwiglu, pg8::DenseOrder, true>(lds, g, S, E, wave_s); } } xcd_barrier(bar, wave_s); }
#define SITE_DDOWN(MUL) { { unsigned char* ws = ARG_WS(); \
              if constexpr (F8) { pg8::GemmK g{DFF / 2, DFF / 2, DFF / 2}; pg8::DenseOrder S{M / 256, 4, G, bx, (const char*)WSP(unsigned char, WS_R), (const char*)(WSP(unsigned char, WS_WFO) + (size_t)(l >> 1) * D * DFF * 2), (size_t)256 * DFF, (size_t)256 * DFF}; \
                pg8::EpiResidD E{(l == 0) ? ARG_IN(0) : (const float*)ARG_OUT(), ARG_OUT(), WSP(bf16_t, WS_DELTA), MUL / (W8_DN * H8_SC)}; \
                pg8::gemm_phase<pg8::EpiResidD, pg8::DenseOrder, true, 1>(lds, g, S, E, wave_s); } \
              else { pg8::GemmK g{DFF, DFF, DFF}; pg8::DenseOrder S{M / 256, 4, G, bx, (const char*)WSP(bf16_t, WS_R), (const char*)(WSP(bf16_t, WS_WFO) + (size_t)(l >> 1) * D * DFF), (size_t)256 * DFF * 2, (size_t)256 * DFF * 2}; \
                pg8::EpiResidD E{(l == 0) ? ARG_IN(0) : (const float*)ARG_OUT(), ARG_OUT(), WSP(bf16_t, WS_DELTA), MUL}; \
                pg8::gemm_phase<pg8::EpiResidD, pg8::DenseOrder, true>(lds, g, S, E, wave_s); } } xcd_barrier(bar, wave_s); }
#define SITE_ROUTER() { { unsigned char* ws = ARG_WS(); \
              norm_phase<false, true, false, F8 ? 1 : 0, true>(ARG_OUT(), WSP(bf16_t, WS_XN), nullptr, nullptr, ARG_IN(2) + l * D, ARG_IN(11) + (size_t)(l >> 1) * D * NE, WSP(int, WS_ROUTE_E), WSP(float, WS_ROUTE_G), WSP(int, WS_TILECNT), lds, cnt_l, G, wave_s, nullptr, WSP(bf16_t, WS_DELTA)); } xcd_barrier(bar, wave_s); }
#define SITE_DISPATCH() { { unsigned char* ws = ARG_WS(); \
              dispatch_phase<F8>(WSP(int, WS_TILECNT), WSP(int, WS_ROUTE_E), WSP(float, WS_ROUTE_G), WSP(int, WS_SLOT_OF), WSP(float, WS_GATE_SLOT), WSP(bf16_t, WS_XN), F8 ? WSP(bf16_t, WS_XS8) : WSP(bf16_t, WS_XS), lds, pend, G, wave_s); } xcd_barrier(bar, wave_s); }
#define SITE_MUP() { { unsigned char* ws = ARG_WS(); \
              if constexpr (F8) { pg8::GemmK g{512, 512, 512}; \
                pg8::MoeGatherOrder S{nb, DFFE / 128, G, bx, blk0, (const char*)WSP(unsigned char, WS_XN), (const char*)(WSP(unsigned char, WS_WMI) + (size_t)(l >> 1) * 8 * 2 * DFFE * D * 2), (size_t)256 * 1024, (size_t)2 * DFFE * D, pend, WSP(int, WS_XS8), (LAS int*)(lds + LCTL_OFF + 2048)}; \
                pg8::EpiSwiglu8 E{WSP(unsigned char, WS_R), DFFE, 1.0f / W8_UP}; \
                pg8::gemm_phase<pg8::EpiSwiglu8, pg8::MoeGatherOrder, true, 1, true>(lds, g, S, E, wave_s); } \
              else { pg8::GemmK g{1024, 1024, 1024}; \
                pg8::MoeOrder S{nb, DFFE / 128, G, bx, blk0, 0, (const char*)WSP(bf16_t, WS_XS), (const char*)(WSP(bf16_t, WS_WMI) + (size_t)(l >> 1) * 8 * 2 * DFFE * D), (size_t)256 * 1024 * 2, (size_t)256 * 1024 * 2, (size_t)2 * DFFE * D * 2, pend}; \
                pg8::EpiSwiglu E{WSP(bf16_t, WS_R), DFFE}; \
                pg8::gemm_phase<pg8::EpiSwiglu, pg8::MoeOrder, true>(lds, g, S, E, wave_s); } } xcd_barrier(bar, wave_s); }
#define SITE_MDOWN() { { unsigned char* ws = ARG_WS(); \
              if constexpr (F8) { pg8::GemmK g{DFFE / 2, DFFE / 2, DFFE / 2}; \
                pg8::MoeOrder S{nb, 4, G, bx, blk0, 1, (const char*)WSP(unsigned char, WS_R), (const char*)(WSP(unsigned char, WS_WMO) + (size_t)(l >> 1) * 8 * D * DFFE * 2), (size_t)256 * DFFE, (size_t)256 * DFFE, (size_t)D * DFFE, pend}; \
                pg8::EpiMoeDown E{WSP(bf16_t, WS_XS), WSP(float, WS_GATE_SLOT), 1.0f / (W8_DN * H8_SC)}; \
                pg8::gemm_phase<pg8::EpiMoeDown, pg8::MoeOrder, true, 1>(lds, g, S, E, wave_s); } \
              else { pg8::GemmK g{DFFE, DFFE, DFFE}; \
                pg8::MoeOrder S{nb, 4, G, bx, blk0, 1, (const char*)WSP(bf16_t, WS_R), (const char*)(WSP(bf16_t, WS_WMO) + (size_t)(l >> 1) * 8 * D * DFFE), (size_t)256 * DFFE * 2, (size_t)256 * DFFE * 2, (size_t)D * DFFE * 2, pend}; \
                pg8::EpiMoeDown E{WSP(bf16_t, WS_XS), WSP(float, WS_GATE_SLOT), 1.0f}; \
                pg8::gemm_phase<pg8::EpiMoeDown, pg8::MoeOrder, true>(lds, g, S, E, wave_s); } } xcd_barrier(bar, wave_s); }
    constexpr bool F8 = ((FP8_MASK >> l) & 1) != 0;
    constexpr bool I8 = (INT8_UP0 != 0) && l == 0 && !F8;
    if constexpr (l < 2) {
        if (DUP(5)) SITE_POOLPREP()
        SITE_POOLPREP()
        if (DUP(2)) SITE_POOLGEMM(0.f)
        SITE_POOLGEMM(1.f)
    } else {
        if (DUP(2)) SITE_PROJ()
        SITE_PROJ()
        if (DUP(3)) SITE_ATTN()
        SITE_ATTN()
        if (DUP(2)) SITE_OPROJ(0.f)
        SITE_OPROJ(1.f)
    }
    if constexpr ((l & 1) == 0) {
        if constexpr (I8) { if (DUP(5)) SITE_NORMX(2, true) SITE_NORMX(2, true) } else if constexpr (F8) { if (DUP(5)) SITE_NORMX(1, true) SITE_NORMX(1, true) } else { if (DUP(5)) SITE_NORMX(0, true) SITE_NORMX(0, true) }
        if (DUP(1)) SITE_DUP()
        SITE_DUP()
        SITE_DDOWN(1.f)
        if constexpr (l == 2) { if constexpr (INT8_PROJ != 0) { if (DUP(5)) SITE_NORMI8() SITE_NORMI8() } else { if (DUP(5)) SITE_NORM() SITE_NORM() } }
    } else {
        if (DUP(5)) SITE_ROUTER()
        SITE_ROUTER()
        if (DUP(5)) SITE_DISPATCH()
        SITE_DISPATCH()
        constexpr int CB = F8 ? CAP / 256 : CHUNK_BLKS;
        for (int ch = 0; ch < (F8 ? 1 : 2); ++ch) {
            const int nblk = pend[7];
            const int blk0 = ch * CB; int nb = nblk - blk0; nb = nb < 0 ? 0 : (nb > CB ? CB : nb); nb = __builtin_amdgcn_readfirstlane(nb);
            if (DUP(0)) SITE_MUP()
            SITE_MUP()
            if (DUP(0)) SITE_MDOWN()
            SITE_MDOWN()
        }
        if constexpr (l == 1) { { unsigned char* ws = ARG_WS(); norm_phase<true, false, false, INT8_PROJ ? 2 : 0, true>(ARG_OUT(), WSP(bf16_t, WS_XN), WSP(bf16_t, WS_XS), WSP(int, WS_SLOT_OF), nullptr, nullptr, nullptr, nullptr, nullptr, lds, cnt_l, G, wave_s, WSP(float, WS_ASCALE), WSP(bf16_t, WS_DELTA)); } xcd_barrier(bar, wave_s); }
        else { unsigned char* ws = ARG_WS(); norm_phase<true, false, true, 0, true>(ARG_OUT(), WSP(bf16_t, WS_XN), WSP(bf16_t, WS_XS), WSP(int, WS_SLOT_OF), ARG_IN(14), nullptr, nullptr, nullptr, nullptr, lds, cnt_l, G, wave_s, nullptr, WSP(bf16_t, WS_DELTA)); }
    }
}

__global__ void __launch_bounds__(NTHREADS, 2) yoco_fwd(Args args_unused) {
    extern __shared__ __attribute__((aligned(16))) unsigned char lds_raw[];
    LAS unsigned char* lds = (LAS unsigned char*)lds_raw;
    const int G = gridDim.x; const int bx = blockIdx.x; const int wave_s = __builtin_amdgcn_readfirstlane(threadIdx.x >> 6);
    const int vcu = (G % 8 == 0) ? (bx % 8) * (G / 8) + bx / 8 : bx;
    const int NGW = G * NWAVES;
    LAS unsigned* lctl = (LAS unsigned*)(lds + LCTL_OFF);
    for (int u = threadIdx.x; u < (LDS_BYTES - LCTL_OFF) / 4; u += NTHREADS) lctl[u] = 0u;
    __syncthreads();
    volatile LAS unsigned* bar_st = (volatile LAS unsigned*)lctl;
    LAS int* pend = (LAS int*)(lctl + 16);
    LAS int* cnt_l = (LAS int*)(lctl + 32);
    XcdBarrier bar = xcd_barrier_post((unsigned*)(ARG_WS() + WS_CTL) + 1024, bar_st);

    for (int rep = 0; rep < 1 + DUP(4); ++rep) {
        unsigned char* ws = ARG_WS();
        const int tid = fresh_tid(wave_s); const int lane = tid & 63, wave = __builtin_amdgcn_readfirstlane(tid >> 6), gw = vcu * NWAVES + wave;
        LAS float* scr = (LAS float*)(lds + wave * 16384);
        int base = 0;
        for (int j = 0; j < 50; ++j) {
            const float* W; const float* gain = nullptr; int ldw, K, N; float mul = 1.0f; bool f8 = false, gu = false; size_t dst;
            if (j < 8) { W = ARG_IN(3) + (size_t)j * 65536; ldw = 256; K = 256; N = 256; gain = ARG_IN(1) + (j >> 2) * D + (j & 3) * 256; dst = WS_WPOOL + (size_t)j * 65536 * 2; }
            else if (j < 10) { W = ARG_IN(6) + (j - 8) * 1024; ldw = 2048; K = 1024; N = 1024; gain = ARG_IN(5); dst = (j == 8) ? WS_WK : WS_WV; }
            else if (j < 12) { const int b = j - 10; W = ARG_IN(7) + (size_t)b * D * D; ldw = 1024; K = 1024; N = 1024; gain = ARG_IN(1) + (2 + b) * D; mul = 0.125f * 1.4426950408889634f; dst = WS_WQ + (size_t)b * D * D * 2; }
            else if (j < 14) { const int b = j - 12; W = ARG_IN(8) + (size_t)b * D * D; ldw = 1024; K = 1024; N = 1024; dst = WS_WO + (size_t)b * D * D * 2; }
            else if (j < 16) { const int i = j - 14; f8 = ((FP8_MASK >> (2 * i)) & 1) != 0; gu = true; W = ARG_IN(9) + (size_t)i * D * 2 * DFF; ldw = 2 * DFF; K = 1024; N = 2 * DFF; gain = ARG_IN(2) + (2 * i) * D; mul = f8 ? W8_UP : 1.0f; dst = WS_WFI + (size_t)i * 2 * DFF * D * 2; }
            else if (j < 18) { const int i = j - 16; f8 = ((FP8_MASK >> (2 * i)) & 1) != 0; W = ARG_IN(10) + (size_t)i * DFF * D; ldw = 1024; K = DFF; N = 1024; mul = f8 ? W8_DN : 1.0f; dst = WS_WFO + (size_t)i * D * DFF * 2; }
            else if (j < 34) { const int ie = j - 18, li = 2 * (ie >> 3) + 1, e = ie & 7; f8 = ((FP8_MASK >> li) & 1) != 0; gu = true; W = ARG_IN(12) + (size_t)ie * D * 2 * DFFE; ldw = 2 * DFFE; K = 1024; N = 2 * DFFE; gain = ARG_IN(2) + li * D; mul = f8 ? W8_UP : 1.0f;
                               dst = WS_WMI + (size_t)(ie >> 3) * 8 * 2 * DFFE * D * 2 + (size_t)e * 2 * DFFE * D * (f8 ? 1 : 2); }
            else { const int ie = j - 34, li = 2 * (ie >> 3) + 1, e = ie & 7; f8 = ((FP8_MASK >> li) & 1) != 0; W = ARG_IN(13) + (size_t)ie * DFFE * D; ldw = 1024; K = DFFE; N = 1024; mul = f8 ? W8_DN : 1.0f;
                   dst = WS_WMO + (size_t)(ie >> 3) * 8 * D * DFFE * 2 + (size_t)e * D * DFFE * (f8 ? 1 : 2); }
            const int nitems = (K / 64) * (N / 32);
            int first = (gw - base) % NGW; if (first < 0) first += NGW;
            if ((INT8_UP0 && j == 14) || (INT8_PROJ && j >= 8 && j < 12)) continue;
            tr_mat(W, ldw, K, N, gain, mul, f8 ? 1 : 0, gu, ws + dst, scr, first, NGW, lane);
            base = (base + nitems) % NGW;
        }
    }
    if (INT8_UP0 || INT8_PROJ) {
        unsigned char* ws = ARG_WS(); const int tid = fresh_tid(wave_s); const int lane = tid & 63, gw = vcu * NWAVES + __builtin_amdgcn_readfirstlane(tid >> 6);
        int base = 0;
        for (int j = 0; j < 5; ++j) {
            if ((j == 0 && !INT8_UP0) || (j > 0 && !INT8_PROJ)) continue;
            const GAS float* W; const GAS float* gn; int ldw, ncols; float mul = 1.0f; unsigned* cm;
            if (j == 0) { W = (const GAS float*)ARG_IN(9); gn = (const GAS float*)ARG_IN(2); ldw = 2 * DFF; ncols = 2 * DFF; cm = WSP(unsigned, WS_COLMAX); }
            else if (j < 3) { W = (const GAS float*)ARG_IN(6) + (j - 1) * 1024; gn = (const GAS float*)ARG_IN(5); ldw = 2048; ncols = 1024; cm = WSP(unsigned, WS_COLMAX2) + (j - 1) * 1024; }
            else { W = (const GAS float*)ARG_IN(7) + (size_t)(j - 3) * D * D; gn = (const GAS float*)ARG_IN(1) + (2 + (j - 3)) * D; ldw = 1024; ncols = 1024; mul = 0.125f * 1.4426950408889634f; cm = WSP(unsigned, WS_COLMAX2) + (2 + (j - 3)) * 1024; }
            const int nstrip = ncols / 64, ntask = nstrip * (D / 64);
            int first = (gw - base) % NGW; if (first < 0) first += NGW;
            for (int task = first; task < ntask; task += NGW) { const int strip = task % nstrip, kc = task / nstrip; const int n = strip * 64 + lane; float mx = 0.f;
#pragma unroll 16
                for (int kk = 0; kk < 64; ++kk) { const int k = kc * 64 + kk; mx = fmaxf(mx, fabsf(W[(size_t)k * ldw + n] * gn[k])); }
                const unsigned old = __hip_atomic_fetch_max(cm + n, __builtin_bit_cast(unsigned, mx * mul), __ATOMIC_RELAXED, __HIP_MEMORY_SCOPE_AGENT); asm volatile("" :: "v"(old)); }
            base = (base + ntask) % NGW;
        }
    }
    xcd_barrier(bar, wave_s);

    layer_body<0>(lds, bar, pend, cnt_l, G, bx, vcu, NGW, wave_s);
    layer_body<1>(lds, bar, pend, cnt_l, G, bx, vcu, NGW, wave_s);
    layer_body<2>(lds, bar, pend, cnt_l, G, bx, vcu, NGW, wave_s);
    layer_body<3>(lds, bar, pend, cnt_l, G, bx, vcu, NGW, wave_s);
}

extern "C" void kernel_launch(void* const* d_in, const int* in_sizes, int n_in, void* d_out, int out_size, void* d_ws, size_t ws_size, hipStream_t stream) {
    static int grid = 0;
    if (grid == 0) {
        if (n_in != 15 || out_size != M * D || ws_size < WS_END) { fprintf(stderr, "kernel_launch: unexpected shapes (n_in %d out %d ws %zu)\n", n_in, out_size, ws_size); grid = -1; return; }
        int dev = 0, cus = 0, per_cu = 0;
        if (hipGetDevice(&dev) != hipSuccess || hipDeviceGetAttribute(&cus, hipDeviceAttributeMultiprocessorCount, dev) != hipSuccess) { grid = -1; return; }
        if (hipFuncSetAttribute((const void*)yoco_fwd, hipFuncAttributeMaxDynamicSharedMemorySize, LDS_BYTES) != hipSuccess) { fprintf(stderr, "kernel_launch: hipFuncSetAttribute failed\n"); grid = -1; return; }
        if (hipOccupancyMaxActiveBlocksPerMultiprocessor(&per_cu, (const void*)yoco_fwd, NTHREADS, LDS_BYTES) != hipSuccess || per_cu < 1) { fprintf(stderr, "kernel_launch: occupancy query says %d\n", per_cu); }
        (void)hipGetLastError();
        grid = cus;
    }
    if (grid < 0) return;
    (void)hipMemsetAsync((char*)d_ws + WS_CTL, 0, CTL_ZERO_BYTES, stream);
    Args a{};
    for (int i = 0; i < 15; ++i) a.in[i] = (const float*)d_in[i];
    a.out = (float*)d_out; a.ws = (unsigned char*)d_ws;
    hipLaunchKernelGGL(yoco_fwd, dim3(grid), dim3(NTHREADS), LDS_BYTES, stream, a);
}
```

```cpp
#include <hip/hip_runtime.h>
#include <cstdio>
#include <cstdint>

#define LAS __attribute__((address_space(3)))
#define GAS __attribute__((address_space(1)))
typedef unsigned short bf16_t;
typedef short bf16x8 __attribute__((ext_vector_type(8)));
typedef float f32x2 __attribute__((ext_vector_type(2)));
typedef float f32x4 __attribute__((ext_vector_type(4)));
typedef float f32x16 __attribute__((ext_vector_type(16)));
typedef unsigned u32x2 __attribute__((ext_vector_type(2)));
typedef unsigned u32x4 __attribute__((ext_vector_type(4)));
typedef int i32x4 __attribute__((ext_vector_type(4)));
typedef __bf16 bf16x2_t __attribute__((ext_vector_type(2)));

constexpr int D = 1024, BATCH = 32, SEQ = 2048, M = BATCH * SEQ;
constexpr int DFF = 2816, DFFE = 3584, NE = 8, NH = 16;
constexpr int CAP = 2 * M + NE * 256;
constexpr int CHUNK_BLKS = 260;
constexpr float RMS_EPS = 1e-6f;
#ifndef FP8_MASK
#define FP8_MASK 14
#endif
#ifndef INT8_UP0
#define INT8_UP0 1
#endif
#ifndef INT8_PROJ
#define INT8_PROJ 1
#endif
constexpr float W8_UP = 64.f, W8_DN = 128.f, H8_SC = 8.f;
constexpr int NWAVES = 8, NTHREADS = 512;

constexpr size_t MiB = 1u << 20;
constexpr size_t WS_CTL = 0, CTL_ZERO_BYTES = 80 * 1024;
constexpr size_t WS_COLMAX2 = 65536;
constexpr size_t WS_WSCALE2 = 1 * MiB + 40960;
constexpr size_t WS_COLMAX = 32768;
constexpr size_t WS_WSCALE = 1 * MiB + 16384;
constexpr size_t WS_ASCALE = 3 * MiB + 786432;
constexpr size_t WS_TILECNT = 1 * MiB;
constexpr size_t WS_ROUTE_E = 1 * MiB + 65536;
constexpr size_t WS_ROUTE_G = 2 * MiB;
constexpr size_t WS_SLOT_OF = 2 * MiB + 524288;
constexpr size_t WS_GATE_SLOT = 3 * MiB;
constexpr size_t WS_WPOOL = 4 * MiB;
constexpr size_t WS_WK = 5 * MiB, WS_WV = 7 * MiB, WS_WQ = 9 * MiB, WS_WO = 13 * MiB;
constexpr size_t WS_WFI = 17 * MiB;
constexpr size_t WS_WFO = 39 * MiB;
constexpr size_t WS_WMI = 50 * MiB;
constexpr size_t WS_WMO = 274 * MiB;
constexpr size_t WS_XN = 386 * MiB;
constexpr size_t WS_K = 514 * MiB, WS_VT = 642 * MiB;
constexpr size_t WS_XS = 770 * MiB;
constexpr size_t WS_R = 1030 * MiB;
constexpr size_t WS_XS8 = 1485 * MiB;
constexpr size_t WS_XB = 1485 * MiB;
constexpr size_t WS_TOS = 386 * MiB + 64 * MiB;

constexpr size_t WS_DELTA = 1616 * MiB;
constexpr size_t WS_END = 1744 * MiB;
static_assert(WS_XS8 + (size_t)CAP * D <= WS_END, "xs8");
static_assert(WS_XS + (size_t)CAP * D * 2 <= WS_R, "xs");
static_assert(WS_R + (size_t)CHUNK_BLKS * 256 * DFFE * 2 <= WS_END, "moe hidden chunk");
static_assert(WS_R + (size_t)M * DFF * 2 <= WS_END, "dense hidden");
static_assert(WS_R + (size_t)CAP * DFFE <= WS_XS8, "fp8 moe hidden, one chunk");
static_assert(WS_WMO + (size_t)2 * 8 * 1024 * 3584 * 2 <= WS_XN, "weights");

constexpr int STAGE_BYTES_LDS = 131072;
constexpr int LCTL_OFF = STAGE_BYTES_LDS;
constexpr int LDS_BYTES = 147456;

__device__ __forceinline__ unsigned cvtpk(float lo, float hi) { f32x2 v = {lo, hi}; bf16x2_t b = __builtin_convertvector(v, bf16x2_t); return __builtin_bit_cast(unsigned, b); }
__device__ __forceinline__ unsigned pk4_fp8(float a, float b, float c, float d) { int w = __builtin_amdgcn_cvt_pk_fp8_f32(a, b, 0, false); w = __builtin_amdgcn_cvt_pk_fp8_f32(c, d, w, true); return (unsigned)w; }
__device__ __forceinline__ unsigned pk4_i8(float a, float b, float c, float d) {
    const int i0 = (int)__builtin_rintf(__builtin_amdgcn_fmed3f(a, -127.f, 127.f)), i1 = (int)__builtin_rintf(__builtin_amdgcn_fmed3f(b, -127.f, 127.f));
    const int i2 = (int)__builtin_rintf(__builtin_amdgcn_fmed3f(c, -127.f, 127.f)), i3 = (int)__builtin_rintf(__builtin_amdgcn_fmed3f(d, -127.f, 127.f));
    return (unsigned)(i0 & 255) | ((unsigned)(i1 & 255) << 8) | ((unsigned)(i2 & 255) << 16) | ((unsigned)i3 << 24); }
__device__ __forceinline__ float wave_max(float v) {
#pragma unroll
    for (int o = 1; o < 64; o <<= 1) v = fmaxf(v, __shfl_xor(v, o));
    return v;
}
__device__ __forceinline__ float bf_lo(unsigned w) { return __builtin_bit_cast(float, w << 16); }
__device__ __forceinline__ float bf_hi(unsigned w) { return __builtin_bit_cast(float, w & 0xffff0000u); }
__device__ __forceinline__ f32x4 ld4(const float* p) { return *(const GAS f32x4*)p; }
__device__ __forceinline__ f32x4 ld4(const bf16_t* p) { const u32x2 w = *(const GAS u32x2*)p; return (f32x4){bf_lo(w.x), bf_hi(w.x), bf_lo(w.y), bf_hi(w.y)}; }
__device__ __forceinline__ f32x2 ld2(const float* p) { return *(const GAS f32x2*)p; }
__device__ __forceinline__ f32x2 ld2(const bf16_t* p) { const unsigned w = *(const GAS unsigned*)p; return (f32x2){bf_lo(w), bf_hi(w)}; }
__device__ __forceinline__ f32x4 ldraw4(const float* p) { return *(const GAS f32x4*)p; }
__device__ __forceinline__ u32x2 ldraw4(const bf16_t* p) { return *(const GAS u32x2*)p; }
__device__ __forceinline__ f32x4 cvt4(f32x4 v) { return v; }
__device__ __forceinline__ f32x4 cvt4(u32x2 w) { return (f32x4){bf_lo(w.x), bf_hi(w.x), bf_lo(w.y), bf_hi(w.y)}; }
template <class T> struct Raw4; template <> struct Raw4<float> { typedef f32x4 t; }; template <> struct Raw4<bf16_t> { typedef u32x2 t; };
__device__ __forceinline__ float wave_sum(float v) {
#pragma unroll
    for (int o = 1; o < 64; o <<= 1) v += __shfl_xor(v, o);
    return v;
}
#define LDS_WAIT() asm volatile("s_waitcnt lgkmcnt(0)" ::: "memory")
__device__ __forceinline__ int fresh_tid(int wave_s) { int w = wave_s, z = 0; asm volatile("" : "+s"(w), "+s"(z)); return w * 64 + (int)__builtin_amdgcn_mbcnt_hi(~0u, __builtin_amdgcn_mbcnt_lo(~0u, (unsigned)z)); }
#define RLX_AGENT __ATOMIC_RELAXED, __HIP_MEMORY_SCOPE_AGENT

#define XB_TMO      128
#define XB_XCNT(j)  (256  + 64 * (j))
#define XB_XSUB(j)  (1280 + 64 * (j))
#define XB_XGEN(j)  (2304 + 64 * (j))
#define XB_TOP      3328
#define XB_TOPGEN   3392
#define XCD_BAR_WORDS 3456
#define XB_SPIN_CAP (1u << 22)
__device__ __forceinline__ unsigned xb_ld(unsigned* p)              { return __hip_atomic_load(p, __ATOMIC_RELAXED, __HIP_MEMORY_SCOPE_AGENT); }
__device__ __forceinline__ unsigned xb_add(unsigned* p, unsigned v) { return __hip_atomic_fetch_add(p, v, __ATOMIC_RELAXED, __HIP_MEMORY_SCOPE_AGENT); }
__device__ __forceinline__ unsigned xb_xcc_id() { return (unsigned)__builtin_amdgcn_s_getreg((3 << 11) | 20) & 0xFu; }
#define XB_SPIN(cond, bar) do { unsigned _sp = 0; while (cond) { __builtin_amdgcn_s_sleep(1); \
    if ((++_sp & 255u) == 0u) { if (xb_ld(&(bar)[XB_TMO])) break; if (_sp > XB_SPIN_CAP) { atomicAdd(&(bar)[XB_TMO], 1u); break; } } } } while (0)
struct XcdBarrier { unsigned* bar; unsigned x; volatile LAS unsigned* st; };
__device__ __forceinline__ XcdBarrier xcd_barrier_post(unsigned* bar, volatile LAS unsigned* st) {
    XcdBarrier b; b.bar = bar; b.x = xb_xcc_id(); b.st = st;
    if (threadIdx.x == 0) (void)xb_add(&bar[XB_XCNT(b.x)], 1u);
    return b;
}
__device__ __forceinline__ void xcd_barrier_complete(unsigned* bar, unsigned x, unsigned& nloc, unsigned& nx) {
    const unsigned G = gridDim.x * gridDim.y * gridDim.z;
    unsigned sum, cnt, mine, sp = 0u;
    for (;;) {
        sum = 0u; cnt = 0u; mine = 0u;
#pragma unroll
        for (unsigned j = 0; j < 16; ++j) { const unsigned c = xb_ld(&bar[XB_XCNT(j)]); sum += c; cnt += (c > 0u) ? 1u : 0u; mine = (j == x) ? c : mine; }
        if (sum == G) break;
        __builtin_amdgcn_s_sleep(1);
        if ((++sp & 255u) == 0u) { if (xb_ld(&bar[XB_TMO])) break; if (sp > XB_SPIN_CAP) { atomicAdd(&bar[XB_TMO], 1u); break; } }
    }
    nloc = mine > 0u ? mine : 1u; nx = cnt > 0u ? cnt : 1u;
}
__device__ __forceinline__ void xcd_barrier(const XcdBarrier& b, int wave_s) {
    asm volatile("s_waitcnt vmcnt(0)" ::: "memory");
    __syncthreads();
    if (fresh_tid(wave_s) == 0) {
        unsigned* bar = b.bar;
        __builtin_amdgcn_s_waitcnt(0);
        unsigned nloc = b.st[0], nx = b.st[1];
        if (nloc == 0u) { xcd_barrier_complete(bar, b.x, nloc, nx); b.st[0] = nloc; b.st[1] = nx; }
        const unsigned old = xb_add(&bar[XB_XSUB(b.x)], 1u);
        const unsigned gen = old / nloc;
        if (old + 1u == (gen + 1u) * nloc) {
            __builtin_amdgcn_fence(__ATOMIC_RELEASE, "agent");
            asm volatile("s_waitcnt vmcnt(0)" ::: "memory");
            const unsigned og = xb_add(&bar[XB_TOP], 1u);
            const unsigned tg = og / nx;
            if (og + 1u == (tg + 1u) * nx) xb_add(&bar[XB_TOPGEN], 1u);
            else XB_SPIN(xb_ld(&bar[XB_TOPGEN]) == tg, bar);
            __builtin_amdgcn_fence(__ATOMIC_ACQUIRE, "agent");
            xb_add(&bar[XB_XGEN(b.x)], 1u);
            asm volatile("s_waitcnt vmcnt(0)" ::: "memory");
        } else {
            XB_SPIN(xb_ld(&bar[XB_XGEN(b.x)]) == gen, bar);
            __builtin_amdgcn_fence(__ATOMIC_ACQUIRE, "agent");
            asm volatile("s_waitcnt vmcnt(0)" ::: "memory");
        }
    }
    __syncthreads();
}

namespace pg8 {
constexpr int BM = 256, BK = 64, HALF = 128, HTB = HALF * BK * 2, NXCD = 8, WGM = 8;
__host__ __device__ __forceinline__ int lds_byte(int r, int c) { const int st = (r >> 4) * 2 + (c >> 5), rr = r & 15, cc = c & 31, ob = rr * 64 + cc * 2; return st * 1024 + (ob ^ (((ob >> 9) & 1) << 5)); }
__host__ __device__ __forceinline__ void stage_rc(int b, int& R, int& C) { const int st = b / 1024, sb = b % 1024, swz = sb ^ (((sb >> 9) & 1) << 5); R = (st >> 1) * 16 + swz / 64; C = (st & 1) * 32 + (swz % 64) / 2; }
__host__ __device__ __forceinline__ int perm32(int rho) { const int n = rho >> 4, i = rho & 15; return 8 * (i >> 2) + 4 * n + (i & 3); }

typedef int i32x8 __attribute__((ext_vector_type(8)));
__device__ __forceinline__ i32x8 cat8(bf16x8 lo, bf16x8 hi) { const i32x4 a = __builtin_bit_cast(i32x4, lo), b = __builtin_bit_cast(i32x4, hi); return __builtin_shufflevector(a, b, 0, 1, 2, 3, 4, 5, 6, 7); }
struct Unit { const char* A; const char* B; int pm, pn, aux; };
struct GemmK { int K, lda, ldb; };

__device__ __forceinline__ bool smap(long L, int nM, int nN, int& pm, int& pn) {
    const int nwg = nM * nN; if (L >= nwg) return false;
    int wgid = (int)L; { const int q = nwg / NXCD, r = nwg % NXCD, xcd = wgid % NXCD, off = wgid / NXCD; wgid = (xcd < r ? xcd * (q + 1) : r * (q + 1) + (xcd - r) * q) + off; }
    const int nig = WGM * nN, gid = wgid / nig, fm = gid * WGM, gsz = (nM - fm) < WGM ? (nM - fm) : WGM;
    pm = fm + ((wgid % nig) % gsz); pn = (wgid % nig) / gsz; return true;
}

template <class Epi, class Sched, bool ALIGN_EPI, int MODE = 0, bool GATHER = false>
__device__ __forceinline__ void gemm_phase(LAS unsigned char* lds, const GemmK g, const Sched& S, const Epi& E, int wave_s) {
    const int tid = fresh_tid(wave_s);
    const int wid = __builtin_amdgcn_readfirstlane(tid >> 6), lane = tid & 63, wr = wid >> 2, wc = wid & 3, fr = lane & 15, fq = lane >> 4;
    constexpr bool FP8 = (MODE == 1);
    const int K = g.K, nt = K / BK;
    unsigned voffA[2], voffB[2];
#pragma unroll
    for (int i = 0; i < 2; ++i) { int R, C; stage_rc(tid * 16 + i * 8192, R, C); const int Rb = Epi::PERM ? ((R & ~31) + perm32(R & 31)) : R;
        voffA[i] = (unsigned)(R * g.lda + C) * 2u; voffB[i] = (unsigned)(Rb * g.ldb + C) * 2u; }
    unsigned vG[2][2], vN[2][2];
    const size_t kstep = (size_t)(BK * 2);
    const size_t hstepA = (size_t)HALF * g.lda * 2, hstepB = (size_t)HALF * g.ldb * 2;
    const unsigned ldsw = (unsigned)wid * 1024u;
    const int aoff = lds_byte(wr * 64 + fr, fq * 8), boff = lds_byte(wc * 32 + fr, fq * 8);
#define PG8_SA(b, h) (((b) * 2 + (h)) * HTB)
#define PG8_SB(b, h) ((4 + (b) * 2 + (h)) * HTB)
#define PG8_STAGE(bufoff, gbase, voff) do { _Pragma("unroll") for (int _i = 0; _i < 2; ++_i) \
        __builtin_amdgcn_global_load_lds((const unsigned*)((const char*)(gbase) + (voff)[_i]), (LAS unsigned*)(lds + (bufoff) + ldsw + _i * 8192), 16, 0, 0); } while (0)
#define PG8_STAGE_A(bufoff, gbase, h, nx) do { if constexpr (GATHER) { unsigned _v[2] = { (nx) ? vN[h][0] : vG[h][0], (nx) ? vN[h][1] : vG[h][1] }; PG8_STAGE(bufoff, gbase, _v); } \
        else PG8_STAGE(bufoff, (gbase) + (h) * hstepA, voffA); } while (0)
#define PG8_LD8(p) __builtin_shufflevector(*(const LAS i32x4*)(p), *(const LAS i32x4*)((p) + 1024), 0, 1, 2, 3, 4, 5, 6, 7)
#define PG8_LDA(dst, b, h) do { if constexpr (FP8) { _Pragma("unroll") for (int m = 0; m < 4; ++m) dst##8[m] = PG8_LD8(lds + PG8_SA(b, h) + aoff + m * 2048); } \
        else { _Pragma("unroll") for (int m = 0; m < 4; ++m) _Pragma("unroll") for (int k = 0; k < 2; ++k) dst[m][k] = *(const LAS bf16x8*)(lds + PG8_SA(b, h) + aoff + m * 2048 + k * 1024); } } while (0)
#define PG8_LDB(dst, b, h) do { if constexpr (FP8) { _Pragma("unroll") for (int n = 0; n < 2; ++n) dst##8[n] = PG8_LD8(lds + PG8_SB(b, h) + boff + n * 2048); } \
        else { _Pragma("unroll") for (int n = 0; n < 2; ++n) _Pragma("unroll") for (int k = 0; k < 2; ++k) dst[n][k] = *(const LAS bf16x8*)(lds + PG8_SB(b, h) + boff + n * 2048 + k * 1024); } } while (0)
#define PG8_MMA(ai, bj, At, Bt) do { __builtin_amdgcn_s_setprio(1); _Pragma("unroll") for (int m = 0; m < 4; ++m) _Pragma("unroll") for (int n = 0; n < 2; ++n) { \
        if constexpr (FP8) asm volatile("v_mfma_f32_16x16x128_f8f6f4 %0, %1, %2, %0" : "+v"(acc[ai][bj][m][n]) : "v"(Bt##8[n]), "v"(At##8[m])); \
        else if constexpr (MODE == 2) { _Pragma("unroll") for (int k = 0; k < 2; ++k) acc[ai][bj][m][n] = __builtin_bit_cast(f32x4, __builtin_amdgcn_mfma_i32_16x16x64_i8(__builtin_bit_cast(i32x4, Bt[n][k]), __builtin_bit_cast(i32x4, At[m][k]), __builtin_bit_cast(i32x4, acc[ai][bj][m][n]), 0, 0, 0)); } \
        else { _Pragma("unroll") for (int k = 0; k < 2; ++k) acc[ai][bj][m][n] = __builtin_amdgcn_mfma_f32_16x16x32_bf16(Bt[n][k], At[m][k], acc[ai][bj][m][n], 0, 0, 0); } } \
        __builtin_amdgcn_s_setprio(0); } while (0)
#define PG8_WAIT_V(n) asm volatile("s_waitcnt vmcnt(" #n ")" ::: "memory")
#define PG8_WAIT_L(n) asm volatile("s_waitcnt lgkmcnt(" #n ")" ::: "memory")
#define PG8_BAR __builtin_amdgcn_s_barrier()
#define PG8_SCHED __builtin_amdgcn_sched_barrier(0)
    Unit cur, nxt; int ui = 0;
    if (!S.next(0, cur)) return;
    f32x4 acc[2][2][4][2];
#pragma unroll
    for (int a = 0; a < 2; ++a)
#pragma unroll
        for (int b = 0; b < 2; ++b)
#pragma unroll
            for (int m = 0; m < 4; ++m)
#pragma unroll
                for (int n = 0; n < 2; ++n) acc[a][b][m][n] = (f32x4){0.f, 0.f, 0.f, 0.f};
    bf16x8 At[4][2], B0[2][2], B1[2][2]; i32x8 At8[4], B08[2], B18[2];
    const char* cA = cur.A; const char* cB = cur.B;
    if constexpr (GATHER) {
#pragma unroll
        for (int i = 0; i < 2; ++i) { int R, C; stage_rc(tid * 16 + i * 8192, R, C);
#pragma unroll
            for (int h = 0; h < 2; ++h) { vG[h][i] = (unsigned)S.tos[(size_t)cur.aux * 256 + h * HALF + R] * (unsigned)(g.lda * 2) + (unsigned)C * 2u; vN[h][i] = vG[h][i]; } } }
    PG8_STAGE(PG8_SB(0, 0), cB, voffB); PG8_STAGE(PG8_SB(0, 1), cB + hstepB, voffB); PG8_STAGE_A(PG8_SA(0, 0), cA, 0, false); PG8_STAGE_A(PG8_SA(0, 1), cA, 1, false);
    if (wr == 1) PG8_BAR;
    PG8_WAIT_V(2); PG8_BAR;
    PG8_STAGE(PG8_SB(1, 0), cB + kstep, voffB); PG8_STAGE_A(PG8_SA(1, 0), cA + kstep, 0, false); PG8_STAGE(PG8_SB(1, 1), cB + hstepB + kstep, voffB);
    PG8_WAIT_V(6); PG8_BAR;
    for (;;) {
        const bool has_next = S.next(ui + 1, nxt);
        const char* nA = has_next ? nxt.A : cA; const char* nB = has_next ? nxt.B : cB;
        if constexpr (GATHER) { if (has_next && wid < 4) __builtin_amdgcn_global_load_lds((const unsigned*)(S.tos + (size_t)nxt.aux * 256 + wid * 64 + lane), (LAS unsigned*)(S.idxl + ((ui + 1) & 1) * 256 + wid * 64), 4, 0, 0); }
        for (int t = 0; t < nt; t += 2) {
            const bool last = (t == nt - 2);
            const char* a1 = cA + (size_t)(t + 1) * kstep;
            const char* a2 = last ? nA : cA + (size_t)(t + 2) * kstep; const char* b2 = last ? nB : cB + (size_t)(t + 2) * kstep;
            const char* a3 = a2 + kstep; const char* b3 = b2 + kstep;
            if constexpr (GATHER) { if (last) {
                    const LAS int* ib = S.idxl + ((ui + 1) & 1) * 256;
#pragma unroll
                    for (int i = 0; i < 2; ++i) { int R, C; stage_rc(tid * 16 + i * 8192, R, C);
#pragma unroll
                        for (int h = 0; h < 2; ++h) vN[h][i] = has_next ? (unsigned)ib[h * HALF + R] * (unsigned)(g.lda * 2) + (unsigned)C * 2u : vG[h][i]; } } }
            PG8_LDB(B0, 0, 0); PG8_LDB(B1, 0, 1); PG8_SCHED; PG8_LDA(At, 0, 0); PG8_STAGE_A(PG8_SA(1, 1), a1, 1, false);
            PG8_WAIT_V(8); PG8_WAIT_L(0); PG8_BAR; PG8_MMA(0, 0, At, B0); PG8_MMA(0, 1, At, B1); PG8_BAR; PG8_SCHED;
            PG8_LDA(At, 0, 1); PG8_STAGE(PG8_SB(0, 0), b2, voffB); PG8_STAGE(PG8_SB(0, 1), b2 + hstepB, voffB); PG8_STAGE_A(PG8_SA(0, 0), a2, 0, last);
            PG8_WAIT_V(8); PG8_WAIT_L(0); PG8_BAR; PG8_MMA(1, 0, At, B0); PG8_MMA(1, 1, At, B1); PG8_BAR; PG8_SCHED;
            PG8_LDB(B0, 1, 0); PG8_LDB(B1, 1, 1); PG8_SCHED; PG8_LDA(At, 1, 0); PG8_STAGE_A(PG8_SA(0, 1), a2, 1, last);
            PG8_WAIT_V(8); PG8_WAIT_L(0); PG8_BAR; PG8_MMA(0, 0, At, B0); PG8_MMA(0, 1, At, B1); PG8_BAR; PG8_SCHED;
            PG8_LDA(At, 1, 1); PG8_STAGE(PG8_SB(1, 0), b3, voffB); PG8_STAGE(PG8_SB(1, 1), b3 + hstepB, voffB); PG8_STAGE_A(PG8_SA(1, 0), a3, 0, last);
            PG8_WAIT_V(8); PG8_WAIT_L(0); PG8_BAR; PG8_MMA(1, 0, At, B0); PG8_MMA(1, 1, At, B1); PG8_BAR; PG8_SCHED;
        }
        if constexpr (ALIGN_EPI) { if (wr == 0) PG8_BAR; }
        if constexpr (FP8) asm volatile("s_nop 15\n\ts_nop 15" ::: "memory");
        E(acc, cur, wr, wc, fr, fq);
        if (!has_next) break;
#pragma unroll
        for (int a = 0; a < 2; ++a)
#pragma unroll
            for (int b = 0; b < 2; ++b)
#pragma unroll
                for (int m = 0; m < 4; ++m)
#pragma unroll
                    for (int n = 0; n < 2; ++n) acc[a][b][m][n] = (f32x4){0.f, 0.f, 0.f, 0.f};
        cur = nxt; cA = nA; cB = nB; ++ui;
        if constexpr (GATHER) {
#pragma unroll
            for (int h = 0; h < 2; ++h) { vG[h][0] = vN[h][0]; vG[h][1] = vN[h][1]; } }
        if constexpr (ALIGN_EPI) { if (wr == 1) PG8_BAR; }
    }
    PG8_WAIT_V(0);
    if constexpr (!ALIGN_EPI) { if (wr == 0) PG8_BAR; }
    PG8_BAR;
#undef PG8_SA
#undef PG8_SB
#undef PG8_STAGE
#undef PG8_STAGE_A
#undef PG8_LDA
#undef PG8_LDB
#undef PG8_MMA
#undef PG8_WAIT_V
#undef PG8_WAIT_L
#undef PG8_BAR
#undef PG8_SCHED
}

struct DenseOrder {
    int nM, nN, G, c; const char* A; const char* B; size_t at, bt;
    __device__ __forceinline__ bool next(int i, Unit& u) const { int pm, pn; if (!smap((long)i * G + c, nM, nN, pm, pn)) return false;
        u.A = A + (size_t)pm * at; u.B = B + (size_t)pn * bt; u.pm = pm; u.pn = pn; u.aux = 0; return true; }
};
struct PoolOrder {
    int G, c; const char* P; const char* W;
    __device__ __forceinline__ bool next(int i, Unit& u) const { int pm, pn; if (!smap((long)i * G + c, M / 256, 4, pm, pn)) return false;
        u.A = P + (size_t)pm * (256 * 1024 * 2) + (size_t)pn * 512; u.B = W + (size_t)pn * (256 * 256 * 2); u.pm = pm; u.pn = pn; u.aux = 0; return true; }
};
struct ProjOrder {
    int njobs, G, c; const char* ws; size_t qoff, tb;
    __device__ __forceinline__ bool next(int i, Unit& u) const {
        const long L = (long)i * G + c; if (L >= (long)njobs * 1024) return false;
        const int job = (int)(L >> 10), l = (int)(L & 1023); const int kind = (njobs == 1) ? 1 : job;
        const size_t woff = WS_WK + (size_t)(kind == 1) * (WS_WQ + qoff - WS_WK) + (size_t)(kind == 2) * (WS_WV - WS_WK);
        int pm, pn;
        if (kind == 2) { smap(l, 4, 256, pm, pn); u.A = ws + woff + (size_t)pm * tb; u.B = ws + WS_XN + (size_t)pn * tb; }
        else { smap(l, 256, 4, pm, pn); u.A = ws + WS_XN + (size_t)pm * tb; u.B = ws + woff + (size_t)pn * tb; }
        u.pm = pm; u.pn = pn; u.aux = kind; return true; }
};
struct MoeOrder {
    int nM, nN, G, c, blk0, a_rel; const char* A; const char* B; size_t at, bt, be; const LAS int* pend;
    __device__ __forceinline__ bool next(int i, Unit& u) const { int pm, pn; if (!smap((long)i * G + c, nM, nN, pm, pn)) return false;
        const int b = blk0 + pm; int e = 0;
#pragma unroll
        for (int j = 0; j < 7; ++j) e += (b >= pend[j]) ? 1 : 0;
        e = __builtin_amdgcn_readfirstlane(e);
        u.A = A + (size_t)(a_rel ? pm : b) * at; u.B = B + (size_t)e * be + (size_t)pn * bt; u.pm = a_rel ? b : pm; u.pn = pn; u.aux = 0; return true; }
};

struct MoeGatherOrder {
    int nM, nN, G, c, blk0; const char* A; const char* B; size_t bt, be; const LAS int* pend; const int* tos; LAS int* idxl;
    __device__ __forceinline__ bool next(int i, Unit& u) const { int pm, pn; if (!smap((long)i * G + c, nM, nN, pm, pn)) return false;
        const int b = blk0 + pm; int e = 0;
#pragma unroll
        for (int j = 0; j < 7; ++j) e += (b >= pend[j]) ? 1 : 0;
        e = __builtin_amdgcn_readfirstlane(e);
        u.A = A; u.B = B + (size_t)e * be + (size_t)pn * bt; u.pm = pm; u.pn = pn; u.aux = b; return true; }
};
struct EpiPool {
    static constexpr bool PERM = false;
    const float* xin; float* out; const float* scale; float mul;
    __device__ __forceinline__ void operator()(const f32x4 (&acc)[2][2][4][2], const Unit& u, int wr, int wc, int fr, int fq) const {
        const int row0 = u.pm * BM + wr * 64 + fr, col0 = u.pn * BM + wc * 32 + 4 * fq;
        f32x4 sv[2][2];
#pragma unroll
        for (int bj = 0; bj < 2; ++bj)
#pragma unroll
            for (int n = 0; n < 2; ++n) sv[bj][n] = *(const f32x4*)(scale + col0 + bj * HALF + n * 16) * mul;
#pragma unroll
        for (int ai = 0; ai < 2; ++ai)
#pragma unroll
            for (int m = 0; m < 4; ++m) { const size_t off = (size_t)(row0 + ai * HALF + m * 16) * D + col0;
#pragma unroll
                for (int bj = 0; bj < 2; ++bj)
#pragma unroll
                    for (int n = 0; n < 2; ++n) { const f32x4 xv = *(const f32x4*)(xin + off + bj * HALF + n * 16); *(f32x4*)(out + off + bj * HALF + n * 16) = xv + sv[bj][n] * acc[ai][bj][m][n]; }
                asm volatile("" ::: "memory"); }
    }
};
struct EpiDelta {
    static constexpr bool PERM = true;
    bf16_t* DL; const float* scale;
    __device__ __forceinline__ void operator()(const f32x4 (&acc)[2][2][4][2], const Unit& u, int wr, int wc, int fr, int fq) const {
        const int row0 = u.pm * BM + wr * 64 + fr, col0 = u.pn * BM + wc * 32 + 8 * fq;
        f32x4 sv[2][2];
#pragma unroll
        for (int bj = 0; bj < 2; ++bj) { sv[bj][0] = scale ? *(const f32x4*)(scale + col0 + bj * HALF) : (f32x4){1.f, 1.f, 1.f, 1.f}; sv[bj][1] = scale ? *(const f32x4*)(scale + col0 + bj * HALF + 4) : (f32x4){1.f, 1.f, 1.f, 1.f}; }
#pragma unroll
        for (int ai = 0; ai < 2; ++ai)
#pragma unroll
            for (int m = 0; m < 4; ++m) { bf16_t* rowp = DL + (size_t)(row0 + ai * HALF + m * 16) * D + col0;
#pragma unroll
                for (int bj = 0; bj < 2; ++bj) { const f32x4 v0 = acc[ai][bj][m][0] * sv[bj][0], v1 = acc[ai][bj][m][1] * sv[bj][1];
                    u32x4 w; w.x = cvtpk(v0[0], v0[1]); w.y = cvtpk(v0[2], v0[3]); w.z = cvtpk(v1[0], v1[1]); w.w = cvtpk(v1[2], v1[3]);
                    *(u32x4*)(rowp + bj * HALF) = w; } }
    }
};
template <class XT>
struct EpiResidD {
    static constexpr bool PERM = true;
    const XT* xsrc; bf16_t* out; const bf16_t* DL; float mul;
    __device__ __forceinline__ void operator()(const f32x4 (&acc)[2][2][4][2], const Unit& u, int wr, int wc, int fr, int fq) const {
        const int row0 = u.pm * BM + wr * 64 + fr, col0 = u.pn * BM + wc * 32 + 8 * fq;
#pragma unroll
        for (int ai = 0; ai < 2; ++ai)
#pragma unroll
            for (int m = 0; m < 4; ++m) { const size_t off0 = (size_t)(row0 + ai * HALF + m * 16) * D + col0;
#pragma unroll
                for (int bj = 0; bj < 2; ++bj) { const size_t off = off0 + bj * HALF; const f32x4 x0 = ld4(xsrc + off), x1 = ld4(xsrc + off + 4); const u32x4 d = *(const u32x4*)(DL + off);
                    const f32x4 d0 = {bf_lo(d.x), bf_hi(d.x), bf_lo(d.y), bf_hi(d.y)}, d1 = {bf_lo(d.z), bf_hi(d.z), bf_lo(d.w), bf_hi(d.w)};
                    const f32x4 o0 = x0 + d0 + acc[ai][bj][m][0] * mul, o1 = x1 + d1 + acc[ai][bj][m][1] * mul;
                    u32x4 w; w.x = cvtpk(o0[0], o0[1]); w.y = cvtpk(o0[2], o0[3]); w.z = cvtpk(o1[0], o1[1]); w.w = cvtpk(o1[2], o1[3]); *(u32x4*)(out + off) = w; }
                asm volatile("" ::: "memory"); }
    }
};
struct EpiResid {
    static constexpr bool PERM = false;
    float* x; float mul;
    __device__ __forceinline__ void operator()(const f32x4 (&acc)[2][2][4][2], const Unit& u, int wr, int wc, int fr, int fq) const {
        const int row0 = u.pm * BM + wr * 64 + fr, col0 = u.pn * BM + wc * 32 + 4 * fq;
#pragma unroll
        for (int ai = 0; ai < 2; ++ai)
#pragma unroll
            for (int m = 0; m < 4; ++m) { float* p = x + (size_t)(row0 + ai * HALF + m * 16) * D + col0;
#pragma unroll
                for (int bj = 0; bj < 2; ++bj)
#pragma unroll
                    for (int n = 0; n < 2; ++n) { const f32x4 xv = *(const f32x4*)(p + bj * HALF + n * 16); *(f32x4*)(p + bj * HALF + n * 16) = xv + acc[ai][bj][m][n] * mul; }
                asm volatile("" ::: "memory"); }
    }
};
__device__ __forceinline__ f32x2 swiglu2(f32x2 g, f32x2 u, float c1  , float kinv  ) {
    const f32x2 t = g * c1; f32x2 e; e.x = __builtin_amdgcn_exp2f(t.x); e.y = __builtin_amdgcn_exp2f(t.y);
    const f32x2 d = e * kinv + kinv; f32x2 r; r.x = __builtin_amdgcn_rcpf(d.x); r.y = __builtin_amdgcn_rcpf(d.y);
    return (g * u) * r;
}
__device__ __forceinline__ float silu_mul(float g, float u) { return g * u * __builtin_amdgcn_rcpf(1.0f + __builtin_amdgcn_exp2f(-1.4426950408889634f * g)); }
struct EpiSwiglu {
    static constexpr bool PERM = true;
    bf16_t* H; int ldc;
    __device__ __forceinline__ void operator()(const f32x4 (&acc)[2][2][4][2], const Unit& u, int wr, int wc, int fr, int fq) const {
        const int row0 = u.pm * BM + wr * 64 + fr, col0 = u.pn * HALF + wc * 32 + 8 * fq;
#pragma unroll
        for (int ai = 0; ai < 2; ++ai)
#pragma unroll
            for (int m = 0; m < 4; ++m) { bf16_t* rowp = H + (size_t)(row0 + ai * HALF + m * 16) * ldc + col0;
                const f32x4 g0 = acc[ai][0][m][0], g1 = acc[ai][0][m][1], u0 = acc[ai][1][m][0], u1 = acc[ai][1][m][1];
                const f32x2 h0 = swiglu2((f32x2){g0[0], g0[1]}, (f32x2){u0[0], u0[1]}, -1.4426950408889634f, 1.0f), h1 = swiglu2((f32x2){g0[2], g0[3]}, (f32x2){u0[2], u0[3]}, -1.4426950408889634f, 1.0f);
                const f32x2 h2 = swiglu2((f32x2){g1[0], g1[1]}, (f32x2){u1[0], u1[1]}, -1.4426950408889634f, 1.0f), h3 = swiglu2((f32x2){g1[2], g1[3]}, (f32x2){u1[2], u1[3]}, -1.4426950408889634f, 1.0f);
                u32x4 w; w.x = cvtpk(h0.x, h0.y); w.y = cvtpk(h1.x, h1.y); w.z = cvtpk(h2.x, h2.y); w.w = cvtpk(h3.x, h3.y);
                *(u32x4*)rowp = w; }
    }
};
struct EpiSwigluI8 {
    static constexpr bool PERM = true;
    bf16_t* H; int ldc; const float* ascale; const float* wscale;
    __device__ __forceinline__ void operator()(const f32x4 (&acc)[2][2][4][2], const Unit& u, int wr, int wc, int fr, int fq) const {
        const int row0 = u.pm * BM + wr * 64 + fr, col0 = u.pn * HALF + wc * 32 + 8 * fq;
        const float* wsp = wscale + u.pn * BM + wc * 32 + 8 * fq;
        const f32x4 sg0 = *(const f32x4*)wsp, sg1 = *(const f32x4*)(wsp + 4), su0 = *(const f32x4*)(wsp + HALF), su1 = *(const f32x4*)(wsp + HALF + 4);
#pragma unroll
        for (int ai = 0; ai < 2; ++ai)
#pragma unroll
            for (int m = 0; m < 4; ++m) { const int row = row0 + ai * HALF + m * 16; bf16_t* rowp = H + (size_t)row * ldc + col0; const float sa = ascale[row];
                const i32x4 ig0 = __builtin_bit_cast(i32x4, acc[ai][0][m][0]), ig1 = __builtin_bit_cast(i32x4, acc[ai][0][m][1]), iu0 = __builtin_bit_cast(i32x4, acc[ai][1][m][0]), iu1 = __builtin_bit_cast(i32x4, acc[ai][1][m][1]);
                const f32x4 g0 = __builtin_convertvector(ig0, f32x4) * (sg0 * sa), g1 = __builtin_convertvector(ig1, f32x4) * (sg1 * sa), u0 = __builtin_convertvector(iu0, f32x4) * (su0 * sa), u1 = __builtin_convertvector(iu1, f32x4) * (su1 * sa);
                const f32x2 h0 = swiglu2((f32x2){g0[0], g0[1]}, (f32x2){u0[0], u0[1]}, -1.4426950408889634f, 1.0f), h1 = swiglu2((f32x2){g0[2], g0[3]}, (f32x2){u0[2], u0[3]}, -1.4426950408889634f, 1.0f);
                const f32x2 h2 = swiglu2((f32x2){g1[0], g1[1]}, (f32x2){u1[0], u1[1]}, -1.4426950408889634f, 1.0f), h3 = swiglu2((f32x2){g1[2], g1[3]}, (f32x2){u1[2], u1[3]}, -1.4426950408889634f, 1.0f);
                u32x4 w; w.x = cvtpk(h0.x, h0.y); w.y = cvtpk(h1.x, h1.y); w.z = cvtpk(h2.x, h2.y); w.w = cvtpk(h3.x, h3.y);
                *(u32x4*)rowp = w; }
    }
};
struct EpiSwiglu8 {
    static constexpr bool PERM = true;
    unsigned char* H; int ldc; float gsc;
    __device__ __forceinline__ void operator()(const f32x4 (&acc)[2][2][4][2], const Unit& u, int wr, int wc, int fr, int fq) const {
        const int row0 = u.pm * BM + wr * 64 + fr, col0 = u.pn * HALF + wc * 32 + 8 * fq;
#pragma unroll
        for (int ai = 0; ai < 2; ++ai)
#pragma unroll
            for (int m = 0; m < 4; ++m) { unsigned char* rowp = H + (size_t)(row0 + ai * HALF + m * 16) * ldc + col0;
                const f32x4 g0 = acc[ai][0][m][0], g1 = acc[ai][0][m][1], u0 = acc[ai][1][m][0], u1 = acc[ai][1][m][1];
                const float c1 = -1.4426950408889634f * gsc, kinv = 1.0f / (gsc * gsc * H8_SC);
                const f32x2 h0 = swiglu2((f32x2){g0[0], g0[1]}, (f32x2){u0[0], u0[1]}, c1, kinv), h1 = swiglu2((f32x2){g0[2], g0[3]}, (f32x2){u0[2], u0[3]}, c1, kinv);
                const f32x2 h2 = swiglu2((f32x2){g1[0], g1[1]}, (f32x2){u1[0], u1[1]}, c1, kinv), h3 = swiglu2((f32x2){g1[2], g1[3]}, (f32x2){u1[2], u1[3]}, c1, kinv);
#define CL8(v) __builtin_amdgcn_fmed3f((v), -448.f, 448.f)
                u32x2 w; w.x = pk4_fp8(CL8(h0.x), CL8(h0.y), CL8(h1.x), CL8(h1.y)); w.y = pk4_fp8(CL8(h2.x), CL8(h2.y), CL8(h3.x), CL8(h3.y));
#undef CL8
                *(u32x2*)rowp = w; }
    }
};
struct EpiProj {
    static constexpr bool PERM = true;
    bf16_t *Kb, *Qb, *Vt;
    __device__ __forceinline__ void operator()(const f32x4 (&acc)[2][2][4][2], const Unit& u, int wr, int wc, int fr, int fq) const {
        bf16_t* base = (u.aux == 0) ? Kb : (u.aux == 1 ? Qb : Vt); const size_t ldc = (u.aux == 2) ? (size_t)M : (size_t)D;
        const int row0 = u.pm * BM + wr * 64 + fr, col0 = u.pn * BM + wc * 32 + 8 * fq;
#pragma unroll
        for (int ai = 0; ai < 2; ++ai)
#pragma unroll
            for (int m = 0; m < 4; ++m) { bf16_t* rowp = base + (size_t)(row0 + ai * HALF + m * 16) * ldc + col0;
#pragma unroll
                for (int bj = 0; bj < 2; ++bj) { const f32x4 v0 = acc[ai][bj][m][0], v1 = acc[ai][bj][m][1];
                    u32x4 w; w.x = cvtpk(v0[0], v0[1]); w.y = cvtpk(v0[2], v0[3]); w.z = cvtpk(v1[0], v1[1]); w.w = cvtpk(v1[2], v1[3]);
                    if (u.aux == 2) { bf16_t* p16 = rowp + bj * HALF - (fq & 1) * 8 + (fq & 1) * 4;
                        *(u32x2*)p16 = (u32x2){w.x, w.y}; *(u32x2*)(p16 + 8) = (u32x2){w.z, w.w}; }
                    else *(u32x4*)(rowp + bj * HALF) = w; } }
    }
};
struct EpiProjI8 {
    static constexpr bool PERM = true;
    bf16_t *Kb, *Qb, *Vt; const float* ascale; const float* wsc  ; int qsel;
    __device__ __forceinline__ void operator()(const f32x4 (&acc)[2][2][4][2], const Unit& u, int wr, int wc, int fr, int fq) const {
        bf16_t* base = (u.aux == 0) ? Kb : (u.aux == 1 ? Qb : Vt); const size_t ldc = (u.aux == 2) ? (size_t)M : (size_t)D;
        const float* rs; const float* cs; if (u.aux == 2) { rs = wsc + 1024; cs = ascale; } else { rs = ascale; cs = wsc + u.aux * (2048 + qsel * 1024); }
        const int row0 = u.pm * BM + wr * 64 + fr, col0 = u.pn * BM + wc * 32 + 8 * fq;
        f32x4 cv[2][2];
#pragma unroll
        for (int bj = 0; bj < 2; ++bj) { cv[bj][0] = *(const f32x4*)(cs + col0 + bj * HALF); cv[bj][1] = *(const f32x4*)(cs + col0 + bj * HALF + 4); }
#pragma unroll
        for (int ai = 0; ai < 2; ++ai)
#pragma unroll
            for (int m = 0; m < 4; ++m) { const int row = row0 + ai * HALF + m * 16; bf16_t* rowp = base + (size_t)row * ldc + col0; const float rv = rs[row];
#pragma unroll
                for (int bj = 0; bj < 2; ++bj) { const f32x4 v0 = __builtin_convertvector(__builtin_bit_cast(i32x4, acc[ai][bj][m][0]), f32x4) * (cv[bj][0] * rv), v1 = __builtin_convertvector(__builtin_bit_cast(i32x4, acc[ai][bj][m][1]), f32x4) * (cv[bj][1] * rv);
                    u32x4 w; w.x = cvtpk(v0[0], v0[1]); w.y = cvtpk(v0[2], v0[3]); w.z = cvtpk(v1[0], v1[1]); w.w = cvtpk(v1[2], v1[3]);
                    if (u.aux == 2) { bf16_t* p16 = rowp + bj * HALF - (fq & 1) * 8 + (fq & 1) * 4;
                        *(u32x2*)p16 = (u32x2){w.x, w.y}; *(u32x2*)(p16 + 8) = (u32x2){w.z, w.w}; }
                    else *(u32x4*)(rowp + bj * HALF) = w; } }
    }
};
struct EpiMoeDown {
    static constexpr bool PERM = true;
    bf16_t* Y; const float* gate; float osc;
    __device__ __forceinline__ void operator()(const f32x4 (&acc)[2][2][4][2], const Unit& u, int wr, int wc, int fr, int fq) const {
        const int row0 = u.pm * BM + wr * 64 + fr, col0 = u.pn * BM + wc * 32 + 8 * fq;
#pragma unroll
        for (int ai = 0; ai < 2; ++ai)
#pragma unroll
            for (int m = 0; m < 4; ++m) { const int row = row0 + ai * HALF + m * 16; const float gt = gate[row] * osc; bf16_t* rowp = Y + (size_t)row * D + col0;
#pragma unroll
                for (int bj = 0; bj < 2; ++bj) { const f32x4 v0 = acc[ai][bj][m][0] * gt, v1 = acc[ai][bj][m][1] * gt;
                    u32x4 w; w.x = cvtpk(v0[0], v0[1]); w.y = cvtpk(v0[2], v0[3]); w.z = cvtpk(v1[0], v1[1]); w.w = cvtpk(v1[2], v1[3]);
                    *(u32x4*)(rowp + bj * HALF) = w; } }
    }
};
}

__device__ __forceinline__ void tr_load(float (&tv)[32], const float* W, int ldw, int k0, int n0, int lane) {
    const GAS float* wp = (const GAS float*)W + (size_t)(k0 + (lane >> 5)) * ldw + n0 + (lane & 31);
#pragma unroll
    for (int i = 0; i < 32; ++i) tv[i] = wp[(size_t)(2 * i) * ldw];
}
__device__ __forceinline__ void tr_put(const float (&tv)[32], int k0, const float* gain, float mul, int mode  , unsigned char* WT, int ldk, int drow0, LAS float* scr, int lane,
                                       const unsigned* colmax = nullptr  , int n0 = 0, float* wscale = nullptr  ) {
#pragma unroll
    for (int i = 0; i < 32; ++i) { const int kk = 2 * i + (lane >> 5); const float gv = gain ? gain[k0 + kk] * mul : mul; scr[kk * 33 + (lane & 31)] = tv[i] * gv; }
    LDS_WAIT(); asm volatile("" ::: "memory");
    const int c = lane & 7;
#pragma unroll
    for (int j = 0; j < 4; ++j) { const int n = (lane >> 3) + 8 * j; const LAS float* sp = scr + (8 * c) * 33 + n;
        const float e0 = sp[0 * 33], e1 = sp[1 * 33], e2 = sp[2 * 33], e3 = sp[3 * 33], e4 = sp[4 * 33], e5 = sp[5 * 33], e6 = sp[6 * 33], e7 = sp[7 * 33];
        if (mode == 2) { const float mx = __builtin_bit_cast(float, __hip_atomic_load(colmax + n0 + n, RLX_AGENT)); const float q = mx > 0.f ? 127.0f / mx : 0.f;
            u32x2 o; o.x = pk4_i8(e0 * q, e1 * q, e2 * q, e3 * q); o.y = pk4_i8(e4 * q, e5 * q, e6 * q, e7 * q); *(GAS u32x2*)(WT + (size_t)(drow0 + n) * ldk + k0 + 8 * c) = o;
            if (k0 == 0 && c == 0) wscale[drow0 + n] = mx * (1.0f / 127.0f); }
        else if (mode == 1) { u32x2 o; o.x = pk4_fp8(e0, e1, e2, e3); o.y = pk4_fp8(e4, e5, e6, e7); *(GAS u32x2*)(WT + (size_t)(drow0 + n) * ldk + k0 + 8 * c) = o; }
        else { u32x4 o; o.x = cvtpk(e0, e1); o.y = cvtpk(e2, e3); o.z = cvtpk(e4, e5); o.w = cvtpk(e6, e7); *(GAS u32x4*)(WT + ((size_t)(drow0 + n) * ldk + k0 + 8 * c) * 2) = o; } }
    LDS_WAIT(); asm volatile("" ::: "memory");
}
__device__ __forceinline__ void tr_mat(const float* W, int ldw, int K, int N, const float* gain, float mul, int mode, bool gu, unsigned char* WT, LAS float* scr, int first, int NGW, int lane,
                                       const unsigned* colmax = nullptr, float* wscale = nullptr) {
    const int nblk = N / 32, nitems = (K / 64) * nblk, F = N / 2;
    float tv[32], tn[32];
    int it = first; if (it >= nitems) return;
    tr_load(tv, W, ldw, (it / nblk) * 64, (it % nblk) * 32, lane);
    for (; it < nitems; it += NGW) {
        const int nx = it + NGW; if (nx < nitems) tr_load(tn, W, ldw, (nx / nblk) * 64, (nx % nblk) * 32, lane);
        const int kb = it / nblk, n0 = (it % nblk) * 32; int drow0 = n0;
        if (gu) { const int isup = n0 >= F, j = isup ? n0 - F : n0; drow0 = (j >> 7) * 256 + (isup ? 128 : 0) + (j & 127); }
        tr_put(tv, kb * 64, gain, mul, mode, WT, K, drow0, scr, lane, colmax, n0, wscale);
#pragma unroll
        for (int i = 0; i < 32; ++i) tv[i] = tn[i];
    }
}

struct Args { const float* in[15]; float* out; unsigned char* ws; };
template <int OFF> __device__ __forceinline__ unsigned long long karg() { unsigned long long v; auto ka = __builtin_amdgcn_kernarg_segment_ptr();
    asm volatile("s_load_dwordx2 %0, %1, %2\n\ts_waitcnt lgkmcnt(0)" : "=s"(v) : "s"(ka), "n"(OFF) : "memory"); return v; }
#define ARG_IN(k) ((const float*)(const GAS float*)karg<8 * (k)>())
#define ARG_OUT() ((float*)(GAS float*)karg<120>())
#define ARG_WS() ((unsigned char*)(GAS unsigned char*)karg<128>())

template <int W, class XT>
__device__ __forceinline__ void pool_chan(const XT* xp  , int s0, const LAS float* inv  , bf16_t* pp  ) {
    f32x2 hist[W]; f32x2 S = {0.f, 0.f};
#pragma unroll
    for (int j = 0; j < W; ++j) hist[j] = (f32x2){0.f, 0.f};
    if (s0 > 0) {
#pragma unroll
        for (int j = 1; j < W; ++j) { const int t = j - W; const f32x2 v = ld2(xp + (ptrdiff_t)t * D) * inv[15 + t]; hist[j] = v; S += v; }
    }
    for (int tb = 0; tb < 256; tb += 16) {
        f32x2 v[16];
#pragma unroll
        for (int j = 0; j < 16; ++j) v[j] = ld2(xp + (size_t)(tb + j) * D);
#pragma unroll
        for (int j = 0; j < 16; ++j) { const int t = tb + j; const f32x2 xv = v[j] * inv[15 + t]; S += xv - hist[j % W]; hist[j % W] = xv;
            const int pos = s0 + t + 1; const float rc = (pos >= W) ? (1.0f / W) : (1.0f / (float)pos);
            const f32x2 p = S * rc - xv; *(unsigned*)(pp + (size_t)t * D) = cvtpk(p.x, p.y); }
    }
}
template <class XT>
__device__ __forceinline__ void pool_prep_phase(const XT* x, bf16_t* P, LAS unsigned char* lds, int G, int wave_s) {
    const int tid = fresh_tid(wave_s); const int lane = tid & 63, wave = __builtin_amdgcn_readfirstlane(tid >> 6);
    LAS float* inv = (LAS float*)lds;
    for (int tile = blockIdx.x; tile < M / 256; tile += G) {
        const int r0 = tile * 256, s0 = r0 % SEQ;
        const int start = (s0 > 0) ? -15 : 0;
        for (int rr = start + wave; rr < 256; rr += NWAVES) {
            const XT* xr = x + (size_t)(r0 + rr) * D + 4 * lane; float s = 0.f;
#pragma unroll
            for (int j = 0; j < 4; ++j) { const f32x4 v = ld4(xr + 256 * j); s += (v.x * v.x + v.y * v.y) + (v.z * v.z + v.w * v.w); }
            s = wave_sum(s);
            if (lane == 0) inv[15 + rr] = 1.0f / sqrtf(s * (1.0f / D) + RMS_EPS);
        }
        __syncthreads();
        const int c = 2 * tid; const XT* xp = x + (size_t)r0 * D + c; bf16_t* pp = P + (size_t)r0 * D + c;
        const int grp = wave >> 1;
        if (grp == 0) pool_chan<2, XT>(xp, s0, inv, pp);
        else if (grp == 1) pool_chan<4, XT>(xp, s0, inv, pp);
        else if (grp == 2) pool_chan<8, XT>(xp, s0, inv, pp);
        else pool_chan<16, XT>(xp, s0, inv, pp);
        __syncthreads();
    }
}

template <bool COMBINE, bool ROUTER, bool FINAL, int OUTK, bool DELTA, class XT>
__device__ __forceinline__ void norm_phase(float* x, bf16_t* XN, const bf16_t* YS, const int* slot_of, const float* gvec  , const float* wr  ,
                                           int* route_e, float* route_g, int* tilecnt, LAS unsigned char* lds, LAS int* cnt_l, int G, int wave_s, float* ascale, const bf16_t* DL, const XT* xs  , bf16_t* xw  ) {
    const int tid = fresh_tid(wave_s); const int lane = tid & 63, wave = __builtin_amdgcn_readfirstlane(tid >> 6);
    LAS float* wl = (LAS float*)lds;
    if (ROUTER) {
        for (int i = tid; i < 8 * 1024; i += NTHREADS) { const int c = i >> 3, e = i & 7; wl[e * 1024 + c] = wr[i] * gvec[c]; }
        __syncthreads();
    }
    f32x4 gf[4];
    if (FINAL) {
#pragma unroll
        for (int j = 0; j < 4; ++j) gf[j] = *((const f32x4*)gvec + lane + 64 * j);
    }
    for (int tile = blockIdx.x; tile < M / 256; tile += G) {
        const int rb = tile * 256 + wave * 32;
        typename Raw4<XT>::t vnx[4]; u32x2 yan[4], ybn[4], dnx[4]; int sl0 = 0, sl1 = 0;
        { const XT* xr0 = xs + (size_t)rb * D + 4 * lane;
#pragma unroll
          for (int j = 0; j < 4; ++j) vnx[j] = ldraw4(xr0 + 256 * j);
          if (DELTA) { const GAS u32x2* d0 = (const GAS u32x2*)(DL + (size_t)rb * D) + lane;
#pragma unroll
              for (int j = 0; j < 4; ++j) dnx[j] = d0[64 * j]; }
          if (COMBINE) { const int a0 = __builtin_amdgcn_readfirstlane(__hip_atomic_load(slot_of + 2 * rb, RLX_AGENT)), a1 = __builtin_amdgcn_readfirstlane(__hip_atomic_load(slot_of + 2 * rb + 1, RLX_AGENT));
              const GAS u32x2* y0 = (const GAS u32x2*)(YS + (size_t)a0 * D) + lane; const GAS u32x2* y1 = (const GAS u32x2*)(YS + (size_t)a1 * D) + lane;
#pragma unroll
              for (int j = 0; j < 4; ++j) { yan[j] = y0[64 * j]; ybn[j] = y1[64 * j]; }
              sl0 = __builtin_amdgcn_readfirstlane(__hip_atomic_load(slot_of + 2 * (rb + 1), RLX_AGENT)); sl1 = __builtin_amdgcn_readfirstlane(__hip_atomic_load(slot_of + 2 * (rb + 1) + 1, RLX_AGENT)); } }
        for (int i = 0; i < 32; ++i) {
            const int r = rb + i;
            GAS f32x4* xr = (GAS f32x4*)(x + (size_t)r * D) + lane;
            f32x4 v[4]; u32x2 ya[4], yb[4];
#pragma unroll
            for (int j = 0; j < 4; ++j) { v[j] = cvt4(vnx[j]); if (COMBINE) { ya[j] = yan[j]; yb[j] = ybn[j]; }
                if (DELTA) { const u32x2 d = dnx[j]; v[j].x += bf_lo(d.x); v[j].y += bf_hi(d.x); v[j].z += bf_lo(d.y); v[j].w += bf_hi(d.y); } }
            if (i + 1 < 32) { const XT* xn_ = xs + (size_t)(r + 1) * D + 4 * lane;
#pragma unroll
                for (int j = 0; j < 4; ++j) vnx[j] = ldraw4(xn_ + 256 * j);
                if (DELTA) { const GAS u32x2* d1 = (const GAS u32x2*)(DL + (size_t)(r + 1) * D) + lane;
#pragma unroll
                    for (int j = 0; j < 4; ++j) dnx[j] = d1[64 * j]; }
                if (COMBINE) { const GAS u32x2* y0 = (const GAS u32x2*)(YS + (size_t)sl0 * D) + lane; const GAS u32x2* y1 = (const GAS u32x2*)(YS + (size_t)sl1 * D) + lane;
#pragma unroll
                    for (int j = 0; j < 4; ++j) { yan[j] = y0[64 * j]; ybn[j] = y1[64 * j]; }
                    if (i + 2 < 32) { sl0 = __builtin_amdgcn_readfirstlane(__hip_atomic_load(slot_of + 2 * (r + 2), RLX_AGENT)); sl1 = __builtin_amdgcn_readfirstlane(__hip_atomic_load(slot_of + 2 * (r + 2) + 1, RLX_AGENT)); } } }
            if (COMBINE) {
#pragma unroll
                for (int j = 0; j < 4; ++j) { const u32x2 a = ya[j], b = yb[j];
                    v[j].x += bf_lo(a.x) + bf_lo(b.x); v[j].y += bf_hi(a.x) + bf_hi(b.x); v[j].z += bf_lo(a.y) + bf_lo(b.y); v[j].w += bf_hi(a.y) + bf_hi(b.y); }
                if (!FINAL) { GAS u32x2* xo = (GAS u32x2*)(xw + (size_t)r * D) + lane;
#pragma unroll
                    for (int j = 0; j < 4; ++j) { u32x2 w; w.x = cvtpk(v[j].x, v[j].y); w.y = cvtpk(v[j].z, v[j].w); xo[64 * j] = w; }
                }
            }
            float s = 0.f;
#pragma unroll
            for (int j = 0; j < 4; ++j) s += (v[j].x * v[j].x + v[j].y * v[j].y) + (v[j].z * v[j].z + v[j].w * v[j].w);
            const float inv = 1.0f / sqrtf(wave_sum(s) * (1.0f / D) + RMS_EPS);
#pragma unroll
            for (int j = 0; j < 4; ++j) v[j] = v[j] * inv;
            if (FINAL) {
#pragma unroll
                for (int j = 0; j < 4; ++j) xr[64 * j] = v[j] * gf[j];
            } else if (OUTK == 2) {
                float mx = 0.f;
#pragma unroll
                for (int j = 0; j < 4; ++j) mx = fmaxf(fmaxf(mx, fmaxf(fabsf(v[j].x), fabsf(v[j].y))), fmaxf(fabsf(v[j].z), fabsf(v[j].w)));
                mx = wave_max(mx); const float q = mx > 0.f ? 127.0f / mx : 0.f;
                GAS unsigned* o = (GAS unsigned*)((unsigned char*)XN + (size_t)r * D) + lane;
#pragma unroll
                for (int j = 0; j < 4; ++j) o[64 * j] = pk4_i8(v[j].x * q, v[j].y * q, v[j].z * q, v[j].w * q);
                if (lane == 0) ascale[r] = mx * (1.0f / 127.0f);
            } else if (OUTK == 1) {
                GAS unsigned* o = (GAS unsigned*)((unsigned char*)XN + (size_t)r * D) + lane;
#pragma unroll
                for (int j = 0; j < 4; ++j) o[64 * j] = pk4_fp8(v[j].x, v[j].y, v[j].z, v[j].w);
            } else {
                GAS u32x2* o = (GAS u32x2*)(XN + (size_t)r * D) + lane;
#pragma unroll
                for (int j = 0; j < 4; ++j) { u32x2 w; w.x = cvtpk(v[j].x, v[j].y); w.y = cvtpk(v[j].z, v[j].w); o[64 * j] = w; }
            }
            if (ROUTER) {
                float lg[8];
#pragma unroll
                for (int e = 0; e < 8; ++e) { float a = 0.f;
#pragma unroll
                    for (int j = 0; j < 4; ++j) { const f32x4 w = *((const LAS f32x4*)(wl + e * 1024) + lane + 64 * j); a += (v[j].x * w.x + v[j].y * w.y) + (v[j].z * w.z + v[j].w * w.w); }
                    lg[e] = wave_sum(a); }
                int e0 = 0; float v0 = lg[0];
#pragma unroll
                for (int e = 1; e < 8; ++e) if (lg[e] > v0) { v0 = lg[e]; e0 = e; }
                int e1 = -1; float v1 = -3.0e38f;
#pragma unroll
                for (int e = 0; e < 8; ++e) if (e != e0 && lg[e] > v1) { v1 = lg[e]; e1 = e; }
                const float ex = __expf(v1 - v0), g0 = 1.0f / (1.0f + ex), g1 = ex * g0;
                if (lane == 0) { route_e[r] = e0 | (e1 << 8); route_g[2 * r] = g0; route_g[2 * r + 1] = g1; atomicAdd((int*)(cnt_l + e0), 1); atomicAdd((int*)(cnt_l + e1), 1); }
            }
        }
        if (ROUTER) {
            __syncthreads();
            if (tid < 8) { tilecnt[tile * 8 + tid] = cnt_l[tid]; cnt_l[tid] = 0; }
            __syncthreads();
        }
    }
}

template <bool FP8>
__device__ __forceinline__ void dispatch_phase(const int* tilecnt, const int* route_e, const float* route_g, int* slot_of, float* gate_slot, const bf16_t* XN, bf16_t* XS  ,
                                               LAS unsigned char* lds, LAS int* pend, int G, int wave_s) {
    const int tid = fresh_tid(wave_s); const int lane = tid & 63, wave = __builtin_amdgcn_readfirstlane(tid >> 6);
    LAS int* lc = (LAS int*)lds;
    LAS int* tot_l = (LAS int*)(lds + 8192);
    LAS int* pst_l = (LAS int*)(lds + 8192 + 32);
    LAS int* base_l = (LAS int*)(lds + 8192 + 64);
    LAS int* slot_l = (LAS int*)(lds + 8192 + 128);
    if (tid < 256) { const i32x4 a = *((const i32x4*)tilecnt + 2 * tid), b = *((const i32x4*)tilecnt + 2 * tid + 1); *((LAS i32x4*)lc + 2 * tid) = a; *((LAS i32x4*)lc + 2 * tid + 1) = b; }
    __syncthreads();
    if (tid < 8) { int t = 0; for (int i = 0; i < 256; ++i) t += lc[i * 8 + tid]; tot_l[tid] = t; }
    __syncthreads();
    if (tid == 0) { int ps = 0; for (int e = 0; e < 8; ++e) { const int padded = (tot_l[e] + 255) & ~255; pst_l[e] = ps; ps += padded; pend[e] = ps >> 8; } }
    __syncthreads();
    if (FP8 && blockIdx.x < 8) { const int e = blockIdx.x, t0 = pst_l[e] + tot_l[e], npad = ((tot_l[e] + 255) & ~255) - tot_l[e];
        for (int i = tid; i < npad; i += NTHREADS) ((int*)XS)[t0 + i] = 0; }
    for (int tile = blockIdx.x; tile < M / 256; tile += G) {
        const int r0 = tile * 256;
        if (tid < 8) { int pre = 0; for (int i = 0; i < tile; ++i) pre += lc[i * 8 + tid]; base_l[tid] = pst_l[tid] + pre; }
        __syncthreads();
        if (wave == 0) {
            int run[8];
#pragma unroll
            for (int e = 0; e < 8; ++e) run[e] = 0;
            for (int ch = 0; ch < 8; ++ch) {
                const int i = ch * 64 + lane, tok = r0 + (i >> 1), k = i & 1;
                const int ew = __hip_atomic_load(route_e + tok, RLX_AGENT); const int e = (ew >> (8 * k)) & 0xff;
                int slot = 0;
#pragma unroll
                for (int ee = 0; ee < 8; ++ee) { const unsigned long long mask = __ballot(e == ee);
                    if (e == ee) slot = base_l[ee] + run[ee] + __popcll(mask & ((1ull << lane) - 1ull));
                    run[ee] += __popcll(mask); }
                slot_l[i] = slot; slot_of[2 * tok + k] = slot; gate_slot[slot] = __hip_atomic_load(route_g + 2 * tok + k, RLX_AGENT); if (FP8) ((int*)XS)[slot] = tok;
            }
        }
        __syncthreads();
        if constexpr (!FP8) {
        for (int ii = 0; ii < 64; ii += 4) {
            u32x4 a[4][2];
#pragma unroll
            for (int q = 0; q < 4; ++q) { const int i = wave * 64 + ii + q; const GAS u32x4* src = (const GAS u32x4*)(XN + (size_t)(r0 + (i >> 1)) * D) + lane; a[q][0] = src[0]; a[q][1] = src[64]; }
#pragma unroll
            for (int q = 0; q < 4; ++q) { const int i = wave * 64 + ii + q; GAS u32x4* dst = (GAS u32x4*)(XS + (size_t)slot_l[i] * D) + lane; dst[0] = a[q][0]; dst[64] = a[q][1]; }
        }
        }
        __syncthreads();
    }
}

#define ATT_LOAD(KF, VF, kt_) do { const int k0_ = (kt_) * 32; \
        const GAS u32x4* kp_ = (const GAS u32x4*)(Kb + (rowbase + k0_ + n) * D + h * 64 + 8 * hh); \
        _Pragma("unroll") for (int s_ = 0; s_ < 4; ++s_) KF[s_] = __builtin_bit_cast(bf16x8, kp_[2 * s_]); \
        _Pragma("unroll") for (int dt_ = 0; dt_ < 2; ++dt_) { const GAS u32x4* vp_ = (const GAS u32x4*)(Vt + (size_t)(h * 64 + dt_ * 32 + n) * M + rowbase + k0_ + 8 * hh); \
            _Pragma("unroll") for (int s_ = 0; s_ < 2; ++s_) VF[dt_][s_] = __builtin_bit_cast(bf16x8, vp_[2 * s_]); } } while (0)
constexpr float ATT_STOP = 9.0e-14f;
__device__ __forceinline__ void att_tile(const bf16x8 (&kf)[4], const bf16x8 (&vf)[2][2], const bf16x8 (&qf)[4], f32x16& o0, f32x16& o1, float& carry, bool diag, int n, int hh) {
    f32x16 sc;
#pragma unroll
    for (int r = 0; r < 16; ++r) sc[r] = 0.f;
#pragma unroll
    for (int s = 0; s < 4; ++s) sc = __builtin_amdgcn_mfma_f32_32x32x16_bf16(kf[s], qf[s], sc, 0, 0, 0);
    float be[16], kp[16];
#pragma unroll
    for (int r = 0; r < 16; ++r) { const float zl = sc[r]; const float e = __builtin_amdgcn_exp2f(-fabsf(zl)); const float rr = __builtin_amdgcn_rcpf(1.0f + e), er = e * rr;
        float bt_ = zl >= 0.f ? rr : er, kp_ = zl >= 0.f ? er : rr;
        if (diag) { const int key = (r & 3) + 8 * (r >> 2) + 4 * hh; if (key >= n) { bt_ = 0.f; kp_ = 1.f; } }
        be[r] = bt_; kp[r] = kp_; }
    float T[4], Pp[4], p2[4], p1[4], p0[4];
#pragma unroll
    for (int g = 0; g < 4; ++g) { p2[g] = kp[4 * g + 3]; p1[g] = p2[g] * kp[4 * g + 2]; p0[g] = p1[g] * kp[4 * g + 1]; T[g] = p0[g] * kp[4 * g]; }
#pragma unroll
    for (int g = 0; g < 4; ++g) Pp[g] = __shfl_xor(T[g], 32);
    float off[4];
    { const float own2 = T[3], own1 = T[3] * T[2], own0 = own1 * T[1];
      const float pe2 = Pp[3], pe1 = Pp[3] * Pp[2], pe0 = pe1 * Pp[1];
      if (hh == 0) { off[0] = own0 * pe0 * Pp[0]; off[1] = own1 * pe1 * Pp[1]; off[2] = own2 * pe2 * Pp[2]; off[3] = Pp[3]; }
      else         { off[0] = own0 * pe0;         off[1] = own1 * pe1;         off[2] = own2 * pe2;         off[3] = 1.f; } }
    float a[16];
#pragma unroll
    for (int g = 0; g < 4; ++g) { const float base = carry * off[g];
        a[4 * g + 0] = be[4 * g + 0] * (base * p0[g]); a[4 * g + 1] = be[4 * g + 1] * (base * p1[g]); a[4 * g + 2] = be[4 * g + 2] * (base * p2[g]); a[4 * g + 3] = be[4 * g + 3] * base; }
    carry *= ((T[0] * T[1]) * (T[2] * T[3])) * ((Pp[0] * Pp[1]) * (Pp[2] * Pp[3]));
    bf16x8 pb[2];
#pragma unroll
    for (int s = 0; s < 2; ++s) { u32x4 w; w.x = cvtpk(a[8 * s + 0], a[8 * s + 1]); w.y = cvtpk(a[8 * s + 2], a[8 * s + 3]); w.z = cvtpk(a[8 * s + 4], a[8 * s + 5]); w.w = cvtpk(a[8 * s + 6], a[8 * s + 7]); pb[s] = __builtin_bit_cast(bf16x8, w); }
#pragma unroll
    for (int s = 0; s < 2; ++s) { o0 = __builtin_amdgcn_mfma_f32_32x32x16_bf16(vf[0][s], pb[s], o0, 0, 0, 0); o1 = __builtin_amdgcn_mfma_f32_32x32x16_bf16(vf[1][s], pb[s], o1, 0, 0, 0); }
}
constexpr int ATT_KROW = 144, ATT_VROW = 784, ATT_V_OFF = 384 * ATT_KROW;
static_assert(ATT_V_OFF + 64 * ATT_VROW <= STAGE_BYTES_LDS, "attention LDS image");
__device__ __forceinline__ void attn_phase(const bf16_t* Q, const bf16_t* Kb, const bf16_t* Vt, bf16_t* O, LAS unsigned char* lds, int vcu, int G, int wave_s) {
    const int tid = fresh_tid(wave_s); const int lane = tid & 63, wave = __builtin_amdgcn_readfirstlane(tid >> 6);
    const int n = lane & 31, hh = lane >> 5;
    const int NU = BATCH * NH * (SEQ / 256), per = (NU + G - 1) / G;
    const int u_lo = vcu * per, u_hi = (u_lo + per < NU) ? u_lo + per : NU;
    u32x4 pk[6], pv[6];
#define ATT_FETCH(uu) do { const int bh_ = (uu) >> 3, qb_ = (uu) & 7, h_ = bh_ & 15, b_ = bh_ >> 4; const int kw0_ = qb_ > 0 ? qb_ * 256 - 128 : 0, nk_ = qb_ * 256 + 256 - kw0_; \
        const size_t rb_ = (size_t)b_ * SEQ; \
        _Pragma("unroll") for (int i_ = 0; i_ < 6; ++i_) { const int p_ = tid + i_ * NTHREADS; const int kr_ = p_ >> 3, kc_ = p_ & 7; \
            if (kr_ < nk_) pk[i_] = *(const GAS u32x4*)(Kb + (rb_ + kw0_ + kr_) * D + h_ * 64 + kc_ * 8); \
            const int vd_ = p_ / 48, vc_ = p_ - vd_ * 48; \
            if (vc_ * 8 < nk_) pv[i_] = *(const GAS u32x4*)(Vt + (size_t)(h_ * 64 + vd_) * M + rb_ + kw0_ + vc_ * 8); } } while (0)
#define ATT_PUT(uu) do { const int qb_ = (uu) & 7; const int kw0_ = qb_ > 0 ? qb_ * 256 - 128 : 0, nk_ = qb_ * 256 + 256 - kw0_; \
        _Pragma("unroll") for (int i_ = 0; i_ < 6; ++i_) { const int p_ = tid + i_ * NTHREADS; const int kr_ = p_ >> 3, kc_ = p_ & 7; \
            if (kr_ < nk_) *(LAS u32x4*)(lds + kr_ * ATT_KROW + kc_ * 16) = pk[i_]; \
            const int vd_ = p_ / 48, vc_ = p_ - vd_ * 48; \
            if (vc_ * 8 < nk_) *(LAS u32x4*)(lds + ATT_V_OFF + vd_ * ATT_VROW + vc_ * 16) = pv[i_]; } } while (0)
#define ATT_TILE_LD(KF, VF, kt_) do { const int k0_ = (kt_) * 32; if (k0_ >= kw0) { const int ko_ = k0_ - kw0; \
            _Pragma("unroll") for (int s_ = 0; s_ < 4; ++s_) KF[s_] = *(const LAS bf16x8*)(lds + (ko_ + n) * ATT_KROW + 32 * s_ + 16 * hh); \
            _Pragma("unroll") for (int dt_ = 0; dt_ < 2; ++dt_) _Pragma("unroll") for (int s_ = 0; s_ < 2; ++s_) VF[dt_][s_] = *(const LAS bf16x8*)(lds + ATT_V_OFF + (dt_ * 32 + n) * ATT_VROW + (ko_ + 16 * s_ + 8 * hh) * 2); } \
        else { ATT_LOAD(KF, VF, kt_); } } while (0)
    if (u_lo < u_hi) ATT_FETCH(u_lo);
    for (int u = u_lo; u < u_hi; ++u) {
        const int bh = u >> 3, qb = u & 7, h = bh & 15, b = bh >> 4;
        const size_t rowbase = (size_t)b * SEQ; const int kw0 = qb > 0 ? qb * 256 - 128 : 0;
        const int qt = qb * 8 + wave, q0 = qt * 32;
        bf16x8 qf[4];
        { const GAS u32x4* qp = (const GAS u32x4*)(Q + (rowbase + q0 + n) * D + h * 64 + 8 * hh);
#pragma unroll
          for (int s = 0; s < 4; ++s) qf[s] = __builtin_bit_cast(bf16x8, qp[2 * s]); }
        ATT_PUT(u);
        __syncthreads();
        if (u + 1 < u_hi) ATT_FETCH(u + 1);
        f32x16 o0, o1;
#pragma unroll
        for (int r = 0; r < 16; ++r) { o0[r] = 0.f; o1[r] = 0.f; }
        float carry = 1.f;
        bf16x8 kf[4], vf[2][2];
        for (int kt = qt; kt >= 0; --kt) {
            ATT_TILE_LD(kf, vf, kt);
            att_tile(kf, vf, qf, o0, o1, carry, kt == qt, n, hh);
            if (__all(carry < ATT_STOP)) break;
        }
        bf16_t* op = O + (rowbase + q0 + n) * D + h * 64 + 4 * hh;
#pragma unroll
        for (int g = 0; g < 4; ++g) { u32x2 w0, w1; w0.x = cvtpk(o0[4 * g], o0[4 * g + 1]); w0.y = cvtpk(o0[4 * g + 2], o0[4 * g + 3]); w1.x = cvtpk(o1[4 * g], o1[4 * g + 1]); w1.y = cvtpk(o1[4 * g + 2], o1[4 * g + 3]);
            *(u32x2*)(op + 8 * g) = w0; *(u32x2*)(op + 32 + 8 * g) = w1; }
        __syncthreads();
    }
#undef ATT_FETCH
#undef ATT_PUT
#undef ATT_TILE_LD
}

#define WSP(T, off) ((T*)(ws + (off)))
#ifndef PROBE_DUP
#define PROBE_DUP 0
#endif
#define DUP(k) ((PROBE_DUP >> (k)) & 1)
template <int l>
__device__ __forceinline__ void layer_body(LAS unsigned char* lds, const XcdBarrier& bar, LAS int* pend, LAS int* cnt_l, int G, int bx, int vcu, int NGW, int wave_s) {
#define SITE_POOLPREP() { { unsigned char* ws = ARG_WS(); if constexpr (l == 0) pool_prep_phase<float>(ARG_IN(0), WSP(bf16_t, WS_R), lds, G, wave_s); else pool_prep_phase<bf16_t>((const bf16_t*)WSP(bf16_t, WS_XB), WSP(bf16_t, WS_R), lds, G, wave_s); \
              if constexpr (l == 0 && (INT8_UP0 != 0 || INT8_PROJ != 0)) {     \
                  const int t_ = fresh_tid(wave_s); const int wv_ = __builtin_amdgcn_readfirstlane(t_ >> 6); LAS float* sc_ = (LAS float*)(lds + wv_ * 16384); const int g_ = vcu * NWAVES + wv_; int base_ = 0; \
                  for (int j_ = 0; j_ < 5; ++j_) { if ((j_ == 0 && !I8) || (j_ > 0 && !INT8_PROJ)) continue; \
                      const float* W_; const float* gn_; int ldw_, N_; float mul_ = 1.0f; bool gu_ = false; size_t dst_; const unsigned* cm_; float* wsc_; \
                      if (j_ == 0) { W_ = ARG_IN(9); gn_ = ARG_IN(2); ldw_ = 2 * DFF; N_ = 2 * DFF; gu_ = true; dst_ = WS_WFI; cm_ = WSP(unsigned, WS_COLMAX); wsc_ = WSP(float, WS_WSCALE); } \
                      else if (j_ < 3) { W_ = ARG_IN(6) + (j_ - 1) * 1024; gn_ = ARG_IN(5); ldw_ = 2048; N_ = 1024; dst_ = (j_ == 1) ? WS_WK : WS_WV; cm_ = WSP(unsigned, WS_COLMAX2) + (j_ - 1) * 1024; wsc_ = WSP(float, WS_WSCALE2) + (j_ - 1) * 1024; } \
                      else { const int b_ = j_ - 3; W_ = ARG_IN(7) + (size_t)b_ * D * D; gn_ = ARG_IN(1) + (2 + b_) * D; ldw_ = 1024; N_ = 1024; mul_ = 0.125f * 1.4426950408889634f; dst_ = WS_WQ + (size_t)b_ * D * D * 2; cm_ = WSP(unsigned, WS_COLMAX2) + (2 + b_) * 1024; wsc_ = WSP(float, WS_WSCALE2) + (2 + b_) * 1024; } \
                      int first_ = (g_ - base_) % NGW; if (first_ < 0) first_ += NGW; \
                      tr_mat(W_, ldw_, D, N_, gn_, mul_, 2, gu_, ws + dst_, sc_, first_, NGW, t_ & 63, cm_, wsc_); base_ = (base_ + (D / 64) * (N_ / 32)) % NGW; } } } xcd_barrier(bar, wave_s); }
#define SITE_POOLGEMM(MUL) { { unsigned char* ws = ARG_WS(); \
              pg8::GemmK g{256, 1024, 256}; pg8::PoolOrder S{G, bx, (const char*)WSP(bf16_t, WS_R), (const char*)(WSP(bf16_t, WS_WPOOL) + (size_t)l * 4 * 65536)}; \
              pg8::EpiDelta E{WSP(bf16_t, WS_DELTA), ARG_IN(4) + l * D}; \
              pg8::gemm_phase<pg8::EpiDelta, pg8::PoolOrder, true>(lds, g, S, E, wave_s); } xcd_barrier(bar, wave_s); }
#define SITE_PROJ() { { unsigned char* ws = ARG_WS(); \
              if constexpr (INT8_PROJ != 0) { pg8::GemmK g{512, 512, 512}; pg8::ProjOrder S{(l == 2) ? 3 : 1, G, bx, (const char*)ws, (size_t)(l - 2) * D * D * 2, (size_t)256 * 1024}; \
                pg8::EpiProjI8 E{WSP(bf16_t, WS_K), WSP(bf16_t, WS_R), WSP(bf16_t, WS_VT), WSP(float, WS_ASCALE), WSP(float, WS_WSCALE2), l - 2}; \
                pg8::gemm_phase<pg8::EpiProjI8, pg8::ProjOrder, true, 2>(lds, g, S, E, wave_s); } \
              else { pg8::GemmK g{1024, 1024, 1024}; pg8::ProjOrder S{(l == 2) ? 3 : 1, G, bx, (const char*)ws, (size_t)(l - 2) * D * D * 2, (size_t)256 * 1024 * 2}; \
                pg8::EpiProj E{WSP(bf16_t, WS_K), WSP(bf16_t, WS_R), WSP(bf16_t, WS_VT)}; \
                pg8::gemm_phase<pg8::EpiProj, pg8::ProjOrder, true>(lds, g, S, E, wave_s); } } xcd_barrier(bar, wave_s); }
#define SITE_ATTN() { { unsigned char* ws = ARG_WS(); attn_phase(WSP(bf16_t, WS_R), WSP(bf16_t, WS_K), WSP(bf16_t, WS_VT), WSP(bf16_t, WS_R) + (size_t)M * D, lds, vcu, G, wave_s); } xcd_barrier(bar, wave_s); }
#define SITE_OPROJ(MUL) { { unsigned char* ws = ARG_WS(); \
              pg8::GemmK g{1024, 1024, 1024}; pg8::DenseOrder S{M / 256, 4, G, bx, (const char*)(WSP(bf16_t, WS_R) + (size_t)M * D), (const char*)(WSP(bf16_t, WS_WO) + (size_t)(l - 2) * D * D), (size_t)256 * 1024 * 2, (size_t)256 * 1024 * 2}; \
              pg8::EpiDelta E{WSP(bf16_t, WS_DELTA), nullptr}; \
              pg8::gemm_phase<pg8::EpiDelta, pg8::DenseOrder, true>(lds, g, S, E, wave_s); } xcd_barrier(bar, wave_s); }
#define SITE_NORMX(OUTK_, DELTA_) { { unsigned char* ws = ARG_WS(); \
              if constexpr (l == 0) norm_phase<false, false, false, OUTK_, DELTA_, float>(nullptr, WSP(bf16_t, WS_XN), nullptr, nullptr, nullptr, nullptr, nullptr, nullptr, nullptr, lds, cnt_l, G, wave_s, WSP(float, WS_ASCALE), WSP(bf16_t, WS_DELTA), ARG_IN(0), nullptr);     \
              else norm_phase<false, false, false, OUTK_, DELTA_, bf16_t>(nullptr, WSP(bf16_t, WS_XN), nullptr, nullptr, nullptr, nullptr, nullptr, nullptr, nullptr, lds, cnt_l, G, wave_s, WSP(float, WS_ASCALE), WSP(bf16_t, WS_DELTA), (const bf16_t*)WSP(bf16_t, WS_XB), nullptr); } xcd_barrier(bar, wave_s); }
#define SITE_NORMI8() { { unsigned char* ws = ARG_WS(); norm_phase<false, false, false, 2, false, bf16_t>(nullptr, WSP(bf16_t, WS_XN), nullptr, nullptr, nullptr, nullptr, nullptr, nullptr, nullptr, lds, cnt_l, G, wave_s, WSP(float, WS_ASCALE), nullptr, (const bf16_t*)WSP(bf16_t, WS_XB), nullptr); } xcd_barrier(bar, wave_s); }
#define SITE_NORM8() { { unsigned char* ws = ARG_WS(); norm_phase<false, false, false, 1, false, bf16_t>(nullptr, WSP(bf16_t, WS_XN), nullptr, nullptr, nullptr, nullptr, nullptr, nullptr, nullptr, lds, cnt_l, G, wave_s, nullptr, nullptr, (const bf16_t*)WSP(bf16_t, WS_XB), nullptr); } xcd_barrier(bar, wave_s); }
#define SITE_NORM() { { unsigned char* ws = ARG_WS(); norm_phase<false, false, false, 0, false, bf16_t>(nullptr, WSP(bf16_t, WS_XN), nullptr, nullptr, nullptr, nullptr, nullptr, nullptr, nullptr, lds, cnt_l, G, wave_s, nullptr, nullptr, (const bf16_t*)WSP(bf16_t, WS_XB), nullptr); } xcd_barrier(bar, wave_s); }
#define SITE_DUP() { { unsigned char* ws = ARG_WS(); \
              if constexpr (I8) { pg8::GemmK g{512, 512, 512}; pg8::DenseOrder S{M / 256, DFF / 128, G, bx, (const char*)WSP(unsigned char, WS_XN), (const char*)WSP(unsigned char, WS_WFI), (size_t)256 * 1024, (size_t)256 * 1024}; \
                pg8::EpiSwigluI8 E{WSP(bf16_t, WS_R), DFF, WSP(float, WS_ASCALE), WSP(float, WS_WSCALE)}; \
                pg8::gemm_phase<pg8::EpiSwigluI8, pg8::DenseOrder, true, 2>(lds, g, S, E, wave_s); } \
              else if constexpr (F8) { pg8::GemmK g{512, 512, 512}; pg8::DenseOrder S{M / 256, DFF / 128, G, bx, (const char*)WSP(unsigned char, WS_XN), (const char*)(WSP(unsigned char, WS_WFI) + (size_t)(l >> 1) * 2 * DFF * D * 2), (size_t)256 * 1024, (size_t)256 * 1024}; \
                pg8::EpiSwiglu8 E{WSP(unsigned char, WS_R), DFF, 1.0f / W8_UP}; \
                pg8::gemm_phase<pg8::EpiSwiglu8, pg8::DenseOrder, true, 1>(lds, g, S, E, wave_s); } \
              else { pg8::GemmK g{1024, 1024, 1024}; pg8::DenseOrder S{M / 256, DFF / 128, G, bx, (const char*)WSP(bf16_t, WS_XN), (const char*)(WSP(bf16_t, WS_WFI) + (size_t)(l >> 1) * 2 * DFF * D), (size_t)256 * 1024 * 2, (size_t)256 * 1024 * 2}; \
                pg8::EpiSwiglu E{WSP(bf16_t, WS_R), DFF}; \
                pg8::gemm_phase<pg8::EpiSwiglu, pg8::DenseOrder, true>(lds, g, S, E, wave_s); } } xcd_barrier(bar, wave_s); }
#define SITE_DDOWN(MUL) { { unsigned char* ws = ARG_WS(); \
              if constexpr (F8) { pg8::GemmK g{DFF / 2, DFF / 2, DFF / 2}; pg8::DenseOrder S{M / 256, 4, G, bx, (const char*)WSP(unsigned char, WS_R), (const char*)(WSP(unsigned char, WS_WFO) + (size_t)(l >> 1) * D * DFF * 2), (size_t)256 * DFF, (size_t)256 * DFF}; \
                pg8::EpiResidD<bf16_t> E{(const bf16_t*)WSP(bf16_t, WS_XB), WSP(bf16_t, WS_XB), WSP(bf16_t, WS_DELTA), MUL / (W8_DN * H8_SC)}; \
                pg8::gemm_phase<pg8::EpiResidD<bf16_t>, pg8::DenseOrder, true, 1>(lds, g, S, E, wave_s); } \
              else { pg8::GemmK g{DFF, DFF, DFF}; pg8::DenseOrder S{M / 256, 4, G, bx, (const char*)WSP(bf16_t, WS_R), (const char*)(WSP(bf16_t, WS_WFO) + (size_t)(l >> 1) * D * DFF), (size_t)256 * DFF * 2, (size_t)256 * DFF * 2}; \
                pg8::EpiResidD<float> E{ARG_IN(0), WSP(bf16_t, WS_XB), WSP(bf16_t, WS_DELTA), MUL}; \
                pg8::gemm_phase<pg8::EpiResidD<float>, pg8::DenseOrder, true>(lds, g, S, E, wave_s); } } xcd_barrier(bar, wave_s); }
#define SITE_ROUTER() { { unsigned char* ws = ARG_WS(); \
              norm_phase<false, true, false, F8 ? 1 : 0, true, bf16_t>(nullptr, WSP(bf16_t, WS_XN), nullptr, nullptr, ARG_IN(2) + l * D, ARG_IN(11) + (size_t)(l >> 1) * D * NE, WSP(int, WS_ROUTE_E), WSP(float, WS_ROUTE_G), WSP(int, WS_TILECNT), lds, cnt_l, G, wave_s, nullptr, WSP(bf16_t, WS_DELTA), (const bf16_t*)WSP(bf16_t, WS_XB), nullptr); } xcd_barrier(bar, wave_s); }
#define SITE_DISPATCH() { { unsigned char* ws = ARG_WS(); \
              dispatch_phase<F8>(WSP(int, WS_TILECNT), WSP(int, WS_ROUTE_E), WSP(float, WS_ROUTE_G), WSP(int, WS_SLOT_OF), WSP(float, WS_GATE_SLOT), WSP(bf16_t, WS_XN), F8 ? WSP(bf16_t, WS_TOS) : WSP(bf16_t, WS_XS), lds, pend, G, wave_s); } xcd_barrier(bar, wave_s); }
#define SITE_MUP() { { unsigned char* ws = ARG_WS(); \
              if constexpr (F8) { pg8::GemmK g{512, 512, 512}; \
                pg8::MoeGatherOrder S{nb, DFFE / 128, G, bx, blk0, (const char*)WSP(unsigned char, WS_XN), (const char*)(WSP(unsigned char, WS_WMI) + (size_t)(l >> 1) * 8 * 2 * DFFE * D * 2), (size_t)256 * 1024, (size_t)2 * DFFE * D, pend, WSP(int, WS_TOS), (LAS int*)(lds + LCTL_OFF + 2048)}; \
                pg8::EpiSwiglu8 E{WSP(unsigned char, WS_R), DFFE, 1.0f / W8_UP}; \
                pg8::gemm_phase<pg8::EpiSwiglu8, pg8::MoeGatherOrder, true, 1, true>(lds, g, S, E, wave_s); } \
              else { pg8::GemmK g{1024, 1024, 1024}; \
                pg8::MoeOrder S{nb, DFFE / 128, G, bx, blk0, 0, (const char*)WSP(bf16_t, WS_XS), (const char*)(WSP(bf16_t, WS_WMI) + (size_t)(l >> 1) * 8 * 2 * DFFE * D), (size_t)256 * 1024 * 2, (size_t)256 * 1024 * 2, (size_t)2 * DFFE * D * 2, pend}; \
                pg8::EpiSwiglu E{WSP(bf16_t, WS_R), DFFE}; \
                pg8::gemm_phase<pg8::EpiSwiglu, pg8::MoeOrder, true>(lds, g, S, E, wave_s); } } xcd_barrier(bar, wave_s); }
#define SITE_MDOWN() { { unsigned char* ws = ARG_WS(); \
              if constexpr (F8) { pg8::GemmK g{DFFE / 2, DFFE / 2, DFFE / 2}; \
                pg8::MoeOrder S{nb, 4, G, bx, blk0, 1, (const char*)WSP(unsigned char, WS_R), (const char*)(WSP(unsigned char, WS_WMO) + (size_t)(l >> 1) * 8 * D * DFFE * 2), (size_t)256 * DFFE, (size_t)256 * DFFE, (size_t)D * DFFE, pend}; \
                pg8::EpiMoeDown E{WSP(bf16_t, WS_XS), WSP(float, WS_GATE_SLOT), 1.0f / (W8_DN * H8_SC)}; \
                pg8::gemm_phase<pg8::EpiMoeDown, pg8::MoeOrder, true, 1>(lds, g, S, E, wave_s); } \
              else { pg8::GemmK g{DFFE, DFFE, DFFE}; \
                pg8::MoeOrder S{nb, 4, G, bx, blk0, 1, (const char*)WSP(bf16_t, WS_R), (const char*)(WSP(bf16_t, WS_WMO) + (size_t)(l >> 1) * 8 * D * DFFE), (size_t)256 * DFFE * 2, (size_t)256 * DFFE * 2, (size_t)D * DFFE * 2, pend}; \
                pg8::EpiMoeDown E{WSP(bf16_t, WS_XS), WSP(float, WS_GATE_SLOT), 1.0f}; \
                pg8::gemm_phase<pg8::EpiMoeDown, pg8::MoeOrder, true>(lds, g, S, E, wave_s); } } xcd_barrier(bar, wave_s); }
    constexpr bool F8 = ((FP8_MASK >> l) & 1) != 0;
    constexpr bool I8 = (INT8_UP0 != 0) && l == 0 && !F8;
    if constexpr (l < 2) {
        if (DUP(5)) SITE_POOLPREP()
        SITE_POOLPREP()
        if (DUP(2)) SITE_POOLGEMM(0.f)
        SITE_POOLGEMM(1.f)
    } else {
        if (DUP(2)) SITE_PROJ()
        SITE_PROJ()
        if (DUP(3)) SITE_ATTN()
        SITE_ATTN()
        if (DUP(2)) SITE_OPROJ(0.f)
        SITE_OPROJ(1.f)
    }
    if constexpr ((l & 1) == 0) {
        if constexpr (I8) { if (DUP(5)) SITE_NORMX(2, true) SITE_NORMX(2, true) } else if constexpr (F8) { if (DUP(5)) SITE_NORMX(1, true) SITE_NORMX(1, true) } else { if (DUP(5)) SITE_NORMX(0, true) SITE_NORMX(0, true) }
        if (DUP(1)) SITE_DUP()
        SITE_DUP()
        SITE_DDOWN(1.f)
        if constexpr (l == 2) { if constexpr (INT8_PROJ != 0) { if (DUP(5)) SITE_NORMI8() SITE_NORMI8() } else { if (DUP(5)) SITE_NORM() SITE_NORM() } }
    } else {
        if (DUP(5)) SITE_ROUTER()
        SITE_ROUTER()
        if (DUP(5)) SITE_DISPATCH()
        SITE_DISPATCH()
        constexpr int CB = F8 ? CAP / 256 : CHUNK_BLKS;
        for (int ch = 0; ch < (F8 ? 1 : 2); ++ch) {
            const int nblk = pend[7];
            const int blk0 = ch * CB; int nb = nblk - blk0; nb = nb < 0 ? 0 : (nb > CB ? CB : nb); nb = __builtin_amdgcn_readfirstlane(nb);
            if (DUP(0)) SITE_MUP()
            SITE_MUP()
            if (DUP(0)) SITE_MDOWN()
            SITE_MDOWN()
        }
        if constexpr (l == 1) { { unsigned char* ws = ARG_WS(); norm_phase<true, false, false, INT8_PROJ ? 2 : 0, true, bf16_t>(nullptr, WSP(bf16_t, WS_XN), WSP(bf16_t, WS_XS), WSP(int, WS_SLOT_OF), nullptr, nullptr, nullptr, nullptr, nullptr, lds, cnt_l, G, wave_s, WSP(float, WS_ASCALE), WSP(bf16_t, WS_DELTA), (const bf16_t*)WSP(bf16_t, WS_XB), WSP(bf16_t, WS_XB)); } xcd_barrier(bar, wave_s); }
        else { unsigned char* ws = ARG_WS(); norm_phase<true, false, true, 0, true, bf16_t>(ARG_OUT(), WSP(bf16_t, WS_XN), WSP(bf16_t, WS_XS), WSP(int, WS_SLOT_OF), ARG_IN(14), nullptr, nullptr, nullptr, nullptr, lds, cnt_l, G, wave_s, nullptr, WSP(bf16_t, WS_DELTA), (const bf16_t*)WSP(bf16_t, WS_XB), nullptr); }
    }
}

__global__ void __launch_bounds__(NTHREADS, 2) yoco_fwd(Args args_unused) {
    extern __shared__ __attribute__((aligned(16))) unsigned char lds_raw[];
    LAS unsigned char* lds = (LAS unsigned char*)lds_raw;
    const int G = gridDim.x; const int bx = blockIdx.x; const int wave_s = __builtin_amdgcn_readfirstlane(threadIdx.x >> 6);
    const int vcu = (G % 8 == 0) ? (bx % 8) * (G / 8) + bx / 8 : bx;
    const int NGW = G * NWAVES;
    LAS unsigned* lctl = (LAS unsigned*)(lds + LCTL_OFF);
    for (int u = threadIdx.x; u < (LDS_BYTES - LCTL_OFF) / 4; u += NTHREADS) lctl[u] = 0u;
    __syncthreads();
    volatile LAS unsigned* bar_st = (volatile LAS unsigned*)lctl;
    LAS int* pend = (LAS int*)(lctl + 16);
    LAS int* cnt_l = (LAS int*)(lctl + 32);
    XcdBarrier bar = xcd_barrier_post((unsigned*)(ARG_WS() + WS_CTL) + 1024, bar_st);

    for (int rep = 0; rep < 1 + DUP(4); ++rep) {
        unsigned char* ws = ARG_WS();
        const int tid = fresh_tid(wave_s); const int lane = tid & 63, wave = __builtin_amdgcn_readfirstlane(tid >> 6), gw = vcu * NWAVES + wave;
        LAS float* scr = (LAS float*)(lds + wave * 16384);
        int base = 0;
        for (int j = 0; j < 50; ++j) {
            const float* W; const float* gain = nullptr; int ldw, K, N; float mul = 1.0f; bool f8 = false, gu = false; size_t dst;
            if (j < 8) { W = ARG_IN(3) + (size_t)j * 65536; ldw = 256; K = 256; N = 256; gain = ARG_IN(1) + (j >> 2) * D + (j & 3) * 256; dst = WS_WPOOL + (size_t)j * 65536 * 2; }
            else if (j < 10) { W = ARG_IN(6) + (j - 8) * 1024; ldw = 2048; K = 1024; N = 1024; gain = ARG_IN(5); dst = (j == 8) ? WS_WK : WS_WV; }
            else if (j < 12) { const int b = j - 10; W = ARG_IN(7) + (size_t)b * D * D; ldw = 1024; K = 1024; N = 1024; gain = ARG_IN(1) + (2 + b) * D; mul = 0.125f * 1.4426950408889634f; dst = WS_WQ + (size_t)b * D * D * 2; }
            else if (j < 14) { const int b = j - 12; W = ARG_IN(8) + (size_t)b * D * D; ldw = 1024; K = 1024; N = 1024; dst = WS_WO + (size_t)b * D * D * 2; }
            else if (j < 16) { const int i = j - 14; f8 = ((FP8_MASK >> (2 * i)) & 1) != 0; gu = true; W = ARG_IN(9) + (size_t)i * D * 2 * DFF; ldw = 2 * DFF; K = 1024; N = 2 * DFF; gain = ARG_IN(2) + (2 * i) * D; mul = f8 ? W8_UP : 1.0f; dst = WS_WFI + (size_t)i * 2 * DFF * D * 2; }
            else if (j < 18) { const int i = j - 16; f8 = ((FP8_MASK >> (2 * i)) & 1) != 0; W = ARG_IN(10) + (size_t)i * DFF * D; ldw = 1024; K = DFF; N = 1024; mul = f8 ? W8_DN : 1.0f; dst = WS_WFO + (size_t)i * D * DFF * 2; }
            else if (j < 34) { const int ie = j - 18, li = 2 * (ie >> 3) + 1, e = ie & 7; f8 = ((FP8_MASK >> li) & 1) != 0; gu = true; W = ARG_IN(12) + (size_t)ie * D * 2 * DFFE; ldw = 2 * DFFE; K = 1024; N = 2 * DFFE; gain = ARG_IN(2) + li * D; mul = f8 ? W8_UP : 1.0f;
                               dst = WS_WMI + (size_t)(ie >> 3) * 8 * 2 * DFFE * D * 2 + (size_t)e * 2 * DFFE * D * (f8 ? 1 : 2); }
            else { const int ie = j - 34, li = 2 * (ie >> 3) + 1, e = ie & 7; f8 = ((FP8_MASK >> li) & 1) != 0; W = ARG_IN(13) + (size_t)ie * DFFE * D; ldw = 1024; K = DFFE; N = 1024; mul = f8 ? W8_DN : 1.0f;
                   dst = WS_WMO + (size_t)(ie >> 3) * 8 * D * DFFE * 2 + (size_t)e * D * DFFE * (f8 ? 1 : 2); }
            const int nitems = (K / 64) * (N / 32);
            int first = (gw - base) % NGW; if (first < 0) first += NGW;
            if ((INT8_UP0 && j == 14) || (INT8_PROJ && j >= 8 && j < 12)) continue;
            tr_mat(W, ldw, K, N, gain, mul, f8 ? 1 : 0, gu, ws + dst, scr, first, NGW, lane);
            base = (base + nitems) % NGW;
        }
    }
    if (INT8_UP0 || INT8_PROJ) {
        unsigned char* ws = ARG_WS(); const int tid = fresh_tid(wave_s); const int lane = tid & 63, gw = vcu * NWAVES + __builtin_amdgcn_readfirstlane(tid >> 6);
        int base = 0;
        for (int j = 0; j < 5; ++j) {
            if ((j == 0 && !INT8_UP0) || (j > 0 && !INT8_PROJ)) continue;
            const GAS float* W; const GAS float* gn; int ldw, ncols; float mul = 1.0f; unsigned* cm;
            if (j == 0) { W = (const GAS float*)ARG_IN(9); gn = (const GAS float*)ARG_IN(2); ldw = 2 * DFF; ncols = 2 * DFF; cm = WSP(unsigned, WS_COLMAX); }
            else if (j < 3) { W = (const GAS float*)ARG_IN(6) + (j - 1) * 1024; gn = (const GAS float*)ARG_IN(5); ldw = 2048; ncols = 1024; cm = WSP(unsigned, WS_COLMAX2) + (j - 1) * 1024; }
            else { W = (const GAS float*)ARG_IN(7) + (size_t)(j - 3) * D * D; gn = (const GAS float*)ARG_IN(1) + (2 + (j - 3)) * D; ldw = 1024; ncols = 1024; mul = 0.125f * 1.4426950408889634f; cm = WSP(unsigned, WS_COLMAX2) + (2 + (j - 3)) * 1024; }
            const int nstrip = ncols / 64, ntask = nstrip * (D / 64);
            int first = (gw - base) % NGW; if (first < 0) first += NGW;
            for (int task = first; task < ntask; task += NGW) { const int strip = task % nstrip, kc = task / nstrip; const int n = strip * 64 + lane; float mx = 0.f;
#pragma unroll 16
                for (int kk = 0; kk < 64; ++kk) { const int k = kc * 64 + kk; mx = fmaxf(mx, fabsf(W[(size_t)k * ldw + n] * gn[k])); }
                const unsigned old = __hip_atomic_fetch_max(cm + n, __builtin_bit_cast(unsigned, mx * mul), __ATOMIC_RELAXED, __HIP_MEMORY_SCOPE_AGENT); asm volatile("" :: "v"(old)); }
            base = (base + ntask) % NGW;
        }
    }
    xcd_barrier(bar, wave_s);

    layer_body<0>(lds, bar, pend, cnt_l, G, bx, vcu, NGW, wave_s);
    layer_body<1>(lds, bar, pend, cnt_l, G, bx, vcu, NGW, wave_s);
    layer_body<2>(lds, bar, pend, cnt_l, G, bx, vcu, NGW, wave_s);
    layer_body<3>(lds, bar, pend, cnt_l, G, bx, vcu, NGW, wave_s);
}

extern "C" void kernel_launch(void* const* d_in, const int* in_sizes, int n_in, void* d_out, int out_size, void* d_ws, size_t ws_size, hipStream_t stream) {
    static int grid = 0;
    if (grid == 0) {
        if (n_in != 15 || out_size != M * D || ws_size < WS_END) { fprintf(stderr, "kernel_launch: unexpected shapes (n_in %d out %d ws %zu)\n", n_in, out_size, ws_size); grid = -1; return; }
        int dev = 0, cus = 0, per_cu = 0;
        if (hipGetDevice(&dev) != hipSuccess || hipDeviceGetAttribute(&cus, hipDeviceAttributeMultiprocessorCount, dev) != hipSuccess) { grid = -1; return; }
        if (hipFuncSetAttribute((const void*)yoco_fwd, hipFuncAttributeMaxDynamicSharedMemorySize, LDS_BYTES) != hipSuccess) { fprintf(stderr, "kernel_launch: hipFuncSetAttribute failed\n"); grid = -1; return; }
        if (hipOccupancyMaxActiveBlocksPerMultiprocessor(&per_cu, (const void*)yoco_fwd, NTHREADS, LDS_BYTES) != hipSuccess || per_cu < 1) { fprintf(stderr, "kernel_launch: occupancy query says %d\n", per_cu); }
        (void)hipGetLastError();
        grid = cus;
    }
    if (grid < 0) return;
    (void)hipMemsetAsync((char*)d_ws + WS_CTL, 0, CTL_ZERO_BYTES, stream);
    Args a{};
    for (int i = 0; i < 15; ++i) a.in[i] = (const float*)d_in[i];
    a.out = (float*)d_out; a.ws = (unsigned char*)d_ws;
    hipLaunchKernelGGL(yoco_fwd, dim3(grid), dim3(NTHREADS), LDS_BYTES, stream, a);
}
```

```cpp
#include <hip/hip_runtime.h>
#include <cstdio>
#include <cstdint>

#define LAS __attribute__((address_space(3)))
#define GAS __attribute__((address_space(1)))
typedef unsigned short bf16_t;
typedef short bf16x8 __attribute__((ext_vector_type(8)));
typedef float f32x2 __attribute__((ext_vector_type(2)));
typedef float f32x4 __attribute__((ext_vector_type(4)));
typedef float f32x16 __attribute__((ext_vector_type(16)));
typedef unsigned u32x2 __attribute__((ext_vector_type(2)));
typedef unsigned u32x4 __attribute__((ext_vector_type(4)));
typedef int i32x4 __attribute__((ext_vector_type(4)));
typedef __bf16 bf16x2_t __attribute__((ext_vector_type(2)));

constexpr int D = 1024, BATCH = 32, SEQ = 2048, M = BATCH * SEQ;
constexpr int DFF = 2816, DFFE = 3584, NE = 8, NH = 16;
constexpr int CAP = 2 * M + NE * 256;
constexpr int CHUNK_BLKS = 260;
constexpr float RMS_EPS = 1e-6f;
#ifndef FP8_MASK
#define FP8_MASK 14
#endif
#ifndef INT8_UP0
#define INT8_UP0 1
#endif
#ifndef INT8_PROJ
#define INT8_PROJ 1
#endif
constexpr float W8_UP = 64.f, W8_DN = 128.f, H8_SC = 8.f;
constexpr int NWAVES = 8, NTHREADS = 512;

constexpr size_t MiB = 1u << 20;
constexpr size_t WS_CTL = 0, CTL_ZERO_BYTES = 80 * 1024;
constexpr size_t WS_COLMAX2 = 65536;
constexpr size_t WS_WSCALE2 = 1 * MiB + 40960;
constexpr size_t WS_COLMAX = 32768;
constexpr size_t WS_WSCALE = 1 * MiB + 16384;
constexpr size_t WS_ASCALE = 3 * MiB + 786432;
constexpr size_t WS_TILECNT = 1 * MiB;
constexpr size_t WS_ROUTE_E = 1 * MiB + 65536;
constexpr size_t WS_ROUTE_G = 2 * MiB;
constexpr size_t WS_SLOT_OF = 2 * MiB + 524288;
constexpr size_t WS_GATE_SLOT = 3 * MiB;
constexpr size_t WS_WPOOL = 4 * MiB;
constexpr size_t WS_WK = 5 * MiB, WS_WV = 7 * MiB, WS_WQ = 9 * MiB, WS_WO = 13 * MiB;
constexpr size_t WS_WFI = 17 * MiB;
constexpr size_t WS_WFO = 39 * MiB;
constexpr size_t WS_WMI = 50 * MiB;
constexpr size_t WS_WMO = 274 * MiB;
constexpr size_t WS_XN = 386 * MiB;
constexpr size_t WS_K = 514 * MiB, WS_VT = 642 * MiB;
constexpr size_t WS_XS = 770 * MiB;
constexpr size_t WS_R = 1030 * MiB;
constexpr size_t WS_XS8 = 1485 * MiB;
constexpr size_t WS_XB = 1485 * MiB;
constexpr size_t WS_TOS = 386 * MiB + 64 * MiB;

constexpr size_t WS_DELTA = 1616 * MiB;
constexpr size_t WS_END = 1744 * MiB;
static_assert(WS_XS8 + (size_t)CAP * D <= WS_END, "xs8");
static_assert(WS_XS + (size_t)CAP * D * 2 <= WS_R, "xs");
static_assert(WS_R + (size_t)CHUNK_BLKS * 256 * DFFE * 2 <= WS_END, "moe hidden chunk");
static_assert(WS_R + (size_t)M * DFF * 2 <= WS_END, "dense hidden");
static_assert(WS_R + (size_t)CAP * DFFE <= WS_XS8, "fp8 moe hidden, one chunk");
static_assert(WS_WMO + (size_t)2 * 8 * 1024 * 3584 * 2 <= WS_XN, "weights");

constexpr int STAGE_BYTES_LDS = 131072;
constexpr int LCTL_OFF = STAGE_BYTES_LDS;
constexpr int LDS_BYTES = 147456;

__device__ __forceinline__ unsigned cvtpk(float lo, float hi) { f32x2 v = {lo, hi}; bf16x2_t b = __builtin_convertvector(v, bf16x2_t); return __builtin_bit_cast(unsigned, b); }
__device__ __forceinline__ unsigned pk4_fp8(float a, float b, float c, float d) { int w = __builtin_amdgcn_cvt_pk_fp8_f32(a, b, 0, false); w = __builtin_amdgcn_cvt_pk_fp8_f32(c, d, w, true); return (unsigned)w; }
__device__ __forceinline__ unsigned pk4_i8(float a, float b, float c, float d) {
    const int i0 = (int)__builtin_rintf(__builtin_amdgcn_fmed3f(a, -127.f, 127.f)), i1 = (int)__builtin_rintf(__builtin_amdgcn_fmed3f(b, -127.f, 127.f));
    const int i2 = (int)__builtin_rintf(__builtin_amdgcn_fmed3f(c, -127.f, 127.f)), i3 = (int)__builtin_rintf(__builtin_amdgcn_fmed3f(d, -127.f, 127.f));
    return (unsigned)(i0 & 255) | ((unsigned)(i1 & 255) << 8) | ((unsigned)(i2 & 255) << 16) | ((unsigned)i3 << 24); }
__device__ __forceinline__ float wave_max(float v) {
#pragma unroll
    for (int o = 1; o < 64; o <<= 1) v = fmaxf(v, __shfl_xor(v, o));
    return v;
}
__device__ __forceinline__ float bf_lo(unsigned w) { return __builtin_bit_cast(float, w << 16); }
__device__ __forceinline__ float bf_hi(unsigned w) { return __builtin_bit_cast(float, w & 0xffff0000u); }
__device__ __forceinline__ f32x4 ld4(const float* p) { return *(const GAS f32x4*)p; }
__device__ __forceinline__ f32x4 ld4(const bf16_t* p) { const u32x2 w = *(const GAS u32x2*)p; return (f32x4){bf_lo(w.x), bf_hi(w.x), bf_lo(w.y), bf_hi(w.y)}; }
__device__ __forceinline__ f32x2 ld2(const float* p) { return *(const GAS f32x2*)p; }
__device__ __forceinline__ f32x2 ld2(const bf16_t* p) { const unsigned w = *(const GAS unsigned*)p; return (f32x2){bf_lo(w), bf_hi(w)}; }
__device__ __forceinline__ f32x4 ldraw4(const float* p) { return *(const GAS f32x4*)p; }
__device__ __forceinline__ u32x2 ldraw4(const bf16_t* p) { return *(const GAS u32x2*)p; }
__device__ __forceinline__ f32x4 cvt4(f32x4 v) { return v; }
__device__ __forceinline__ f32x4 cvt4(u32x2 w) { return (f32x4){bf_lo(w.x), bf_hi(w.x), bf_lo(w.y), bf_hi(w.y)}; }
template <class T> struct Raw4; template <> struct Raw4<float> { typedef f32x4 t; }; template <> struct Raw4<bf16_t> { typedef u32x2 t; };
__device__ __forceinline__ float wave_sum(float v) {
#pragma unroll
    for (int o = 1; o < 64; o <<= 1) v += __shfl_xor(v, o);
    return v;
}
#define LDS_WAIT() asm volatile("s_waitcnt lgkmcnt(0)" ::: "memory")
__device__ __forceinline__ int fresh_tid(int wave_s) { int w = wave_s, z = 0; asm volatile("" : "+s"(w), "+s"(z)); return w * 64 + (int)__builtin_amdgcn_mbcnt_hi(~0u, __builtin_amdgcn_mbcnt_lo(~0u, (unsigned)z)); }
#define RLX_AGENT __ATOMIC_RELAXED, __HIP_MEMORY_SCOPE_AGENT

#define XB_TMO      128
#define XB_XCNT(j)  (256  + 64 * (j))
#define XB_XSUB(j)  (1280 + 64 * (j))
#define XB_XGEN(j)  (2304 + 64 * (j))
#define XB_TOP      3328
#define XB_TOPGEN   3392
#define XCD_BAR_WORDS 3456
#define XB_SPIN_CAP (1u << 22)
__device__ __forceinline__ unsigned xb_ld(unsigned* p)              { return __hip_atomic_load(p, __ATOMIC_RELAXED, __HIP_MEMORY_SCOPE_AGENT); }
__device__ __forceinline__ unsigned xb_add(unsigned* p, unsigned v) { return __hip_atomic_fetch_add(p, v, __ATOMIC_RELAXED, __HIP_MEMORY_SCOPE_AGENT); }
__device__ __forceinline__ unsigned xb_xcc_id() { return (unsigned)__builtin_amdgcn_s_getreg((3 << 11) | 20) & 0xFu; }
#define XB_SPIN(cond, bar) do { unsigned _sp = 0; while (cond) { __builtin_amdgcn_s_sleep(1); \
    if ((++_sp & 255u) == 0u) { if (xb_ld(&(bar)[XB_TMO])) break; if (_sp > XB_SPIN_CAP) { atomicAdd(&(bar)[XB_TMO], 1u); break; } } } } while (0)
struct XcdBarrier { unsigned* bar; unsigned x; volatile LAS unsigned* st; };
__device__ __forceinline__ XcdBarrier xcd_barrier_post(unsigned* bar, volatile LAS unsigned* st) {
    XcdBarrier b; b.bar = bar; b.x = xb_xcc_id(); b.st = st;
    if (threadIdx.x == 0) (void)xb_add(&bar[XB_XCNT(b.x)], 1u);
    return b;
}
__device__ __forceinline__ void xcd_barrier_complete(unsigned* bar, unsigned x, unsigned& nloc, unsigned& nx) {
    const unsigned G = gridDim.x * gridDim.y * gridDim.z;
    unsigned sum, cnt, mine, sp = 0u;
    for (;;) {
        sum = 0u; cnt = 0u; mine = 0u;
#pragma unroll
        for (unsigned j = 0; j < 16; ++j) { const unsigned c = xb_ld(&bar[XB_XCNT(j)]); sum += c; cnt += (c > 0u) ? 1u : 0u; mine = (j == x) ? c : mine; }
        if (sum == G) break;
        __builtin_amdgcn_s_sleep(1);
        if ((++sp & 255u) == 0u) { if (xb_ld(&bar[XB_TMO])) break; if (sp > XB_SPIN_CAP) { atomicAdd(&bar[XB_TMO], 1u); break; } }
    }
    nloc = mine > 0u ? mine : 1u; nx = cnt > 0u ? cnt : 1u;
}
__device__ __forceinline__ void xcd_barrier(const XcdBarrier& b, int wave_s) {
    asm volatile("s_waitcnt vmcnt(0)" ::: "memory");
    __syncthreads();
    if (fresh_tid(wave_s) == 0) {
        unsigned* bar = b.bar;
        __builtin_amdgcn_s_waitcnt(0);
        unsigned nloc = b.st[0], nx = b.st[1];
        if (nloc == 0u) { xcd_barrier_complete(bar, b.x, nloc, nx); b.st[0] = nloc; b.st[1] = nx; }
        const unsigned old = xb_add(&bar[XB_XSUB(b.x)], 1u);
        const unsigned gen = old / nloc;
        if (old + 1u == (gen + 1u) * nloc) {
            __builtin_amdgcn_fence(__ATOMIC_RELEASE, "agent");
            asm volatile("s_waitcnt vmcnt(0)" ::: "memory");
            const unsigned og = xb_add(&bar[XB_TOP], 1u);
            const unsigned tg = og / nx;
            if (og + 1u == (tg + 1u) * nx) xb_add(&bar[XB_TOPGEN], 1u);
            else XB_SPIN(xb_ld(&bar[XB_TOPGEN]) == tg, bar);
            __builtin_amdgcn_fence(__ATOMIC_ACQUIRE, "agent");
            xb_add(&bar[XB_XGEN(b.x)], 1u);
            asm volatile("s_waitcnt vmcnt(0)" ::: "memory");
        } else {
            XB_SPIN(xb_ld(&bar[XB_XGEN(b.x)]) == gen, bar);
            __builtin_amdgcn_fence(__ATOMIC_ACQUIRE, "agent");
            asm volatile("s_waitcnt vmcnt(0)" ::: "memory");
        }
    }
    __syncthreads();
}

namespace pg8 {
constexpr int BM = 256, BK = 64, HALF = 128, HTB = HALF * BK * 2, NXCD = 8, WGM = 8;
__host__ __device__ __forceinline__ int lds_byte(int r, int c) { const int st = (r >> 4) * 2 + (c >> 5), rr = r & 15, cc = c & 31, ob = rr * 64 + cc * 2; return st * 1024 + (ob ^ (((ob >> 9) & 1) << 5)); }
__host__ __device__ __forceinline__ void stage_rc(int b, int& R, int& C) { const int st = b / 1024, sb = b % 1024, swz = sb ^ (((sb >> 9) & 1) << 5); R = (st >> 1) * 16 + swz / 64; C = (st & 1) * 32 + (swz % 64) / 2; }
__host__ __device__ __forceinline__ int perm32(int rho) { const int n = rho >> 4, i = rho & 15; return 8 * (i >> 2) + 4 * n + (i & 3); }

typedef int i32x8 __attribute__((ext_vector_type(8)));
__device__ __forceinline__ i32x8 cat8(bf16x8 lo, bf16x8 hi) { const i32x4 a = __builtin_bit_cast(i32x4, lo), b = __builtin_bit_cast(i32x4, hi); return __builtin_shufflevector(a, b, 0, 1, 2, 3, 4, 5, 6, 7); }
struct Unit { const char* A; const char* B; int pm, pn, aux; };
struct GemmK { int K, lda, ldb; };

__device__ __forceinline__ bool smap(long L, int nM, int nN, int& pm, int& pn) {
    const int nwg = nM * nN; if (L >= nwg) return false;
    int wgid = (int)L; { const int q = nwg / NXCD, r = nwg % NXCD, xcd = wgid % NXCD, off = wgid / NXCD; wgid = (xcd < r ? xcd * (q + 1) : r * (q + 1) + (xcd - r) * q) + off; }
    const int nig = WGM * nN, gid = wgid / nig, fm = gid * WGM, gsz = (nM - fm) < WGM ? (nM - fm) : WGM;
    pm = fm + ((wgid % nig) % gsz); pn = (wgid % nig) / gsz; return true;
}

template <class Epi, class Sched, bool ALIGN_EPI, int MODE = 0, bool GATHER = false>
__device__ __forceinline__ void gemm_phase(LAS unsigned char* lds, const GemmK g, const Sched& S, const Epi& E, int wave_s) {
    const int tid = fresh_tid(wave_s);
    const int wid = __builtin_amdgcn_readfirstlane(tid >> 6), lane = tid & 63, wr = wid >> 2, wc = wid & 3, fr = lane & 15, fq = lane >> 4;
    constexpr bool FP8 = (MODE == 1);
    const int K = g.K, nt = K / BK;
    unsigned voffA[2], voffB[2];
#pragma unroll
    for (int i = 0; i < 2; ++i) { int R, C; stage_rc(tid * 16 + i * 8192, R, C); const int Rb = Epi::PERM ? ((R & ~31) + perm32(R & 31)) : R;
        voffA[i] = (unsigned)(R * g.lda + C) * 2u; voffB[i] = (unsigned)(Rb * g.ldb + C) * 2u; }
    unsigned vG[2][2], vN[2][2];
    const size_t kstep = (size_t)(BK * 2);
    const size_t hstepA = (size_t)HALF * g.lda * 2, hstepB = (size_t)HALF * g.ldb * 2;
    const unsigned ldsw = (unsigned)wid * 1024u;
    const int aoff = lds_byte(wr * 64 + fr, fq * 8), boff = lds_byte(wc * 32 + fr, fq * 8);
#define PG8_SA(b, h) (((b) * 2 + (h)) * HTB)
#define PG8_SB(b, h) ((4 + (b) * 2 + (h)) * HTB)
#define PG8_STAGE(bufoff, gbase, voff) do { _Pragma("unroll") for (int _i = 0; _i < 2; ++_i) \
        __builtin_amdgcn_global_load_lds((const unsigned*)((const char*)(gbase) + (voff)[_i]), (LAS unsigned*)(lds + (bufoff) + ldsw + _i * 8192), 16, 0, 0); } while (0)
#define PG8_STAGE_A(bufoff, gbase, h, nx) do { if constexpr (GATHER) { unsigned _v[2] = { (nx) ? vN[h][0] : vG[h][0], (nx) ? vN[h][1] : vG[h][1] }; PG8_STAGE(bufoff, gbase, _v); } \
        else PG8_STAGE(bufoff, (gbase) + (h) * hstepA, voffA); } while (0)
#define PG8_LD8(p) __builtin_shufflevector(*(const LAS i32x4*)(p), *(const LAS i32x4*)((p) + 1024), 0, 1, 2, 3, 4, 5, 6, 7)
#define PG8_LDA(dst, b, h) do { if constexpr (FP8) { _Pragma("unroll") for (int m = 0; m < 4; ++m) dst##8[m] = PG8_LD8(lds + PG8_SA(b, h) + aoff + m * 2048); } \
        else { _Pragma("unroll") for (int m = 0; m < 4; ++m) _Pragma("unroll") for (int k = 0; k < 2; ++k) dst[m][k] = *(const LAS bf16x8*)(lds + PG8_SA(b, h) + aoff + m * 2048 + k * 1024); } } while (0)
#define PG8_LDB(dst, b, h) do { if constexpr (FP8) { _Pragma("unroll") for (int n = 0; n < 2; ++n) dst##8[n] = PG8_LD8(lds + PG8_SB(b, h) + boff + n * 2048); } \
        else { _Pragma("unroll") for (int n = 0; n < 2; ++n) _Pragma("unroll") for (int k = 0; k < 2; ++k) dst[n][k] = *(const LAS bf16x8*)(lds + PG8_SB(b, h) + boff + n * 2048 + k * 1024); } } while (0)
#define PG8_MMA(ai, bj, At, Bt) do { __builtin_amdgcn_s_setprio(1); _Pragma("unroll") for (int m = 0; m < 4; ++m) _Pragma("unroll") for (int n = 0; n < 2; ++n) { \
        if constexpr (FP8) asm volatile("v_mfma_f32_16x16x128_f8f6f4 %0, %1, %2, %0" : "+v"(acc[ai][bj][m][n]) : "v"(Bt##8[n]), "v"(At##8[m])); \
        else if constexpr (MODE == 2) { _Pragma("unroll") for (int k = 0; k < 2; ++k) acc[ai][bj][m][n] = __builtin_bit_cast(f32x4, __builtin_amdgcn_mfma_i32_16x16x64_i8(__builtin_bit_cast(i32x4, Bt[n][k]), __builtin_bit_cast(i32x4, At[m][k]), __builtin_bit_cast(i32x4, acc[ai][bj][m][n]), 0, 0, 0)); } \
        else { _Pragma("unroll") for (int k = 0; k < 2; ++k) acc[ai][bj][m][n] = __builtin_amdgcn_mfma_f32_16x16x32_bf16(Bt[n][k], At[m][k], acc[ai][bj][m][n], 0, 0, 0); } } \
        __builtin_amdgcn_s_setprio(0); } while (0)
#define PG8_WAIT_V(n) asm volatile("s_waitcnt vmcnt(" #n ")" ::: "memory")
#define PG8_WAIT_L(n) asm volatile("s_waitcnt lgkmcnt(" #n ")" ::: "memory")
#define PG8_BAR __builtin_amdgcn_s_barrier()
#define PG8_SCHED __builtin_amdgcn_sched_barrier(0)
    Unit cur, nxt; int ui = 0;
    if (!S.next(0, cur)) return;
    f32x4 acc[2][2][4][2];
#pragma unroll
    for (int a = 0; a < 2; ++a)
#pragma unroll
        for (int b = 0; b < 2; ++b)
#pragma unroll
            for (int m = 0; m < 4; ++m)
#pragma unroll
                for (int n = 0; n < 2; ++n) acc[a][b][m][n] = (f32x4){0.f, 0.f, 0.f, 0.f};
    bf16x8 At[4][2], B0[2][2], B1[2][2]; i32x8 At8[4], B08[2], B18[2];
    const char* cA = cur.A; const char* cB = cur.B;
    if constexpr (GATHER) {
#pragma unroll
        for (int i = 0; i < 2; ++i) { int R, C; stage_rc(tid * 16 + i * 8192, R, C);
#pragma unroll
            for (int h = 0; h < 2; ++h) { vG[h][i] = (unsigned)S.tos[(size_t)cur.aux * 256 + h * HALF + R] * (unsigned)(g.lda * 2) + (unsigned)C * 2u; vN[h][i] = vG[h][i]; } } }
    PG8_STAGE(PG8_SB(0, 0), cB, voffB); PG8_STAGE(PG8_SB(0, 1), cB + hstepB, voffB); PG8_STAGE_A(PG8_SA(0, 0), cA, 0, false); PG8_STAGE_A(PG8_SA(0, 1), cA, 1, false);
    if (wr == 1) PG8_BAR;
    PG8_WAIT_V(2); PG8_BAR;
    PG8_STAGE(PG8_SB(1, 0), cB + kstep, voffB); PG8_STAGE_A(PG8_SA(1, 0), cA + kstep, 0, false); PG8_STAGE(PG8_SB(1, 1), cB + hstepB + kstep, voffB);
    PG8_WAIT_V(6); PG8_BAR;
    for (;;) {
        const bool has_next = S.next(ui + 1, nxt);
        const char* nA = has_next ? nxt.A : cA; const char* nB = has_next ? nxt.B : cB;
        if constexpr (GATHER) { if (has_next && wid < 4) __builtin_amdgcn_global_load_lds((const unsigned*)(S.tos + (size_t)nxt.aux * 256 + wid * 64 + lane), (LAS unsigned*)(S.idxl + ((ui + 1) & 1) * 256 + wid * 64), 4, 0, 0); }
        for (int t = 0; t < nt; t += 2) {
            const bool last = (t == nt - 2);
            const char* a1 = cA + (size_t)(t + 1) * kstep;
            const char* a2 = last ? nA : cA + (size_t)(t + 2) * kstep; const char* b2 = last ? nB : cB + (size_t)(t + 2) * kstep;
            const char* a3 = a2 + kstep; const char* b3 = b2 + kstep;
            if constexpr (GATHER) { if (last) {
                    const LAS int* ib = S.idxl + ((ui + 1) & 1) * 256;
#pragma unroll
                    for (int i = 0; i < 2; ++i) { int R, C; stage_rc(tid * 16 + i * 8192, R, C);
#pragma unroll
                        for (int h = 0; h < 2; ++h) vN[h][i] = has_next ? (unsigned)ib[h * HALF + R] * (unsigned)(g.lda * 2) + (unsigned)C * 2u : vG[h][i]; } } }
            PG8_LDB(B0, 0, 0); PG8_LDB(B1, 0, 1); PG8_SCHED; PG8_LDA(At, 0, 0); PG8_STAGE_A(PG8_SA(1, 1), a1, 1, false);
            PG8_WAIT_V(8); PG8_WAIT_L(0); PG8_BAR; PG8_MMA(0, 0, At, B0); PG8_MMA(0, 1, At, B1); PG8_BAR; PG8_SCHED;
            PG8_LDA(At, 0, 1); PG8_STAGE(PG8_SB(0, 0), b2, voffB); PG8_STAGE(PG8_SB(0, 1), b2 + hstepB, voffB); PG8_STAGE_A(PG8_SA(0, 0), a2, 0, last);
            PG8_WAIT_V(8); PG8_WAIT_L(0); PG8_BAR; PG8_MMA(1, 0, At, B0); PG8_MMA(1, 1, At, B1); PG8_BAR; PG8_SCHED;
            PG8_LDB(B0, 1, 0); PG8_LDB(B1, 1, 1); PG8_SCHED; PG8_LDA(At, 1, 0); PG8_STAGE_A(PG8_SA(0, 1), a2, 1, last);
            PG8_WAIT_V(8); PG8_WAIT_L(0); PG8_BAR; PG8_MMA(0, 0, At, B0); PG8_MMA(0, 1, At, B1); PG8_BAR; PG8_SCHED;
            PG8_LDA(At, 1, 1); PG8_STAGE(PG8_SB(1, 0), b3, voffB); PG8_STAGE(PG8_SB(1, 1), b3 + hstepB, voffB); PG8_STAGE_A(PG8_SA(1, 0), a3, 0, last);
            PG8_WAIT_V(8); PG8_WAIT_L(0); PG8_BAR; PG8_MMA(1, 0, At, B0); PG8_MMA(1, 1, At, B1); PG8_BAR; PG8_SCHED;
        }
        if constexpr (ALIGN_EPI) { if (wr == 0) PG8_BAR; }
        if constexpr (FP8) asm volatile("s_nop 15\n\ts_nop 15" ::: "memory");
        E(acc, cur, wr, wc, fr, fq);
        if (!has_next) break;
#pragma unroll
        for (int a = 0; a < 2; ++a)
#pragma unroll
            for (int b = 0; b < 2; ++b)
#pragma unroll
                for (int m = 0; m < 4; ++m)
#pragma unroll
                    for (int n = 0; n < 2; ++n) acc[a][b][m][n] = (f32x4){0.f, 0.f, 0.f, 0.f};
        cur = nxt; cA = nA; cB = nB; ++ui;
        if constexpr (GATHER) {
#pragma unroll
            for (int h = 0; h < 2; ++h) { vG[h][0] = vN[h][0]; vG[h][1] = vN[h][1]; } }
        if constexpr (ALIGN_EPI) { if (wr == 1) PG8_BAR; }
    }
    PG8_WAIT_V(0);
    if constexpr (!ALIGN_EPI) { if (wr == 0) PG8_BAR; }
    PG8_BAR;
#undef PG8_SA
#undef PG8_SB
#undef PG8_STAGE
#undef PG8_STAGE_A
#undef PG8_LDA
#undef PG8_LDB
#undef PG8_MMA
#undef PG8_WAIT_V
#undef PG8_WAIT_L
#undef PG8_BAR
#undef PG8_SCHED
}

struct DenseOrder {
    int nM, nN, G, c; const char* A; const char* B; size_t at, bt;
    __device__ __forceinline__ bool next(int i, Unit& u) const { int pm, pn; if (!smap((long)i * G + c, nM, nN, pm, pn)) return false;
        u.A = A + (size_t)pm * at; u.B = B + (size_t)pn * bt; u.pm = pm; u.pn = pn; u.aux = 0; return true; }
};
struct PoolOrder {
    int G, c; const char* P; const char* W;
    __device__ __forceinline__ bool next(int i, Unit& u) const { int pm, pn; if (!smap((long)i * G + c, M / 256, 4, pm, pn)) return false;
        u.A = P + (size_t)pm * (256 * 1024 * 2) + (size_t)pn * 512; u.B = W + (size_t)pn * (256 * 256 * 2); u.pm = pm; u.pn = pn; u.aux = 0; return true; }
};
struct ProjOrder {
    int njobs, G, c; const char* ws; size_t qoff, tb;
    __device__ __forceinline__ bool next(int i, Unit& u) const {
        const long L = (long)i * G + c; if (L >= (long)njobs * 1024) return false;
        const int job = (int)(L >> 10), l = (int)(L & 1023); const int kind = (njobs == 1) ? 1 : job;
        const size_t woff = WS_WK + (size_t)(kind == 1) * (WS_WQ + qoff - WS_WK) + (size_t)(kind == 2) * (WS_WV - WS_WK);
        int pm, pn;
        if (kind == 2) { smap(l, 4, 256, pm, pn); u.A = ws + woff + (size_t)pm * tb; u.B = ws + WS_XN + (size_t)pn * tb; }
        else { smap(l, 256, 4, pm, pn); u.A = ws + WS_XN + (size_t)pm * tb; u.B = ws + woff + (size_t)pn * tb; }
        u.pm = pm; u.pn = pn; u.aux = kind; return true; }
};
struct MoeOrder {
    int nM, nN, G, c, blk0, a_rel; const char* A; const char* B; size_t at, bt, be; const LAS int* pend;
    __device__ __forceinline__ bool next(int i, Unit& u) const { int pm, pn; if (!smap((long)i * G + c, nM, nN, pm, pn)) return false;
        const int b = blk0 + pm; int e = 0;
#pragma unroll
        for (int j = 0; j < 7; ++j) e += (b >= pend[j]) ? 1 : 0;
        e = __builtin_amdgcn_readfirstlane(e);
        u.A = A + (size_t)(a_rel ? pm : b) * at; u.B = B + (size_t)e * be + (size_t)pn * bt; u.pm = a_rel ? b : pm; u.pn = pn; u.aux = 0; return true; }
};

struct MoeGatherOrder {
    int nM, nN, G, c, blk0; const char* A; const char* B; size_t bt, be; const LAS int* pend; const int* tos; LAS int* idxl;
    __device__ __forceinline__ bool next(int i, Unit& u) const { int pm, pn; if (!smap((long)i * G + c, nM, nN, pm, pn)) return false;
        const int b = blk0 + pm; int e = 0;
#pragma unroll
        for (int j = 0; j < 7; ++j) e += (b >= pend[j]) ? 1 : 0;
        e = __builtin_amdgcn_readfirstlane(e);
        u.A = A; u.B = B + (size_t)e * be + (size_t)pn * bt; u.pm = pm; u.pn = pn; u.aux = b; return true; }
};
struct EpiPool {
    static constexpr bool PERM = false;
    const float* xin; float* out; const float* scale; float mul;
    __device__ __forceinline__ void operator()(const f32x4 (&acc)[2][2][4][2], const Unit& u, int wr, int wc, int fr, int fq) const {
        const int row0 = u.pm * BM + wr * 64 + fr, col0 = u.pn * BM + wc * 32 + 4 * fq;
        f32x4 sv[2][2];
#pragma unroll
        for (int bj = 0; bj < 2; ++bj)
#pragma unroll
            for (int n = 0; n < 2; ++n) sv[bj][n] = *(const f32x4*)(scale + col0 + bj * HALF + n * 16) * mul;
#pragma unroll
        for (int ai = 0; ai < 2; ++ai)
#pragma unroll
            for (int m = 0; m < 4; ++m) { const size_t off = (size_t)(row0 + ai * HALF + m * 16) * D + col0;
#pragma unroll
                for (int bj = 0; bj < 2; ++bj)
#pragma unroll
                    for (int n = 0; n < 2; ++n) { const f32x4 xv = *(const f32x4*)(xin + off + bj * HALF + n * 16); *(f32x4*)(out + off + bj * HALF + n * 16) = xv + sv[bj][n] * acc[ai][bj][m][n]; }
                asm volatile("" ::: "memory"); }
    }
};
struct EpiDelta {
    static constexpr bool PERM = true;
    bf16_t* DL; const float* scale;
    __device__ __forceinline__ void operator()(const f32x4 (&acc)[2][2][4][2], const Unit& u, int wr, int wc, int fr, int fq) const {
        const int row0 = u.pm * BM + wr * 64 + fr, col0 = u.pn * BM + wc * 32 + 8 * fq;
        f32x4 sv[2][2];
#pragma unroll
        for (int bj = 0; bj < 2; ++bj) { sv[bj][0] = scale ? *(const f32x4*)(scale + col0 + bj * HALF) : (f32x4){1.f, 1.f, 1.f, 1.f}; sv[bj][1] = scale ? *(const f32x4*)(scale + col0 + bj * HALF + 4) : (f32x4){1.f, 1.f, 1.f, 1.f}; }
#pragma unroll
        for (int ai = 0; ai < 2; ++ai)
#pragma unroll
            for (int m = 0; m < 4; ++m) { bf16_t* rowp = DL + (size_t)(row0 + ai * HALF + m * 16) * D + col0;
#pragma unroll
                for (int bj = 0; bj < 2; ++bj) { const f32x4 v0 = acc[ai][bj][m][0] * sv[bj][0], v1 = acc[ai][bj][m][1] * sv[bj][1];
                    u32x4 w; w.x = cvtpk(v0[0], v0[1]); w.y = cvtpk(v0[2], v0[3]); w.z = cvtpk(v1[0], v1[1]); w.w = cvtpk(v1[2], v1[3]);
                    *(u32x4*)(rowp + bj * HALF) = w; } }
    }
};
struct EpiResidB {
    static constexpr bool PERM = true;
    bf16_t* xb; const float* scale; float mul;
    __device__ __forceinline__ void operator()(const f32x4 (&acc)[2][2][4][2], const Unit& u, int wr, int wc, int fr, int fq) const {
        const int row0 = u.pm * BM + wr * 64 + fr, col0 = u.pn * BM + wc * 32 + 8 * fq;
        f32x4 sv[2][2];
#pragma unroll
        for (int bj = 0; bj < 2; ++bj) { sv[bj][0] = (scale ? *(const f32x4*)(scale + col0 + bj * HALF) : (f32x4){1.f, 1.f, 1.f, 1.f}) * mul; sv[bj][1] = (scale ? *(const f32x4*)(scale + col0 + bj * HALF + 4) : (f32x4){1.f, 1.f, 1.f, 1.f}) * mul; }
#pragma unroll
        for (int ai = 0; ai < 2; ++ai)
#pragma unroll
            for (int m = 0; m < 4; ++m) { bf16_t* rowp = xb + (size_t)(row0 + ai * HALF + m * 16) * D + col0;
#pragma unroll
                for (int bj = 0; bj < 2; ++bj) { const u32x4 d = *(const u32x4*)(rowp + bj * HALF);
                    const f32x4 o0 = (f32x4){bf_lo(d.x), bf_hi(d.x), bf_lo(d.y), bf_hi(d.y)} + acc[ai][bj][m][0] * sv[bj][0], o1 = (f32x4){bf_lo(d.z), bf_hi(d.z), bf_lo(d.w), bf_hi(d.w)} + acc[ai][bj][m][1] * sv[bj][1];
                    u32x4 w; w.x = cvtpk(o0[0], o0[1]); w.y = cvtpk(o0[2], o0[3]); w.z = cvtpk(o1[0], o1[1]); w.w = cvtpk(o1[2], o1[3]); *(u32x4*)(rowp + bj * HALF) = w; }
                asm volatile("" ::: "memory"); }
    }
};
template <class XT>
struct EpiResidD {
    static constexpr bool PERM = true;
    const XT* xsrc; bf16_t* out; const bf16_t* DL; float mul;
    __device__ __forceinline__ void operator()(const f32x4 (&acc)[2][2][4][2], const Unit& u, int wr, int wc, int fr, int fq) const {
        const int row0 = u.pm * BM + wr * 64 + fr, col0 = u.pn * BM + wc * 32 + 8 * fq;
#pragma unroll
        for (int ai = 0; ai < 2; ++ai)
#pragma unroll
            for (int m = 0; m < 4; ++m) { const size_t off0 = (size_t)(row0 + ai * HALF + m * 16) * D + col0;
#pragma unroll
                for (int bj = 0; bj < 2; ++bj) { const size_t off = off0 + bj * HALF; const f32x4 x0 = ld4(xsrc + off), x1 = ld4(xsrc + off + 4); const u32x4 d = *(const u32x4*)(DL + off);
                    const f32x4 d0 = {bf_lo(d.x), bf_hi(d.x), bf_lo(d.y), bf_hi(d.y)}, d1 = {bf_lo(d.z), bf_hi(d.z), bf_lo(d.w), bf_hi(d.w)};
                    const f32x4 o0 = x0 + d0 + acc[ai][bj][m][0] * mul, o1 = x1 + d1 + acc[ai][bj][m][1] * mul;
                    u32x4 w; w.x = cvtpk(o0[0], o0[1]); w.y = cvtpk(o0[2], o0[3]); w.z = cvtpk(o1[0], o1[1]); w.w = cvtpk(o1[2], o1[3]); *(u32x4*)(out + off) = w; }
                asm volatile("" ::: "memory"); }
    }
};
struct EpiResid {
    static constexpr bool PERM = false;
    float* x; float mul;
    __device__ __forceinline__ void operator()(const f32x4 (&acc)[2][2][4][2], const Unit& u, int wr, int wc, int fr, int fq) const {
        const int row0 = u.pm * BM + wr * 64 + fr, col0 = u.pn * BM + wc * 32 + 4 * fq;
#pragma unroll
        for (int ai = 0; ai < 2; ++ai)
#pragma unroll
            for (int m = 0; m < 4; ++m) { float* p = x + (size_t)(row0 + ai * HALF + m * 16) * D + col0;
#pragma unroll
                for (int bj = 0; bj < 2; ++bj)
#pragma unroll
                    for (int n = 0; n < 2; ++n) { const f32x4 xv = *(const f32x4*)(p + bj * HALF + n * 16); *(f32x4*)(p + bj * HALF + n * 16) = xv + acc[ai][bj][m][n] * mul; }
                asm volatile("" ::: "memory"); }
    }
};
__device__ __forceinline__ f32x2 swiglu2(f32x2 g, f32x2 u, float c1  , float kinv  ) {
    const f32x2 t = g * c1; f32x2 e; e.x = __builtin_amdgcn_exp2f(t.x); e.y = __builtin_amdgcn_exp2f(t.y);
    const f32x2 d = e * kinv + kinv; f32x2 r; r.x = __builtin_amdgcn_rcpf(d.x); r.y = __builtin_amdgcn_rcpf(d.y);
    return (g * u) * r;
}
__device__ __forceinline__ float silu_mul(float g, float u) { return g * u * __builtin_amdgcn_rcpf(1.0f + __builtin_amdgcn_exp2f(-1.4426950408889634f * g)); }
struct EpiSwiglu {
    static constexpr bool PERM = true;
    bf16_t* H; int ldc;
    __device__ __forceinline__ void operator()(const f32x4 (&acc)[2][2][4][2], const Unit& u, int wr, int wc, int fr, int fq) const {
        const int row0 = u.pm * BM + wr * 64 + fr, col0 = u.pn * HALF + wc * 32 + 8 * fq;
#pragma unroll
        for (int ai = 0; ai < 2; ++ai)
#pragma unroll
            for (int m = 0; m < 4; ++m) { bf16_t* rowp = H + (size_t)(row0 + ai * HALF + m * 16) * ldc + col0;
                const f32x4 g0 = acc[ai][0][m][0], g1 = acc[ai][0][m][1], u0 = acc[ai][1][m][0], u1 = acc[ai][1][m][1];
                const f32x2 h0 = swiglu2((f32x2){g0[0], g0[1]}, (f32x2){u0[0], u0[1]}, -1.4426950408889634f, 1.0f), h1 = swiglu2((f32x2){g0[2], g0[3]}, (f32x2){u0[2], u0[3]}, -1.4426950408889634f, 1.0f);
                const f32x2 h2 = swiglu2((f32x2){g1[0], g1[1]}, (f32x2){u1[0], u1[1]}, -1.4426950408889634f, 1.0f), h3 = swiglu2((f32x2){g1[2], g1[3]}, (f32x2){u1[2], u1[3]}, -1.4426950408889634f, 1.0f);
                u32x4 w; w.x = cvtpk(h0.x, h0.y); w.y = cvtpk(h1.x, h1.y); w.z = cvtpk(h2.x, h2.y); w.w = cvtpk(h3.x, h3.y);
                *(u32x4*)rowp = w; }
    }
};
struct EpiSwigluI8 {
    static constexpr bool PERM = true;
    bf16_t* H; int ldc; const float* ascale; const float* wscale;
    __device__ __forceinline__ void operator()(const f32x4 (&acc)[2][2][4][2], const Unit& u, int wr, int wc, int fr, int fq) const {
        const int row0 = u.pm * BM + wr * 64 + fr, col0 = u.pn * HALF + wc * 32 + 8 * fq;
        const float* wsp = wscale + u.pn * BM + wc * 32 + 8 * fq;
        const f32x4 sg0 = *(const f32x4*)wsp, sg1 = *(const f32x4*)(wsp + 4), su0 = *(const f32x4*)(wsp + HALF), su1 = *(const f32x4*)(wsp + HALF + 4);
#pragma unroll
        for (int ai = 0; ai < 2; ++ai)
#pragma unroll
            for (int m = 0; m < 4; ++m) { const int row = row0 + ai * HALF + m * 16; bf16_t* rowp = H + (size_t)row * ldc + col0; const float sa = ascale[row];
                const i32x4 ig0 = __builtin_bit_cast(i32x4, acc[ai][0][m][0]), ig1 = __builtin_bit_cast(i32x4, acc[ai][0][m][1]), iu0 = __builtin_bit_cast(i32x4, acc[ai][1][m][0]), iu1 = __builtin_bit_cast(i32x4, acc[ai][1][m][1]);
                const f32x4 g0 = __builtin_convertvector(ig0, f32x4) * (sg0 * sa), g1 = __builtin_convertvector(ig1, f32x4) * (sg1 * sa), u0 = __builtin_convertvector(iu0, f32x4) * (su0 * sa), u1 = __builtin_convertvector(iu1, f32x4) * (su1 * sa);
                const f32x2 h0 = swiglu2((f32x2){g0[0], g0[1]}, (f32x2){u0[0], u0[1]}, -1.4426950408889634f, 1.0f), h1 = swiglu2((f32x2){g0[2], g0[3]}, (f32x2){u0[2], u0[3]}, -1.4426950408889634f, 1.0f);
                const f32x2 h2 = swiglu2((f32x2){g1[0], g1[1]}, (f32x2){u1[0], u1[1]}, -1.4426950408889634f, 1.0f), h3 = swiglu2((f32x2){g1[2], g1[3]}, (f32x2){u1[2], u1[3]}, -1.4426950408889634f, 1.0f);
                u32x4 w; w.x = cvtpk(h0.x, h0.y); w.y = cvtpk(h1.x, h1.y); w.z = cvtpk(h2.x, h2.y); w.w = cvtpk(h3.x, h3.y);
                *(u32x4*)rowp = w; }
    }
};
struct EpiSwiglu8 {
    static constexpr bool PERM = true;
    unsigned char* H; int ldc; float gsc;
    __device__ __forceinline__ void operator()(const f32x4 (&acc)[2][2][4][2], const Unit& u, int wr, int wc, int fr, int fq) const {
        const int row0 = u.pm * BM + wr * 64 + fr, col0 = u.pn * HALF + wc * 32 + 8 * fq;
#pragma unroll
        for (int ai = 0; ai < 2; ++ai)
#pragma unroll
            for (int m = 0; m < 4; ++m) { unsigned char* rowp = H + (size_t)(row0 + ai * HALF + m * 16) * ldc + col0;
                const f32x4 g0 = acc[ai][0][m][0], g1 = acc[ai][0][m][1], u0 = acc[ai][1][m][0], u1 = acc[ai][1][m][1];
                const float c1 = -1.4426950408889634f * gsc, kinv = 1.0f / (gsc * gsc * H8_SC);
                const f32x2 h0 = swiglu2((f32x2){g0[0], g0[1]}, (f32x2){u0[0], u0[1]}, c1, kinv), h1 = swiglu2((f32x2){g0[2], g0[3]}, (f32x2){u0[2], u0[3]}, c1, kinv);
                const f32x2 h2 = swiglu2((f32x2){g1[0], g1[1]}, (f32x2){u1[0], u1[1]}, c1, kinv), h3 = swiglu2((f32x2){g1[2], g1[3]}, (f32x2){u1[2], u1[3]}, c1, kinv);
#define CL8(v) __builtin_amdgcn_fmed3f((v), -448.f, 448.f)
                u32x2 w; w.x = pk4_fp8(CL8(h0.x), CL8(h0.y), CL8(h1.x), CL8(h1.y)); w.y = pk4_fp8(CL8(h2.x), CL8(h2.y), CL8(h3.x), CL8(h3.y));
#undef CL8
                *(u32x2*)rowp = w; }
    }
};
struct EpiProj {
    static constexpr bool PERM = true;
    bf16_t *Kb, *Qb, *Vt;
    __device__ __forceinline__ void operator()(const f32x4 (&acc)[2][2][4][2], const Unit& u, int wr, int wc, int fr, int fq) const {
        bf16_t* base = (u.aux == 0) ? Kb : (u.aux == 1 ? Qb : Vt); const size_t ldc = (u.aux == 2) ? (size_t)M : (size_t)D;
        const int row0 = u.pm * BM + wr * 64 + fr, col0 = u.pn * BM + wc * 32 + 8 * fq;
#pragma unroll
        for (int ai = 0; ai < 2; ++ai)
#pragma unroll
            for (int m = 0; m < 4; ++m) { bf16_t* rowp = base + (size_t)(row0 + ai * HALF + m * 16) * ldc + col0;
#pragma unroll
                for (int bj = 0; bj < 2; ++bj) { const f32x4 v0 = acc[ai][bj][m][0], v1 = acc[ai][bj][m][1];
                    u32x4 w; w.x = cvtpk(v0[0], v0[1]); w.y = cvtpk(v0[2], v0[3]); w.z = cvtpk(v1[0], v1[1]); w.w = cvtpk(v1[2], v1[3]);
                    if (u.aux == 2) { bf16_t* p16 = rowp + bj * HALF - (fq & 1) * 8 + (fq & 1) * 4;
                        *(u32x2*)p16 = (u32x2){w.x, w.y}; *(u32x2*)(p16 + 8) = (u32x2){w.z, w.w}; }
                    else *(u32x4*)(rowp + bj * HALF) = w; } }
    }
};
struct EpiProjI8 {
    static constexpr bool PERM = true;
    bf16_t *Kb, *Qb, *Vt; const float* ascale; const float* wsc  ; int qsel;
    __device__ __forceinline__ void operator()(const f32x4 (&acc)[2][2][4][2], const Unit& u, int wr, int wc, int fr, int fq) const {
        bf16_t* base = (u.aux == 0) ? Kb : (u.aux == 1 ? Qb : Vt); const size_t ldc = (u.aux == 2) ? (size_t)M : (size_t)D;
        const float* rs; const float* cs; if (u.aux == 2) { rs = wsc + 1024; cs = ascale; } else { rs = ascale; cs = wsc + u.aux * (2048 + qsel * 1024); }
        const int row0 = u.pm * BM + wr * 64 + fr, col0 = u.pn * BM + wc * 32 + 8 * fq;
        f32x4 cv[2][2];
#pragma unroll
        for (int bj = 0; bj < 2; ++bj) { cv[bj][0] = *(const f32x4*)(cs + col0 + bj * HALF); cv[bj][1] = *(const f32x4*)(cs + col0 + bj * HALF + 4); }
#pragma unroll
        for (int ai = 0; ai < 2; ++ai)
#pragma unroll
            for (int m = 0; m < 4; ++m) { const int row = row0 + ai * HALF + m * 16; bf16_t* rowp = base + (size_t)row * ldc + col0; const float rv = rs[row];
#pragma unroll
                for (int bj = 0; bj < 2; ++bj) { const f32x4 v0 = __builtin_convertvector(__builtin_bit_cast(i32x4, acc[ai][bj][m][0]), f32x4) * (cv[bj][0] * rv), v1 = __builtin_convertvector(__builtin_bit_cast(i32x4, acc[ai][bj][m][1]), f32x4) * (cv[bj][1] * rv);
                    u32x4 w; w.x = cvtpk(v0[0], v0[1]); w.y = cvtpk(v0[2], v0[3]); w.z = cvtpk(v1[0], v1[1]); w.w = cvtpk(v1[2], v1[3]);
                    if (u.aux == 2) { bf16_t* p16 = rowp + bj * HALF - (fq & 1) * 8 + (fq & 1) * 4;
                        *(u32x2*)p16 = (u32x2){w.x, w.y}; *(u32x2*)(p16 + 8) = (u32x2){w.z, w.w}; }
                    else *(u32x4*)(rowp + bj * HALF) = w; } }
    }
};
struct EpiMoeDown {
    static constexpr bool PERM = true;
    bf16_t* Y; const float* gate; float osc;
    __device__ __forceinline__ void operator()(const f32x4 (&acc)[2][2][4][2], const Unit& u, int wr, int wc, int fr, int fq) const {
        const int row0 = u.pm * BM + wr * 64 + fr, col0 = u.pn * BM + wc * 32 + 8 * fq;
#pragma unroll
        for (int ai = 0; ai < 2; ++ai)
#pragma unroll
            for (int m = 0; m < 4; ++m) { const int row = row0 + ai * HALF + m * 16; const float gt = gate[row] * osc; bf16_t* rowp = Y + (size_t)row * D + col0;
#pragma unroll
                for (int bj = 0; bj < 2; ++bj) { const f32x4 v0 = acc[ai][bj][m][0] * gt, v1 = acc[ai][bj][m][1] * gt;
                    u32x4 w; w.x = cvtpk(v0[0], v0[1]); w.y = cvtpk(v0[2], v0[3]); w.z = cvtpk(v1[0], v1[1]); w.w = cvtpk(v1[2], v1[3]);
                    *(u32x4*)(rowp + bj * HALF) = w; } }
    }
};
}

__device__ __forceinline__ void tr_load(float (&tv)[32], const float* W, int ldw, int k0, int n0, int lane) {
    const GAS float* wp = (const GAS float*)W + (size_t)(k0 + (lane >> 5)) * ldw + n0 + (lane & 31);
#pragma unroll
    for (int i = 0; i < 32; ++i) tv[i] = wp[(size_t)(2 * i) * ldw];
}
__device__ __forceinline__ void tr_put(const float (&tv)[32], int k0, const float* gain, float mul, int mode  , unsigned char* WT, int ldk, int drow0, LAS float* scr, int lane,
                                       const unsigned* colmax = nullptr  , int n0 = 0, float* wscale = nullptr  ) {
#pragma unroll
    for (int i = 0; i < 32; ++i) { const int kk = 2 * i + (lane >> 5); const float gv = gain ? gain[k0 + kk] * mul : mul; scr[kk * 33 + (lane & 31)] = tv[i] * gv; }
    LDS_WAIT(); asm volatile("" ::: "memory");
    const int c = lane & 7;
#pragma unroll
    for (int j = 0; j < 4; ++j) { const int n = (lane >> 3) + 8 * j; const LAS float* sp = scr + (8 * c) * 33 + n;
        const float e0 = sp[0 * 33], e1 = sp[1 * 33], e2 = sp[2 * 33], e3 = sp[3 * 33], e4 = sp[4 * 33], e5 = sp[5 * 33], e6 = sp[6 * 33], e7 = sp[7 * 33];
        if (mode == 2) { const float mx = __builtin_bit_cast(float, __hip_atomic_load(colmax + n0 + n, RLX_AGENT)); const float q = mx > 0.f ? 127.0f / mx : 0.f;
            u32x2 o; o.x = pk4_i8(e0 * q, e1 * q, e2 * q, e3 * q); o.y = pk4_i8(e4 * q, e5 * q, e6 * q, e7 * q); *(GAS u32x2*)(WT + (size_t)(drow0 + n) * ldk + k0 + 8 * c) = o;
            if (k0 == 0 && c == 0) wscale[drow0 + n] = mx * (1.0f / 127.0f); }
        else if (mode == 1) { u32x2 o; o.x = pk4_fp8(e0, e1, e2, e3); o.y = pk4_fp8(e4, e5, e6, e7); *(GAS u32x2*)(WT + (size_t)(drow0 + n) * ldk + k0 + 8 * c) = o; }
        else { u32x4 o; o.x = cvtpk(e0, e1); o.y = cvtpk(e2, e3); o.z = cvtpk(e4, e5); o.w = cvtpk(e6, e7); *(GAS u32x4*)(WT + ((size_t)(drow0 + n) * ldk + k0 + 8 * c) * 2) = o; } }
    LDS_WAIT(); asm volatile("" ::: "memory");
}
__device__ __forceinline__ void tr_mat(const float* W, int ldw, int K, int N, const float* gain, float mul, int mode, bool gu, unsigned char* WT, LAS float* scr, int first, int NGW, int lane,
                                       const unsigned* colmax = nullptr, float* wscale = nullptr) {
    const int nblk = N / 32, nitems = (K / 64) * nblk, F = N / 2;
    float tv[32], tn[32];
    int it = first; if (it >= nitems) return;
    tr_load(tv, W, ldw, (it / nblk) * 64, (it % nblk) * 32, lane);
    for (; it < nitems; it += NGW) {
        const int nx = it + NGW; if (nx < nitems) tr_load(tn, W, ldw, (nx / nblk) * 64, (nx % nblk) * 32, lane);
        const int kb = it / nblk, n0 = (it % nblk) * 32; int drow0 = n0;
        if (gu) { const int isup = n0 >= F, j = isup ? n0 - F : n0; drow0 = (j >> 7) * 256 + (isup ? 128 : 0) + (j & 127); }
        tr_put(tv, kb * 64, gain, mul, mode, WT, K, drow0, scr, lane, colmax, n0, wscale);
#pragma unroll
        for (int i = 0; i < 32; ++i) tv[i] = tn[i];
    }
}

struct Args { const float* in[15]; float* out; unsigned char* ws; };
template <int OFF> __device__ __forceinline__ unsigned long long karg() { unsigned long long v; auto ka = __builtin_amdgcn_kernarg_segment_ptr();
    asm volatile("s_load_dwordx2 %0, %1, %2\n\ts_waitcnt lgkmcnt(0)" : "=s"(v) : "s"(ka), "n"(OFF) : "memory"); return v; }
#define ARG_IN(k) ((const float*)(const GAS float*)karg<8 * (k)>())
#define ARG_OUT() ((float*)(GAS float*)karg<120>())
#define ARG_WS() ((unsigned char*)(GAS unsigned char*)karg<128>())

template <int W, class XT>
__device__ __forceinline__ void pool_chan(const XT* xp  , int s0, const LAS float* inv  , bf16_t* pp  ) {
    f32x2 hist[W]; f32x2 S = {0.f, 0.f};
#pragma unroll
    for (int j = 0; j < W; ++j) hist[j] = (f32x2){0.f, 0.f};
    if (s0 > 0) {
#pragma unroll
        for (int j = 1; j < W; ++j) { const int t = j - W; const f32x2 v = ld2(xp + (ptrdiff_t)t * D) * inv[15 + t]; hist[j] = v; S += v; }
    }
    for (int tb = 0; tb < 256; tb += 16) {
        f32x2 v[16];
#pragma unroll
        for (int j = 0; j < 16; ++j) v[j] = ld2(xp + (size_t)(tb + j) * D);
#pragma unroll
        for (int j = 0; j < 16; ++j) { const int t = tb + j; const f32x2 xv = v[j] * inv[15 + t]; S += xv - hist[j % W]; hist[j % W] = xv;
            const int pos = s0 + t + 1; const float rc = (pos >= W) ? (1.0f / W) : (1.0f / (float)pos);
            const f32x2 p = S * rc - xv; *(unsigned*)(pp + (size_t)t * D) = cvtpk(p.x, p.y); }
    }
}
template <class XT>
__device__ __forceinline__ void pool_prep_phase(const XT* x, bf16_t* P, LAS unsigned char* lds, int G, int wave_s) {
    const int tid = fresh_tid(wave_s); const int lane = tid & 63, wave = __builtin_amdgcn_readfirstlane(tid >> 6);
    LAS float* inv = (LAS float*)lds;
    for (int tile = blockIdx.x; tile < M / 256; tile += G) {
        const int r0 = tile * 256, s0 = r0 % SEQ;
        const int start = (s0 > 0) ? -15 : 0;
        for (int rr = start + wave; rr < 256; rr += NWAVES) {
            const XT* xr = x + (size_t)(r0 + rr) * D + 4 * lane; float s = 0.f;
#pragma unroll
            for (int j = 0; j < 4; ++j) { const f32x4 v = ld4(xr + 256 * j); s += (v.x * v.x + v.y * v.y) + (v.z * v.z + v.w * v.w); }
            s = wave_sum(s);
            if (lane == 0) inv[15 + rr] = 1.0f / sqrtf(s * (1.0f / D) + RMS_EPS);
        }
        __syncthreads();
        const int c = 2 * tid; const XT* xp = x + (size_t)r0 * D + c; bf16_t* pp = P + (size_t)r0 * D + c;
        const int grp = wave >> 1;
        if (grp == 0) pool_chan<2, XT>(xp, s0, inv, pp);
        else if (grp == 1) pool_chan<4, XT>(xp, s0, inv, pp);
        else if (grp == 2) pool_chan<8, XT>(xp, s0, inv, pp);
        else pool_chan<16, XT>(xp, s0, inv, pp);
        __syncthreads();
    }
}

template <bool COMBINE, bool ROUTER, bool FINAL, int OUTK, bool DELTA, class XT>
__device__ __forceinline__ void norm_phase(float* x, bf16_t* XN, const bf16_t* YS, const int* slot_of, const float* gvec  , const float* wr  ,
                                           int* route_e, float* route_g, int* tilecnt, LAS unsigned char* lds, LAS int* cnt_l, int G, int wave_s, float* ascale, const bf16_t* DL, const XT* xs  , bf16_t* xw  ) {
    const int tid = fresh_tid(wave_s); const int lane = tid & 63, wave = __builtin_amdgcn_readfirstlane(tid >> 6);
    LAS float* wl = (LAS float*)lds;
    if (ROUTER) {
        for (int i = tid; i < 8 * 1024; i += NTHREADS) { const int c = i >> 3, e = i & 7; wl[e * 1024 + c] = wr[i] * gvec[c]; }
        __syncthreads();
    }
    f32x4 gf[4];
    if (FINAL) {
#pragma unroll
        for (int j = 0; j < 4; ++j) gf[j] = *((const f32x4*)gvec + lane + 64 * j);
    }
    for (int tile = blockIdx.x; tile < M / 256; tile += G) {
        const int rb = tile * 256 + wave * 32;
        typename Raw4<XT>::t vnx[4]; u32x2 yan[4], ybn[4], dnx[4]; int sl0 = 0, sl1 = 0;
        { const XT* xr0 = xs + (size_t)rb * D + 4 * lane;
#pragma unroll
          for (int j = 0; j < 4; ++j) vnx[j] = ldraw4(xr0 + 256 * j);
          if (DELTA) { const GAS u32x2* d0 = (const GAS u32x2*)(DL + (size_t)rb * D) + lane;
#pragma unroll
              for (int j = 0; j < 4; ++j) dnx[j] = d0[64 * j]; }
          if (COMBINE) { const int a0 = __builtin_amdgcn_readfirstlane(__hip_atomic_load(slot_of + 2 * rb, RLX_AGENT)), a1 = __builtin_amdgcn_readfirstlane(__hip_atomic_load(slot_of + 2 * rb + 1, RLX_AGENT));
              const GAS u32x2* y0 = (const GAS u32x2*)(YS + (size_t)a0 * D) + lane; const GAS u32x2* y1 = (const GAS u32x2*)(YS + (size_t)a1 * D) + lane;
#pragma unroll
              for (int j = 0; j < 4; ++j) { yan[j] = y0[64 * j]; ybn[j] = y1[64 * j]; }
              sl0 = __builtin_amdgcn_readfirstlane(__hip_atomic_load(slot_of + 2 * (rb + 1), RLX_AGENT)); sl1 = __builtin_amdgcn_readfirstlane(__hip_atomic_load(slot_of + 2 * (rb + 1) + 1, RLX_AGENT)); } }
        for (int i = 0; i < 32; ++i) {
            const int r = rb + i;
            GAS f32x4* xr = (GAS f32x4*)(x + (size_t)r * D) + lane;
            f32x4 v[4]; u32x2 ya[4], yb[4];
#pragma unroll
            for (int j = 0; j < 4; ++j) { v[j] = cvt4(vnx[j]); if (COMBINE) { ya[j] = yan[j]; yb[j] = ybn[j]; }
                if (DELTA) { const u32x2 d = dnx[j]; v[j].x += bf_lo(d.x); v[j].y += bf_hi(d.x); v[j].z += bf_lo(d.y); v[j].w += bf_hi(d.y); } }
            if (i + 1 < 32) { const XT* xn_ = xs + (size_t)(r + 1) * D + 4 * lane;
#pragma unroll
                for (int j = 0; j < 4; ++j) vnx[j] = ldraw4(xn_ + 256 * j);
                if (DELTA) { const GAS u32x2* d1 = (const GAS u32x2*)(DL + (size_t)(r + 1) * D) + lane;
#pragma unroll
                    for (int j = 0; j < 4; ++j) dnx[j] = d1[64 * j]; }
                if (COMBINE) { const GAS u32x2* y0 = (const GAS u32x2*)(YS + (size_t)sl0 * D) + lane; const GAS u32x2* y1 = (const GAS u32x2*)(YS + (size_t)sl1 * D) + lane;
#pragma unroll
                    for (int j = 0; j < 4; ++j) { yan[j] = y0[64 * j]; ybn[j] = y1[64 * j]; }
                    if (i + 2 < 32) { sl0 = __builtin_amdgcn_readfirstlane(__hip_atomic_load(slot_of + 2 * (r + 2), RLX_AGENT)); sl1 = __builtin_amdgcn_readfirstlane(__hip_atomic_load(slot_of + 2 * (r + 2) + 1, RLX_AGENT)); } } }
            if (COMBINE) {
#pragma unroll
                for (int j = 0; j < 4; ++j) { const u32x2 a = ya[j], b = yb[j];
                    v[j].x += bf_lo(a.x) + bf_lo(b.x); v[j].y += bf_hi(a.x) + bf_hi(b.x); v[j].z += bf_lo(a.y) + bf_lo(b.y); v[j].w += bf_hi(a.y) + bf_hi(b.y); }
                if (!FINAL) { GAS u32x2* xo = (GAS u32x2*)(xw + (size_t)r * D) + lane;
#pragma unroll
                    for (int j = 0; j < 4; ++j) { u32x2 w; w.x = cvtpk(v[j].x, v[j].y); w.y = cvtpk(v[j].z, v[j].w); xo[64 * j] = w; }
                }
            }
            float s = 0.f;
#pragma unroll
            for (int j = 0; j < 4; ++j) s += (v[j].x * v[j].x + v[j].y * v[j].y) + (v[j].z * v[j].z + v[j].w * v[j].w);
            const float inv = 1.0f / sqrtf(wave_sum(s) * (1.0f / D) + RMS_EPS);
#pragma unroll
            for (int j = 0; j < 4; ++j) v[j] = v[j] * inv;
            if (FINAL) {
#pragma unroll
                for (int j = 0; j < 4; ++j) xr[64 * j] = v[j] * gf[j];
            } else if (OUTK == 2) {
                float mx = 0.f;
#pragma unroll
                for (int j = 0; j < 4; ++j) mx = fmaxf(fmaxf(mx, fmaxf(fabsf(v[j].x), fabsf(v[j].y))), fmaxf(fabsf(v[j].z), fabsf(v[j].w)));
                mx = wave_max(mx); const float q = mx > 0.f ? 127.0f / mx : 0.f;
                GAS unsigned* o = (GAS unsigned*)((unsigned char*)XN + (size_t)r * D) + lane;
#pragma unroll
                for (int j = 0; j < 4; ++j) o[64 * j] = pk4_i8(v[j].x * q, v[j].y * q, v[j].z * q, v[j].w * q);
                if (lane == 0) ascale[r] = mx * (1.0f / 127.0f);
            } else if (OUTK == 1) {
                GAS unsigned* o = (GAS unsigned*)((unsigned char*)XN + (size_t)r * D) + lane;
#pragma unroll
                for (int j = 0; j < 4; ++j) o[64 * j] = pk4_fp8(v[j].x, v[j].y, v[j].z, v[j].w);
            } else {
                GAS u32x2* o = (GAS u32x2*)(XN + (size_t)r * D) + lane;
#pragma unroll
                for (int j = 0; j < 4; ++j) { u32x2 w; w.x = cvtpk(v[j].x, v[j].y); w.y = cvtpk(v[j].z, v[j].w); o[64 * j] = w; }
            }
            if (ROUTER) {
                float lg[8];
#pragma unroll
                for (int e = 0; e < 8; ++e) { float a = 0.f;
#pragma unroll
                    for (int j = 0; j < 4; ++j) { const f32x4 w = *((const LAS f32x4*)(wl + e * 1024) + lane + 64 * j); a += (v[j].x * w.x + v[j].y * w.y) + (v[j].z * w.z + v[j].w * w.w); }
                    lg[e] = wave_sum(a); }
                int e0 = 0; float v0 = lg[0];
#pragma unroll
                for (int e = 1; e < 8; ++e) if (lg[e] > v0) { v0 = lg[e]; e0 = e; }
                int e1 = -1; float v1 = -3.0e38f;
#pragma unroll
                for (int e = 0; e < 8; ++e) if (e != e0 && lg[e] > v1) { v1 = lg[e]; e1 = e; }
                const float ex = __expf(v1 - v0), g0 = 1.0f / (1.0f + ex), g1 = ex * g0;
                if (lane == 0) { route_e[r] = e0 | (e1 << 8); route_g[2 * r] = g0; route_g[2 * r + 1] = g1; atomicAdd((int*)(cnt_l + e0), 1); atomicAdd((int*)(cnt_l + e1), 1); }
            }
        }
        if (ROUTER) {
            __syncthreads();
            if (tid < 8) { tilecnt[tile * 8 + tid] = cnt_l[tid]; cnt_l[tid] = 0; }
            __syncthreads();
        }
    }
}

template <bool FP8>
__device__ __forceinline__ void dispatch_phase(const int* tilecnt, const int* route_e, const float* route_g, int* slot_of, float* gate_slot, const bf16_t* XN, bf16_t* XS  ,
                                               LAS unsigned char* lds, LAS int* pend, int G, int wave_s) {
    const int tid = fresh_tid(wave_s); const int lane = tid & 63, wave = __builtin_amdgcn_readfirstlane(tid >> 6);
    LAS int* lc = (LAS int*)lds;
    LAS int* tot_l = (LAS int*)(lds + 8192);
    LAS int* pst_l = (LAS int*)(lds + 8192 + 32);
    LAS int* base_l = (LAS int*)(lds + 8192 + 64);
    LAS int* slot_l = (LAS int*)(lds + 8192 + 128);
    if (tid < 256) { const i32x4 a = *((const i32x4*)tilecnt + 2 * tid), b = *((const i32x4*)tilecnt + 2 * tid + 1); *((LAS i32x4*)lc + 2 * tid) = a; *((LAS i32x4*)lc + 2 * tid + 1) = b; }
    __syncthreads();
    if (tid < 8) { int t = 0; for (int i = 0; i < 256; ++i) t += lc[i * 8 + tid]; tot_l[tid] = t; }
    __syncthreads();
    if (tid == 0) { int ps = 0; for (int e = 0; e < 8; ++e) { const int padded = (tot_l[e] + 255) & ~255; pst_l[e] = ps; ps += padded; pend[e] = ps >> 8; } }
    __syncthreads();
    if (FP8 && blockIdx.x < 8) { const int e = blockIdx.x, t0 = pst_l[e] + tot_l[e], npad = ((tot_l[e] + 255) & ~255) - tot_l[e];
        for (int i = tid; i < npad; i += NTHREADS) ((int*)XS)[t0 + i] = 0; }
    for (int tile = blockIdx.x; tile < M / 256; tile += G) {
        const int r0 = tile * 256;
        if (tid < 8) { int pre = 0; for (int i = 0; i < tile; ++i) pre += lc[i * 8 + tid]; base_l[tid] = pst_l[tid] + pre; }
        __syncthreads();
        if (wave == 0) {
            int run[8];
#pragma unroll
            for (int e = 0; e < 8; ++e) run[e] = 0;
            for (int ch = 0; ch < 8; ++ch) {
                const int i = ch * 64 + lane, tok = r0 + (i >> 1), k = i & 1;
                const int ew = __hip_atomic_load(route_e + tok, RLX_AGENT); const int e = (ew >> (8 * k)) & 0xff;
                int slot = 0;
#pragma unroll
                for (int ee = 0; ee < 8; ++ee) { const unsigned long long mask = __ballot(e == ee);
                    if (e == ee) slot = base_l[ee] + run[ee] + __popcll(mask & ((1ull << lane) - 1ull));
                    run[ee] += __popcll(mask); }
                slot_l[i] = slot; slot_of[2 * tok + k] = slot; gate_slot[slot] = __hip_atomic_load(route_g + 2 * tok + k, RLX_AGENT); if (FP8) ((int*)XS)[slot] = tok;
            }
        }
        __syncthreads();
        if constexpr (!FP8) {
        for (int ii = 0; ii < 64; ii += 4) {
            u32x4 a[4][2];
#pragma unroll
            for (int q = 0; q < 4; ++q) { const int i = wave * 64 + ii + q; const GAS u32x4* src = (const GAS u32x4*)(XN + (size_t)(r0 + (i >> 1)) * D) + lane; a[q][0] = src[0]; a[q][1] = src[64]; }
#pragma unroll
            for (int q = 0; q < 4; ++q) { const int i = wave * 64 + ii + q; GAS u32x4* dst = (GAS u32x4*)(XS + (size_t)slot_l[i] * D) + lane; dst[0] = a[q][0]; dst[64] = a[q][1]; }
        }
        }
        __syncthreads();
    }
}

#define ATT_LOAD(KF, VF, kt_) do { const int k0_ = (kt_) * 32; \
        const GAS u32x4* kp_ = (const GAS u32x4*)(Kb + (rowbase + k0_ + n) * D + h * 64 + 8 * hh); \
        _Pragma("unroll") for (int s_ = 0; s_ < 4; ++s_) KF[s_] = __builtin_bit_cast(bf16x8, kp_[2 * s_]); \
        _Pragma("unroll") for (int dt_ = 0; dt_ < 2; ++dt_) { const GAS u32x4* vp_ = (const GAS u32x4*)(Vt + (size_t)(h * 64 + dt_ * 32 + n) * M + rowbase + k0_ + 8 * hh); \
            _Pragma("unroll") for (int s_ = 0; s_ < 2; ++s_) VF[dt_][s_] = __builtin_bit_cast(bf16x8, vp_[2 * s_]); } } while (0)
constexpr float ATT_STOP = 9.0e-14f;
__device__ __forceinline__ void att_tile(const bf16x8 (&kf)[4], const bf16x8 (&vf)[2][2], const bf16x8 (&qf)[4], f32x16& o0, f32x16& o1, float& carry, bool diag, int n, int hh) {
    f32x16 sc;
#pragma unroll
    for (int r = 0; r < 16; ++r) sc[r] = 0.f;
#pragma unroll
    for (int s = 0; s < 4; ++s) sc = __builtin_amdgcn_mfma_f32_32x32x16_bf16(kf[s], qf[s], sc, 0, 0, 0);
    float be[16], kp[16];
#pragma unroll
    for (int r = 0; r < 16; ++r) { const float zl = sc[r]; const float e = __builtin_amdgcn_exp2f(-fabsf(zl)); const float rr = __builtin_amdgcn_rcpf(1.0f + e), er = e * rr;
        float bt_ = zl >= 0.f ? rr : er, kp_ = zl >= 0.f ? er : rr;
        if (diag) { const int key = (r & 3) + 8 * (r >> 2) + 4 * hh; if (key >= n) { bt_ = 0.f; kp_ = 1.f; } }
        be[r] = bt_; kp[r] = kp_; }
    float T[4], Pp[4], p2[4], p1[4], p0[4];
#pragma unroll
    for (int g = 0; g < 4; ++g) { p2[g] = kp[4 * g + 3]; p1[g] = p2[g] * kp[4 * g + 2]; p0[g] = p1[g] * kp[4 * g + 1]; T[g] = p0[g] * kp[4 * g]; }
#pragma unroll
    for (int g = 0; g < 4; ++g) Pp[g] = __shfl_xor(T[g], 32);
    float off[4];
    { const float own2 = T[3], own1 = T[3] * T[2], own0 = own1 * T[1];
      const float pe2 = Pp[3], pe1 = Pp[3] * Pp[2], pe0 = pe1 * Pp[1];
      if (hh == 0) { off[0] = own0 * pe0 * Pp[0]; off[1] = own1 * pe1 * Pp[1]; off[2] = own2 * pe2 * Pp[2]; off[3] = Pp[3]; }
      else         { off[0] = own0 * pe0;         off[1] = own1 * pe1;         off[2] = own2 * pe2;         off[3] = 1.f; } }
    float a[16];
#pragma unroll
    for (int g = 0; g < 4; ++g) { const float base = carry * off[g];
        a[4 * g + 0] = be[4 * g + 0] * (base * p0[g]); a[4 * g + 1] = be[4 * g + 1] * (base * p1[g]); a[4 * g + 2] = be[4 * g + 2] * (base * p2[g]); a[4 * g + 3] = be[4 * g + 3] * base; }
    carry *= ((T[0] * T[1]) * (T[2] * T[3])) * ((Pp[0] * Pp[1]) * (Pp[2] * Pp[3]));
    bf16x8 pb[2];
#pragma unroll
    for (int s = 0; s < 2; ++s) { u32x4 w; w.x = cvtpk(a[8 * s + 0], a[8 * s + 1]); w.y = cvtpk(a[8 * s + 2], a[8 * s + 3]); w.z = cvtpk(a[8 * s + 4], a[8 * s + 5]); w.w = cvtpk(a[8 * s + 6], a[8 * s + 7]); pb[s] = __builtin_bit_cast(bf16x8, w); }
#pragma unroll
    for (int s = 0; s < 2; ++s) { o0 = __builtin_amdgcn_mfma_f32_32x32x16_bf16(vf[0][s], pb[s], o0, 0, 0, 0); o1 = __builtin_amdgcn_mfma_f32_32x32x16_bf16(vf[1][s], pb[s], o1, 0, 0, 0); }
}
constexpr int ATT_KROW = 144, ATT_VROW = 784, ATT_V_OFF = 384 * ATT_KROW;
static_assert(ATT_V_OFF + 64 * ATT_VROW <= STAGE_BYTES_LDS, "attention LDS image");
__device__ __forceinline__ void attn_phase(const bf16_t* Q, const bf16_t* Kb, const bf16_t* Vt, bf16_t* O, LAS unsigned char* lds, int vcu, int G, int wave_s) {
    const int tid = fresh_tid(wave_s); const int lane = tid & 63, wave = __builtin_amdgcn_readfirstlane(tid >> 6);
    const int n = lane & 31, hh = lane >> 5;
    const int NU = BATCH * NH * (SEQ / 256), per = (NU + G - 1) / G;
    const int u_lo = vcu * per, u_hi = (u_lo + per < NU) ? u_lo + per : NU;
    u32x4 pk[6], pv[6];
#define ATT_FETCH(uu) do { const int bh_ = (uu) >> 3, qb_ = (uu) & 7, h_ = bh_ & 15, b_ = bh_ >> 4; const int kw0_ = qb_ > 0 ? qb_ * 256 - 128 : 0, nk_ = qb_ * 256 + 256 - kw0_; \
        const size_t rb_ = (size_t)b_ * SEQ; \
        _Pragma("unroll") for (int i_ = 0; i_ < 6; ++i_) { const int p_ = tid + i_ * NTHREADS; const int kr_ = p_ >> 3, kc_ = p_ & 7; \
            if (kr_ < nk_) pk[i_] = *(const GAS u32x4*)(Kb + (rb_ + kw0_ + kr_) * D + h_ * 64 + kc_ * 8); \
            const int vd_ = p_ / 48, vc_ = p_ - vd_ * 48; \
            if (vc_ * 8 < nk_) pv[i_] = *(const GAS u32x4*)(Vt + (size_t)(h_ * 64 + vd_) * M + rb_ + kw0_ + vc_ * 8); } } while (0)
#define ATT_PUT(uu) do { const int qb_ = (uu) & 7; const int kw0_ = qb_ > 0 ? qb_ * 256 - 128 : 0, nk_ = qb_ * 256 + 256 - kw0_; \
        _Pragma("unroll") for (int i_ = 0; i_ < 6; ++i_) { const int p_ = tid + i_ * NTHREADS; const int kr_ = p_ >> 3, kc_ = p_ & 7; \
            if (kr_ < nk_) *(LAS u32x4*)(lds + kr_ * ATT_KROW + kc_ * 16) = pk[i_]; \
            const int vd_ = p_ / 48, vc_ = p_ - vd_ * 48; \
            if (vc_ * 8 < nk_) *(LAS u32x4*)(lds + ATT_V_OFF + vd_ * ATT_VROW + vc_ * 16) = pv[i_]; } } while (0)
#define ATT_TILE_LD(KF, VF, kt_) do { const int k0_ = (kt_) * 32; if (k0_ >= kw0) { const int ko_ = k0_ - kw0; \
            _Pragma("unroll") for (int s_ = 0; s_ < 4; ++s_) KF[s_] = *(const LAS bf16x8*)(lds + (ko_ + n) * ATT_KROW + 32 * s_ + 16 * hh); \
            _Pragma("unroll") for (int dt_ = 0; dt_ < 2; ++dt_) _Pragma("unroll") for (int s_ = 0; s_ < 2; ++s_) VF[dt_][s_] = *(const LAS bf16x8*)(lds + ATT_V_OFF + (dt_ * 32 + n) * ATT_VROW + (ko_ + 16 * s_ + 8 * hh) * 2); } \
        else { ATT_LOAD(KF, VF, kt_); } } while (0)
    if (u_lo < u_hi) ATT_FETCH(u_lo);
    for (int u = u_lo; u < u_hi; ++u) {
        const int bh = u >> 3, qb = u & 7, h = bh & 15, b = bh >> 4;
        const size_t rowbase = (size_t)b * SEQ; const int kw0 = qb > 0 ? qb * 256 - 128 : 0;
        const int qt = qb * 8 + wave, q0 = qt * 32;
        bf16x8 qf[4];
        { const GAS u32x4* qp = (const GAS u32x4*)(Q + (rowbase + q0 + n) * D + h * 64 + 8 * hh);
#pragma unroll
          for (int s = 0; s < 4; ++s) qf[s] = __builtin_bit_cast(bf16x8, qp[2 * s]); }
        ATT_PUT(u);
        __syncthreads();
        if (u + 1 < u_hi) ATT_FETCH(u + 1);
        f32x16 o0, o1;
#pragma unroll
        for (int r = 0; r < 16; ++r) { o0[r] = 0.f; o1[r] = 0.f; }
        float carry = 1.f;
        bf16x8 kf[4], vf[2][2];
        for (int kt = qt; kt >= 0; --kt) {
            ATT_TILE_LD(kf, vf, kt);
            att_tile(kf, vf, qf, o0, o1, carry, kt == qt, n, hh);
            if (__all(carry < ATT_STOP)) break;
        }
        bf16_t* op = O + (rowbase + q0 + n) * D + h * 64 + 4 * hh;
#pragma unroll
        for (int g = 0; g < 4; ++g) { u32x2 w0, w1; w0.x = cvtpk(o0[4 * g], o0[4 * g + 1]); w0.y = cvtpk(o0[4 * g + 2], o0[4 * g + 3]); w1.x = cvtpk(o1[4 * g], o1[4 * g + 1]); w1.y = cvtpk(o1[4 * g + 2], o1[4 * g + 3]);
            *(u32x2*)(op + 8 * g) = w0; *(u32x2*)(op + 32 + 8 * g) = w1; }
        __syncthreads();
    }
#undef ATT_FETCH
#undef ATT_PUT
#undef ATT_TILE_LD
}

#define WSP(T, off) ((T*)(ws + (off)))
#ifndef PROBE_DUP
#define PROBE_DUP 0
#endif
#define DUP(k) ((PROBE_DUP >> (k)) & 1)
template <int l>
__device__ __forceinline__ void layer_body(LAS unsigned char* lds, const XcdBarrier& bar, LAS int* pend, LAS int* cnt_l, int G, int bx, int vcu, int NGW, int wave_s) {
#define SITE_POOLPREP() { { unsigned char* ws = ARG_WS(); pool_prep_phase<bf16_t>((const bf16_t*)WSP(bf16_t, WS_XB), WSP(bf16_t, WS_R), lds, G, wave_s); \
              if constexpr (l == 0 && (INT8_UP0 != 0 || INT8_PROJ != 0)) {     \
                  const int t_ = fresh_tid(wave_s); const int wv_ = __builtin_amdgcn_readfirstlane(t_ >> 6); LAS float* sc_ = (LAS float*)(lds + wv_ * 16384); const int g_ = vcu * NWAVES + wv_; int base_ = 0; \
                  for (int j_ = 0; j_ < 5; ++j_) { if ((j_ == 0 && !I8) || (j_ > 0 && !INT8_PROJ)) continue; \
                      const float* W_; const float* gn_; int ldw_, N_; float mul_ = 1.0f; bool gu_ = false; size_t dst_; const unsigned* cm_; float* wsc_; \
                      if (j_ == 0) { W_ = ARG_IN(9); gn_ = ARG_IN(2); ldw_ = 2 * DFF; N_ = 2 * DFF; gu_ = true; dst_ = WS_WFI; cm_ = WSP(unsigned, WS_COLMAX); wsc_ = WSP(float, WS_WSCALE); } \
                      else if (j_ < 3) { W_ = ARG_IN(6) + (j_ - 1) * 1024; gn_ = ARG_IN(5); ldw_ = 2048; N_ = 1024; dst_ = (j_ == 1) ? WS_WK : WS_WV; cm_ = WSP(unsigned, WS_COLMAX2) + (j_ - 1) * 1024; wsc_ = WSP(float, WS_WSCALE2) + (j_ - 1) * 1024; } \
                      else { const int b_ = j_ - 3; W_ = ARG_IN(7) + (size_t)b_ * D * D; gn_ = ARG_IN(1) + (2 + b_) * D; ldw_ = 1024; N_ = 1024; mul_ = 0.125f * 1.4426950408889634f; dst_ = WS_WQ + (size_t)b_ * D * D * 2; cm_ = WSP(unsigned, WS_COLMAX2) + (2 + b_) * 1024; wsc_ = WSP(float, WS_WSCALE2) + (2 + b_) * 1024; } \
                      int first_ = (g_ - base_) % NGW; if (first_ < 0) first_ += NGW; \
                      tr_mat(W_, ldw_, D, N_, gn_, mul_, 2, gu_, ws + dst_, sc_, first_, NGW, t_ & 63, cm_, wsc_); base_ = (base_ + (D / 64) * (N_ / 32)) % NGW; } } } xcd_barrier(bar, wave_s); }
#define SITE_POOLGEMM(MUL) { { unsigned char* ws = ARG_WS(); \
              pg8::GemmK g{256, 1024, 256}; pg8::PoolOrder S{G, bx, (const char*)WSP(bf16_t, WS_R), (const char*)(WSP(bf16_t, WS_WPOOL) + (size_t)l * 4 * 65536)}; \
              pg8::EpiResidB E{WSP(bf16_t, WS_XB), ARG_IN(4) + l * D, MUL}; \
              pg8::gemm_phase<pg8::EpiResidB, pg8::PoolOrder, true>(lds, g, S, E, wave_s); } xcd_barrier(bar, wave_s); }
#define SITE_PROJ() { { unsigned char* ws = ARG_WS(); \
              if constexpr (INT8_PROJ != 0) { pg8::GemmK g{512, 512, 512}; pg8::ProjOrder S{(l == 2) ? 3 : 1, G, bx, (const char*)ws, (size_t)(l - 2) * D * D * 2, (size_t)256 * 1024}; \
                pg8::EpiProjI8 E{WSP(bf16_t, WS_K), WSP(bf16_t, WS_R), WSP(bf16_t, WS_VT), WSP(float, WS_ASCALE), WSP(float, WS_WSCALE2), l - 2}; \
                pg8::gemm_phase<pg8::EpiProjI8, pg8::ProjOrder, true, 2>(lds, g, S, E, wave_s); } \
              else { pg8::GemmK g{1024, 1024, 1024}; pg8::ProjOrder S{(l == 2) ? 3 : 1, G, bx, (const char*)ws, (size_t)(l - 2) * D * D * 2, (size_t)256 * 1024 * 2}; \
                pg8::EpiProj E{WSP(bf16_t, WS_K), WSP(bf16_t, WS_R), WSP(bf16_t, WS_VT)}; \
                pg8::gemm_phase<pg8::EpiProj, pg8::ProjOrder, true>(lds, g, S, E, wave_s); } } xcd_barrier(bar, wave_s); }
#define SITE_ATTN() { { unsigned char* ws = ARG_WS(); attn_phase(WSP(bf16_t, WS_R), WSP(bf16_t, WS_K), WSP(bf16_t, WS_VT), WSP(bf16_t, WS_R) + (size_t)M * D, lds, vcu, G, wave_s); } xcd_barrier(bar, wave_s); }
#define SITE_OPROJ(MUL) { { unsigned char* ws = ARG_WS(); \
              pg8::GemmK g{1024, 1024, 1024}; pg8::DenseOrder S{M / 256, 4, G, bx, (const char*)(WSP(bf16_t, WS_R) + (size_t)M * D), (const char*)(WSP(bf16_t, WS_WO) + (size_t)(l - 2) * D * D), (size_t)256 * 1024 * 2, (size_t)256 * 1024 * 2}; \
              pg8::EpiResidB E{WSP(bf16_t, WS_XB), nullptr, MUL}; \
              pg8::gemm_phase<pg8::EpiResidB, pg8::DenseOrder, true>(lds, g, S, E, wave_s); } xcd_barrier(bar, wave_s); }
#define SITE_NORMX(OUTK_, DELTA_) { { unsigned char* ws = ARG_WS(); \
              norm_phase<false, false, false, OUTK_, false, bf16_t>(nullptr, WSP(bf16_t, WS_XN), nullptr, nullptr, nullptr, nullptr, nullptr, nullptr, nullptr, lds, cnt_l, G, wave_s, WSP(float, WS_ASCALE), nullptr, (const bf16_t*)WSP(bf16_t, WS_XB), nullptr); } xcd_barrier(bar, wave_s); }
#define SITE_NORMI8() { { unsigned char* ws = ARG_WS(); norm_phase<false, false, false, 2, false, bf16_t>(nullptr, WSP(bf16_t, WS_XN), nullptr, nullptr, nullptr, nullptr, nullptr, nullptr, nullptr, lds, cnt_l, G, wave_s, WSP(float, WS_ASCALE), nullptr, (const bf16_t*)WSP(bf16_t, WS_XB), nullptr); } xcd_barrier(bar, wave_s); }
#define SITE_NORM8() { { unsigned char* ws = ARG_WS(); norm_phase<false, false, false, 1, false, bf16_t>(nullptr, WSP(bf16_t, WS_XN), nullptr, nullptr, nullptr, nullptr, nullptr, nullptr, nullptr, lds, cnt_l, G, wave_s, nullptr, nullptr, (const bf16_t*)WSP(bf16_t, WS_XB), nullptr); } xcd_barrier(bar, wave_s); }
#define SITE_NORM() { { unsigned char* ws = ARG_WS(); norm_phase<false, false, false, 0, false, bf16_t>(nullptr, WSP(bf16_t, WS_XN), nullptr, nullptr, nullptr, nullptr, nullptr, nullptr, nullptr, lds, cnt_l, G, wave_s, nullptr, nullptr, (const bf16_t*)WSP(bf16_t, WS_XB), nullptr); } xcd_barrier(bar, wave_s); }
#define SITE_DUP() { { unsigned char* ws = ARG_WS(); \
              if constexpr (I8) { pg8::GemmK g{512, 512, 512}; pg8::DenseOrder S{M / 256, DFF / 128, G, bx, (const char*)WSP(unsigned char, WS_XN), (const char*)WSP(unsigned char, WS_WFI), (size_t)256 * 1024, (size_t)256 * 1024}; \
                pg8::EpiSwigluI8 E{WSP(bf16_t, WS_R), DFF, WSP(float, WS_ASCALE), WSP(float, WS_WSCALE)}; \
                pg8::gemm_phase<pg8::EpiSwigluI8, pg8::DenseOrder, true, 2>(lds, g, S, E, wave_s); } \
              else if constexpr (F8) { pg8::GemmK g{512, 512, 512}; pg8::DenseOrder S{M / 256, DFF / 128, G, bx, (const char*)WSP(unsigned char, WS_XN), (const char*)(WSP(unsigned char, WS_WFI) + (size_t)(l >> 1) * 2 * DFF * D * 2), (size_t)256 * 1024, (size_t)256 * 1024}; \
                pg8::EpiSwiglu8 E{WSP(unsigned char, WS_R), DFF, 1.0f / W8_UP}; \
                pg8::gemm_phase<pg8::EpiSwiglu8, pg8::DenseOrder, true, 1>(lds, g, S, E, wave_s); } \
              else { pg8::GemmK g{1024, 1024, 1024}; pg8::DenseOrder S{M / 256, DFF / 128, G, bx, (const char*)WSP(bf16_t, WS_XN), (const char*)(WSP(bf16_t, WS_WFI) + (size_t)(l >> 1) * 2 * DFF * D), (size_t)256 * 1024 * 2, (size_t)256 * 1024 * 2}; \
                pg8::EpiSwiglu E{WSP(bf16_t, WS_R), DFF}; \
                pg8::gemm_phase<pg8::EpiSwiglu, pg8::DenseOrder, true>(lds, g, S, E, wave_s); } } xcd_barrier(bar, wave_s); }
#define SITE_DDOWN(MUL) { { unsigned char* ws = ARG_WS(); \
              if constexpr (F8) { pg8::GemmK g{DFF / 2, DFF / 2, DFF / 2}; pg8::DenseOrder S{M / 256, 4, G, bx, (const char*)WSP(unsigned char, WS_R), (const char*)(WSP(unsigned char, WS_WFO) + (size_t)(l >> 1) * D * DFF * 2), (size_t)256 * DFF, (size_t)256 * DFF}; \
                pg8::EpiResidB E{WSP(bf16_t, WS_XB), nullptr, MUL / (W8_DN * H8_SC)}; \
                pg8::gemm_phase<pg8::EpiResidB, pg8::DenseOrder, true, 1>(lds, g, S, E, wave_s); } \
              else { pg8::GemmK g{DFF, DFF, DFF}; pg8::DenseOrder S{M / 256, 4, G, bx, (const char*)WSP(bf16_t, WS_R), (const char*)(WSP(bf16_t, WS_WFO) + (size_t)(l >> 1) * D * DFF), (size_t)256 * DFF * 2, (size_t)256 * DFF * 2}; \
                pg8::EpiResidB E{WSP(bf16_t, WS_XB), nullptr, MUL}; \
                pg8::gemm_phase<pg8::EpiResidB, pg8::DenseOrder, true>(lds, g, S, E, wave_s); } } xcd_barrier(bar, wave_s); }
#define SITE_ROUTER() { { unsigned char* ws = ARG_WS(); \
              norm_phase<false, true, false, F8 ? 1 : 0, false, bf16_t>(nullptr, WSP(bf16_t, WS_XN), nullptr, nullptr, ARG_IN(2) + l * D, ARG_IN(11) + (size_t)(l >> 1) * D * NE, WSP(int, WS_ROUTE_E), WSP(float, WS_ROUTE_G), WSP(int, WS_TILECNT), lds, cnt_l, G, wave_s, nullptr, WSP(bf16_t, WS_DELTA), (const bf16_t*)WSP(bf16_t, WS_XB), nullptr); } xcd_barrier(bar, wave_s); }
#define SITE_DISPATCH() { { unsigned char* ws = ARG_WS(); \
              dispatch_phase<F8>(WSP(int, WS_TILECNT), WSP(int, WS_ROUTE_E), WSP(float, WS_ROUTE_G), WSP(int, WS_SLOT_OF), WSP(float, WS_GATE_SLOT), WSP(bf16_t, WS_XN), F8 ? WSP(bf16_t, WS_TOS) : WSP(bf16_t, WS_XS), lds, pend, G, wave_s); } xcd_barrier(bar, wave_s); }
#define SITE_MUP() { { unsigned char* ws = ARG_WS(); \
              if constexpr (F8) { pg8::GemmK g{512, 512, 512}; \
                pg8::MoeGatherOrder S{nb, DFFE / 128, G, bx, blk0, (const char*)WSP(unsigned char, WS_XN), (const char*)(WSP(unsigned char, WS_WMI) + (size_t)(l >> 1) * 8 * 2 * DFFE * D * 2), (size_t)256 * 1024, (size_t)2 * DFFE * D, pend, WSP(int, WS_TOS), (LAS int*)(lds + LCTL_OFF + 2048)}; \
                pg8::EpiSwiglu8 E{WSP(unsigned char, WS_R), DFFE, 1.0f / W8_UP}; \
                pg8::gemm_phase<pg8::EpiSwiglu8, pg8::MoeGatherOrder, true, 1, true>(lds, g, S, E, wave_s); } \
              else { pg8::GemmK g{1024, 1024, 1024}; \
                pg8::MoeOrder S{nb, DFFE / 128, G, bx, blk0, 0, (const char*)WSP(bf16_t, WS_XS), (const char*)(WSP(bf16_t, WS_WMI) + (size_t)(l >> 1) * 8 * 2 * DFFE * D), (size_t)256 * 1024 * 2, (size_t)256 * 1024 * 2, (size_t)2 * DFFE * D * 2, pend}; \
                pg8::EpiSwiglu E{WSP(bf16_t, WS_R), DFFE}; \
                pg8::gemm_phase<pg8::EpiSwiglu, pg8::MoeOrder, true>(lds, g, S, E, wave_s); } } xcd_barrier(bar, wave_s); }
#define SITE_MDOWN() { { unsigned char* ws = ARG_WS(); \
              if constexpr (F8) { pg8::GemmK g{DFFE / 2, DFFE / 2, DFFE / 2}; \
                pg8::MoeOrder S{nb, 4, G, bx, blk0, 1, (const char*)WSP(unsigned char, WS_R), (const char*)(WSP(unsigned char, WS_WMO) + (size_t)(l >> 1) * 8 * D * DFFE * 2), (size_t)256 * DFFE, (size_t)256 * DFFE, (size_t)D * DFFE, pend}; \
                pg8::EpiMoeDown E{WSP(bf16_t, WS_XS), WSP(float, WS_GATE_SLOT), 1.0f / (W8_DN * H8_SC)}; \
                pg8::gemm_phase<pg8::EpiMoeDown, pg8::MoeOrder, true, 1>(lds, g, S, E, wave_s); } \
              else { pg8::GemmK g{DFFE, DFFE, DFFE}; \
                pg8::MoeOrder S{nb, 4, G, bx, blk0, 1, (const char*)WSP(bf16_t, WS_R), (const char*)(WSP(bf16_t, WS_WMO) + (size_t)(l >> 1) * 8 * D * DFFE), (size_t)256 * DFFE * 2, (size_t)256 * DFFE * 2, (size_t)D * DFFE * 2, pend}; \
                pg8::EpiMoeDown E{WSP(bf16_t, WS_XS), WSP(float, WS_GATE_SLOT), 1.0f}; \
                pg8::gemm_phase<pg8::EpiMoeDown, pg8::MoeOrder, true>(lds, g, S, E, wave_s); } } xcd_barrier(bar, wave_s); }
    constexpr bool F8 = ((FP8_MASK >> l) & 1) != 0;
    constexpr bool I8 = (INT8_UP0 != 0) && l == 0 && !F8;
    if constexpr (l < 2) {
        if (DUP(5)) SITE_POOLPREP()
        SITE_POOLPREP()
        if (DUP(2)) SITE_POOLGEMM(0.f)
        SITE_POOLGEMM(1.f)
    } else {
        if (DUP(2)) SITE_PROJ()
        SITE_PROJ()
        if (DUP(3)) SITE_ATTN()
        SITE_ATTN()
        if (DUP(2)) SITE_OPROJ(0.f)
        SITE_OPROJ(1.f)
    }
    if constexpr ((l & 1) == 0) {
        if constexpr (I8) { if (DUP(5)) SITE_NORMX(2, true) SITE_NORMX(2, true) } else if constexpr (F8) { if (DUP(5)) SITE_NORMX(1, true) SITE_NORMX(1, true) } else { if (DUP(5)) SITE_NORMX(0, true) SITE_NORMX(0, true) }
        if (DUP(1)) SITE_DUP()
        SITE_DUP()
        if (DUP(1)) SITE_DDOWN(0.f)
        SITE_DDOWN(1.f)
        if constexpr (l == 2) { if constexpr (INT8_PROJ != 0) { if (DUP(5)) SITE_NORMI8() SITE_NORMI8() } else { if (DUP(5)) SITE_NORM() SITE_NORM() } }
    } else {
        if (DUP(5)) SITE_ROUTER()
        SITE_ROUTER()
        if (DUP(5)) SITE_DISPATCH()
        SITE_DISPATCH()
        constexpr int CB = F8 ? CAP / 256 : CHUNK_BLKS;
        for (int ch = 0; ch < (F8 ? 1 : 2); ++ch) {
            const int nblk = pend[7];
            const int blk0 = ch * CB; int nb = nblk - blk0; nb = nb < 0 ? 0 : (nb > CB ? CB : nb); nb = __builtin_amdgcn_readfirstlane(nb);
            if (DUP(0)) SITE_MUP()
            SITE_MUP()
            if (DUP(0)) SITE_MDOWN()
            SITE_MDOWN()
        }
        if constexpr (l == 1) { { unsigned char* ws = ARG_WS(); norm_phase<true, false, false, INT8_PROJ ? 2 : 0, false, bf16_t>(nullptr, WSP(bf16_t, WS_XN), WSP(bf16_t, WS_XS), WSP(int, WS_SLOT_OF), nullptr, nullptr, nullptr, nullptr, nullptr, lds, cnt_l, G, wave_s, WSP(float, WS_ASCALE), WSP(bf16_t, WS_DELTA), (const bf16_t*)WSP(bf16_t, WS_XB), WSP(bf16_t, WS_XB)); } xcd_barrier(bar, wave_s); }
        else { unsigned char* ws = ARG_WS(); norm_phase<true, false, true, 0, false, bf16_t>(ARG_OUT(), WSP(bf16_t, WS_XN), WSP(bf16_t, WS_XS), WSP(int, WS_SLOT_OF), ARG_IN(14), nullptr, nullptr, nullptr, nullptr, lds, cnt_l, G, wave_s, nullptr, WSP(bf16_t, WS_DELTA), (const bf16_t*)WSP(bf16_t, WS_XB), nullptr); }
    }
}

__global__ void __launch_bounds__(NTHREADS, 2) yoco_fwd(Args args_unused) {
    extern __shared__ __attribute__((aligned(16))) unsigned char lds_raw[];
    LAS unsigned char* lds = (LAS unsigned char*)lds_raw;
    const int G = gridDim.x; const int bx = blockIdx.x; const int wave_s = __builtin_amdgcn_readfirstlane(threadIdx.x >> 6);
    const int vcu = (G % 8 == 0) ? (bx % 8) * (G / 8) + bx / 8 : bx;
    const int NGW = G * NWAVES;
    LAS unsigned* lctl = (LAS unsigned*)(lds + LCTL_OFF);
    for (int u = threadIdx.x; u < (LDS_BYTES - LCTL_OFF) / 4; u += NTHREADS) lctl[u] = 0u;
    __syncthreads();
    volatile LAS unsigned* bar_st = (volatile LAS unsigned*)lctl;
    LAS int* pend = (LAS int*)(lctl + 16);
    LAS int* cnt_l = (LAS int*)(lctl + 32);
    XcdBarrier bar = xcd_barrier_post((unsigned*)(ARG_WS() + WS_CTL) + 1024, bar_st);

    for (int rep = 0; rep < 1 + DUP(4); ++rep) {
        unsigned char* ws = ARG_WS();
        const int tid = fresh_tid(wave_s); const int lane = tid & 63, wave = __builtin_amdgcn_readfirstlane(tid >> 6), gw = vcu * NWAVES + wave;
        LAS float* scr = (LAS float*)(lds + wave * 16384);
        { const GAS f32x4* xi = (const GAS f32x4*)ARG_IN(0); GAS u32x2* xo = WSP(GAS u32x2, WS_XB);
          for (size_t i = (size_t)gw * 64 + lane; i < (size_t)M * D / 4; i += (size_t)NGW * 64 * 4) {
              f32x4 v[4];
#pragma unroll
              for (int q = 0; q < 4; ++q) if (i + (size_t)q * NGW * 64 < (size_t)M * D / 4) v[q] = xi[i + (size_t)q * NGW * 64];
#pragma unroll
              for (int q = 0; q < 4; ++q) if (i + (size_t)q * NGW * 64 < (size_t)M * D / 4) { u32x2 w; w.x = cvtpk(v[q].x, v[q].y); w.y = cvtpk(v[q].z, v[q].w); xo[i + (size_t)q * NGW * 64] = w; } } }
        int base = 0;
        for (int j = 0; j < 50; ++j) {
            const float* W; const float* gain = nullptr; int ldw, K, N; float mul = 1.0f; bool f8 = false, gu = false; size_t dst;
            if (j < 8) { W = ARG_IN(3) + (size_t)j * 65536; ldw = 256; K = 256; N = 256; gain = ARG_IN(1) + (j >> 2) * D + (j & 3) * 256; dst = WS_WPOOL + (size_t)j * 65536 * 2; }
            else if (j < 10) { W = ARG_IN(6) + (j - 8) * 1024; ldw = 2048; K = 1024; N = 1024; gain = ARG_IN(5); dst = (j == 8) ? WS_WK : WS_WV; }
            else if (j < 12) { const int b = j - 10; W = ARG_IN(7) + (size_t)b * D * D; ldw = 1024; K = 1024; N = 1024; gain = ARG_IN(1) + (2 + b) * D; mul = 0.125f * 1.4426950408889634f; dst = WS_WQ + (size_t)b * D * D * 2; }
            else if (j < 14) { const int b = j - 12; W = ARG_IN(8) + (size_t)b * D * D; ldw = 1024; K = 1024; N = 1024; dst = WS_WO + (size_t)b * D * D * 2; }
            else if (j < 16) { const int i = j - 14; f8 = ((FP8_MASK >> (2 * i)) & 1) != 0; gu = true; W = ARG_IN(9) + (size_t)i * D * 2 * DFF; ldw = 2 * DFF; K = 1024; N = 2 * DFF; gain = ARG_IN(2) + (2 * i) * D; mul = f8 ? W8_UP : 1.0f; dst = WS_WFI + (size_t)i * 2 * DFF * D * 2; }
            else if (j < 18) { const int i = j - 16; f8 = ((FP8_MASK >> (2 * i)) & 1) != 0; W = ARG_IN(10) + (size_t)i * DFF * D; ldw = 1024; K = DFF; N = 1024; mul = f8 ? W8_DN : 1.0f; dst = WS_WFO + (size_t)i * D * DFF * 2; }
            else if (j < 34) { const int ie = j - 18, li = 2 * (ie >> 3) + 1, e = ie & 7; f8 = ((FP8_MASK >> li) & 1) != 0; gu = true; W = ARG_IN(12) + (size_t)ie * D * 2 * DFFE; ldw = 2 * DFFE; K = 1024; N = 2 * DFFE; gain = ARG_IN(2) + li * D; mul = f8 ? W8_UP : 1.0f;
                               dst = WS_WMI + (size_t)(ie >> 3) * 8 * 2 * DFFE * D * 2 + (size_t)e * 2 * DFFE * D * (f8 ? 1 : 2); }
            else { const int ie = j - 34, li = 2 * (ie >> 3) + 1, e = ie & 7; f8 = ((FP8_MASK >> li) & 1) != 0; W = ARG_IN(13) + (size_t)ie * DFFE * D; ldw = 1024; K = DFFE; N = 1024; mul = f8 ? W8_DN : 1.0f;
                   dst = WS_WMO + (size_t)(ie >> 3) * 8 * D * DFFE * 2 + (size_t)e * D * DFFE * (f8 ? 1 : 2); }
            const int nitems = (K / 64) * (N / 32);
            int first = (gw - base) % NGW; if (first < 0) first += NGW;
            if ((INT8_UP0 && j == 14) || (INT8_PROJ && j >= 8 && j < 12)) continue;
            tr_mat(W, ldw, K, N, gain, mul, f8 ? 1 : 0, gu, ws + dst, scr, first, NGW, lane);
            base = (base + nitems) % NGW;
        }
    }
    if (INT8_UP0 || INT8_PROJ) {
        unsigned char* ws = ARG_WS(); const int tid = fresh_tid(wave_s); const int lane = tid & 63, gw = vcu * NWAVES + __builtin_amdgcn_readfirstlane(tid >> 6);
        int base = 0;
        for (int j = 0; j < 5; ++j) {
            if ((j == 0 && !INT8_UP0) || (j > 0 && !INT8_PROJ)) continue;
            const GAS float* W; const GAS float* gn; int ldw, ncols; float mul = 1.0f; unsigned* cm;
            if (j == 0) { W = (const GAS float*)ARG_IN(9); gn = (const GAS float*)ARG_IN(2); ldw = 2 * DFF; ncols = 2 * DFF; cm = WSP(unsigned, WS_COLMAX); }
            else if (j < 3) { W = (const GAS float*)ARG_IN(6) + (j - 1) * 1024; gn = (const GAS float*)ARG_IN(5); ldw = 2048; ncols = 1024; cm = WSP(unsigned, WS_COLMAX2) + (j - 1) * 1024; }
            else { W = (const GAS float*)ARG_IN(7) + (size_t)(j - 3) * D * D; gn = (const GAS float*)ARG_IN(1) + (2 + (j - 3)) * D; ldw = 1024; ncols = 1024; mul = 0.125f * 1.4426950408889634f; cm = WSP(unsigned, WS_COLMAX2) + (2 + (j - 3)) * 1024; }
            const int nstrip = ncols / 64, ntask = nstrip * (D / 64);
            int first = (gw - base) % NGW; if (first < 0) first += NGW;
            for (int task = first; task < ntask; task += NGW) { const int strip = task % nstrip, kc = task / nstrip; const int n = strip * 64 + lane; float mx = 0.f;
#pragma unroll 16
                for (int kk = 0; kk < 64; ++kk) { const int k = kc * 64 + kk; mx = fmaxf(mx, fabsf(W[(size_t)k * ldw + n] * gn[k])); }
                const unsigned old = __hip_atomic_fetch_max(cm + n, __builtin_bit_cast(unsigned, mx * mul), __ATOMIC_RELAXED, __HIP_MEMORY_SCOPE_AGENT); asm volatile("" :: "v"(old)); }
            base = (base + ntask) % NGW;
        }
    }
    xcd_barrier(bar, wave_s);

    layer_body<0>(lds, bar, pend, cnt_l, G, bx, vcu, NGW, wave_s);
    layer_body<1>(lds, bar, pend, cnt_l, G, bx, vcu, NGW, wave_s);
    layer_body<2>(lds, bar, pend, cnt_l, G, bx, vcu, NGW, wave_s);
    layer_body<3>(lds, bar, pend, cnt_l, G, bx, vcu, NGW, wave_s);
}

extern "C" void kernel_launch(void* const* d_in, const int* in_sizes, int n_in, void* d_out, int out_size, void* d_ws, size_t ws_size, hipStream_t stream) {
    static int grid = 0;
    if (grid == 0) {
        if (n_in != 15 || out_size != M * D || ws_size < WS_END) { fprintf(stderr, "kernel_launch: unexpected shapes (n_in %d out %d ws %zu)\n", n_in, out_size, ws_size); grid = -1; return; }
        int dev = 0, cus = 0, per_cu = 0;
        if (hipGetDevice(&dev) != hipSuccess || hipDeviceGetAttribute(&cus, hipDeviceAttributeMultiprocessorCount, dev) != hipSuccess) { grid = -1; return; }
        if (hipFuncSetAttribute((const void*)yoco_fwd, hipFuncAttributeMaxDynamicSharedMemorySize, LDS_BYTES) != hipSuccess) { fprintf(stderr, "kernel_launch: hipFuncSetAttribute failed\n"); grid = -1; return; }
        if (hipOccupancyMaxActiveBlocksPerMultiprocessor(&per_cu, (const void*)yoco_fwd, NTHREADS, LDS_BYTES) != hipSuccess || per_cu < 1) { fprintf(stderr, "kernel_launch: occupancy query says %d\n", per_cu); }
        (void)hipGetLastError();
        grid = cus;
    }
    if (grid < 0) return;
    (void)hipMemsetAsync((char*)d_ws + WS_CTL, 0, CTL_ZERO_BYTES, stream);
    Args a{};
    for (int i = 0; i < 15; ++i) a.in[i] = (const float*)d_in[i];
    a.out = (float*)d_out; a.ws = (unsigned char*)d_ws;
    hipLaunchKernelGGL(yoco_fwd, dim3(grid), dim3(NTHREADS), LDS_BYTES, stream, a);
}
```

```cpp
#include <hip/hip_runtime.h>
#include <cstdio>
#include <cstdint>

#define LAS __attribute__((address_space(3)))
#define GAS __attribute__((address_space(1)))
typedef unsigned short bf16_t;
typedef short bf16x8 __attribute__((ext_vector_type(8)));
typedef float f32x2 __attribute__((ext_vector_type(2)));
typedef float f32x4 __attribute__((ext_vector_type(4)));
typedef float f32x16 __attribute__((ext_vector_type(16)));
typedef unsigned u32x2 __attribute__((ext_vector_type(2)));
typedef unsigned u32x4 __attribute__((ext_vector_type(4)));
typedef int i32x4 __attribute__((ext_vector_type(4)));
typedef __bf16 bf16x2_t __attribute__((ext_vector_type(2)));

constexpr int D = 1024, BATCH = 32, SEQ = 2048, M = BATCH * SEQ;
constexpr int DFF = 2816, DFFE = 3584, NE = 8, NH = 16;
constexpr int CAP = 2 * M + NE * 256;
constexpr int CHUNK_BLKS = 260;
constexpr float RMS_EPS = 1e-6f;
#ifndef FP8_MASK
#define FP8_MASK 14
#endif
#ifndef INT8_UP0
#define INT8_UP0 1
#endif
#ifndef INT8_PROJ
#define INT8_PROJ 1
#endif
constexpr float W8_UP = 64.f, W8_DN = 128.f, H8_SC = 8.f;
constexpr float W8_GATE = 1.4426950408889634f;
constexpr int NWAVES = 8, NTHREADS = 512;

constexpr size_t MiB = 1u << 20;
constexpr size_t WS_CTL = 0, CTL_ZERO_BYTES = 80 * 1024;
constexpr size_t WS_COLMAX2 = 65536;
constexpr size_t WS_WSCALE2 = 1 * MiB + 40960;
constexpr size_t WS_HALO_FLAGS = 20480;
constexpr size_t WS_COLMAX = 32768;
constexpr size_t WS_WSCALE = 1 * MiB + 16384;
constexpr size_t WS_ASCALE = 3 * MiB + 786432;
constexpr size_t WS_TILECNT = 1 * MiB;
constexpr size_t WS_ROUTE_E = 1 * MiB + 65536;
constexpr size_t WS_ROUTE_G = 2 * MiB;
constexpr size_t WS_SLOT_OF = 2 * MiB + 524288;
constexpr size_t WS_GATE_SLOT = 3 * MiB;
constexpr size_t WS_WPOOL = 4 * MiB;
constexpr size_t WS_WK = 5 * MiB, WS_WV = 7 * MiB, WS_WQ = 9 * MiB, WS_WO = 13 * MiB;
constexpr size_t WS_WFI = 17 * MiB;
constexpr size_t WS_WFO = 39 * MiB;
constexpr size_t WS_WMI = 50 * MiB;
constexpr size_t WS_WMO = 274 * MiB;
constexpr size_t WS_XN = 386 * MiB;
constexpr size_t WS_K = 514 * MiB, WS_VT = 642 * MiB;
constexpr size_t WS_XS = 770 * MiB;
constexpr size_t WS_R = 1030 * MiB;
constexpr size_t WS_XS8 = 1485 * MiB;
constexpr size_t WS_XB = 1485 * MiB;
constexpr size_t WS_TOS = 386 * MiB + 64 * MiB;

constexpr size_t WS_YT = 1616 * MiB;
constexpr size_t WS_DELTA = 1616 * MiB;
constexpr size_t WS_END = 1744 * MiB;
static_assert(WS_XS8 + (size_t)CAP * D <= WS_END, "xs8");
static_assert(WS_XS + (size_t)CAP * D * 2 <= WS_R, "xs");
static_assert(WS_R + (size_t)CHUNK_BLKS * 256 * DFFE * 2 <= WS_END, "moe hidden chunk");
static_assert(WS_R + (size_t)M * DFF * 2 <= WS_END, "dense hidden");
static_assert(WS_R + (size_t)CAP * DFFE <= WS_XS8, "fp8 moe hidden, one chunk");
static_assert(WS_WMO + (size_t)2 * 8 * 1024 * 3584 * 2 <= WS_XN, "weights");

constexpr int STAGE_BYTES_LDS = 131072;
constexpr int LCTL_OFF = STAGE_BYTES_LDS;
constexpr int LDS_BYTES = 147456;

__device__ __forceinline__ unsigned cvtpk(float lo, float hi) { f32x2 v = {lo, hi}; bf16x2_t b = __builtin_convertvector(v, bf16x2_t); return __builtin_bit_cast(unsigned, b); }
__device__ __forceinline__ unsigned pk4_fp8(float a, float b, float c, float d) { int w = __builtin_amdgcn_cvt_pk_fp8_f32(a, b, 0, false); w = __builtin_amdgcn_cvt_pk_fp8_f32(c, d, w, true); return (unsigned)w; }
__device__ __forceinline__ unsigned pk4_i8(float a, float b, float c, float d) {
    const int i0 = (int)__builtin_rintf(__builtin_amdgcn_fmed3f(a, -127.f, 127.f)), i1 = (int)__builtin_rintf(__builtin_amdgcn_fmed3f(b, -127.f, 127.f));
    const int i2 = (int)__builtin_rintf(__builtin_amdgcn_fmed3f(c, -127.f, 127.f)), i3 = (int)__builtin_rintf(__builtin_amdgcn_fmed3f(d, -127.f, 127.f));
    return (unsigned)(i0 & 255) | ((unsigned)(i1 & 255) << 8) | ((unsigned)(i2 & 255) << 16) | ((unsigned)i3 << 24); }
__device__ __forceinline__ float wave_max(float v) {
#pragma unroll
    for (int o = 1; o < 64; o <<= 1) v = fmaxf(v, __shfl_xor(v, o));
    return v;
}
__device__ __forceinline__ float bf_lo(unsigned w) { return __builtin_bit_cast(float, w << 16); }
__device__ __forceinline__ float bf_hi(unsigned w) { return __builtin_bit_cast(float, w & 0xffff0000u); }
__device__ __forceinline__ f32x4 ld4(const float* p) { return *(const GAS f32x4*)p; }
__device__ __forceinline__ f32x4 ld4(const bf16_t* p) { const u32x2 w = *(const GAS u32x2*)p; return (f32x4){bf_lo(w.x), bf_hi(w.x), bf_lo(w.y), bf_hi(w.y)}; }
__device__ __forceinline__ f32x2 ld2(const float* p) { return *(const GAS f32x2*)p; }
__device__ __forceinline__ f32x2 ld2(const bf16_t* p) { const unsigned w = *(const GAS unsigned*)p; return (f32x2){bf_lo(w), bf_hi(w)}; }
__device__ __forceinline__ f32x4 ldraw4(const float* p) { return *(const GAS f32x4*)p; }
__device__ __forceinline__ u32x2 ldraw4(const bf16_t* p) { return *(const GAS u32x2*)p; }
__device__ __forceinline__ f32x4 cvt4(f32x4 v) { return v; }
__device__ __forceinline__ f32x4 cvt4(u32x2 w) { return (f32x4){bf_lo(w.x), bf_hi(w.x), bf_lo(w.y), bf_hi(w.y)}; }
template <class T> struct Raw4; template <> struct Raw4<float> { typedef f32x4 t; }; template <> struct Raw4<bf16_t> { typedef u32x2 t; };
__device__ __forceinline__ float wave_sum(float v) {
#pragma unroll
    for (int o = 1; o < 64; o <<= 1) v += __shfl_xor(v, o);
    return v;
}
#define LDS_WAIT() asm volatile("s_waitcnt lgkmcnt(0)" ::: "memory")
__device__ __forceinline__ int fresh_tid(int wave_s) { int w = wave_s, z = 0; asm volatile("" : "+s"(w), "+s"(z)); return w * 64 + (int)__builtin_amdgcn_mbcnt_hi(~0u, __builtin_amdgcn_mbcnt_lo(~0u, (unsigned)z)); }
#define RLX_AGENT __ATOMIC_RELAXED, __HIP_MEMORY_SCOPE_AGENT

#define XB_TMO      128
#define XB_XCNT(j)  (256  + 64 * (j))
#define XB_XSUB(j)  (1280 + 64 * (j))
#define XB_XGEN(j)  (2304 + 64 * (j))
#define XB_TOP      3328
#define XB_TOPGEN   3392
#define XCD_BAR_WORDS 3456
#define XB_SPIN_CAP (1u << 22)
__device__ __forceinline__ unsigned xb_ld(unsigned* p)              { return __hip_atomic_load(p, __ATOMIC_RELAXED, __HIP_MEMORY_SCOPE_AGENT); }
__device__ __forceinline__ unsigned xb_add(unsigned* p, unsigned v) { return __hip_atomic_fetch_add(p, v, __ATOMIC_RELAXED, __HIP_MEMORY_SCOPE_AGENT); }
__device__ __forceinline__ unsigned xb_xcc_id() { return (unsigned)__builtin_amdgcn_s_getreg((3 << 11) | 20) & 0xFu; }
#define XB_SPIN(cond, bar) do { unsigned _sp = 0; while (cond) { __builtin_amdgcn_s_sleep(1); \
    if ((++_sp & 255u) == 0u) { if (xb_ld(&(bar)[XB_TMO])) break; if (_sp > XB_SPIN_CAP) { atomicAdd(&(bar)[XB_TMO], 1u); break; } } } } while (0)
struct XcdBarrier { unsigned* bar; unsigned x; volatile LAS unsigned* st; };
__device__ __forceinline__ XcdBarrier xcd_barrier_post(unsigned* bar, volatile LAS unsigned* st) {
    XcdBarrier b; b.bar = bar; b.x = xb_xcc_id(); b.st = st;
    if (threadIdx.x == 0) (void)xb_add(&bar[XB_XCNT(b.x)], 1u);
    return b;
}
__device__ __forceinline__ void xcd_barrier_complete(unsigned* bar, unsigned x, unsigned& nloc, unsigned& nx) {
    const unsigned G = gridDim.x * gridDim.y * gridDim.z;
    unsigned sum, cnt, mine, sp = 0u;
    for (;;) {
        sum = 0u; cnt = 0u; mine = 0u;
#pragma unroll
        for (unsigned j = 0; j < 16; ++j) { const unsigned c = xb_ld(&bar[XB_XCNT(j)]); sum += c; cnt += (c > 0u) ? 1u : 0u; mine = (j == x) ? c : mine; }
        if (sum == G) break;
        __builtin_amdgcn_s_sleep(1);
        if ((++sp & 255u) == 0u) { if (xb_ld(&bar[XB_TMO])) break; if (sp > XB_SPIN_CAP) { atomicAdd(&bar[XB_TMO], 1u); break; } }
    }
    nloc = mine > 0u ? mine : 1u; nx = cnt > 0u ? cnt : 1u;
}
__device__ __forceinline__ void xcd_barrier(const XcdBarrier& b, int wave_s) {
    asm volatile("s_waitcnt vmcnt(0)" ::: "memory");
    __syncthreads();
    if (fresh_tid(wave_s) == 0) {
        unsigned* bar = b.bar;
        __builtin_amdgcn_s_waitcnt(0);
        unsigned nloc = b.st[0], nx = b.st[1];
        if (nloc == 0u) { xcd_barrier_complete(bar, b.x, nloc, nx); b.st[0] = nloc; b.st[1] = nx; }
        const unsigned old = xb_add(&bar[XB_XSUB(b.x)], 1u);
        const unsigned gen = old / nloc;
        if (old + 1u == (gen + 1u) * nloc) {
            __builtin_amdgcn_fence(__ATOMIC_RELEASE, "agent");
            asm volatile("s_waitcnt vmcnt(0)" ::: "memory");
            const unsigned og = xb_add(&bar[XB_TOP], 1u);
            const unsigned tg = og / nx;
            if (og + 1u == (tg + 1u) * nx) xb_add(&bar[XB_TOPGEN], 1u);
            else XB_SPIN(xb_ld(&bar[XB_TOPGEN]) == tg, bar);
            __builtin_amdgcn_fence(__ATOMIC_ACQUIRE, "agent");
            xb_add(&bar[XB_XGEN(b.x)], 1u);
            asm volatile("s_waitcnt vmcnt(0)" ::: "memory");
        } else {
            XB_SPIN(xb_ld(&bar[XB_XGEN(b.x)]) == gen, bar);
            __builtin_amdgcn_fence(__ATOMIC_ACQUIRE, "agent");
            asm volatile("s_waitcnt vmcnt(0)" ::: "memory");
        }
    }
    __syncthreads();
}

namespace pg8 {
constexpr int BM = 256, BK = 64, HALF = 128, HTB = HALF * BK * 2, NXCD = 8, WGM = 8;
__host__ __device__ __forceinline__ int lds_byte(int r, int c) { const int st = (r >> 4) * 2 + (c >> 5), rr = r & 15, cc = c & 31, ob = rr * 64 + cc * 2; return st * 1024 + (ob ^ (((ob >> 9) & 1) << 5)); }
__host__ __device__ __forceinline__ void stage_rc(int b, int& R, int& C) { const int st = b / 1024, sb = b % 1024, swz = sb ^ (((sb >> 9) & 1) << 5); R = (st >> 1) * 16 + swz / 64; C = (st & 1) * 32 + (swz % 64) / 2; }
__host__ __device__ __forceinline__ int perm32(int rho) { const int n = rho >> 4, i = rho & 15; return 8 * (i >> 2) + 4 * n + (i & 3); }

typedef int i32x8 __attribute__((ext_vector_type(8)));
__device__ __forceinline__ i32x8 cat8(bf16x8 lo, bf16x8 hi) { const i32x4 a = __builtin_bit_cast(i32x4, lo), b = __builtin_bit_cast(i32x4, hi); return __builtin_shufflevector(a, b, 0, 1, 2, 3, 4, 5, 6, 7); }
struct Unit { const char* A; const char* B; int pm, pn, aux; };
struct GemmK { int K, lda, ldb; };

__device__ __forceinline__ bool smap(long L, int nM, int nN, int& pm, int& pn) {
    const int nwg = nM * nN; if (L >= nwg) return false;
    int wgid = (int)L; { const int q = nwg / NXCD, r = nwg % NXCD, xcd = wgid % NXCD, off = wgid / NXCD; wgid = (xcd < r ? xcd * (q + 1) : r * (q + 1) + (xcd - r) * q) + off; }
    const int nig = WGM * nN, gid = wgid / nig, fm = gid * WGM, gsz = (nM - fm) < WGM ? (nM - fm) : WGM;
    pm = fm + ((wgid % nig) % gsz); pn = (wgid % nig) / gsz; return true;
}

template <class Epi, class Sched, bool ALIGN_EPI, int MODE = 0, bool GATHER = false>
__device__ __forceinline__ void gemm_phase(LAS unsigned char* lds, const GemmK g, const Sched& S, const Epi& E, int wave_s, int stag = 0  ) {
    if (stag > 0 && (blockIdx.x & 1)) { const unsigned long long t0 = __builtin_amdgcn_s_memrealtime(); while (__builtin_amdgcn_s_memrealtime() - t0 < (unsigned long long)stag) __builtin_amdgcn_s_sleep(4); }
    const int tid = fresh_tid(wave_s);
    const int wid = __builtin_amdgcn_readfirstlane(tid >> 6), lane = tid & 63, wr = wid >> 2, wc = wid & 3, fr = lane & 15, fq = lane >> 4;
    constexpr bool FP8 = (MODE == 1);
    const int K = g.K, nt = K / BK;
    unsigned voffA[2], voffB[2];
#pragma unroll
    for (int i = 0; i < 2; ++i) { int R, C; stage_rc(tid * 16 + i * 8192, R, C); const int Rb = Epi::PERM ? ((R & ~31) + perm32(R & 31)) : R;
        voffA[i] = (unsigned)(R * g.lda + C) * 2u; voffB[i] = (unsigned)(Rb * g.ldb + C) * 2u; }
    unsigned vG[2][2], vN[2][2];
    const size_t kstep = (size_t)(BK * 2);
    const size_t hstepA = (size_t)HALF * g.lda * 2, hstepB = (size_t)HALF * g.ldb * 2;
    const unsigned ldsw = (unsigned)wid * 1024u;
    const int aoff = lds_byte(wr * 64 + fr, fq * 8), boff = lds_byte(wc * 32 + fr, fq * 8);
#define PG8_SA(b, h) (((b) * 2 + (h)) * HTB)
#define PG8_SB(b, h) ((4 + (b) * 2 + (h)) * HTB)
#define PG8_STAGE(bufoff, gbase, voff) do { _Pragma("unroll") for (int _i = 0; _i < 2; ++_i) \
        __builtin_amdgcn_global_load_lds((const unsigned*)((const char*)(gbase) + (voff)[_i]), (LAS unsigned*)(lds + (bufoff) + ldsw + _i * 8192), 16, 0, 0); } while (0)
#define PG8_STAGE_A(bufoff, gbase, h, nx) do { if constexpr (GATHER) { unsigned _v[2] = { (nx) ? vN[h][0] : vG[h][0], (nx) ? vN[h][1] : vG[h][1] }; PG8_STAGE(bufoff, gbase, _v); } \
        else PG8_STAGE(bufoff, (gbase) + (h) * hstepA, voffA); } while (0)
#define PG8_LD8(p) __builtin_shufflevector(*(const LAS i32x4*)(p), *(const LAS i32x4*)((p) + 1024), 0, 1, 2, 3, 4, 5, 6, 7)
#define PG8_LDA(dst, b, h) do { if constexpr (FP8) { _Pragma("unroll") for (int m = 0; m < 4; ++m) dst##8[m] = PG8_LD8(lds + PG8_SA(b, h) + aoff + m * 2048); } \
        else { _Pragma("unroll") for (int m = 0; m < 4; ++m) _Pragma("unroll") for (int k = 0; k < 2; ++k) dst[m][k] = *(const LAS bf16x8*)(lds + PG8_SA(b, h) + aoff + m * 2048 + k * 1024); } } while (0)
#define PG8_LDB(dst, b, h) do { if constexpr (FP8) { _Pragma("unroll") for (int n = 0; n < 2; ++n) dst##8[n] = PG8_LD8(lds + PG8_SB(b, h) + boff + n * 2048); } \
        else { _Pragma("unroll") for (int n = 0; n < 2; ++n) _Pragma("unroll") for (int k = 0; k < 2; ++k) dst[n][k] = *(const LAS bf16x8*)(lds + PG8_SB(b, h) + boff + n * 2048 + k * 1024); } } while (0)
#define PG8_MFMA_ASM(INS, C, OUT, a_, b_) asm volatile(INS " %0, %1, %2, " C : OUT(acc[ai_][bj_][m][n]) : "v"(b_), "v"(a_))
#define PG8_MMA(ai, bj, At, Bt, Z) do { constexpr int ai_ = ai, bj_ = bj; __builtin_amdgcn_s_setprio(1); \
        if constexpr (FP8) { if (Z) { _Pragma("unroll") for (int m = 0; m < 4; ++m) _Pragma("unroll") for (int n = 0; n < 2; ++n) PG8_MFMA_ASM("v_mfma_f32_16x16x128_f8f6f4", "0", "=&v", At##8[m], Bt##8[n]); } \
                             else { _Pragma("unroll") for (int m = 0; m < 4; ++m) _Pragma("unroll") for (int n = 0; n < 2; ++n) PG8_MFMA_ASM("v_mfma_f32_16x16x128_f8f6f4", "%0", "+v", At##8[m], Bt##8[n]); } } \
        else if constexpr (MODE == 2) { if (Z) { _Pragma("unroll") for (int m = 0; m < 4; ++m) _Pragma("unroll") for (int n = 0; n < 2; ++n) PG8_MFMA_ASM("v_mfma_i32_16x16x64_i8", "0", "=&v", At[m][0], Bt[n][0]); } \
                             else { _Pragma("unroll") for (int m = 0; m < 4; ++m) _Pragma("unroll") for (int n = 0; n < 2; ++n) PG8_MFMA_ASM("v_mfma_i32_16x16x64_i8", "%0", "+v", At[m][0], Bt[n][0]); } \
                             _Pragma("unroll") for (int m = 0; m < 4; ++m) _Pragma("unroll") for (int n = 0; n < 2; ++n) PG8_MFMA_ASM("v_mfma_i32_16x16x64_i8", "%0", "+v", At[m][1], Bt[n][1]); } \
        else { if (Z) { _Pragma("unroll") for (int m = 0; m < 4; ++m) _Pragma("unroll") for (int n = 0; n < 2; ++n) PG8_MFMA_ASM("v_mfma_f32_16x16x32_bf16", "0", "=&v", At[m][0], Bt[n][0]); } \
               else { _Pragma("unroll") for (int m = 0; m < 4; ++m) _Pragma("unroll") for (int n = 0; n < 2; ++n) PG8_MFMA_ASM("v_mfma_f32_16x16x32_bf16", "%0", "+v", At[m][0], Bt[n][0]); } \
               _Pragma("unroll") for (int m = 0; m < 4; ++m) _Pragma("unroll") for (int n = 0; n < 2; ++n) PG8_MFMA_ASM("v_mfma_f32_16x16x32_bf16", "%0", "+v", At[m][1], Bt[n][1]); } \
        __builtin_amdgcn_s_setprio(0); } while (0)
#define PG8_WAIT_V(n) asm volatile("s_waitcnt vmcnt(" #n ")" ::: "memory")
#define PG8_WAIT_L(n) asm volatile("s_waitcnt lgkmcnt(" #n ")" ::: "memory")
#define PG8_BAR __builtin_amdgcn_s_barrier()
#define PG8_SCHED __builtin_amdgcn_sched_barrier(0)
    Unit cur, nxt; int ui = 0;
    constexpr int NS = Epi::NS;
#define PG8_WAIT_V1(n) do { if (NS > 0 && first && ui > 0) asm volatile("s_waitcnt vmcnt(%0)" :: "n"((n) + NS) : "memory"); else PG8_WAIT_V(n); } while (0)
    if (!S.next(0, cur)) return;
    f32x4 acc[2][2][4][2];
    bf16x8 At[4][2], B0[2][2], B1[2][2]; i32x8 At8[4], B08[2], B18[2];
    const char* cA = cur.A; const char* cB = cur.B;
    if constexpr (GATHER) {
#pragma unroll
        for (int i = 0; i < 2; ++i) { int R, C; stage_rc(tid * 16 + i * 8192, R, C);
#pragma unroll
            for (int h = 0; h < 2; ++h) { vG[h][i] = (unsigned)S.tos[(size_t)cur.aux * 256 + h * HALF + R] * (unsigned)(g.lda * 2) + (unsigned)C * 2u; vN[h][i] = vG[h][i]; } } }
    PG8_STAGE(PG8_SB(0, 0), cB, voffB); PG8_STAGE(PG8_SB(0, 1), cB + hstepB, voffB); PG8_STAGE_A(PG8_SA(0, 0), cA, 0, false); PG8_STAGE_A(PG8_SA(0, 1), cA, 1, false);
    if (wr == 1) PG8_BAR;
    PG8_WAIT_V(2); PG8_BAR;
    PG8_STAGE(PG8_SB(1, 0), cB + kstep, voffB); PG8_STAGE_A(PG8_SA(1, 0), cA + kstep, 0, false); PG8_STAGE(PG8_SB(1, 1), cB + hstepB + kstep, voffB);
    PG8_WAIT_V(6); PG8_BAR;
    for (;;) {
        const bool has_next = S.next(ui + 1, nxt);
        const char* nA = has_next ? nxt.A : cA; const char* nB = has_next ? nxt.B : cB;
        if constexpr (GATHER) { if (has_next && wid < 4) __builtin_amdgcn_global_load_lds((const unsigned*)(S.tos + (size_t)nxt.aux * 256 + wid * 64 + lane), (LAS unsigned*)(S.idxl + ((ui + 1) & 1) * 256 + wid * 64), 4, 0, 0); }
        for (int t = 0; t < nt; t += 2) {
            const bool last = (t == nt - 2), first = (t == 0);
            const char* a1 = cA + (size_t)(t + 1) * kstep;
            const char* a2 = last ? nA : cA + (size_t)(t + 2) * kstep; const char* b2 = last ? nB : cB + (size_t)(t + 2) * kstep;
            const char* a3 = a2 + kstep; const char* b3 = b2 + kstep;
            if constexpr (GATHER) { if (last) {
                    const LAS int* ib = S.idxl + ((ui + 1) & 1) * 256;
#pragma unroll
                    for (int i = 0; i < 2; ++i) { int R, C; stage_rc(tid * 16 + i * 8192, R, C);
#pragma unroll
                        for (int h = 0; h < 2; ++h) vN[h][i] = has_next ? (unsigned)ib[h * HALF + R] * (unsigned)(g.lda * 2) + (unsigned)C * 2u : vG[h][i]; } } }
            PG8_LDB(B0, 0, 0); PG8_LDB(B1, 0, 1); PG8_SCHED; PG8_LDA(At, 0, 0); if (!(first && ui > 0)) PG8_STAGE_A(PG8_SA(1, 1), a1, 1, false);
            PG8_WAIT_V1(8); PG8_WAIT_L(0); PG8_BAR; PG8_MMA(0, 0, At, B0, first); PG8_MMA(0, 1, At, B1, first); PG8_BAR; PG8_SCHED;
            PG8_LDA(At, 0, 1); PG8_STAGE(PG8_SB(0, 0), b2, voffB); PG8_STAGE(PG8_SB(0, 1), b2 + hstepB, voffB); PG8_STAGE_A(PG8_SA(0, 0), a2, 0, last);
            PG8_WAIT_V1(8); PG8_WAIT_L(0); PG8_BAR; PG8_MMA(1, 0, At, B0, first); PG8_MMA(1, 1, At, B1, first); PG8_BAR; PG8_SCHED;
            PG8_LDB(B0, 1, 0); PG8_LDB(B1, 1, 1); PG8_SCHED; PG8_LDA(At, 1, 0); PG8_STAGE_A(PG8_SA(0, 1), a2, 1, last);
            PG8_WAIT_V1(8); PG8_WAIT_L(0); PG8_BAR; PG8_MMA(0, 0, At, B0, false); PG8_MMA(0, 1, At, B1, false); PG8_BAR; PG8_SCHED;
            PG8_LDA(At, 1, 1); PG8_STAGE(PG8_SB(1, 0), b3, voffB); PG8_STAGE(PG8_SB(1, 1), b3 + hstepB, voffB); PG8_STAGE_A(PG8_SA(1, 0), a3, 0, last);
            PG8_WAIT_V(8); PG8_WAIT_L(0); PG8_BAR; PG8_MMA(1, 0, At, B0, false); PG8_MMA(1, 1, At, B1, false); PG8_BAR; PG8_SCHED;
        }
        if constexpr (ALIGN_EPI) { if (wr == 0) PG8_BAR; }
        if (has_next) PG8_STAGE_A(PG8_SA(1, 1), nA + kstep, 1, true);
        asm volatile("s_nop 15\n\ts_nop 15" ::: "memory");
        E(acc, cur, wr, wc, fr, fq);
        if (!has_next) break;
        cur = nxt; cA = nA; cB = nB; ++ui;
        if constexpr (GATHER) {
#pragma unroll
            for (int h = 0; h < 2; ++h) { vG[h][0] = vN[h][0]; vG[h][1] = vN[h][1]; } }
        if constexpr (ALIGN_EPI) { if (wr == 1) PG8_BAR; }
    }
    PG8_WAIT_V(0);
    if constexpr (!ALIGN_EPI) { if (wr == 0) PG8_BAR; }
    PG8_BAR;
#undef PG8_SA
#undef PG8_SB
#undef PG8_STAGE
#undef PG8_STAGE_A
#undef PG8_LDA
#undef PG8_LDB
#undef PG8_MMA
#undef PG8_WAIT_V1
#undef PG8_MFMA_ASM
#undef PG8_WAIT_V
#undef PG8_WAIT_L
#undef PG8_BAR
#undef PG8_SCHED
}

struct EpiMoeDownT {
    static constexpr int NS = 16; static constexpr bool PERM = true;
    bf16_t* Y2; const float* gate; float osc;
    __device__ __forceinline__ void operator()(const f32x4 (&acc)[2][2][4][2], const Unit& u, int wr, int wc, int fr, int fq) const {
        const int row0 = u.pm * BM + wr * 64 + fr, col0 = u.pn * BM + wc * 32 + 8 * fq;
        float gtv[2][4];
#pragma unroll
        for (int ai = 0; ai < 2; ++ai)
#pragma unroll
            for (int m = 0; m < 4; ++m) gtv[ai][m] = gate[row0 + ai * HALF + m * 16];
#pragma unroll
        for (int ai = 0; ai < 2; ++ai)
#pragma unroll
            for (int m = 0; m < 4; ++m) { const int row = row0 + ai * HALF + m * 16; const float gt = gtv[ai][m] * osc; bf16_t* rowp = Y2 + ((size_t)u.aux * (8 * 256) + (size_t)(row - 2 * M)) * D + col0;
#pragma unroll
                for (int bj = 0; bj < 2; ++bj) { const f32x4 v0 = acc[ai][bj][m][0] * gt, v1 = acc[ai][bj][m][1] * gt;
                    u32x4 w; w.x = cvtpk(v0[0], v0[1]); w.y = cvtpk(v0[2], v0[3]); w.z = cvtpk(v1[0], v1[1]); w.w = cvtpk(v1[2], v1[3]);
                    *(u32x4*)(rowp + bj * HALF) = w; } }
    }
};
struct DenseOrder {
    int nM, nN, G, c; const char* A; const char* B; size_t at, bt;
    __device__ __forceinline__ bool next(int i, Unit& u) const { int pm, pn; if (!smap((long)i * G + c, nM, nN, pm, pn)) return false;
        u.A = A + (size_t)pm * at; u.B = B + (size_t)pn * bt; u.pm = pm; u.pn = pn; u.aux = 0; return true; }
};
struct PanelOrder {
    int nM, nN, G, c; const char* A; const char* B; size_t at, bt;
    __device__ __forceinline__ bool next(int i, Unit& u) const { const int pm = c + (i / nN) * G, pn = i % nN; if (pm >= nM) return false;
        u.A = A + (size_t)pm * at; u.B = B + (size_t)pn * bt; u.pm = pm; u.pn = pn; u.aux = 0; return true; }
};
struct PoolOrder {
    int G, c; const char* P; const char* W;
    __device__ __forceinline__ bool next(int i, Unit& u) const { const int pm = c + (i >> 2) * G, pn = i & 3; if (pm >= M / 256) return false;
        u.A = P + (size_t)pm * (256 * 1024 * 2) + (size_t)pn * 512; u.B = W + (size_t)pn * (256 * 256 * 2); u.pm = pm; u.pn = pn; u.aux = 0; return true; }
};
struct ProjOrder {
    int njobs, G, c; const char* ws; size_t qoff, tb;
    __device__ __forceinline__ bool next(int i, Unit& u) const {
        const long L = (long)i * G + c; if (L >= (long)njobs * 1024) return false;
        const int job = (int)(L >> 10), l = (int)(L & 1023); const int kind = (njobs == 1) ? 1 : job;
        const size_t woff = WS_WK + (size_t)(kind == 1) * (WS_WQ + qoff - WS_WK) + (size_t)(kind == 2) * (WS_WV - WS_WK);
        int pm, pn;
        if (kind == 2) { smap(l, 4, 256, pm, pn); u.A = ws + woff + (size_t)pm * tb; u.B = ws + WS_XN + (size_t)pn * tb; }
        else { smap(l, 256, 4, pm, pn); u.A = ws + WS_XN + (size_t)pm * tb; u.B = ws + woff + (size_t)pn * tb; }
        u.pm = pm; u.pn = pn; u.aux = kind; return true; }
};
struct MoeOrder {
    int nM, nN, G, c, blk0, a_rel; const char* A; const char* B; size_t at, bt, be; const LAS int* pend;
    __device__ __forceinline__ bool next(int i, Unit& u) const { int pm, pn; if (!smap((long)i * G + c, nM, nN, pm, pn)) return false;
        const int b = blk0 + pm; int e = 0;
#pragma unroll
        for (int j = 0; j < 7; ++j) e += (b >= pend[j]) ? 1 : 0;
        e = __builtin_amdgcn_readfirstlane(e);
        u.A = A + (size_t)(a_rel ? pm : b) * at; u.B = B + (size_t)e * be + (size_t)pn * bt; u.pm = a_rel ? b : pm; u.pn = pn; u.aux = 0; return true; }
};

constexpr int TAIL_B0 = 2 * M / 256, TAIL_KS = 7;
struct MoeTailOrder {
    int nT, G, c; const char* A; const char* B; size_t at, bt, be, kq; const LAS int* pend;
    __device__ __forceinline__ bool next(int i, Unit& u) const { const int L = i * G + c; if (L >= nT * 4 * TAIL_KS) return false;
        const int q = L % TAIL_KS, r = L / TAIL_KS, pn = r & 3, b = TAIL_B0 + (r >> 2); int e = 0;
#pragma unroll
        for (int j = 0; j < 7; ++j) e += (b >= pend[j]) ? 1 : 0;
        e = __builtin_amdgcn_readfirstlane(e);
        u.A = A + (size_t)b * at + (size_t)q * kq; u.B = B + (size_t)e * be + (size_t)pn * bt + (size_t)q * kq; u.pm = b; u.pn = pn; u.aux = q; return true; }
};
struct MoeGatherOrder {
    int nM, nN, G, c, blk0; const char* A; const char* B; size_t bt, be; const LAS int* pend; const int* tos; LAS int* idxl;
    __device__ __forceinline__ bool next(int i, Unit& u) const { int pm, pn; if (!smap((long)i * G + c, nM, nN, pm, pn)) return false;
        const int b = blk0 + pm; int e = 0;
#pragma unroll
        for (int j = 0; j < 7; ++j) e += (b >= pend[j]) ? 1 : 0;
        e = __builtin_amdgcn_readfirstlane(e);
        u.A = A; u.B = B + (size_t)e * be + (size_t)pn * bt; u.pm = pm; u.pn = pn; u.aux = b; return true; }
};
struct EpiPool {
    static constexpr int NS = 0; static constexpr bool PERM = false;
    const float* xin; float* out; const float* scale; float mul;
    __device__ __forceinline__ void operator()(const f32x4 (&acc)[2][2][4][2], const Unit& u, int wr, int wc, int fr, int fq) const {
        const int row0 = u.pm * BM + wr * 64 + fr, col0 = u.pn * BM + wc * 32 + 4 * fq;
        f32x4 sv[2][2];
#pragma unroll
        for (int bj = 0; bj < 2; ++bj)
#pragma unroll
            for (int n = 0; n < 2; ++n) sv[bj][n] = *(const f32x4*)(scale + col0 + bj * HALF + n * 16) * mul;
#pragma unroll
        for (int ai = 0; ai < 2; ++ai)
#pragma unroll
            for (int m = 0; m < 4; ++m) { const size_t off = (size_t)(row0 + ai * HALF + m * 16) * D + col0;
#pragma unroll
                for (int bj = 0; bj < 2; ++bj)
#pragma unroll
                    for (int n = 0; n < 2; ++n) { const f32x4 xv = *(const f32x4*)(xin + off + bj * HALF + n * 16); *(f32x4*)(out + off + bj * HALF + n * 16) = xv + sv[bj][n] * acc[ai][bj][m][n]; }
                asm volatile("" ::: "memory"); }
    }
};
struct EpiDelta {
    static constexpr int NS = 0; static constexpr bool PERM = true;
    bf16_t* DL; const float* scale;
    __device__ __forceinline__ void operator()(const f32x4 (&acc)[2][2][4][2], const Unit& u, int wr, int wc, int fr, int fq) const {
        const int row0 = u.pm * BM + wr * 64 + fr, col0 = u.pn * BM + wc * 32 + 8 * fq;
        f32x4 sv[2][2];
#pragma unroll
        for (int bj = 0; bj < 2; ++bj) { sv[bj][0] = scale ? *(const f32x4*)(scale + col0 + bj * HALF) : (f32x4){1.f, 1.f, 1.f, 1.f}; sv[bj][1] = scale ? *(const f32x4*)(scale + col0 + bj * HALF + 4) : (f32x4){1.f, 1.f, 1.f, 1.f}; }
#pragma unroll
        for (int ai = 0; ai < 2; ++ai)
#pragma unroll
            for (int m = 0; m < 4; ++m) { bf16_t* rowp = DL + (size_t)(row0 + ai * HALF + m * 16) * D + col0;
#pragma unroll
                for (int bj = 0; bj < 2; ++bj) { const f32x4 v0 = acc[ai][bj][m][0] * sv[bj][0], v1 = acc[ai][bj][m][1] * sv[bj][1];
                    u32x4 w; w.x = cvtpk(v0[0], v0[1]); w.y = cvtpk(v0[2], v0[3]); w.z = cvtpk(v1[0], v1[1]); w.w = cvtpk(v1[2], v1[3]);
                    *(u32x4*)(rowp + bj * HALF) = w; } }
    }
};
struct EpiResidB {
    static constexpr int NS = 16; static constexpr bool PERM = true; static constexpr bool SPLIT = false;
    bf16_t* xb; const float* scale; float mul;
    __device__ __forceinline__ void operator()(const f32x4 (&acc)[2][2][4][2], const Unit& u, int wr, int wc, int fr, int fq) const {
        const int row0 = u.pm * BM + wr * 64 + fr, col0 = u.pn * BM + wc * 32 + 8 * fq;
        u32x4 d[2][4][2];
#pragma unroll
        for (int ai = 0; ai < 2; ++ai)
#pragma unroll
            for (int m = 0; m < 4; ++m) { const GAS bf16_t* rowp = (const GAS bf16_t*)xb + (size_t)(row0 + ai * HALF + m * 16) * D + col0;
#pragma unroll
                for (int bj = 0; bj < 2; ++bj) d[ai][m][bj] = *(const GAS u32x4*)(rowp + bj * HALF); }
        f32x4 sv[2][2];
#pragma unroll
        for (int bj = 0; bj < 2; ++bj) { sv[bj][0] = (scale ? *(const f32x4*)(scale + col0 + bj * HALF) : (f32x4){1.f, 1.f, 1.f, 1.f}) * mul; sv[bj][1] = (scale ? *(const f32x4*)(scale + col0 + bj * HALF + 4) : (f32x4){1.f, 1.f, 1.f, 1.f}) * mul; }
#pragma unroll
        for (int ai = 0; ai < 2; ++ai)
#pragma unroll
            for (int m = 0; m < 4; ++m) { GAS bf16_t* rowp = (GAS bf16_t*)xb + (size_t)(row0 + ai * HALF + m * 16) * D + col0;
#pragma unroll
                for (int bj = 0; bj < 2; ++bj) { const u32x4 dd = d[ai][m][bj];
                    const f32x4 o0 = (f32x4){bf_lo(dd.x), bf_hi(dd.x), bf_lo(dd.y), bf_hi(dd.y)} + acc[ai][bj][m][0] * sv[bj][0], o1 = (f32x4){bf_lo(dd.z), bf_hi(dd.z), bf_lo(dd.w), bf_hi(dd.w)} + acc[ai][bj][m][1] * sv[bj][1];
                    u32x4 w; w.x = cvtpk(o0[0], o0[1]); w.y = cvtpk(o0[2], o0[3]); w.z = cvtpk(o1[0], o1[1]); w.w = cvtpk(o1[2], o1[3]); *(GAS u32x4*)(rowp + bj * HALF) = w; } }
    }
};
template <class XT>
struct EpiResidD {
    static constexpr int NS = 0; static constexpr bool PERM = true;
    const XT* xsrc; bf16_t* out; const bf16_t* DL; float mul;
    __device__ __forceinline__ void operator()(const f32x4 (&acc)[2][2][4][2], const Unit& u, int wr, int wc, int fr, int fq) const {
        const int row0 = u.pm * BM + wr * 64 + fr, col0 = u.pn * BM + wc * 32 + 8 * fq;
#pragma unroll
        for (int ai = 0; ai < 2; ++ai)
#pragma unroll
            for (int m = 0; m < 4; ++m) { const size_t off0 = (size_t)(row0 + ai * HALF + m * 16) * D + col0;
#pragma unroll
                for (int bj = 0; bj < 2; ++bj) { const size_t off = off0 + bj * HALF; const f32x4 x0 = ld4(xsrc + off), x1 = ld4(xsrc + off + 4); const u32x4 d = *(const u32x4*)(DL + off);
                    const f32x4 d0 = {bf_lo(d.x), bf_hi(d.x), bf_lo(d.y), bf_hi(d.y)}, d1 = {bf_lo(d.z), bf_hi(d.z), bf_lo(d.w), bf_hi(d.w)};
                    const f32x4 o0 = x0 + d0 + acc[ai][bj][m][0] * mul, o1 = x1 + d1 + acc[ai][bj][m][1] * mul;
                    u32x4 w; w.x = cvtpk(o0[0], o0[1]); w.y = cvtpk(o0[2], o0[3]); w.z = cvtpk(o1[0], o1[1]); w.w = cvtpk(o1[2], o1[3]); *(u32x4*)(out + off) = w; }
                asm volatile("" ::: "memory"); }
    }
};
struct EpiResid {
    static constexpr int NS = 0; static constexpr bool PERM = false;
    float* x; float mul;
    __device__ __forceinline__ void operator()(const f32x4 (&acc)[2][2][4][2], const Unit& u, int wr, int wc, int fr, int fq) const {
        const int row0 = u.pm * BM + wr * 64 + fr, col0 = u.pn * BM + wc * 32 + 4 * fq;
#pragma unroll
        for (int ai = 0; ai < 2; ++ai)
#pragma unroll
            for (int m = 0; m < 4; ++m) { float* p = x + (size_t)(row0 + ai * HALF + m * 16) * D + col0;
#pragma unroll
                for (int bj = 0; bj < 2; ++bj)
#pragma unroll
                    for (int n = 0; n < 2; ++n) { const f32x4 xv = *(const f32x4*)(p + bj * HALF + n * 16); *(f32x4*)(p + bj * HALF + n * 16) = xv + acc[ai][bj][m][n] * mul; }
                asm volatile("" ::: "memory"); }
    }
};
__device__ __forceinline__ f32x2 swiglu2(f32x2 g, f32x2 u, float c1  , float kinv  ) {
    const f32x2 t = g * c1; f32x2 e; e.x = __builtin_amdgcn_exp2f(t.x); e.y = __builtin_amdgcn_exp2f(t.y);
    const f32x2 d = e * kinv + kinv; f32x2 r; r.x = __builtin_amdgcn_rcpf(d.x); r.y = __builtin_amdgcn_rcpf(d.y);
    return (g * u) * r;
}
__device__ __forceinline__ f32x2 swiglu2n(f32x2 gl, f32x2 us, float k) {
    f32x2 e; e.x = __builtin_amdgcn_exp2f(-gl.x); e.y = __builtin_amdgcn_exp2f(-gl.y);
    const f32x2 d = e * k + k; f32x2 r; r.x = __builtin_amdgcn_rcpf(d.x); r.y = __builtin_amdgcn_rcpf(d.y);
    return (gl * us) * r;
}
__device__ __forceinline__ float silu_mul(float g, float u) { return g * u * __builtin_amdgcn_rcpf(1.0f + __builtin_amdgcn_exp2f(-1.4426950408889634f * g)); }
struct EpiSwiglu {
    static constexpr int NS = 0; static constexpr bool PERM = true;
    bf16_t* H; int ldc;
    __device__ __forceinline__ void operator()(const f32x4 (&acc)[2][2][4][2], const Unit& u, int wr, int wc, int fr, int fq) const {
        const int row0 = u.pm * BM + wr * 64 + fr, col0 = u.pn * HALF + wc * 32 + 8 * fq;
#pragma unroll
        for (int ai = 0; ai < 2; ++ai)
#pragma unroll
            for (int m = 0; m < 4; ++m) { bf16_t* rowp = H + (size_t)(row0 + ai * HALF + m * 16) * ldc + col0;
                const f32x4 g0 = acc[ai][0][m][0], g1 = acc[ai][0][m][1], u0 = acc[ai][1][m][0], u1 = acc[ai][1][m][1];
                const f32x2 h0 = swiglu2((f32x2){g0[0], g0[1]}, (f32x2){u0[0], u0[1]}, -1.4426950408889634f, 1.0f), h1 = swiglu2((f32x2){g0[2], g0[3]}, (f32x2){u0[2], u0[3]}, -1.4426950408889634f, 1.0f);
                const f32x2 h2 = swiglu2((f32x2){g1[0], g1[1]}, (f32x2){u1[0], u1[1]}, -1.4426950408889634f, 1.0f), h3 = swiglu2((f32x2){g1[2], g1[3]}, (f32x2){u1[2], u1[3]}, -1.4426950408889634f, 1.0f);
                u32x4 w; w.x = cvtpk(h0.x, h0.y); w.y = cvtpk(h1.x, h1.y); w.z = cvtpk(h2.x, h2.y); w.w = cvtpk(h3.x, h3.y);
                *(u32x4*)rowp = w; }
    }
};
struct EpiSwigluI8 {
    static constexpr int NS = 8; static constexpr bool PERM = true;
    bf16_t* H; int ldc; const float* ascale; const float* wscale;
    __device__ __forceinline__ void operator()(const f32x4 (&acc)[2][2][4][2], const Unit& u, int wr, int wc, int fr, int fq) const {
        const int row0 = u.pm * BM + wr * 64 + fr, col0 = u.pn * HALF + wc * 32 + 8 * fq;
        const float* wsp = wscale + u.pn * BM + wc * 32 + 8 * fq;
        const f32x4 sg0 = *(const f32x4*)wsp, sg1 = *(const f32x4*)(wsp + 4), su0 = *(const f32x4*)(wsp + HALF), su1 = *(const f32x4*)(wsp + HALF + 4);
        float sav[2][4];
#pragma unroll
        for (int ai = 0; ai < 2; ++ai)
#pragma unroll
            for (int m = 0; m < 4; ++m) sav[ai][m] = ascale[row0 + ai * HALF + m * 16];
#pragma unroll
        for (int ai = 0; ai < 2; ++ai)
#pragma unroll
            for (int m = 0; m < 4; ++m) { const int row = row0 + ai * HALF + m * 16; bf16_t* rowp = H + (size_t)row * ldc + col0; const float sa = sav[ai][m];
                const i32x4 ig0 = __builtin_bit_cast(i32x4, acc[ai][0][m][0]), ig1 = __builtin_bit_cast(i32x4, acc[ai][0][m][1]), iu0 = __builtin_bit_cast(i32x4, acc[ai][1][m][0]), iu1 = __builtin_bit_cast(i32x4, acc[ai][1][m][1]);
                const f32x4 g0 = __builtin_convertvector(ig0, f32x4) * (sg0 * sa), g1 = __builtin_convertvector(ig1, f32x4) * (sg1 * sa), u0 = __builtin_convertvector(iu0, f32x4) * (su0 * sa), u1 = __builtin_convertvector(iu1, f32x4) * (su1 * sa);
                const f32x2 h0 = swiglu2((f32x2){g0[0], g0[1]}, (f32x2){u0[0], u0[1]}, -1.4426950408889634f, 1.0f), h1 = swiglu2((f32x2){g0[2], g0[3]}, (f32x2){u0[2], u0[3]}, -1.4426950408889634f, 1.0f);
                const f32x2 h2 = swiglu2((f32x2){g1[0], g1[1]}, (f32x2){u1[0], u1[1]}, -1.4426950408889634f, 1.0f), h3 = swiglu2((f32x2){g1[2], g1[3]}, (f32x2){u1[2], u1[3]}, -1.4426950408889634f, 1.0f);
                u32x4 w; w.x = cvtpk(h0.x, h0.y); w.y = cvtpk(h1.x, h1.y); w.z = cvtpk(h2.x, h2.y); w.w = cvtpk(h3.x, h3.y);
                *(u32x4*)rowp = w; }
    }
};
struct EpiSwiglu8 {
    static constexpr int NS = 8; static constexpr bool PERM = true;
    unsigned char* H; int ldc; float gsc;
    __device__ __forceinline__ void operator()(const f32x4 (&acc)[2][2][4][2], const Unit& u, int wr, int wc, int fr, int fq) const {
        const int row0 = u.pm * BM + wr * 64 + fr, col0 = u.pn * HALF + wc * 32 + 8 * fq;
#pragma unroll
        for (int ai = 0; ai < 2; ++ai)
#pragma unroll
            for (int m = 0; m < 4; ++m) { unsigned char* rowp = H + (size_t)(row0 + ai * HALF + m * 16) * ldc + col0;
                const f32x4 g0 = acc[ai][0][m][0], g1 = acc[ai][0][m][1], u0 = acc[ai][1][m][0], u1 = acc[ai][1][m][1];
                const float kk = W8_GATE / (gsc * H8_SC);
                const f32x2 h0 = swiglu2n((f32x2){g0[0], g0[1]}, (f32x2){u0[0], u0[1]}, kk), h1 = swiglu2n((f32x2){g0[2], g0[3]}, (f32x2){u0[2], u0[3]}, kk);
                const f32x2 h2 = swiglu2n((f32x2){g1[0], g1[1]}, (f32x2){u1[0], u1[1]}, kk), h3 = swiglu2n((f32x2){g1[2], g1[3]}, (f32x2){u1[2], u1[3]}, kk);
                u32x2 w; w.x = pk4_fp8(h0.x, h0.y, h1.x, h1.y); w.y = pk4_fp8(h2.x, h2.y, h3.x, h3.y);
                *(u32x2*)rowp = w; }
    }
};
struct EpiProj {
    static constexpr int NS = 0; static constexpr bool PERM = true;
    bf16_t *Kb, *Qb, *Vt;
    __device__ __forceinline__ void operator()(const f32x4 (&acc)[2][2][4][2], const Unit& u, int wr, int wc, int fr, int fq) const {
        bf16_t* base = (u.aux == 0) ? Kb : (u.aux == 1 ? Qb : Vt); const size_t ldc = (u.aux == 2) ? (size_t)M : (size_t)D;
        const int row0 = u.pm * BM + wr * 64 + fr, col0 = u.pn * BM + wc * 32 + 8 * fq;
#pragma unroll
        for (int ai = 0; ai < 2; ++ai)
#pragma unroll
            for (int m = 0; m < 4; ++m) { bf16_t* rowp = base + (size_t)(row0 + ai * HALF + m * 16) * ldc + col0;
#pragma unroll
                for (int bj = 0; bj < 2; ++bj) { const f32x4 v0 = acc[ai][bj][m][0], v1 = acc[ai][bj][m][1];
                    u32x4 w; w.x = cvtpk(v0[0], v0[1]); w.y = cvtpk(v0[2], v0[3]); w.z = cvtpk(v1[0], v1[1]); w.w = cvtpk(v1[2], v1[3]);
                    if (u.aux == 2) { bf16_t* p16 = rowp + bj * HALF - (fq & 1) * 8 + (fq & 1) * 4;
                        *(u32x2*)p16 = (u32x2){w.x, w.y}; *(u32x2*)(p16 + 8) = (u32x2){w.z, w.w}; }
                    else *(u32x4*)(rowp + bj * HALF) = w; } }
    }
};
struct EpiProjI8 {
    static constexpr int NS = 16; static constexpr bool PERM = true;
    bf16_t *Kb, *Qb, *Vt; const float* ascale; const float* wsc  ; int qsel;
    __device__ __forceinline__ void operator()(const f32x4 (&acc)[2][2][4][2], const Unit& u, int wr, int wc, int fr, int fq) const {
        bf16_t* base = (u.aux == 0) ? Kb : (u.aux == 1 ? Qb : Vt); const size_t ldc = (u.aux == 2) ? (size_t)M : (size_t)D;
        const float* rs; const float* cs; if (u.aux == 2) { rs = wsc + 1024; cs = ascale; } else { rs = ascale; cs = wsc + u.aux * (2048 + qsel * 1024); }
        const int row0 = u.pm * BM + wr * 64 + fr, col0 = u.pn * BM + wc * 32 + 8 * fq;
        f32x4 cv[2][2];
#pragma unroll
        for (int bj = 0; bj < 2; ++bj) { cv[bj][0] = *(const f32x4*)(cs + col0 + bj * HALF); cv[bj][1] = *(const f32x4*)(cs + col0 + bj * HALF + 4); }
        float rvv[2][4];
#pragma unroll
        for (int ai = 0; ai < 2; ++ai)
#pragma unroll
            for (int m = 0; m < 4; ++m) rvv[ai][m] = rs[row0 + ai * HALF + m * 16];
#pragma unroll
        for (int ai = 0; ai < 2; ++ai)
#pragma unroll
            for (int m = 0; m < 4; ++m) { const int row = row0 + ai * HALF + m * 16; bf16_t* rowp = base + (size_t)row * ldc + col0; const float rv = rvv[ai][m];
#pragma unroll
                for (int bj = 0; bj < 2; ++bj) { const f32x4 v0 = __builtin_convertvector(__builtin_bit_cast(i32x4, acc[ai][bj][m][0]), f32x4) * (cv[bj][0] * rv), v1 = __builtin_convertvector(__builtin_bit_cast(i32x4, acc[ai][bj][m][1]), f32x4) * (cv[bj][1] * rv);
                    u32x4 w; w.x = cvtpk(v0[0], v0[1]); w.y = cvtpk(v0[2], v0[3]); w.z = cvtpk(v1[0], v1[1]); w.w = cvtpk(v1[2], v1[3]);
                    if (u.aux == 2) { bf16_t* p16 = rowp + bj * HALF - (fq & 1) * 8 + (fq & 1) * 4;
                        *(u32x2*)p16 = (u32x2){w.x, w.y}; *(u32x2*)(p16 + 8) = (u32x2){w.z, w.w}; }
                    else *(u32x4*)(rowp + bj * HALF) = w; } }
    }
};
struct EpiMoeDown {
    static constexpr int NS = 16; static constexpr bool PERM = true;
    bf16_t* Y; const float* gate; float osc;
    __device__ __forceinline__ void operator()(const f32x4 (&acc)[2][2][4][2], const Unit& u, int wr, int wc, int fr, int fq) const {
        const int row0 = u.pm * BM + wr * 64 + fr, col0 = u.pn * BM + wc * 32 + 8 * fq;
        float gtv[2][4];
#pragma unroll
        for (int ai = 0; ai < 2; ++ai)
#pragma unroll
            for (int m = 0; m < 4; ++m) gtv[ai][m] = gate[row0 + ai * HALF + m * 16];
#pragma unroll
        for (int ai = 0; ai < 2; ++ai)
#pragma unroll
            for (int m = 0; m < 4; ++m) { const int row = row0 + ai * HALF + m * 16; const float gt = gtv[ai][m] * osc; bf16_t* rowp = Y + (size_t)row * D + col0;
#pragma unroll
                for (int bj = 0; bj < 2; ++bj) { const f32x4 v0 = acc[ai][bj][m][0] * gt, v1 = acc[ai][bj][m][1] * gt;
                    u32x4 w; w.x = cvtpk(v0[0], v0[1]); w.y = cvtpk(v0[2], v0[3]); w.z = cvtpk(v1[0], v1[1]); w.w = cvtpk(v1[2], v1[3]);
                    *(u32x4*)(rowp + bj * HALF) = w; } }
    }
};
}

__device__ __forceinline__ void tr_load(float (&tv)[32], const float* W, int ldw, int k0, int n0, int lane) {
    const GAS float* wp = (const GAS float*)W + (size_t)(k0 + (lane >> 5)) * ldw + n0 + (lane & 31);
#pragma unroll
    for (int i = 0; i < 32; ++i) tv[i] = wp[(size_t)(2 * i) * ldw];
}
__device__ __forceinline__ void tr_put(const float (&tv)[32], int k0, const float* gain, float mul, int mode  , unsigned char* WT, int ldk, int drow0, LAS float* scr, int lane,
                                       const unsigned* colmax = nullptr  , int n0 = 0, float* wscale = nullptr  ) {
#pragma unroll
    for (int i = 0; i < 32; ++i) { const int kk = 2 * i + (lane >> 5); const float gv = gain ? gain[k0 + kk] * mul : mul; scr[kk * 33 + (lane & 31)] = tv[i] * gv; }
    LDS_WAIT(); asm volatile("" ::: "memory");
    const int c = lane & 7;
#pragma unroll
    for (int j = 0; j < 4; ++j) { const int n = (lane >> 3) + 8 * j; const LAS float* sp = scr + (8 * c) * 33 + n;
        const float e0 = sp[0 * 33], e1 = sp[1 * 33], e2 = sp[2 * 33], e3 = sp[3 * 33], e4 = sp[4 * 33], e5 = sp[5 * 33], e6 = sp[6 * 33], e7 = sp[7 * 33];
        if (mode == 2) { const float mx = __builtin_bit_cast(float, __hip_atomic_load(colmax + n0 + n, RLX_AGENT)); const float q = mx > 0.f ? 127.0f / mx : 0.f;
            u32x2 o; o.x = pk4_i8(e0 * q, e1 * q, e2 * q, e3 * q); o.y = pk4_i8(e4 * q, e5 * q, e6 * q, e7 * q); *(GAS u32x2*)(WT + (size_t)(drow0 + n) * ldk + k0 + 8 * c) = o;
            if (k0 == 0 && c == 0) wscale[drow0 + n] = mx * (1.0f / 127.0f); }
        else if (mode == 1) { u32x2 o; o.x = pk4_fp8(e0, e1, e2, e3); o.y = pk4_fp8(e4, e5, e6, e7); *(GAS u32x2*)(WT + (size_t)(drow0 + n) * ldk + k0 + 8 * c) = o; }
        else { u32x4 o; o.x = cvtpk(e0, e1); o.y = cvtpk(e2, e3); o.z = cvtpk(e4, e5); o.w = cvtpk(e6, e7); *(GAS u32x4*)(WT + ((size_t)(drow0 + n) * ldk + k0 + 8 * c) * 2) = o; } }
    LDS_WAIT(); asm volatile("" ::: "memory");
}
__device__ __forceinline__ void tr_mat(const float* W, int ldw, int K, int N, const float* gain, float mul, int mode, bool gu, unsigned char* WT, LAS float* scr, int first, int NGW, int lane,
                                       const unsigned* colmax = nullptr, float* wscale = nullptr, float gmul = 0.f  ) {
    const int nblk = N / 32, nitems = (K / 64) * nblk, F = N / 2;
    float tv[32], tn[32];
    int it = first; if (it >= nitems) return;
    tr_load(tv, W, ldw, (it / nblk) * 64, (it % nblk) * 32, lane);
    for (; it < nitems; it += NGW) {
        const int nx = it + NGW; if (nx < nitems) tr_load(tn, W, ldw, (nx / nblk) * 64, (nx % nblk) * 32, lane);
        const int kb = it / nblk, n0 = (it % nblk) * 32; int drow0 = n0;
        if (gu) { const int isup = n0 >= F, j = isup ? n0 - F : n0; drow0 = (j >> 7) * 256 + (isup ? 128 : 0) + (j & 127); }
        tr_put(tv, kb * 64, gain, (gu && n0 < F && gmul != 0.f) ? gmul : mul, mode, WT, K, drow0, scr, lane, colmax, n0, wscale);
#pragma unroll
        for (int i = 0; i < 32; ++i) tv[i] = tn[i];
    }
}

struct Args { const float* in[15]; float* out; unsigned char* ws; };
template <int OFF> __device__ __forceinline__ unsigned long long karg() { unsigned long long v; auto ka = __builtin_amdgcn_kernarg_segment_ptr();
    asm volatile("s_load_dwordx2 %0, %1, %2\n\ts_waitcnt lgkmcnt(0)" : "=s"(v) : "s"(ka), "n"(OFF) : "memory"); return v; }
#define ARG_IN(k) ((const float*)(const GAS float*)karg<8 * (k)>())
#define ARG_OUT() ((float*)(GAS float*)karg<120>())
#define ARG_WS() ((unsigned char*)(GAS unsigned char*)karg<128>())

template <int CTRL> __device__ __forceinline__ float dpp_mov(float s) { return __builtin_bit_cast(float, __builtin_amdgcn_update_dpp(0, __builtin_bit_cast(int, s), CTRL, 0xF, 0xF, true)); }
__device__ __forceinline__ void swap16(float& a, float& b) { asm("s_nop 1\n\tv_permlane16_swap_b32 %0, %1" : "+v"(a), "+v"(b)); }
__device__ __forceinline__ void swap32(float& a, float& b) { asm("s_nop 1\n\tv_permlane32_swap_b32 %0, %1" : "+v"(a), "+v"(b)); }
__device__ __forceinline__ float fast_wave_sum(float v) {
    v += dpp_mov<0xB1>(v); v += dpp_mov<0x4E>(v); v += dpp_mov<0x141>(v); v += dpp_mov<0x140>(v);
    { float w = v; swap16(v, w); v += w; } { float w = v; swap32(v, w); v += w; }
    return v;
}
__device__ __forceinline__ float fast_wave_max(float v) {
    v = fmaxf(v, dpp_mov<0xB1>(v)); v = fmaxf(v, dpp_mov<0x4E>(v)); v = fmaxf(v, dpp_mov<0x141>(v)); v = fmaxf(v, dpp_mov<0x140>(v));
    { float w = v; swap16(v, w); v = fmaxf(v, w); } { float w = v; swap32(v, w); v = fmaxf(v, w); }
    return v;
}
__device__ __forceinline__ float reduce8(float (&a)[8], int lane) {
    float b[4], c[2];
#pragma unroll
    for (int k = 0; k < 4; ++k) { float x = a[k], y = a[k + 4]; swap32(x, y); b[k] = x + y; }
#pragma unroll
    for (int k = 0; k < 2; ++k) { float x = b[k], y = b[k + 2]; swap16(x, y); c[k] = x + y; }
    const bool hi = (lane & 8) != 0;
    const float keep = hi ? c[1] : c[0], send = hi ? c[0] : c[1];
    float d = keep + dpp_mov<0x140>(send);
    d += dpp_mov<0x141>(d); d += dpp_mov<0xB1>(d); d += dpp_mov<0x4E>(d);
    return d;
}
template <int W, class HT>
__device__ __forceinline__ void pool_chan(const bf16_t* xp  , const HT* hp  , int s0, const LAS float* inv  , bf16_t* pp  ) {
    f32x2 hist[W]; f32x2 S = {0.f, 0.f};
#pragma unroll
    for (int j = 0; j < W; ++j) hist[j] = (f32x2){0.f, 0.f};
    if (s0 > 0) {
#pragma unroll
        for (int j = 1; j < W; ++j) { const int t = j - W; const f32x2 v = ld2(hp + (ptrdiff_t)t * D) * inv[15 + t]; hist[j] = v; S += v; }
    }
    for (int tb = 0; tb < 256; tb += 64) {
        unsigned raw[64];
#pragma unroll
        for (int j = 0; j < 64; ++j) raw[j] = *(const GAS unsigned*)(xp + (size_t)(tb + j) * D);
#pragma unroll
        for (int j = 0; j < 64; ++j) { const int t = tb + j; const f32x2 xv = (f32x2){bf_lo(raw[j]), bf_hi(raw[j])} * inv[15 + t]; S += xv - hist[j % W]; hist[j % W] = xv;
            const int pos = s0 + t + 1; const float rc = (pos >= W) ? (1.0f / W) : (1.0f / (float)pos);
            const f32x2 p = S * rc - xv; *(GAS unsigned*)(pp + (size_t)t * D) = cvtpk(p.x, p.y); }
    }
}
template <bool FIRST>
__device__ __forceinline__ void pool_prep_phase(const float* xin, bf16_t* xb, bf16_t* P, LAS unsigned char* lds, int G, int wave_s) {
    const int tid = fresh_tid(wave_s); const int lane = tid & 63, wave = __builtin_amdgcn_readfirstlane(tid >> 6);
    LAS float* inv = (LAS float*)lds;
    for (int tile = blockIdx.x; tile < M / 256; tile += G) {
        const int r0 = tile * 256, s0 = r0 % SEQ;
        const int start = (s0 > 0) ? -15 : 0;
        for (int base = start + wave; base < 256; base += 8 * NWAVES) {
            typename Raw4<float>::t vf[8][4]; typename Raw4<bf16_t>::t vb[8][4];
#pragma unroll
            for (int k = 0; k < 8; ++k) { int rr = base + k * NWAVES; rr = rr < 256 ? rr : 255;
                if (FIRST) { const float* xr = xin + (size_t)(r0 + rr) * D + 4 * lane;
#pragma unroll
                    for (int j = 0; j < 4; ++j) vf[k][j] = ldraw4(xr + 256 * j); }
                else { const bf16_t* xr = xb + (size_t)(r0 + rr) * D + 4 * lane;
#pragma unroll
                    for (int j = 0; j < 4; ++j) vb[k][j] = ldraw4(xr + 256 * j); } }
#pragma unroll
            for (int k = 0; k < 8; ++k) { const int rr = base + k * NWAVES; float s = 0.f; f32x4 v[4];
#pragma unroll
                for (int j = 0; j < 4; ++j) { if (FIRST) v[j] = cvt4(vf[k][j]); else v[j] = cvt4(vb[k][j]); s += (v[j].x * v[j].x + v[j].y * v[j].y) + (v[j].z * v[j].z + v[j].w * v[j].w); }
                s = fast_wave_sum(s);
                if (rr < 256) {
                    if (lane == 0) inv[15 + rr] = 1.0f / sqrtf(s * (1.0f / D) + RMS_EPS);
                    if (FIRST && rr >= 0) { GAS u32x2* xo = (GAS u32x2*)(xb + (size_t)(r0 + rr) * D) + lane;
#pragma unroll
                        for (int j = 0; j < 4; ++j) { u32x2 w; w.x = cvtpk(v[j].x, v[j].y); w.y = cvtpk(v[j].z, v[j].w); xo[64 * j] = w; } } } }
        }
        __syncthreads();
        const int c = 2 * tid; const bf16_t* xp = xb + (size_t)r0 * D + c; bf16_t* pp = P + (size_t)r0 * D + c;
        const int grp = wave >> 1;
        if (FIRST) { const float* hp = xin + (size_t)r0 * D + c;
            if (grp == 0) pool_chan<2, float>(xp, hp, s0, inv, pp); else if (grp == 1) pool_chan<4, float>(xp, hp, s0, inv, pp); else if (grp == 2) pool_chan<8, float>(xp, hp, s0, inv, pp); else pool_chan<16, float>(xp, hp, s0, inv, pp); }
        else { if (grp == 0) pool_chan<2, bf16_t>(xp, xp, s0, inv, pp); else if (grp == 1) pool_chan<4, bf16_t>(xp, xp, s0, inv, pp); else if (grp == 2) pool_chan<8, bf16_t>(xp, xp, s0, inv, pp); else pool_chan<16, bf16_t>(xp, xp, s0, inv, pp); }
        __syncthreads();
    }
}

template <bool COMBINE, bool ROUTER, bool FINAL, int OUTK, bool DELTA, class XT>
__device__ __forceinline__ void norm_phase(float* x, bf16_t* XN, const bf16_t* YS, const int* slot_of, const float* gvec  , const float* wr  ,
                                           int* route_e, float* route_g, int* tilecnt, LAS unsigned char* lds, LAS int* cnt_l, int G, int wave_s, float* ascale, const bf16_t* DL, const XT* xs  , bf16_t* xw  ) {
    const int tid = fresh_tid(wave_s); const int lane = tid & 63, wave = __builtin_amdgcn_readfirstlane(tid >> 6);
    f32x2 wreg[8][8];
    if (ROUTER) {
#pragma unroll
        for (int j = 0; j < 4; ++j)
#pragma unroll
            for (int k = 0; k < 4; ++k) { const int c = 4 * lane + 256 * j + k; const float gc = gvec[c]; const f32x4 w0 = *(const f32x4*)(wr + (size_t)c * 8), w1 = *(const f32x4*)(wr + (size_t)c * 8 + 4);
#pragma unroll
                for (int e = 0; e < 4; ++e) { wreg[e][2 * j + (k >> 1)][k & 1] = w0[e] * gc; wreg[e + 4][2 * j + (k >> 1)][k & 1] = w1[e] * gc; } }
    }
    f32x4 gf[4];
    if (FINAL) {
#pragma unroll
        for (int j = 0; j < 4; ++j) gf[j] = *((const f32x4*)gvec + lane + 64 * j);
    }
    for (int tile = blockIdx.x; tile < M / 256; tile += G) {
        const int rb = tile * 256 + wave * 32;
        int slv = 0; if (COMBINE) slv = slot_of[2 * rb + lane];
        u32x2 nx[2][4], na[2][4], nb[2][4];
#define NP_LOAD(u, idx) do { const GAS u32x2* p_ = (const GAS u32x2*)((const bf16_t*)xs + (size_t)(rb + (idx)) * D) + lane; \
            _Pragma("unroll") for (int j = 0; j < 4; ++j) nx[u][j] = p_[64 * j]; \
            if (COMBINE) { const int a0_ = __builtin_amdgcn_readlane(slv, 2 * (idx)), a1_ = __builtin_amdgcn_readlane(slv, 2 * (idx) + 1); \
                const GAS u32x2* y0_ = (const GAS u32x2*)(YS + (size_t)a0_ * D) + lane; const GAS u32x2* y1_ = (const GAS u32x2*)(YS + (size_t)a1_ * D) + lane; \
                _Pragma("unroll") for (int j = 0; j < 4; ++j) { na[u][j] = y0_[64 * j]; nb[u][j] = y1_[64 * j]; } } } while (0)
        NP_LOAD(0, 0); NP_LOAD(1, 1);
        for (int i = 0; i < 32; i += 2) {
            f32x4 v[2][4];
#pragma unroll
            for (int u = 0; u < 2; ++u)
#pragma unroll
                for (int j = 0; j < 4; ++j) { const u32x2 d = nx[u][j]; v[u][j] = (f32x4){bf_lo(d.x), bf_hi(d.x), bf_lo(d.y), bf_hi(d.y)}; }
            if (COMBINE) {
#pragma unroll
                for (int u = 0; u < 2; ++u)
#pragma unroll
                    for (int w = 0; w < 2; ++w) { const int sl = __builtin_amdgcn_readlane(slv, 2 * (i + u) + w);
                        if (sl < 2 * M) {
#pragma unroll
                            for (int j = 0; j < 4; ++j) { const u32x2 a = w ? nb[u][j] : na[u][j]; v[u][j] += (f32x4){bf_lo(a.x), bf_hi(a.x), bf_lo(a.y), bf_hi(a.y)}; } }
                        else {
                            for (int q = 0; q < 7; ++q) { const GAS u32x2* yq = (const GAS u32x2*)(DL + ((size_t)q * (8 * 256) + (size_t)(sl - 2 * M)) * D) + lane;
#pragma unroll
                                for (int j = 0; j < 4; ++j) { const u32x2 a = yq[64 * j]; v[u][j] += (f32x4){bf_lo(a.x), bf_hi(a.x), bf_lo(a.y), bf_hi(a.y)}; } } } } }
            if (i + 2 < 32) { NP_LOAD(0, i + 2); NP_LOAD(1, i + 3); }
#pragma unroll
            for (int u = 0; u < 2; ++u) {
                const int r = rb + i + u;
                if (COMBINE && !FINAL) { GAS u32x2* xo = (GAS u32x2*)(xw + (size_t)r * D) + lane;
#pragma unroll
                    for (int j = 0; j < 4; ++j) { u32x2 w; w.x = cvtpk(v[u][j].x, v[u][j].y); w.y = cvtpk(v[u][j].z, v[u][j].w); xo[64 * j] = w; } }
                float s = 0.f;
#pragma unroll
                for (int j = 0; j < 4; ++j) s += (v[u][j].x * v[u][j].x + v[u][j].y * v[u][j].y) + (v[u][j].z * v[u][j].z + v[u][j].w * v[u][j].w);
                float lgp[8];
                if (ROUTER) {
#pragma unroll
                    for (int e = 0; e < 8; ++e) { f32x2 a2 = {0.f, 0.f};
#pragma unroll
                        for (int j = 0; j < 4; ++j) { a2 += (f32x2){v[u][j].x, v[u][j].y} * wreg[e][2 * j] ; a2 += (f32x2){v[u][j].z, v[u][j].w} * wreg[e][2 * j + 1]; }
                        lgp[e] = a2.x + a2.y; }
                }
                const float inv = 1.0f / sqrtf(fast_wave_sum(s) * (1.0f / D) + RMS_EPS);
#pragma unroll
                for (int j = 0; j < 4; ++j) v[u][j] = v[u][j] * inv;
                if (FINAL) { GAS f32x4* xr = (GAS f32x4*)(x + (size_t)r * D) + lane;
#pragma unroll
                    for (int j = 0; j < 4; ++j) xr[64 * j] = v[u][j] * gf[j];
                } else if (OUTK == 2) {
                    float mx = 0.f;
#pragma unroll
                    for (int j = 0; j < 4; ++j) mx = fmaxf(fmaxf(mx, fmaxf(fabsf(v[u][j].x), fabsf(v[u][j].y))), fmaxf(fabsf(v[u][j].z), fabsf(v[u][j].w)));
                    mx = fast_wave_max(mx); const float q = mx > 0.f ? 127.0f / mx : 0.f;
                    GAS unsigned* o = (GAS unsigned*)((unsigned char*)XN + (size_t)r * D) + lane;
#pragma unroll
                    for (int j = 0; j < 4; ++j) o[64 * j] = pk4_i8(v[u][j].x * q, v[u][j].y * q, v[u][j].z * q, v[u][j].w * q);
                    if (lane == 0) ascale[r] = mx * (1.0f / 127.0f);
                } else if (OUTK == 1) {
                    GAS unsigned* o = (GAS unsigned*)((unsigned char*)XN + (size_t)r * D) + lane;
#pragma unroll
                    for (int j = 0; j < 4; ++j) o[64 * j] = pk4_fp8(v[u][j].x, v[u][j].y, v[u][j].z, v[u][j].w);
                } else {
                    GAS u32x2* o = (GAS u32x2*)(XN + (size_t)r * D) + lane;
#pragma unroll
                    for (int j = 0; j < 4; ++j) { u32x2 w; w.x = cvtpk(v[u][j].x, v[u][j].y); w.y = cvtpk(v[u][j].z, v[u][j].w); o[64 * j] = w; }
                }
                if (ROUTER) {
                    const float dsum = reduce8(lgp, lane) * inv;
                    float lg[8];
#pragma unroll
                    for (int e = 0; e < 8; ++e) lg[e] = __builtin_bit_cast(float, __builtin_amdgcn_readlane(__builtin_bit_cast(int, dsum), 8 * e));
                    int e0 = 0; float v0 = lg[0];
#pragma unroll
                    for (int e = 1; e < 8; ++e) if (lg[e] > v0) { v0 = lg[e]; e0 = e; }
                    int e1 = -1; float v1 = -3.0e38f;
#pragma unroll
                    for (int e = 0; e < 8; ++e) if (e != e0 && lg[e] > v1) { v1 = lg[e]; e1 = e; }
                    const float ex = __expf(v1 - v0), g0 = 1.0f / (1.0f + ex), g1 = ex * g0;
                    if (lane == 0) { route_e[r] = e0 | (e1 << 8); route_g[2 * r] = g0; route_g[2 * r + 1] = g1; atomicAdd((int*)(cnt_l + e0), 1); atomicAdd((int*)(cnt_l + e1), 1); }
                }
            }
        }
#undef NP_LOAD
        if (ROUTER) {
            __syncthreads();
            if (tid < 8) { tilecnt[tile * 8 + tid] = cnt_l[tid]; cnt_l[tid] = 0; }
            __syncthreads();
        }
    }
}

template <bool FP8>
__device__ __forceinline__ void dispatch_phase(const int* tilecnt, const int* route_e, const float* route_g, int* slot_of, float* gate_slot, const bf16_t* XN, bf16_t* XS  ,
                                               LAS unsigned char* lds, LAS int* pend, int G, int wave_s) {
    const int tid = fresh_tid(wave_s); const int lane = tid & 63, wave = __builtin_amdgcn_readfirstlane(tid >> 6);
    LAS int* lc = (LAS int*)lds;
    LAS int* tot_l = (LAS int*)(lds + 8192);
    LAS int* pst_l = (LAS int*)(lds + 8192 + 32);
    LAS int* base_l = (LAS int*)(lds + 8192 + 64);
    LAS int* slot_l = (LAS int*)(lds + 8192 + 128);
    if (tid < 256) { const i32x4 a = *((const i32x4*)tilecnt + 2 * tid), b = *((const i32x4*)tilecnt + 2 * tid + 1); *((LAS i32x4*)lc + 2 * tid) = a; *((LAS i32x4*)lc + 2 * tid + 1) = b; }
    __syncthreads();
    if (tid < 8) { int t = 0; for (int i = 0; i < 256; ++i) t += lc[i * 8 + tid]; tot_l[tid] = t; }
    __syncthreads();
    if (tid == 0) { int ps = 0; for (int e = 0; e < 8; ++e) { const int padded = (tot_l[e] + 255) & ~255; pst_l[e] = ps; ps += padded; pend[e] = ps >> 8; } }
    __syncthreads();
    if (FP8 && blockIdx.x < 8) { const int e = blockIdx.x, t0 = pst_l[e] + tot_l[e], npad = ((tot_l[e] + 255) & ~255) - tot_l[e];
        for (int i = tid; i < npad; i += NTHREADS) ((int*)XS)[t0 + i] = 0; }
    for (int tile = blockIdx.x; tile < M / 256; tile += G) {
        const int r0 = tile * 256;
        if (tid < 8) { int pre = 0; for (int i = 0; i < tile; ++i) pre += lc[i * 8 + tid]; base_l[tid] = pst_l[tid] + pre; }
        __syncthreads();
        if (wave == 0) {
            int run[8];
#pragma unroll
            for (int e = 0; e < 8; ++e) run[e] = 0;
            for (int ch = 0; ch < 8; ++ch) {
                const int i = ch * 64 + lane, tok = r0 + (i >> 1), k = i & 1;
                const int ew = __hip_atomic_load(route_e + tok, RLX_AGENT); const int e = (ew >> (8 * k)) & 0xff;
                int slot = 0;
#pragma unroll
                for (int ee = 0; ee < 8; ++ee) { const unsigned long long mask = __ballot(e == ee);
                    if (e == ee) slot = base_l[ee] + run[ee] + __popcll(mask & ((1ull << lane) - 1ull));
                    run[ee] += __popcll(mask); }
                slot_l[i] = slot; slot_of[2 * tok + k] = slot; gate_slot[slot] = __hip_atomic_load(route_g + 2 * tok + k, RLX_AGENT); if (FP8) ((int*)XS)[slot] = tok;
            }
        }
        __syncthreads();
        if constexpr (!FP8) {
        for (int ii = 0; ii < 64; ii += 4) {
            u32x4 a[4][2];
#pragma unroll
            for (int q = 0; q < 4; ++q) { const int i = wave * 64 + ii + q; const GAS u32x4* src = (const GAS u32x4*)(XN + (size_t)(r0 + (i >> 1)) * D) + lane; a[q][0] = src[0]; a[q][1] = src[64]; }
#pragma unroll
            for (int q = 0; q < 4; ++q) { const int i = wave * 64 + ii + q; GAS u32x4* dst = (GAS u32x4*)(XS + (size_t)slot_l[i] * D) + lane; dst[0] = a[q][0]; dst[64] = a[q][1]; }
        }
        }
        __syncthreads();
    }
}

#define ATT_LOAD(KF, VF, kt_) do { const int k0_ = (kt_) * 32; \
        const GAS u32x4* kp_ = (const GAS u32x4*)(Kb + (rowbase + k0_ + n) * D + h * 64 + 8 * hh); \
        _Pragma("unroll") for (int s_ = 0; s_ < 4; ++s_) KF[s_] = __builtin_bit_cast(bf16x8, kp_[2 * s_]); \
        _Pragma("unroll") for (int dt_ = 0; dt_ < 2; ++dt_) { const GAS u32x4* vp_ = (const GAS u32x4*)(Vt + (size_t)(h * 64 + dt_ * 32 + n) * M + rowbase + k0_ + 8 * hh); \
            _Pragma("unroll") for (int s_ = 0; s_ < 2; ++s_) VF[dt_][s_] = __builtin_bit_cast(bf16x8, vp_[2 * s_]); } } while (0)
constexpr float ATT_STOP = 9.0e-14f;
template <bool DIAG>
__device__ __forceinline__ void att_tile(const bf16x8 (&kf)[4], const bf16x8 (&vf)[2][2], const bf16x8 (&qf)[4], f32x16& o0, f32x16& o1, float& carry, int n, int hh) {
    f32x16 sc = __builtin_amdgcn_mfma_f32_32x32x16_bf16(kf[0], qf[0], (f32x16){0.f, 0.f, 0.f, 0.f, 0.f, 0.f, 0.f, 0.f, 0.f, 0.f, 0.f, 0.f, 0.f, 0.f, 0.f, 0.f}, 0, 0, 0);
#pragma unroll
    for (int s = 1; s < 4; ++s) sc = __builtin_amdgcn_mfma_f32_32x32x16_bf16(kf[s], qf[s], sc, 0, 0, 0);
    float be[16], kp[16];
#pragma unroll
    for (int r = 0; r < 16; r += 2) { f32x2 e; e.x = __builtin_amdgcn_exp2f(-__builtin_amdgcn_fmed3f(sc[r], -64.f, 3.0e38f)); e.y = __builtin_amdgcn_exp2f(-__builtin_amdgcn_fmed3f(sc[r + 1], -64.f, 3.0e38f));
        const f32x2 d = e + 1.0f; f32x2 b2; b2.x = __builtin_amdgcn_rcpf(d.x); b2.y = __builtin_amdgcn_rcpf(d.y); const f32x2 k2 = e * b2;
        be[r] = b2.x; be[r + 1] = b2.y; kp[r] = k2.x; kp[r + 1] = k2.y; }
    if constexpr (DIAG) {
#pragma unroll
        for (int r = 0; r < 16; ++r) { const int key = (r & 3) + 8 * (r >> 2) + 4 * hh; if (key >= n) { be[r] = 0.f; kp[r] = 1.f; } } }
    float T[4], Pp[4], p2[4], p1[4], p0[4];
#pragma unroll
    for (int g = 0; g < 4; ++g) { p2[g] = kp[4 * g + 3]; p1[g] = p2[g] * kp[4 * g + 2]; p0[g] = p1[g] * kp[4 * g + 1]; T[g] = p0[g] * kp[4 * g]; }
#pragma unroll
    for (int g = 0; g < 4; ++g) Pp[g] = __shfl_xor(T[g], 32);
    float off[4];
    { const float own2 = T[3], own1 = T[3] * T[2], own0 = own1 * T[1];
      const float pe2 = Pp[3], pe1 = Pp[3] * Pp[2], pe0 = pe1 * Pp[1];
      if (hh == 0) { off[0] = own0 * pe0 * Pp[0]; off[1] = own1 * pe1 * Pp[1]; off[2] = own2 * pe2 * Pp[2]; off[3] = Pp[3]; }
      else         { off[0] = own0 * pe0;         off[1] = own1 * pe1;         off[2] = own2 * pe2;         off[3] = 1.f; } }
    float a[16];
#pragma unroll
    for (int g = 0; g < 4; ++g) { const float base = carry * off[g];
        a[4 * g + 0] = be[4 * g + 0] * (base * p0[g]); a[4 * g + 1] = be[4 * g + 1] * (base * p1[g]); a[4 * g + 2] = be[4 * g + 2] * (base * p2[g]); a[4 * g + 3] = be[4 * g + 3] * base; }
    carry *= ((T[0] * T[1]) * (T[2] * T[3])) * ((Pp[0] * Pp[1]) * (Pp[2] * Pp[3]));
    bf16x8 pb[2];
#pragma unroll
    for (int s = 0; s < 2; ++s) { u32x4 w; w.x = cvtpk(a[8 * s + 0], a[8 * s + 1]); w.y = cvtpk(a[8 * s + 2], a[8 * s + 3]); w.z = cvtpk(a[8 * s + 4], a[8 * s + 5]); w.w = cvtpk(a[8 * s + 6], a[8 * s + 7]); pb[s] = __builtin_bit_cast(bf16x8, w); }
#pragma unroll
    for (int s = 0; s < 2; ++s) { o0 = __builtin_amdgcn_mfma_f32_32x32x16_bf16(vf[0][s], pb[s], o0, 0, 0, 0); o1 = __builtin_amdgcn_mfma_f32_32x32x16_bf16(vf[1][s], pb[s], o1, 0, 0, 0); }
}
constexpr int ATT_KROW = 144, ATT_VROW = 784, ATT_V_OFF = 384 * ATT_KROW;
static_assert(ATT_V_OFF + 64 * ATT_VROW <= STAGE_BYTES_LDS, "attention LDS image");
__device__ __forceinline__ void attn_phase(const bf16_t* Q, const bf16_t* Kb, const bf16_t* Vt, bf16_t* O, LAS unsigned char* lds, int vcu, int G, int wave_s) {
    const int tid = fresh_tid(wave_s); const int lane = tid & 63, wave = __builtin_amdgcn_readfirstlane(tid >> 6);
    const int n = lane & 31, hh = lane >> 5;
    const int NU = BATCH * NH * (SEQ / 256), per = (NU + G - 1) / G;
    const int u_lo = vcu * per, u_hi = (u_lo + per < NU) ? u_lo + per : NU;
    u32x4 pk[6], pv[6];
#define ATT_FETCH(uu) do { const int bh_ = (uu) >> 3, qb_ = (uu) & 7, h_ = bh_ & 15, b_ = bh_ >> 4; const int kw0_ = qb_ > 0 ? qb_ * 256 - 128 : 0, nk_ = qb_ * 256 + 256 - kw0_; \
        const size_t rb_ = (size_t)b_ * SEQ; \
        _Pragma("unroll") for (int i_ = 0; i_ < 6; ++i_) { const int p_ = tid + i_ * NTHREADS; const int kr_ = p_ >> 3, kc_ = p_ & 7; \
            if (kr_ < nk_) pk[i_] = *(const GAS u32x4*)(Kb + (rb_ + kw0_ + kr_) * D + h_ * 64 + kc_ * 8); \
            const int vd_ = p_ / 48, vc_ = p_ - vd_ * 48; \
            if (vc_ * 8 < nk_) pv[i_] = *(const GAS u32x4*)(Vt + (size_t)(h_ * 64 + vd_) * M + rb_ + kw0_ + vc_ * 8); } } while (0)
#define ATT_PUT(uu) do { const int qb_ = (uu) & 7; const int kw0_ = qb_ > 0 ? qb_ * 256 - 128 : 0, nk_ = qb_ * 256 + 256 - kw0_; \
        _Pragma("unroll") for (int i_ = 0; i_ < 6; ++i_) { const int p_ = tid + i_ * NTHREADS; const int kr_ = p_ >> 3, kc_ = p_ & 7; \
            if (kr_ < nk_) *(LAS u32x4*)(lds + kr_ * ATT_KROW + kc_ * 16) = pk[i_]; \
            const int vd_ = p_ / 48, vc_ = p_ - vd_ * 48; \
            if (vc_ * 8 < nk_) *(LAS u32x4*)(lds + ATT_V_OFF + vd_ * ATT_VROW + vc_ * 16) = pv[i_]; } } while (0)
#define ATT_TILE_LD(KF, VF, kt_) do { const int k0_ = (kt_) * 32; if (k0_ >= kw0) { const int ko_ = k0_ - kw0; \
            _Pragma("unroll") for (int s_ = 0; s_ < 4; ++s_) KF[s_] = *(const LAS bf16x8*)(lds + (ko_ + n) * ATT_KROW + 32 * s_ + 16 * hh); \
            _Pragma("unroll") for (int dt_ = 0; dt_ < 2; ++dt_) _Pragma("unroll") for (int s_ = 0; s_ < 2; ++s_) VF[dt_][s_] = *(const LAS bf16x8*)(lds + ATT_V_OFF + (dt_ * 32 + n) * ATT_VROW + (ko_ + 16 * s_ + 8 * hh) * 2); } \
        else { ATT_LOAD(KF, VF, kt_); } } while (0)
    if (u_lo < u_hi) ATT_FETCH(u_lo);
    for (int u = u_lo; u < u_hi; ++u) {
        const int bh = u >> 3, qb = u & 7, h = bh & 15, b = bh >> 4;
        const size_t rowbase = (size_t)b * SEQ; const int kw0 = qb > 0 ? qb * 256 - 128 : 0;
        const int qt = qb * 8 + wave, q0 = qt * 32;
        bf16x8 qf[4];
        { const GAS u32x4* qp = (const GAS u32x4*)(Q + (rowbase + q0 + n) * D + h * 64 + 8 * hh);
#pragma unroll
          for (int s = 0; s < 4; ++s) qf[s] = __builtin_bit_cast(bf16x8, qp[2 * s]); }
        ATT_PUT(u);
        __syncthreads();
        if (u + 1 < u_hi) ATT_FETCH(u + 1);
        f32x16 o0, o1;
#pragma unroll
        for (int r = 0; r < 16; ++r) { o0[r] = 0.f; o1[r] = 0.f; }
        float carry = 1.f;
        bf16x8 kf[4], vf[2][2];
        ATT_TILE_LD(kf, vf, qt);
        att_tile<true>(kf, vf, qf, o0, o1, carry, n, hh);
        if (!__all(carry < ATT_STOP)) for (int kt = qt - 1; kt >= 0; --kt) {
            ATT_TILE_LD(kf, vf, kt);
            att_tile<false>(kf, vf, qf, o0, o1, carry, n, hh);
            if (__all(carry < ATT_STOP)) break;
        }
        bf16_t* op = O + (rowbase + q0 + n) * D + h * 64 + 4 * hh;
#pragma unroll
        for (int g = 0; g < 4; ++g) { u32x2 w0, w1; w0.x = cvtpk(o0[4 * g], o0[4 * g + 1]); w0.y = cvtpk(o0[4 * g + 2], o0[4 * g + 3]); w1.x = cvtpk(o1[4 * g], o1[4 * g + 1]); w1.y = cvtpk(o1[4 * g + 2], o1[4 * g + 3]);
            *(u32x2*)(op + 8 * g) = w0; *(u32x2*)(op + 32 + 8 * g) = w1; }
        __syncthreads();
    }
#undef ATT_FETCH
#undef ATT_PUT
#undef ATT_TILE_LD
}

#define WSP(T, off) ((T*)(ws + (off)))
#ifndef STAG_POOL
#define STAG_POOL 0
#define STAG_PROJ 0
#define STAG_OPROJ 0
#define STAG_DUP 0
#define STAG_MUP 0
#endif
#ifndef PROBE_DUP
#define PROBE_DUP 0
#endif
#define DUP(k) ((PROBE_DUP >> (k)) & 1)
template <int l>
__device__ __forceinline__ void layer_body(LAS unsigned char* lds, const XcdBarrier& bar, LAS int* pend, LAS int* cnt_l, int G, int bx, int vcu, int NGW, int wave_s) {
#define SITE_POOLPREP(GRIDBAR) { { unsigned char* ws = ARG_WS(); pool_prep_phase<l == 0>(ARG_IN(0), WSP(bf16_t, WS_XB), WSP(bf16_t, WS_R), lds, G, wave_s); \
              if constexpr (l == 0 && (INT8_UP0 != 0 || INT8_PROJ != 0)) {     \
                  const int t_ = fresh_tid(wave_s); const int wv_ = __builtin_amdgcn_readfirstlane(t_ >> 6); LAS float* sc_ = (LAS float*)(lds + wv_ * 16384); const int g_ = vcu * NWAVES + wv_; int base_ = 0; \
                  for (int j_ = 0; j_ < 5; ++j_) { if ((j_ == 0 && !I8) || (j_ > 0 && !INT8_PROJ)) continue; \
                      const float* W_; const float* gn_; int ldw_, N_; float mul_ = 1.0f; bool gu_ = false; size_t dst_; const unsigned* cm_; float* wsc_; \
                      if (j_ == 0) { W_ = ARG_IN(9); gn_ = ARG_IN(2); ldw_ = 2 * DFF; N_ = 2 * DFF; gu_ = true; dst_ = WS_WFI; cm_ = WSP(unsigned, WS_COLMAX); wsc_ = WSP(float, WS_WSCALE); } \
                      else if (j_ < 3) { W_ = ARG_IN(6) + (j_ - 1) * 1024; gn_ = ARG_IN(5); ldw_ = 2048; N_ = 1024; dst_ = (j_ == 1) ? WS_WK : WS_WV; cm_ = WSP(unsigned, WS_COLMAX2) + (j_ - 1) * 1024; wsc_ = WSP(float, WS_WSCALE2) + (j_ - 1) * 1024; } \
                      else { const int b_ = j_ - 3; W_ = ARG_IN(7) + (size_t)b_ * D * D; gn_ = ARG_IN(1) + (2 + b_) * D; ldw_ = 1024; N_ = 1024; mul_ = 0.125f * 1.4426950408889634f; dst_ = WS_WQ + (size_t)b_ * D * D * 2; cm_ = WSP(unsigned, WS_COLMAX2) + (2 + b_) * 1024; wsc_ = WSP(float, WS_WSCALE2) + (2 + b_) * 1024; } \
                      int first_ = (g_ - base_) % NGW; if (first_ < 0) first_ += NGW; \
                      tr_mat(W_, ldw_, D, N_, gn_, mul_, 2, gu_, ws + dst_, sc_, first_, NGW, t_ & 63, cm_, wsc_); base_ = (base_ + (D / 64) * (N_ / 32)) % NGW; } } } \
          if (GRIDBAR) xcd_barrier(bar, wave_s); \
          else {   \
              __syncthreads(); \
              if constexpr (l == 1) { if (fresh_tid(wave_s) == 0) { unsigned* fl_ = (unsigned*)(ARG_WS() + WS_HALO_FLAGS); __hip_atomic_store(fl_ + blockIdx.x, 1u, __ATOMIC_RELEASE, __HIP_MEMORY_SCOPE_AGENT); \
                      const int nb_ = (int)blockIdx.x + 1; if (nb_ < M / 256 && (nb_ % (SEQ / 256)) != 0) { unsigned sp_ = 0; while (__hip_atomic_load(fl_ + nb_, __ATOMIC_ACQUIRE, __HIP_MEMORY_SCOPE_AGENT) == 0u) { __builtin_amdgcn_s_sleep(1); if (++sp_ > (1u << 24)) break; } } } \
                  __syncthreads(); } } }
#define SITE_POOLGEMM(MUL, GRIDBAR) { { unsigned char* ws = ARG_WS(); \
              pg8::GemmK g{256, 1024, 256}; pg8::PoolOrder S{G, bx, (const char*)WSP(bf16_t, WS_R), (const char*)(WSP(bf16_t, WS_WPOOL) + (size_t)l * 4 * 65536)}; \
              pg8::EpiResidB E{WSP(bf16_t, WS_XB), ARG_IN(4) + l * D, MUL}; \
              pg8::gemm_phase<pg8::EpiResidB, pg8::PoolOrder, true>(lds, g, S, E, wave_s, STAG_POOL); } if (GRIDBAR) xcd_barrier(bar, wave_s); else __syncthreads(); }
#define SITE_PROJ() { { unsigned char* ws = ARG_WS(); \
              if constexpr (INT8_PROJ != 0) { pg8::GemmK g{512, 512, 512}; pg8::ProjOrder S{(l == 2) ? 3 : 1, G, bx, (const char*)ws, (size_t)(l - 2) * D * D * 2, (size_t)256 * 1024}; \
                pg8::EpiProjI8 E{WSP(bf16_t, WS_K), WSP(bf16_t, WS_R), WSP(bf16_t, WS_VT), WSP(float, WS_ASCALE), WSP(float, WS_WSCALE2), l - 2}; \
                pg8::gemm_phase<pg8::EpiProjI8, pg8::ProjOrder, true, 2>(lds, g, S, E, wave_s, STAG_PROJ); } \
              else { pg8::GemmK g{1024, 1024, 1024}; pg8::ProjOrder S{(l == 2) ? 3 : 1, G, bx, (const char*)ws, (size_t)(l - 2) * D * D * 2, (size_t)256 * 1024 * 2}; \
                pg8::EpiProj E{WSP(bf16_t, WS_K), WSP(bf16_t, WS_R), WSP(bf16_t, WS_VT)}; \
                pg8::gemm_phase<pg8::EpiProj, pg8::ProjOrder, true>(lds, g, S, E, wave_s); } } xcd_barrier(bar, wave_s); }
#define SITE_ATTN() { { unsigned char* ws = ARG_WS(); attn_phase(WSP(bf16_t, WS_R), WSP(bf16_t, WS_K), WSP(bf16_t, WS_VT), WSP(bf16_t, WS_R) + (size_t)M * D, lds, vcu, G, wave_s); } xcd_barrier(bar, wave_s); }
#define SITE_OPROJ(MUL, GRIDBAR) { { unsigned char* ws = ARG_WS(); \
              pg8::GemmK g{1024, 1024, 1024}; pg8::PanelOrder S{M / 256, 4, G, bx, (const char*)(WSP(bf16_t, WS_R) + (size_t)M * D), (const char*)(WSP(bf16_t, WS_WO) + (size_t)(l - 2) * D * D), (size_t)256 * 1024 * 2, (size_t)256 * 1024 * 2}; \
              pg8::EpiResidB E{WSP(bf16_t, WS_XB), nullptr, MUL}; \
              pg8::gemm_phase<pg8::EpiResidB, pg8::PanelOrder, true>(lds, g, S, E, wave_s, STAG_OPROJ); } if (GRIDBAR) xcd_barrier(bar, wave_s); else __syncthreads(); }
#define SITE_NORMX(OUTK_, DELTA_) { { unsigned char* ws = ARG_WS(); \
              norm_phase<false, false, false, OUTK_, false, bf16_t>(nullptr, WSP(bf16_t, WS_XN), nullptr, nullptr, nullptr, nullptr, nullptr, nullptr, nullptr, lds, cnt_l, G, wave_s, WSP(float, WS_ASCALE), nullptr, (const bf16_t*)WSP(bf16_t, WS_XB), nullptr); } xcd_barrier(bar, wave_s); }
#define SITE_NORMI8() { { unsigned char* ws = ARG_WS(); norm_phase<false, false, false, 2, false, bf16_t>(nullptr, WSP(bf16_t, WS_XN), nullptr, nullptr, nullptr, nullptr, nullptr, nullptr, nullptr, lds, cnt_l, G, wave_s, WSP(float, WS_ASCALE), nullptr, (const bf16_t*)WSP(bf16_t, WS_XB), nullptr); } xcd_barrier(bar, wave_s); }
#define SITE_NORM8() { { unsigned char* ws = ARG_WS(); norm_phase<false, false, false, 1, false, bf16_t>(nullptr, WSP(bf16_t, WS_XN), nullptr, nullptr, nullptr, nullptr, nullptr, nullptr, nullptr, lds, cnt_l, G, wave_s, nullptr, nullptr, (const bf16_t*)WSP(bf16_t, WS_XB), nullptr); } xcd_barrier(bar, wave_s); }
#define SITE_NORM() { { unsigned char* ws = ARG_WS(); norm_phase<false, false, false, 0, false, bf16_t>(nullptr, WSP(bf16_t, WS_XN), nullptr, nullptr, nullptr, nullptr, nullptr, nullptr, nullptr, lds, cnt_l, G, wave_s, nullptr, nullptr, (const bf16_t*)WSP(bf16_t, WS_XB), nullptr); } xcd_barrier(bar, wave_s); }
#define SITE_DUP() { { unsigned char* ws = ARG_WS(); \
              if constexpr (I8) { pg8::GemmK g{512, 512, 512}; pg8::DenseOrder S{M / 256, DFF / 128, G, bx, (const char*)WSP(unsigned char, WS_XN), (const char*)WSP(unsigned char, WS_WFI), (size_t)256 * 1024, (size_t)256 * 1024}; \
                pg8::EpiSwigluI8 E{WSP(bf16_t, WS_R), DFF, WSP(float, WS_ASCALE), WSP(float, WS_WSCALE)}; \
                pg8::gemm_phase<pg8::EpiSwigluI8, pg8::DenseOrder, true, 2>(lds, g, S, E, wave_s, STAG_DUP); } \
              else if constexpr (F8) { pg8::GemmK g{512, 512, 512}; pg8::DenseOrder S{M / 256, DFF / 128, G, bx, (const char*)WSP(unsigned char, WS_XN), (const char*)(WSP(unsigned char, WS_WFI) + (size_t)(l >> 1) * 2 * DFF * D * 2), (size_t)256 * 1024, (size_t)256 * 1024}; \
                pg8::EpiSwiglu8 E{WSP(unsigned char, WS_R), DFF, 1.0f / W8_UP}; \
                pg8::gemm_phase<pg8::EpiSwiglu8, pg8::DenseOrder, true, 1>(lds, g, S, E, wave_s, STAG_DUP); } \
              else { pg8::GemmK g{1024, 1024, 1024}; pg8::DenseOrder S{M / 256, DFF / 128, G, bx, (const char*)WSP(bf16_t, WS_XN), (const char*)(WSP(bf16_t, WS_WFI) + (size_t)(l >> 1) * 2 * DFF * D), (size_t)256 * 1024 * 2, (size_t)256 * 1024 * 2}; \
                pg8::EpiSwiglu E{WSP(bf16_t, WS_R), DFF}; \
                pg8::gemm_phase<pg8::EpiSwiglu, pg8::DenseOrder, true>(lds, g, S, E, wave_s); } } xcd_barrier(bar, wave_s); }
#define SITE_DDOWN(MUL) { { unsigned char* ws = ARG_WS(); \
              if constexpr (F8) { pg8::GemmK g{DFF / 2, DFF / 2, DFF / 2}; pg8::DenseOrder S{M / 256, 4, G, bx, (const char*)WSP(unsigned char, WS_R), (const char*)(WSP(unsigned char, WS_WFO) + (size_t)(l >> 1) * D * DFF * 2), (size_t)256 * DFF, (size_t)256 * DFF}; \
                pg8::EpiResidB E{WSP(bf16_t, WS_XB), nullptr, MUL / (W8_DN * H8_SC)}; \
                pg8::gemm_phase<pg8::EpiResidB, pg8::DenseOrder, true, 1>(lds, g, S, E, wave_s); } \
              else { pg8::GemmK g{DFF, DFF, DFF}; pg8::DenseOrder S{M / 256, 4, G, bx, (const char*)WSP(bf16_t, WS_R), (const char*)(WSP(bf16_t, WS_WFO) + (size_t)(l >> 1) * D * DFF), (size_t)256 * DFF * 2, (size_t)256 * DFF * 2}; \
                pg8::EpiResidB E{WSP(bf16_t, WS_XB), nullptr, MUL}; \
                pg8::gemm_phase<pg8::EpiResidB, pg8::DenseOrder, true>(lds, g, S, E, wave_s); } } xcd_barrier(bar, wave_s); }
#define SITE_ROUTER() { { unsigned char* ws = ARG_WS(); \
              norm_phase<false, true, false, F8 ? 1 : 0, false, bf16_t>(nullptr, WSP(bf16_t, WS_XN), nullptr, nullptr, ARG_IN(2) + l * D, ARG_IN(11) + (size_t)(l >> 1) * D * NE, WSP(int, WS_ROUTE_E), WSP(float, WS_ROUTE_G), WSP(int, WS_TILECNT), lds, cnt_l, G, wave_s, nullptr, WSP(bf16_t, WS_DELTA), (const bf16_t*)WSP(bf16_t, WS_XB), nullptr); } xcd_barrier(bar, wave_s); }
#define SITE_DISPATCH() { { unsigned char* ws = ARG_WS(); \
              dispatch_phase<F8>(WSP(int, WS_TILECNT), WSP(int, WS_ROUTE_E), WSP(float, WS_ROUTE_G), WSP(int, WS_SLOT_OF), WSP(float, WS_GATE_SLOT), WSP(bf16_t, WS_XN), F8 ? WSP(bf16_t, WS_TOS) : WSP(bf16_t, WS_XS), lds, pend, G, wave_s); } xcd_barrier(bar, wave_s); }
#define SITE_MUP() { { unsigned char* ws = ARG_WS(); \
              if constexpr (F8) { pg8::GemmK g{512, 512, 512}; \
                pg8::MoeGatherOrder S{nb, DFFE / 128, G, bx, blk0, (const char*)WSP(unsigned char, WS_XN), (const char*)(WSP(unsigned char, WS_WMI) + (size_t)(l >> 1) * 8 * 2 * DFFE * D * 2), (size_t)256 * 1024, (size_t)2 * DFFE * D, pend, WSP(int, WS_TOS), (LAS int*)(lds + LCTL_OFF + 2048)}; \
                pg8::EpiSwiglu8 E{WSP(unsigned char, WS_R), DFFE, 1.0f / W8_UP}; \
                pg8::gemm_phase<pg8::EpiSwiglu8, pg8::MoeGatherOrder, true, 1, true>(lds, g, S, E, wave_s, STAG_MUP); } \
              else { pg8::GemmK g{1024, 1024, 1024}; \
                pg8::MoeOrder S{nb, DFFE / 128, G, bx, blk0, 0, (const char*)WSP(bf16_t, WS_XS), (const char*)(WSP(bf16_t, WS_WMI) + (size_t)(l >> 1) * 8 * 2 * DFFE * D), (size_t)256 * 1024 * 2, (size_t)256 * 1024 * 2, (size_t)2 * DFFE * D * 2, pend}; \
                pg8::EpiSwiglu E{WSP(bf16_t, WS_R), DFFE}; \
                pg8::gemm_phase<pg8::EpiSwiglu, pg8::MoeOrder, true>(lds, g, S, E, wave_s); } } xcd_barrier(bar, wave_s); }
#define SITE_MDOWN() { { unsigned char* ws = ARG_WS(); \
              if constexpr (F8) { pg8::GemmK g{DFFE / 2, DFFE / 2, DFFE / 2}; \
                const int nbm = nb < pg8::TAIL_B0 ? nb : pg8::TAIL_B0;     \
                pg8::MoeOrder S{nbm, 4, G, bx, blk0, 1, (const char*)WSP(unsigned char, WS_R), (const char*)(WSP(unsigned char, WS_WMO) + (size_t)(l >> 1) * 8 * D * DFFE * 2), (size_t)256 * DFFE, (size_t)256 * DFFE, (size_t)D * DFFE, pend}; \
                pg8::EpiMoeDown E{WSP(bf16_t, WS_XS), WSP(float, WS_GATE_SLOT), 1.0f / (W8_DN * H8_SC)}; \
                pg8::gemm_phase<pg8::EpiMoeDown, pg8::MoeOrder, true, 1>(lds, g, S, E, wave_s); \
                if (nb > pg8::TAIL_B0) { pg8::GemmK g2{DFFE / (2 * pg8::TAIL_KS), DFFE / 2, DFFE / 2}; \
                  pg8::MoeTailOrder S2{nb - pg8::TAIL_B0, G, bx, (const char*)WSP(unsigned char, WS_R), (const char*)(WSP(unsigned char, WS_WMO) + (size_t)(l >> 1) * 8 * D * DFFE * 2), (size_t)256 * DFFE, (size_t)256 * DFFE, (size_t)D * DFFE, (size_t)(DFFE / pg8::TAIL_KS), pend}; \
                  pg8::EpiMoeDownT E2{WSP(bf16_t, WS_YT), WSP(float, WS_GATE_SLOT), 1.0f / (W8_DN * H8_SC)}; \
                  pg8::gemm_phase<pg8::EpiMoeDownT, pg8::MoeTailOrder, true, 1>(lds, g2, S2, E2, wave_s); } } \
              else { pg8::GemmK g{DFFE, DFFE, DFFE}; \
                pg8::MoeOrder S{nb, 4, G, bx, blk0, 1, (const char*)WSP(bf16_t, WS_R), (const char*)(WSP(bf16_t, WS_WMO) + (size_t)(l >> 1) * 8 * D * DFFE), (size_t)256 * DFFE * 2, (size_t)256 * DFFE * 2, (size_t)D * DFFE * 2, pend}; \
                pg8::EpiMoeDown E{WSP(bf16_t, WS_XS), WSP(float, WS_GATE_SLOT), 1.0f}; \
                pg8::gemm_phase<pg8::EpiMoeDown, pg8::MoeOrder, true>(lds, g, S, E, wave_s); } } xcd_barrier(bar, wave_s); }
    constexpr bool F8 = ((FP8_MASK >> l) & 1) != 0;
    constexpr bool I8 = (INT8_UP0 != 0) && l == 0 && !F8;
    if constexpr (l < 2) {
        const bool chain = (G == M / 256);
        if (DUP(5) || (DUP(7) && l == 1) || (DUP(11) && l == 0)) SITE_POOLPREP(true)
        SITE_POOLPREP(!chain)
        if (DUP(2) || DUP(12)) SITE_POOLGEMM(0.f, true)
        SITE_POOLGEMM(1.f, !chain)
    } else {
        if (DUP(2) || DUP(13)) SITE_PROJ()
        SITE_PROJ()
        if (DUP(3)) SITE_ATTN()
        SITE_ATTN()
        if (DUP(2) || DUP(14)) SITE_OPROJ(0.f, true)
        SITE_OPROJ(1.f, G != M / 256)
    }
    if constexpr ((l & 1) == 0) {
        if constexpr (I8) { if (DUP(5) || DUP(8)) SITE_NORMX(2, true) SITE_NORMX(2, true) } else if constexpr (F8) { if (DUP(5) || DUP(8)) SITE_NORMX(1, true) SITE_NORMX(1, true) } else { if (DUP(5)) SITE_NORMX(0, true) SITE_NORMX(0, true) }
        if (DUP(1)) SITE_DUP()
        SITE_DUP()
        if (DUP(1)) SITE_DDOWN(0.f)
        SITE_DDOWN(1.f)
        if constexpr (l == 2) { if constexpr (INT8_PROJ != 0) { if (DUP(5) || DUP(8)) SITE_NORMI8() SITE_NORMI8() } else { if (DUP(5)) SITE_NORM() SITE_NORM() } }
    } else {
        if (DUP(5) || DUP(9)) SITE_ROUTER()
        SITE_ROUTER()
        if (DUP(5) || DUP(10)) SITE_DISPATCH()
        SITE_DISPATCH()
        constexpr int CB = F8 ? CAP / 256 : CHUNK_BLKS;
        for (int ch = 0; ch < (F8 ? 1 : 2); ++ch) {
            const int nblk = pend[7];
            const int blk0 = ch * CB; int nb = nblk - blk0; nb = nb < 0 ? 0 : (nb > CB ? CB : nb); nb = __builtin_amdgcn_readfirstlane(nb);
            if (DUP(0)) SITE_MUP()
            SITE_MUP()
            if (DUP(0)) SITE_MDOWN()
            SITE_MDOWN()
        }
        if constexpr (l == 1) { { unsigned char* ws = ARG_WS(); norm_phase<true, false, false, INT8_PROJ ? 2 : 0, false, bf16_t>(nullptr, WSP(bf16_t, WS_XN), WSP(bf16_t, WS_XS), WSP(int, WS_SLOT_OF), nullptr, nullptr, nullptr, nullptr, nullptr, lds, cnt_l, G, wave_s, WSP(float, WS_ASCALE), WSP(bf16_t, WS_DELTA), (const bf16_t*)WSP(bf16_t, WS_XB), WSP(bf16_t, WS_XB)); } xcd_barrier(bar, wave_s); }
        else for (int rep_ = 0; rep_ < 1 + DUP(6); ++rep_) { unsigned char* ws = ARG_WS(); if (rep_) xcd_barrier(bar, wave_s); norm_phase<true, false, true, 0, false, bf16_t>(ARG_OUT(), WSP(bf16_t, WS_XN), WSP(bf16_t, WS_XS), WSP(int, WS_SLOT_OF), ARG_IN(14), nullptr, nullptr, nullptr, nullptr, lds, cnt_l, G, wave_s, nullptr, WSP(bf16_t, WS_DELTA), (const bf16_t*)WSP(bf16_t, WS_XB), nullptr); }
    }
}

__global__ void __launch_bounds__(NTHREADS, 2) yoco_fwd(Args args_unused) {
    extern __shared__ __attribute__((aligned(16))) unsigned char lds_raw[];
    LAS unsigned char* lds = (LAS unsigned char*)lds_raw;
    __builtin_amdgcn_s_setreg((0 << 11) | (23 << 6) | 1, 1u);
    const int G = gridDim.x; const int bx = blockIdx.x; const int wave_s = __builtin_amdgcn_readfirstlane(threadIdx.x >> 6);
    const int vcu = (G % 8 == 0) ? (bx % 8) * (G / 8) + bx / 8 : bx;
    const int NGW = G * NWAVES;
    LAS unsigned* lctl = (LAS unsigned*)(lds + LCTL_OFF);
    for (int u = threadIdx.x; u < (LDS_BYTES - LCTL_OFF) / 4; u += NTHREADS) lctl[u] = 0u;
    __syncthreads();
    volatile LAS unsigned* bar_st = (volatile LAS unsigned*)lctl;
    LAS int* pend = (LAS int*)(lctl + 16);
    LAS int* cnt_l = (LAS int*)(lctl + 32);
    XcdBarrier bar = xcd_barrier_post((unsigned*)(ARG_WS() + WS_CTL) + 1024, bar_st);

    for (int rep = 0; rep < 1 + DUP(4); ++rep) {
        unsigned char* ws = ARG_WS();
        const int tid = fresh_tid(wave_s); const int lane = tid & 63, wave = __builtin_amdgcn_readfirstlane(tid >> 6), gw = vcu * NWAVES + wave;
        LAS float* scr = (LAS float*)(lds + wave * 16384);
        int base = 0;
        for (int j = 0; j < 50; ++j) {
            const float* W; const float* gain = nullptr; int ldw, K, N; float mul = 1.0f; bool f8 = false, gu = false; size_t dst;
            if (j < 8) { W = ARG_IN(3) + (size_t)j * 65536; ldw = 256; K = 256; N = 256; gain = ARG_IN(1) + (j >> 2) * D + (j & 3) * 256; dst = WS_WPOOL + (size_t)j * 65536 * 2; }
            else if (j < 10) { W = ARG_IN(6) + (j - 8) * 1024; ldw = 2048; K = 1024; N = 1024; gain = ARG_IN(5); dst = (j == 8) ? WS_WK : WS_WV; }
            else if (j < 12) { const int b = j - 10; W = ARG_IN(7) + (size_t)b * D * D; ldw = 1024; K = 1024; N = 1024; gain = ARG_IN(1) + (2 + b) * D; mul = 0.125f * 1.4426950408889634f; dst = WS_WQ + (size_t)b * D * D * 2; }
            else if (j < 14) { const int b = j - 12; W = ARG_IN(8) + (size_t)b * D * D; ldw = 1024; K = 1024; N = 1024; dst = WS_WO + (size_t)b * D * D * 2; }
            else if (j < 16) { const int i = j - 14; f8 = ((FP8_MASK >> (2 * i)) & 1) != 0; gu = true; W = ARG_IN(9) + (size_t)i * D * 2 * DFF; ldw = 2 * DFF; K = 1024; N = 2 * DFF; gain = ARG_IN(2) + (2 * i) * D; mul = f8 ? W8_UP : 1.0f; dst = WS_WFI + (size_t)i * 2 * DFF * D * 2; }
            else if (j < 18) { const int i = j - 16; f8 = ((FP8_MASK >> (2 * i)) & 1) != 0; W = ARG_IN(10) + (size_t)i * DFF * D; ldw = 1024; K = DFF; N = 1024; mul = f8 ? W8_DN : 1.0f; dst = WS_WFO + (size_t)i * D * DFF * 2; }
            else if (j < 34) { const int ie = j - 18, li = 2 * (ie >> 3) + 1, e = ie & 7; f8 = ((FP8_MASK >> li) & 1) != 0; gu = true; W = ARG_IN(12) + (size_t)ie * D * 2 * DFFE; ldw = 2 * DFFE; K = 1024; N = 2 * DFFE; gain = ARG_IN(2) + li * D; mul = f8 ? W8_UP : 1.0f;
                               dst = WS_WMI + (size_t)(ie >> 3) * 8 * 2 * DFFE * D * 2 + (size_t)e * 2 * DFFE * D * (f8 ? 1 : 2); }
            else { const int ie = j - 34, li = 2 * (ie >> 3) + 1, e = ie & 7; f8 = ((FP8_MASK >> li) & 1) != 0; W = ARG_IN(13) + (size_t)ie * DFFE * D; ldw = 1024; K = DFFE; N = 1024; mul = f8 ? W8_DN : 1.0f;
                   dst = WS_WMO + (size_t)(ie >> 3) * 8 * D * DFFE * 2 + (size_t)e * D * DFFE * (f8 ? 1 : 2); }
            const int nitems = (K / 64) * (N / 32);
            int first = (gw - base) % NGW; if (first < 0) first += NGW;
            if ((INT8_UP0 && j == 14) || (INT8_PROJ && j >= 8 && j < 12)) continue;
            tr_mat(W, ldw, K, N, gain, mul, f8 ? 1 : 0, gu, ws + dst, scr, first, NGW, lane, nullptr, nullptr, (gu && f8) ? W8_GATE : 0.f);
            base = (base + nitems) % NGW;
        }
    }
    if (INT8_UP0 || INT8_PROJ) {
        unsigned char* ws = ARG_WS(); const int tid = fresh_tid(wave_s); const int lane = tid & 63, gw = vcu * NWAVES + __builtin_amdgcn_readfirstlane(tid >> 6);
        int base = 0;
        for (int j = 0; j < 5; ++j) {
            if ((j == 0 && !INT8_UP0) || (j > 0 && !INT8_PROJ)) continue;
            const GAS float* W; const GAS float* gn; int ldw, ncols; float mul = 1.0f; unsigned* cm;
            if (j == 0) { W = (const GAS float*)ARG_IN(9); gn = (const GAS float*)ARG_IN(2); ldw = 2 * DFF; ncols = 2 * DFF; cm = WSP(unsigned, WS_COLMAX); }
            else if (j < 3) { W = (const GAS float*)ARG_IN(6) + (j - 1) * 1024; gn = (const GAS float*)ARG_IN(5); ldw = 2048; ncols = 1024; cm = WSP(unsigned, WS_COLMAX2) + (j - 1) * 1024; }
            else { W = (const GAS float*)ARG_IN(7) + (size_t)(j - 3) * D * D; gn = (const GAS float*)ARG_IN(1) + (2 + (j - 3)) * D; ldw = 1024; ncols = 1024; mul = 0.125f * 1.4426950408889634f; cm = WSP(unsigned, WS_COLMAX2) + (2 + (j - 3)) * 1024; }
            const int nstrip = ncols / 64, ntask = nstrip * (D / 64);
            int first = (gw - base) % NGW; if (first < 0) first += NGW;
            for (int task = first; task < ntask; task += NGW) { const int strip = task % nstrip, kc = task / nstrip; const int n = strip * 64 + lane; float mx = 0.f;
#pragma unroll 16
                for (int kk = 0; kk < 64; ++kk) { const int k = kc * 64 + kk; mx = fmaxf(mx, fabsf(W[(size_t)k * ldw + n] * gn[k])); }
                const unsigned old = __hip_atomic_fetch_max(cm + n, __builtin_bit_cast(unsigned, mx * mul), __ATOMIC_RELAXED, __HIP_MEMORY_SCOPE_AGENT); asm volatile("" :: "v"(old)); }
            base = (base + ntask) % NGW;
        }
    }
    xcd_barrier(bar, wave_s);

    layer_body<0>(lds, bar, pend, cnt_l, G, bx, vcu, NGW, wave_s);
    layer_body<1>(lds, bar, pend, cnt_l, G, bx, vcu, NGW, wave_s);
    layer_body<2>(lds, bar, pend, cnt_l, G, bx, vcu, NGW, wave_s);
    layer_body<3>(lds, bar, pend, cnt_l, G, bx, vcu, NGW, wave_s);
}

extern "C" void kernel_launch(void* const* d_in, const int* in_sizes, int n_in, void* d_out, int out_size, void* d_ws, size_t ws_size, hipStream_t stream) {
    static int grid = 0;
    if (grid == 0) {
        if (n_in != 15 || out_size != M * D || ws_size < WS_END) { fprintf(stderr, "kernel_launch: unexpected shapes (n_in %d out %d ws %zu)\n", n_in, out_size, ws_size); grid = -1; return; }
        int dev = 0, cus = 0, per_cu = 0;
        if (hipGetDevice(&dev) != hipSuccess || hipDeviceGetAttribute(&cus, hipDeviceAttributeMultiprocessorCount, dev) != hipSuccess) { grid = -1; return; }
        if (hipFuncSetAttribute((const void*)yoco_fwd, hipFuncAttributeMaxDynamicSharedMemorySize, LDS_BYTES) != hipSuccess) { fprintf(stderr, "kernel_launch: hipFuncSetAttribute failed\n"); grid = -1; return; }
        if (hipOccupancyMaxActiveBlocksPerMultiprocessor(&per_cu, (const void*)yoco_fwd, NTHREADS, LDS_BYTES) != hipSuccess || per_cu < 1) { fprintf(stderr, "kernel_launch: occupancy query says %d\n", per_cu); }
        (void)hipGetLastError();
        grid = cus;
    }
    if (grid < 0) return;
    (void)hipMemsetAsync((char*)d_ws + WS_CTL, 0, CTL_ZERO_BYTES, stream);
    Args a{};
    for (int i = 0; i < 15; ++i) a.in[i] = (const float*)d_in[i];
    a.out = (float*)d_out; a.ws = (unsigned char*)d_ws;
    hipLaunchKernelGGL(yoco_fwd, dim3(grid), dim3(NTHREADS), LDS_BYTES, stream, a);
}
```

```cpp
#include <hip/hip_runtime.h>
#include <cstdio>
#include <cstdint>

#define LAS __attribute__((address_space(3)))
#define GAS __attribute__((address_space(1)))
typedef unsigned short bf16_t;
typedef short bf16x8 __attribute__((ext_vector_type(8)));
typedef float f32x2 __attribute__((ext_vector_type(2)));
typedef float f32x4 __attribute__((ext_vector_type(4)));
typedef float f32x16 __attribute__((ext_vector_type(16)));
typedef unsigned u32x2 __attribute__((ext_vector_type(2)));
typedef unsigned u32x4 __attribute__((ext_vector_type(4)));
typedef int i32x4 __attribute__((ext_vector_type(4)));
typedef __bf16 bf16x2_t __attribute__((ext_vector_type(2)));

constexpr int D = 1024, BATCH = 32, SEQ = 2048, M = BATCH * SEQ;
constexpr int DFF = 2816, DFFE = 3584, NE = 8, NH = 16;
constexpr int CAP = 2 * M + NE * 256;
constexpr int CHUNK_BLKS = 260;
constexpr float RMS_EPS = 1e-6f;
#ifndef FP8_MASK
#define FP8_MASK 14
#endif
#ifndef INT8_UP0
#define INT8_UP0 1
#endif
#ifndef INT8_PROJ
#define INT8_PROJ 1
#endif
constexpr float W8_UP = 64.f, W8_DN = 128.f, H8_SC = 8.f;
constexpr float W8_GATE = 1.4426950408889634f;
constexpr int NWAVES = 8, NTHREADS = 512;

constexpr size_t MiB = 1u << 20;
constexpr size_t WS_CTL = 0, CTL_ZERO_BYTES = 80 * 1024;
constexpr size_t WS_COLMAX2 = 65536;
constexpr size_t WS_WSCALE2 = 1 * MiB + 40960;
constexpr size_t WS_HALO_FLAGS = 20480;
constexpr size_t WS_COLMAX = 32768;
constexpr size_t WS_WSCALE = 1 * MiB + 16384;
constexpr size_t WS_ASCALE = 3 * MiB + 786432;
constexpr size_t WS_TILECNT = 1 * MiB;
constexpr size_t WS_ROUTE_E = 1 * MiB + 65536;
constexpr size_t WS_ROUTE_G = 2 * MiB;
constexpr size_t WS_SLOT_OF = 2 * MiB + 524288;
constexpr size_t WS_GATE_SLOT = 3 * MiB;
constexpr size_t WS_WPOOL = 4 * MiB;
constexpr size_t WS_WK = 5 * MiB, WS_WV = 7 * MiB, WS_WQ = 9 * MiB, WS_WO = 13 * MiB;
constexpr size_t WS_WFI = 17 * MiB;
constexpr size_t WS_WFO = 39 * MiB;
constexpr size_t WS_WMI = 50 * MiB;
constexpr size_t WS_WMO = 274 * MiB;
constexpr size_t WS_XN = 386 * MiB;
constexpr size_t WS_K = 514 * MiB, WS_VT = 642 * MiB;
constexpr size_t WS_XS = 770 * MiB;
constexpr size_t WS_R = 1030 * MiB;
constexpr size_t WS_XS8 = 1485 * MiB;
constexpr size_t WS_XB = 1485 * MiB;
constexpr size_t WS_TOS = 386 * MiB + 64 * MiB;

constexpr size_t WS_YT = 1616 * MiB;
constexpr size_t WS_DELTA = 1616 * MiB;
constexpr size_t WS_END = 1744 * MiB;
static_assert(WS_XS8 + (size_t)CAP * D <= WS_END, "xs8");
static_assert(WS_XS + (size_t)CAP * D * 2 <= WS_R, "xs");
static_assert(WS_R + (size_t)CHUNK_BLKS * 256 * DFFE * 2 <= WS_END, "moe hidden chunk");
static_assert(WS_R + (size_t)M * DFF * 2 <= WS_END, "dense hidden");
static_assert(WS_R + (size_t)CAP * DFFE <= WS_XS8, "fp8 moe hidden, one chunk");
static_assert(WS_WMO + (size_t)2 * 8 * 1024 * 3584 * 2 <= WS_XN, "weights");

constexpr int STAGE_BYTES_LDS = 131072;
constexpr int LCTL_OFF = STAGE_BYTES_LDS;
constexpr int LDS_BYTES = 147456;

__device__ __forceinline__ unsigned cvtpk(float lo, float hi) { f32x2 v = {lo, hi}; bf16x2_t b = __builtin_convertvector(v, bf16x2_t); return __builtin_bit_cast(unsigned, b); }
__device__ __forceinline__ unsigned pk4_fp8(float a, float b, float c, float d) { int w = __builtin_amdgcn_cvt_pk_fp8_f32(a, b, 0, false); w = __builtin_amdgcn_cvt_pk_fp8_f32(c, d, w, true); return (unsigned)w; }
__device__ __forceinline__ unsigned pk4_i8(float a, float b, float c, float d) {
    const int i0 = (int)__builtin_rintf(__builtin_amdgcn_fmed3f(a, -127.f, 127.f)), i1 = (int)__builtin_rintf(__builtin_amdgcn_fmed3f(b, -127.f, 127.f));
    const int i2 = (int)__builtin_rintf(__builtin_amdgcn_fmed3f(c, -127.f, 127.f)), i3 = (int)__builtin_rintf(__builtin_amdgcn_fmed3f(d, -127.f, 127.f));
    return (unsigned)(i0 & 255) | ((unsigned)(i1 & 255) << 8) | ((unsigned)(i2 & 255) << 16) | ((unsigned)i3 << 24); }
__device__ __forceinline__ float wave_max(float v) {
#pragma unroll
    for (int o = 1; o < 64; o <<= 1) v = fmaxf(v, __shfl_xor(v, o));
    return v;
}
__device__ __forceinline__ float bf_lo(unsigned w) { return __builtin_bit_cast(float, w << 16); }
__device__ __forceinline__ float bf_hi(unsigned w) { return __builtin_bit_cast(float, w & 0xffff0000u); }
__device__ __forceinline__ f32x4 ld4(const float* p) { return *(const GAS f32x4*)p; }
__device__ __forceinline__ f32x4 ld4(const bf16_t* p) { const u32x2 w = *(const GAS u32x2*)p; return (f32x4){bf_lo(w.x), bf_hi(w.x), bf_lo(w.y), bf_hi(w.y)}; }
__device__ __forceinline__ f32x2 ld2(const float* p) { return *(const GAS f32x2*)p; }
__device__ __forceinline__ f32x2 ld2(const bf16_t* p) { const unsigned w = *(const GAS unsigned*)p; return (f32x2){bf_lo(w), bf_hi(w)}; }
__device__ __forceinline__ f32x4 ldraw4(const float* p) { return *(const GAS f32x4*)p; }
__device__ __forceinline__ u32x2 ldraw4(const bf16_t* p) { return *(const GAS u32x2*)p; }
__device__ __forceinline__ f32x4 cvt4(f32x4 v) { return v; }
__device__ __forceinline__ f32x4 cvt4(u32x2 w) { return (f32x4){bf_lo(w.x), bf_hi(w.x), bf_lo(w.y), bf_hi(w.y)}; }
template <class T> struct Raw4; template <> struct Raw4<float> { typedef f32x4 t; }; template <> struct Raw4<bf16_t> { typedef u32x2 t; };
__device__ __forceinline__ float wave_sum(float v) {
#pragma unroll
    for (int o = 1; o < 64; o <<= 1) v += __shfl_xor(v, o);
    return v;
}
#define LDS_WAIT() asm volatile("s_waitcnt lgkmcnt(0)" ::: "memory")
__device__ __forceinline__ int fresh_tid(int wave_s) { int w = wave_s, z = 0; asm volatile("" : "+s"(w), "+s"(z)); return w * 64 + (int)__builtin_amdgcn_mbcnt_hi(~0u, __builtin_amdgcn_mbcnt_lo(~0u, (unsigned)z)); }
#define RLX_AGENT __ATOMIC_RELAXED, __HIP_MEMORY_SCOPE_AGENT

#define XB_TMO      128
#define XB_XCNT(j)  (256  + 64 * (j))
#define XB_XSUB(j)  (1280 + 64 * (j))
#define XB_XGEN(j)  (2304 + 64 * (j))
#define XB_TOP      3328
#define XB_TOPGEN   3392
#define XCD_BAR_WORDS 3456
#define XB_SPIN_CAP (1u << 22)
__device__ __forceinline__ unsigned xb_ld(unsigned* p)              { return __hip_atomic_load(p, __ATOMIC_RELAXED, __HIP_MEMORY_SCOPE_AGENT); }
__device__ __forceinline__ unsigned xb_add(unsigned* p, unsigned v) { return __hip_atomic_fetch_add(p, v, __ATOMIC_RELAXED, __HIP_MEMORY_SCOPE_AGENT); }
__device__ __forceinline__ unsigned xb_xcc_id() { return (unsigned)__builtin_amdgcn_s_getreg((3 << 11) | 20) & 0xFu; }
#define XB_SPIN(cond, bar) do { unsigned _sp = 0; while (cond) { __builtin_amdgcn_s_sleep(1); \
    if ((++_sp & 255u) == 0u) { if (xb_ld(&(bar)[XB_TMO])) break; if (_sp > XB_SPIN_CAP) { atomicAdd(&(bar)[XB_TMO], 1u); break; } } } } while (0)
struct XcdBarrier { unsigned* bar; unsigned x; volatile LAS unsigned* st; };
__device__ __forceinline__ XcdBarrier xcd_barrier_post(unsigned* bar, volatile LAS unsigned* st) {
    XcdBarrier b; b.bar = bar; b.x = xb_xcc_id(); b.st = st;
    if (threadIdx.x == 0) (void)xb_add(&bar[XB_XCNT(b.x)], 1u);
    return b;
}
__device__ __forceinline__ void xcd_barrier_complete(unsigned* bar, unsigned x, unsigned& nloc, unsigned& nx) {
    const unsigned G = gridDim.x * gridDim.y * gridDim.z;
    unsigned sum, cnt, mine, sp = 0u;
    for (;;) {
        sum = 0u; cnt = 0u; mine = 0u;
#pragma unroll
        for (unsigned j = 0; j < 16; ++j) { const unsigned c = xb_ld(&bar[XB_XCNT(j)]); sum += c; cnt += (c > 0u) ? 1u : 0u; mine = (j == x) ? c : mine; }
        if (sum == G) break;
        __builtin_amdgcn_s_sleep(1);
        if ((++sp & 255u) == 0u) { if (xb_ld(&bar[XB_TMO])) break; if (sp > XB_SPIN_CAP) { atomicAdd(&bar[XB_TMO], 1u); break; } }
    }
    nloc = mine > 0u ? mine : 1u; nx = cnt > 0u ? cnt : 1u;
}
__device__ __forceinline__ void xcd_barrier(const XcdBarrier& b, int wave_s) {
    asm volatile("s_waitcnt vmcnt(0)" ::: "memory");
    __syncthreads();
    if (fresh_tid(wave_s) == 0) {
        unsigned* bar = b.bar;
        __builtin_amdgcn_s_waitcnt(0);
        unsigned nloc = b.st[0], nx = b.st[1];
        if (nloc == 0u) { xcd_barrier_complete(bar, b.x, nloc, nx); b.st[0] = nloc; b.st[1] = nx; }
        const unsigned old = xb_add(&bar[XB_XSUB(b.x)], 1u);
        const unsigned gen = old / nloc;
        if (old + 1u == (gen + 1u) * nloc) {
            __builtin_amdgcn_fence(__ATOMIC_RELEASE, "agent");
            asm volatile("s_waitcnt vmcnt(0)" ::: "memory");
            const unsigned og = xb_add(&bar[XB_TOP], 1u);
            const unsigned tg = og / nx;
            if (og + 1u == (tg + 1u) * nx) xb_add(&bar[XB_TOPGEN], 1u);
            else XB_SPIN(xb_ld(&bar[XB_TOPGEN]) == tg, bar);
            __builtin_amdgcn_fence(__ATOMIC_ACQUIRE, "agent");
            xb_add(&bar[XB_XGEN(b.x)], 1u);
            asm volatile("s_waitcnt vmcnt(0)" ::: "memory");
        } else {
            XB_SPIN(xb_ld(&bar[XB_XGEN(b.x)]) == gen, bar);
            __builtin_amdgcn_fence(__ATOMIC_ACQUIRE, "agent");
            asm volatile("s_waitcnt vmcnt(0)" ::: "memory");
        }
    }
    __syncthreads();
}

namespace pg8 {
constexpr int BM = 256, BK = 64, HALF = 128, HTB = HALF * BK * 2, NXCD = 8, WGM = 8;
__host__ __device__ __forceinline__ int lds_byte(int r, int c) { const int st = (r >> 4) * 2 + (c >> 5), rr = r & 15, cc = c & 31, ob = rr * 64 + cc * 2; return st * 1024 + (ob ^ (((ob >> 9) & 1) << 5)); }
__host__ __device__ __forceinline__ void stage_rc(int b, int& R, int& C) { const int st = b / 1024, sb = b % 1024, swz = sb ^ (((sb >> 9) & 1) << 5); R = (st >> 1) * 16 + swz / 64; C = (st & 1) * 32 + (swz % 64) / 2; }
__host__ __device__ __forceinline__ int perm32(int rho) { const int n = rho >> 4, i = rho & 15; return 8 * (i >> 2) + 4 * n + (i & 3); }

typedef int i32x8 __attribute__((ext_vector_type(8)));
__device__ __forceinline__ i32x8 cat8(bf16x8 lo, bf16x8 hi) { const i32x4 a = __builtin_bit_cast(i32x4, lo), b = __builtin_bit_cast(i32x4, hi); return __builtin_shufflevector(a, b, 0, 1, 2, 3, 4, 5, 6, 7); }
struct Unit { const char* A; const char* B; int pm, pn, aux; };
struct GemmK { int K, lda, ldb; };

__device__ __forceinline__ bool smap(long L, int nM, int nN, int& pm, int& pn) {
    const int nwg = nM * nN; if (L >= nwg) return false;
    int wgid = (int)L; { const int q = nwg / NXCD, r = nwg % NXCD, xcd = wgid % NXCD, off = wgid / NXCD; wgid = (xcd < r ? xcd * (q + 1) : r * (q + 1) + (xcd - r) * q) + off; }
    const int nig = WGM * nN, gid = wgid / nig, fm = gid * WGM, gsz = (nM - fm) < WGM ? (nM - fm) : WGM;
    pm = fm + ((wgid % nig) % gsz); pn = (wgid % nig) / gsz; return true;
}

template <class Epi, class Sched, bool ALIGN_EPI, int MODE = 0, bool GATHER = false>
__device__ __forceinline__ void gemm_phase(LAS unsigned char* lds, const GemmK g, const Sched& S, const Epi& E, int wave_s, int stag = 0  ) {
    if (stag > 0 && (blockIdx.x & 1)) { const unsigned long long t0 = __builtin_amdgcn_s_memrealtime(); while (__builtin_amdgcn_s_memrealtime() - t0 < (unsigned long long)stag) __builtin_amdgcn_s_sleep(4); }
    const int tid = fresh_tid(wave_s);
    const int wid = __builtin_amdgcn_readfirstlane(tid >> 6), lane = tid & 63, wr = wid >> 2, wc = wid & 3, fr = lane & 15, fq = lane >> 4;
    constexpr bool FP8 = (MODE == 1);
    const int K = g.K, nt = K / BK;
    unsigned voffA[2], voffB[2];
#pragma unroll
    for (int i = 0; i < 2; ++i) { int R, C; stage_rc(tid * 16 + i * 8192, R, C); const int Rb = Epi::PERM ? ((R & ~31) + perm32(R & 31)) : R;
        voffA[i] = (unsigned)(R * g.lda + C) * 2u; voffB[i] = (unsigned)(Rb * g.ldb + C) * 2u; }
    unsigned vG[2][2], vN[2][2];
    const size_t kstep = (size_t)(BK * 2);
    const size_t hstepA = (size_t)HALF * g.lda * 2, hstepB = (size_t)HALF * g.ldb * 2;
    const unsigned ldsw = (unsigned)wid * 1024u;
    const int aoff = lds_byte(wr * 64 + fr, fq * 8), boff = lds_byte(wc * 32 + fr, fq * 8);
#define PG8_SA(b, h) (((b) * 2 + (h)) * HTB)
#define PG8_SB(b, h) ((4 + (b) * 2 + (h)) * HTB)
#define PG8_STAGE(bufoff, gbase, voff) do { _Pragma("unroll") for (int _i = 0; _i < 2; ++_i) \
        __builtin_amdgcn_global_load_lds((const unsigned*)((const char*)(gbase) + (voff)[_i]), (LAS unsigned*)(lds + (bufoff) + ldsw + _i * 8192), 16, 0, 0); } while (0)
#define PG8_STAGE_A(bufoff, gbase, h, nx) do { if constexpr (GATHER) { unsigned _v[2] = { (nx) ? vN[h][0] : vG[h][0], (nx) ? vN[h][1] : vG[h][1] }; PG8_STAGE(bufoff, gbase, _v); } \
        else PG8_STAGE(bufoff, (gbase) + (h) * hstepA, voffA); } while (0)
#define PG8_LD8(p) __builtin_shufflevector(*(const LAS i32x4*)(p), *(const LAS i32x4*)((p) + 1024), 0, 1, 2, 3, 4, 5, 6, 7)
#define PG8_LDA(dst, b, h) do { if constexpr (FP8) { _Pragma("unroll") for (int m = 0; m < 4; ++m) dst##8[m] = PG8_LD8(lds + PG8_SA(b, h) + aoff + m * 2048); } \
        else { _Pragma("unroll") for (int m = 0; m < 4; ++m) _Pragma("unroll") for (int k = 0; k < 2; ++k) dst[m][k] = *(const LAS bf16x8*)(lds + PG8_SA(b, h) + aoff + m * 2048 + k * 1024); } } while (0)
#define PG8_LDB(dst, b, h) do { if constexpr (FP8) { _Pragma("unroll") for (int n = 0; n < 2; ++n) dst##8[n] = PG8_LD8(lds + PG8_SB(b, h) + boff + n * 2048); } \
        else { _Pragma("unroll") for (int n = 0; n < 2; ++n) _Pragma("unroll") for (int k = 0; k < 2; ++k) dst[n][k] = *(const LAS bf16x8*)(lds + PG8_SB(b, h) + boff + n * 2048 + k * 1024); } } while (0)
#define PG8_MFMA_ASM(INS, C, OUT, a_, b_) asm volatile(INS " %0, %1, %2, " C : OUT(acc[ai_][bj_][m][n]) : "v"(b_), "v"(a_))
#define PG8_MMA(ai, bj, At, Bt, Z) do { constexpr int ai_ = ai, bj_ = bj; __builtin_amdgcn_s_setprio(1); \
        if constexpr (FP8) { if (Z) { _Pragma("unroll") for (int m = 0; m < 4; ++m) _Pragma("unroll") for (int n = 0; n < 2; ++n) PG8_MFMA_ASM("v_mfma_f32_16x16x128_f8f6f4", "0", "=&v", At##8[m], Bt##8[n]); } \
                             else { _Pragma("unroll") for (int m = 0; m < 4; ++m) _Pragma("unroll") for (int n = 0; n < 2; ++n) PG8_MFMA_ASM("v_mfma_f32_16x16x128_f8f6f4", "%0", "+v", At##8[m], Bt##8[n]); } } \
        else if constexpr (MODE == 2) { if (Z) { _Pragma("unroll") for (int m = 0; m < 4; ++m) _Pragma("unroll") for (int n = 0; n < 2; ++n) PG8_MFMA_ASM("v_mfma_i32_16x16x64_i8", "0", "=&v", At[m][0], Bt[n][0]); } \
                             else { _Pragma("unroll") for (int m = 0; m < 4; ++m) _Pragma("unroll") for (int n = 0; n < 2; ++n) PG8_MFMA_ASM("v_mfma_i32_16x16x64_i8", "%0", "+v", At[m][0], Bt[n][0]); } \
                             _Pragma("unroll") for (int m = 0; m < 4; ++m) _Pragma("unroll") for (int n = 0; n < 2; ++n) PG8_MFMA_ASM("v_mfma_i32_16x16x64_i8", "%0", "+v", At[m][1], Bt[n][1]); } \
        else { if (Z) { _Pragma("unroll") for (int m = 0; m < 4; ++m) _Pragma("unroll") for (int n = 0; n < 2; ++n) PG8_MFMA_ASM("v_mfma_f32_16x16x32_bf16", "0", "=&v", At[m][0], Bt[n][0]); } \
               else { _Pragma("unroll") for (int m = 0; m < 4; ++m) _Pragma("unroll") for (int n = 0; n < 2; ++n) PG8_MFMA_ASM("v_mfma_f32_16x16x32_bf16", "%0", "+v", At[m][0], Bt[n][0]); } \
               _Pragma("unroll") for (int m = 0; m < 4; ++m) _Pragma("unroll") for (int n = 0; n < 2; ++n) PG8_MFMA_ASM("v_mfma_f32_16x16x32_bf16", "%0", "+v", At[m][1], Bt[n][1]); } \
        __builtin_amdgcn_s_setprio(0); } while (0)
#define PG8_WAIT_V(n) asm volatile("s_waitcnt vmcnt(" #n ")" ::: "memory")
#define PG8_WAIT_L(n) asm volatile("s_waitcnt lgkmcnt(" #n ")" ::: "memory")
#define PG8_BAR __builtin_amdgcn_s_barrier()
#define PG8_SCHED __builtin_amdgcn_sched_barrier(0)
    Unit cur, nxt; int ui = 0;
    constexpr int NS = Epi::NS;
#define PG8_WAIT_V1(n) do { if (NS > 0 && first && ui > 0) asm volatile("s_waitcnt vmcnt(%0)" :: "n"((n) + NS) : "memory"); else PG8_WAIT_V(n); } while (0)
    if (!S.next(0, cur)) return;
    f32x4 acc[2][2][4][2];
    bf16x8 At[4][2], B0[2][2], B1[2][2]; i32x8 At8[4], B08[2], B18[2];
    const char* cA = cur.A; const char* cB = cur.B;
    if constexpr (GATHER) {
#pragma unroll
        for (int i = 0; i < 2; ++i) { int R, C; stage_rc(tid * 16 + i * 8192, R, C);
#pragma unroll
            for (int h = 0; h < 2; ++h) { vG[h][i] = (unsigned)S.tos[(size_t)cur.aux * 256 + h * HALF + R] * (unsigned)(g.lda * 2) + (unsigned)C * 2u; vN[h][i] = vG[h][i]; } } }
    PG8_STAGE(PG8_SB(0, 0), cB, voffB); PG8_STAGE(PG8_SB(0, 1), cB + hstepB, voffB); PG8_STAGE_A(PG8_SA(0, 0), cA, 0, false); PG8_STAGE_A(PG8_SA(0, 1), cA, 1, false);
    if (wr == 1) PG8_BAR;
    PG8_WAIT_V(2); PG8_BAR;
    PG8_STAGE(PG8_SB(1, 0), cB + kstep, voffB); PG8_STAGE_A(PG8_SA(1, 0), cA + kstep, 0, false); PG8_STAGE(PG8_SB(1, 1), cB + hstepB + kstep, voffB);
    PG8_WAIT_V(6); PG8_BAR;
    for (;;) {
        const bool has_next = S.next(ui + 1, nxt);
        const char* nA = has_next ? nxt.A : cA; const char* nB = has_next ? nxt.B : cB;
        if constexpr (GATHER) { if (has_next && wid < 4) __builtin_amdgcn_global_load_lds((const unsigned*)(S.tos + (size_t)nxt.aux * 256 + wid * 64 + lane), (LAS unsigned*)(S.idxl + ((ui + 1) & 1) * 256 + wid * 64), 4, 0, 0); }
        for (int t = 0; t < nt; t += 2) {
            const bool last = (t == nt - 2), first = (t == 0);
            const char* a1 = cA + (size_t)(t + 1) * kstep;
            const char* a2 = last ? nA : cA + (size_t)(t + 2) * kstep; const char* b2 = last ? nB : cB + (size_t)(t + 2) * kstep;
            const char* a3 = a2 + kstep; const char* b3 = b2 + kstep;
            if constexpr (GATHER) { if (last) {
                    const LAS int* ib = S.idxl + ((ui + 1) & 1) * 256;
#pragma unroll
                    for (int i = 0; i < 2; ++i) { int R, C; stage_rc(tid * 16 + i * 8192, R, C);
#pragma unroll
                        for (int h = 0; h < 2; ++h) vN[h][i] = has_next ? (unsigned)ib[h * HALF + R] * (unsigned)(g.lda * 2) + (unsigned)C * 2u : vG[h][i]; } } }
            PG8_LDB(B0, 0, 0); PG8_LDB(B1, 0, 1); PG8_SCHED; PG8_LDA(At, 0, 0); if (!(first && ui > 0)) PG8_STAGE_A(PG8_SA(1, 1), a1, 1, false);
            PG8_WAIT_V1(8); PG8_WAIT_L(0); PG8_BAR; PG8_MMA(0, 0, At, B0, first); PG8_MMA(0, 1, At, B1, first); PG8_BAR; PG8_SCHED;
            PG8_LDA(At, 0, 1); PG8_STAGE(PG8_SB(0, 0), b2, voffB); PG8_STAGE(PG8_SB(0, 1), b2 + hstepB, voffB); PG8_STAGE_A(PG8_SA(0, 0), a2, 0, last);
            PG8_WAIT_V1(8); PG8_WAIT_L(0); PG8_BAR; PG8_MMA(1, 0, At, B0, first); PG8_MMA(1, 1, At, B1, first); PG8_BAR; PG8_SCHED;
            PG8_LDB(B0, 1, 0); PG8_LDB(B1, 1, 1); PG8_SCHED; PG8_LDA(At, 1, 0); PG8_STAGE_A(PG8_SA(0, 1), a2, 1, last);
            PG8_WAIT_V1(8); PG8_WAIT_L(0); PG8_BAR; PG8_MMA(0, 0, At, B0, false); PG8_MMA(0, 1, At, B1, false); PG8_BAR; PG8_SCHED;
            PG8_LDA(At, 1, 1); PG8_STAGE(PG8_SB(1, 0), b3, voffB); PG8_STAGE(PG8_SB(1, 1), b3 + hstepB, voffB); PG8_STAGE_A(PG8_SA(1, 0), a3, 0, last);
            PG8_WAIT_V(8); PG8_WAIT_L(0); PG8_BAR; PG8_MMA(1, 0, At, B0, false); PG8_MMA(1, 1, At, B1, false); PG8_BAR; PG8_SCHED;
        }
        if constexpr (ALIGN_EPI) { if (wr == 0) PG8_BAR; }
        if (has_next) PG8_STAGE_A(PG8_SA(1, 1), nA + kstep, 1, true);
        asm volatile("s_nop 15\n\ts_nop 15" ::: "memory");
        E(acc, cur, wr, wc, fr, fq);
        if (!has_next) break;
        cur = nxt; cA = nA; cB = nB; ++ui;
        if constexpr (GATHER) {
#pragma unroll
            for (int h = 0; h < 2; ++h) { vG[h][0] = vN[h][0]; vG[h][1] = vN[h][1]; } }
        if constexpr (ALIGN_EPI) { if (wr == 1) PG8_BAR; }
    }
    PG8_WAIT_V(0);
    if constexpr (!ALIGN_EPI) { if (wr == 0) PG8_BAR; }
    PG8_BAR;
#undef PG8_SA
#undef PG8_SB
#undef PG8_STAGE
#undef PG8_STAGE_A
#undef PG8_LDA
#undef PG8_LDB
#undef PG8_MMA
#undef PG8_WAIT_V1
#undef PG8_MFMA_ASM
#undef PG8_WAIT_V
#undef PG8_WAIT_L
#undef PG8_BAR
#undef PG8_SCHED
}

struct EpiMoeDownT {
    static constexpr int NS = 16; static constexpr bool PERM = true;
    bf16_t* Y2; const float* gate; float osc;
    __device__ __forceinline__ void operator()(const f32x4 (&acc)[2][2][4][2], const Unit& u, int wr, int wc, int fr, int fq) const {
        const int row0 = u.pm * BM + wr * 64 + fr, col0 = u.pn * BM + wc * 32 + 8 * fq;
        float gtv[2][4];
#pragma unroll
        for (int ai = 0; ai < 2; ++ai)
#pragma unroll
            for (int m = 0; m < 4; ++m) gtv[ai][m] = gate[row0 + ai * HALF + m * 16];
#pragma unroll
        for (int ai = 0; ai < 2; ++ai)
#pragma unroll
            for (int m = 0; m < 4; ++m) { const int row = row0 + ai * HALF + m * 16; const float gt = gtv[ai][m] * osc; bf16_t* rowp = Y2 + ((size_t)u.aux * (8 * 256) + (size_t)(row - 2 * M)) * D + col0;
#pragma unroll
                for (int bj = 0; bj < 2; ++bj) { const f32x4 v0 = acc[ai][bj][m][0] * gt, v1 = acc[ai][bj][m][1] * gt;
                    u32x4 w; w.x = cvtpk(v0[0], v0[1]); w.y = cvtpk(v0[2], v0[3]); w.z = cvtpk(v1[0], v1[1]); w.w = cvtpk(v1[2], v1[3]);
                    *(u32x4*)(rowp + bj * HALF) = w; } }
    }
};
struct DenseOrder {
    int nM, nN, G, c; const char* A; const char* B; size_t at, bt;
    __device__ __forceinline__ bool next(int i, Unit& u) const { int pm, pn; if (!smap((long)i * G + c, nM, nN, pm, pn)) return false;
        u.A = A + (size_t)pm * at; u.B = B + (size_t)pn * bt; u.pm = pm; u.pn = pn; u.aux = 0; return true; }
};
struct PoolOrder {
    int G, c; const char* P; const char* W;
    __device__ __forceinline__ bool next(int i, Unit& u) const { const int pm = c + (i >> 2) * G, pn = i & 3; if (pm >= M / 256) return false;
        u.A = P + (size_t)pm * (256 * 1024 * 2) + (size_t)pn * 512; u.B = W + (size_t)pn * (256 * 256 * 2); u.pm = pm; u.pn = pn; u.aux = 0; return true; }
};
struct ProjOrder {
    int njobs, G, c, nsp, sp; const char* ws; size_t qoff, tb;
    __device__ __forceinline__ bool next(int i, Unit& u) const {
        const int upj = 1024 / nsp, nrb = 256 / nsp; const long L = (long)i * G + c; if (L >= (long)njobs * upj) return false;
        const int job = (int)(L / upj), l = (int)(L % upj); const int kind = (njobs == 1) ? 1 : job;
        const size_t woff = WS_WK + (size_t)(kind == 1) * (WS_WQ + qoff - WS_WK) + (size_t)(kind == 2) * (WS_WV - WS_WK);
        int pm, pn;
        if (kind == 2) { smap(l, 4, nrb, pm, pn); pn += sp * nrb; u.A = ws + woff + (size_t)pm * tb; u.B = ws + WS_XN + (size_t)pn * tb; }
        else { smap(l, nrb, 4, pm, pn); pm += sp * nrb; u.A = ws + WS_XN + (size_t)pm * tb; u.B = ws + woff + (size_t)pn * tb; }
        u.pm = pm; u.pn = pn; u.aux = kind; return true; }
};
struct MoeOrder {
    int nM, nN, G, c, blk0, a_rel; const char* A; const char* B; size_t at, bt, be; const LAS int* pend;
    __device__ __forceinline__ bool next(int i, Unit& u) const { int pm, pn; if (!smap((long)i * G + c, nM, nN, pm, pn)) return false;
        const int b = blk0 + pm; int e = 0;
#pragma unroll
        for (int j = 0; j < 7; ++j) e += (b >= pend[j]) ? 1 : 0;
        e = __builtin_amdgcn_readfirstlane(e);
        u.A = A + (size_t)(a_rel ? pm : b) * at; u.B = B + (size_t)e * be + (size_t)pn * bt; u.pm = a_rel ? b : pm; u.pn = pn; u.aux = 0; return true; }
};

constexpr int TAIL_B0 = 2 * M / 256, TAIL_KS = 7;
struct MoeTailOrder {
    int nT, G, c; const char* A; const char* B; size_t at, bt, be, kq; const LAS int* pend;
    __device__ __forceinline__ bool next(int i, Unit& u) const { const int L = i * G + c; if (L >= nT * 4 * TAIL_KS) return false;
        const int q = L % TAIL_KS, r = L / TAIL_KS, pn = r & 3, b = TAIL_B0 + (r >> 2); int e = 0;
#pragma unroll
        for (int j = 0; j < 7; ++j) e += (b >= pend[j]) ? 1 : 0;
        e = __builtin_amdgcn_readfirstlane(e);
        u.A = A + (size_t)b * at + (size_t)q * kq; u.B = B + (size_t)e * be + (size_t)pn * bt + (size_t)q * kq; u.pm = b; u.pn = pn; u.aux = q; return true; }
};
struct MoeGatherOrder {
    int nM, nN, G, c, blk0; const char* A; const char* B; size_t bt, be; const LAS int* pend; const int* tos; LAS int* idxl;
    __device__ __forceinline__ bool next(int i, Unit& u) const { int pm, pn; if (!smap((long)i * G + c, nM, nN, pm, pn)) return false;
        const int b = blk0 + pm; int e = 0;
#pragma unroll
        for (int j = 0; j < 7; ++j) e += (b >= pend[j]) ? 1 : 0;
        e = __builtin_amdgcn_readfirstlane(e);
        u.A = A; u.B = B + (size_t)e * be + (size_t)pn * bt; u.pm = pm; u.pn = pn; u.aux = b; return true; }
};
struct EpiPool {
    static constexpr int NS = 0; static constexpr bool PERM = false;
    const float* xin; float* out; const float* scale; float mul;
    __device__ __forceinline__ void operator()(const f32x4 (&acc)[2][2][4][2], const Unit& u, int wr, int wc, int fr, int fq) const {
        const int row0 = u.pm * BM + wr * 64 + fr, col0 = u.pn * BM + wc * 32 + 4 * fq;
        f32x4 sv[2][2];
#pragma unroll
        for (int bj = 0; bj < 2; ++bj)
#pragma unroll
            for (int n = 0; n < 2; ++n) sv[bj][n] = *(const f32x4*)(scale + col0 + bj * HALF + n * 16) * mul;
#pragma unroll
        for (int ai = 0; ai < 2; ++ai)
#pragma unroll
            for (int m = 0; m < 4; ++m) { const size_t off = (size_t)(row0 + ai * HALF + m * 16) * D + col0;
#pragma unroll
                for (int bj = 0; bj < 2; ++bj)
#pragma unroll
                    for (int n = 0; n < 2; ++n) { const f32x4 xv = *(const f32x4*)(xin + off + bj * HALF + n * 16); *(f32x4*)(out + off + bj * HALF + n * 16) = xv + sv[bj][n] * acc[ai][bj][m][n]; }
                asm volatile("" ::: "memory"); }
    }
};
struct EpiDelta {
    static constexpr int NS = 0; static constexpr bool PERM = true;
    bf16_t* DL; const float* scale;
    __device__ __forceinline__ void operator()(const f32x4 (&acc)[2][2][4][2], const Unit& u, int wr, int wc, int fr, int fq) const {
        const int row0 = u.pm * BM + wr * 64 + fr, col0 = u.pn * BM + wc * 32 + 8 * fq;
        f32x4 sv[2][2];
#pragma unroll
        for (int bj = 0; bj < 2; ++bj) { sv[bj][0] = scale ? *(const f32x4*)(scale + col0 + bj * HALF) : (f32x4){1.f, 1.f, 1.f, 1.f}; sv[bj][1] = scale ? *(const f32x4*)(scale + col0 + bj * HALF + 4) : (f32x4){1.f, 1.f, 1.f, 1.f}; }
#pragma unroll
        for (int ai = 0; ai < 2; ++ai)
#pragma unroll
            for (int m = 0; m < 4; ++m) { bf16_t* rowp = DL + (size_t)(row0 + ai * HALF + m * 16) * D + col0;
#pragma unroll
                for (int bj = 0; bj < 2; ++bj) { const f32x4 v0 = acc[ai][bj][m][0] * sv[bj][0], v1 = acc[ai][bj][m][1] * sv[bj][1];
                    u32x4 w; w.x = cvtpk(v0[0], v0[1]); w.y = cvtpk(v0[2], v0[3]); w.z = cvtpk(v1[0], v1[1]); w.w = cvtpk(v1[2], v1[3]);
                    *(u32x4*)(rowp + bj * HALF) = w; } }
    }
};
struct EpiResidB {
    static constexpr int NS = 16; static constexpr bool PERM = true; static constexpr bool SPLIT = false;
    bf16_t* xb; const float* scale; float mul;
    __device__ __forceinline__ void operator()(const f32x4 (&acc)[2][2][4][2], const Unit& u, int wr, int wc, int fr, int fq) const {
        const int row0 = u.pm * BM + wr * 64 + fr, col0 = u.pn * BM + wc * 32 + 8 * fq;
        u32x4 d[2][4][2];
#pragma unroll
        for (int ai = 0; ai < 2; ++ai)
#pragma unroll
            for (int m = 0; m < 4; ++m) { const GAS bf16_t* rowp = (const GAS bf16_t*)xb + (size_t)(row0 + ai * HALF + m * 16) * D + col0;
#pragma unroll
                for (int bj = 0; bj < 2; ++bj) d[ai][m][bj] = *(const GAS u32x4*)(rowp + bj * HALF); }
        f32x4 sv[2][2];
#pragma unroll
        for (int bj = 0; bj < 2; ++bj) { sv[bj][0] = (scale ? *(const f32x4*)(scale + col0 + bj * HALF) : (f32x4){1.f, 1.f, 1.f, 1.f}) * mul; sv[bj][1] = (scale ? *(const f32x4*)(scale + col0 + bj * HALF + 4) : (f32x4){1.f, 1.f, 1.f, 1.f}) * mul; }
#pragma unroll
        for (int ai = 0; ai < 2; ++ai)
#pragma unroll
            for (int m = 0; m < 4; ++m) { GAS bf16_t* rowp = (GAS bf16_t*)xb + (size_t)(row0 + ai * HALF + m * 16) * D + col0;
#pragma unroll
                for (int bj = 0; bj < 2; ++bj) { const u32x4 dd = d[ai][m][bj];
                    const f32x4 o0 = (f32x4){bf_lo(dd.x), bf_hi(dd.x), bf_lo(dd.y), bf_hi(dd.y)} + acc[ai][bj][m][0] * sv[bj][0], o1 = (f32x4){bf_lo(dd.z), bf_hi(dd.z), bf_lo(dd.w), bf_hi(dd.w)} + acc[ai][bj][m][1] * sv[bj][1];
                    u32x4 w; w.x = cvtpk(o0[0], o0[1]); w.y = cvtpk(o0[2], o0[3]); w.z = cvtpk(o1[0], o1[1]); w.w = cvtpk(o1[2], o1[3]); *(GAS u32x4*)(rowp + bj * HALF) = w; } }
    }
};
template <class XT>
struct EpiResidD {
    static constexpr int NS = 0; static constexpr bool PERM = true;
    const XT* xsrc; bf16_t* out; const bf16_t* DL; float mul;
    __device__ __forceinline__ void operator()(const f32x4 (&acc)[2][2][4][2], const Unit& u, int wr, int wc, int fr, int fq) const {
        const int row0 = u.pm * BM + wr * 64 + fr, col0 = u.pn * BM + wc * 32 + 8 * fq;
#pragma unroll
        for (int ai = 0; ai < 2; ++ai)
#pragma unroll
            for (int m = 0; m < 4; ++m) { const size_t off0 = (size_t)(row0 + ai * HALF + m * 16) * D + col0;
#pragma unroll
                for (int bj = 0; bj < 2; ++bj) { const size_t off = off0 + bj * HALF; const f32x4 x0 = ld4(xsrc + off), x1 = ld4(xsrc + off + 4); const u32x4 d = *(const u32x4*)(DL + off);
                    const f32x4 d0 = {bf_lo(d.x), bf_hi(d.x), bf_lo(d.y), bf_hi(d.y)}, d1 = {bf_lo(d.z), bf_hi(d.z), bf_lo(d.w), bf_hi(d.w)};
                    const f32x4 o0 = x0 + d0 + acc[ai][bj][m][0] * mul, o1 = x1 + d1 + acc[ai][bj][m][1] * mul;
                    u32x4 w; w.x = cvtpk(o0[0], o0[1]); w.y = cvtpk(o0[2], o0[3]); w.z = cvtpk(o1[0], o1[1]); w.w = cvtpk(o1[2], o1[3]); *(u32x4*)(out + off) = w; }
                asm volatile("" ::: "memory"); }
    }
};
struct EpiResid {
    static constexpr int NS = 0; static constexpr bool PERM = false;
    float* x; float mul;
    __device__ __forceinline__ void operator()(const f32x4 (&acc)[2][2][4][2], const Unit& u, int wr, int wc, int fr, int fq) const {
        const int row0 = u.pm * BM + wr * 64 + fr, col0 = u.pn * BM + wc * 32 + 4 * fq;
#pragma unroll
        for (int ai = 0; ai < 2; ++ai)
#pragma unroll
            for (int m = 0; m < 4; ++m) { float* p = x + (size_t)(row0 + ai * HALF + m * 16) * D + col0;
#pragma unroll
                for (int bj = 0; bj < 2; ++bj)
#pragma unroll
                    for (int n = 0; n < 2; ++n) { const f32x4 xv = *(const f32x4*)(p + bj * HALF + n * 16); *(f32x4*)(p + bj * HALF + n * 16) = xv + acc[ai][bj][m][n] * mul; }
                asm volatile("" ::: "memory"); }
    }
};
__device__ __forceinline__ f32x2 swiglu2(f32x2 g, f32x2 u, float c1  , float kinv  ) {
    const f32x2 t = g * c1; f32x2 e; e.x = __builtin_amdgcn_exp2f(t.x); e.y = __builtin_amdgcn_exp2f(t.y);
    const f32x2 d = e * kinv + kinv; f32x2 r; r.x = __builtin_amdgcn_rcpf(d.x); r.y = __builtin_amdgcn_rcpf(d.y);
    return (g * u) * r;
}
__device__ __forceinline__ f32x2 swiglu2n(f32x2 gl, f32x2 us, float k) {
    f32x2 e; e.x = __builtin_amdgcn_exp2f(-gl.x); e.y = __builtin_amdgcn_exp2f(-gl.y);
    const f32x2 d = e * k + k; f32x2 r; r.x = __builtin_amdgcn_rcpf(d.x); r.y = __builtin_amdgcn_rcpf(d.y);
    return (gl * us) * r;
}
__device__ __forceinline__ float silu_mul(float g, float u) { return g * u * __builtin_amdgcn_rcpf(1.0f + __builtin_amdgcn_exp2f(-1.4426950408889634f * g)); }
struct EpiSwiglu {
    static constexpr int NS = 0; static constexpr bool PERM = true;
    bf16_t* H; int ldc;
    __device__ __forceinline__ void operator()(const f32x4 (&acc)[2][2][4][2], const Unit& u, int wr, int wc, int fr, int fq) const {
        const int row0 = u.pm * BM + wr * 64 + fr, col0 = u.pn * HALF + wc * 32 + 8 * fq;
#pragma unroll
        for (int ai = 0; ai < 2; ++ai)
#pragma unroll
            for (int m = 0; m < 4; ++m) { bf16_t* rowp = H + (size_t)(row0 + ai * HALF + m * 16) * ldc + col0;
                const f32x4 g0 = acc[ai][0][m][0], g1 = acc[ai][0][m][1], u0 = acc[ai][1][m][0], u1 = acc[ai][1][m][1];
                const f32x2 h0 = swiglu2((f32x2){g0[0], g0[1]}, (f32x2){u0[0], u0[1]}, -1.4426950408889634f, 1.0f), h1 = swiglu2((f32x2){g0[2], g0[3]}, (f32x2){u0[2], u0[3]}, -1.4426950408889634f, 1.0f);
                const f32x2 h2 = swiglu2((f32x2){g1[0], g1[1]}, (f32x2){u1[0], u1[1]}, -1.4426950408889634f, 1.0f), h3 = swiglu2((f32x2){g1[2], g1[3]}, (f32x2){u1[2], u1[3]}, -1.4426950408889634f, 1.0f);
                u32x4 w; w.x = cvtpk(h0.x, h0.y); w.y = cvtpk(h1.x, h1.y); w.z = cvtpk(h2.x, h2.y); w.w = cvtpk(h3.x, h3.y);
                *(u32x4*)rowp = w; }
    }
};
struct EpiSwigluI8 {
    static constexpr int NS = 8; static constexpr bool PERM = true;
    bf16_t* H; int ldc; const float* ascale; const float* wscale;
    __device__ __forceinline__ void operator()(const f32x4 (&acc)[2][2][4][2], const Unit& u, int wr, int wc, int fr, int fq) const {
        const int row0 = u.pm * BM + wr * 64 + fr, col0 = u.pn * HALF + wc * 32 + 8 * fq;
        const float* wsp = wscale + u.pn * BM + wc * 32 + 8 * fq;
        const f32x4 sg0 = *(const f32x4*)wsp, sg1 = *(const f32x4*)(wsp + 4), su0 = *(const f32x4*)(wsp + HALF), su1 = *(const f32x4*)(wsp + HALF + 4);
        float sav[2][4];
#pragma unroll
        for (int ai = 0; ai < 2; ++ai)
#pragma unroll
            for (int m = 0; m < 4; ++m) sav[ai][m] = ascale[row0 + ai * HALF + m * 16];
#pragma unroll
        for (int ai = 0; ai < 2; ++ai)
#pragma unroll
            for (int m = 0; m < 4; ++m) { const int row = row0 + ai * HALF + m * 16; bf16_t* rowp = H + (size_t)row * ldc + col0; const float sa = sav[ai][m];
                const i32x4 ig0 = __builtin_bit_cast(i32x4, acc[ai][0][m][0]), ig1 = __builtin_bit_cast(i32x4, acc[ai][0][m][1]), iu0 = __builtin_bit_cast(i32x4, acc[ai][1][m][0]), iu1 = __builtin_bit_cast(i32x4, acc[ai][1][m][1]);
                const f32x4 g0 = __builtin_convertvector(ig0, f32x4) * (sg0 * sa), g1 = __builtin_convertvector(ig1, f32x4) * (sg1 * sa), u0 = __builtin_convertvector(iu0, f32x4) * (su0 * sa), u1 = __builtin_convertvector(iu1, f32x4) * (su1 * sa);
                const f32x2 h0 = swiglu2((f32x2){g0[0], g0[1]}, (f32x2){u0[0], u0[1]}, -1.4426950408889634f, 1.0f), h1 = swiglu2((f32x2){g0[2], g0[3]}, (f32x2){u0[2], u0[3]}, -1.4426950408889634f, 1.0f);
                const f32x2 h2 = swiglu2((f32x2){g1[0], g1[1]}, (f32x2){u1[0], u1[1]}, -1.4426950408889634f, 1.0f), h3 = swiglu2((f32x2){g1[2], g1[3]}, (f32x2){u1[2], u1[3]}, -1.4426950408889634f, 1.0f);
                u32x4 w; w.x = cvtpk(h0.x, h0.y); w.y = cvtpk(h1.x, h1.y); w.z = cvtpk(h2.x, h2.y); w.w = cvtpk(h3.x, h3.y);
                *(u32x4*)rowp = w; }
    }
};
struct EpiSwiglu8 {
    static constexpr int NS = 8; static constexpr bool PERM = true;
    unsigned char* H; int ldc; float gsc;
    __device__ __forceinline__ void operator()(const f32x4 (&acc)[2][2][4][2], const Unit& u, int wr, int wc, int fr, int fq) const {
        const int row0 = u.pm * BM + wr * 64 + fr, col0 = u.pn * HALF + wc * 32 + 8 * fq;
#pragma unroll
        for (int ai = 0; ai < 2; ++ai)
#pragma unroll
            for (int m = 0; m < 4; ++m) { unsigned char* rowp = H + (size_t)(row0 + ai * HALF + m * 16) * ldc + col0;
                const f32x4 g0 = acc[ai][0][m][0], g1 = acc[ai][0][m][1], u0 = acc[ai][1][m][0], u1 = acc[ai][1][m][1];
                const float kk = W8_GATE / (gsc * H8_SC);
                const f32x2 h0 = swiglu2n((f32x2){g0[0], g0[1]}, (f32x2){u0[0], u0[1]}, kk), h1 = swiglu2n((f32x2){g0[2], g0[3]}, (f32x2){u0[2], u0[3]}, kk);
                const f32x2 h2 = swiglu2n((f32x2){g1[0], g1[1]}, (f32x2){u1[0], u1[1]}, kk), h3 = swiglu2n((f32x2){g1[2], g1[3]}, (f32x2){u1[2], u1[3]}, kk);
                u32x2 w; w.x = pk4_fp8(h0.x, h0.y, h1.x, h1.y); w.y = pk4_fp8(h2.x, h2.y, h3.x, h3.y);
                *(u32x2*)rowp = w; }
    }
};
struct EpiProj {
    static constexpr int NS = 0; static constexpr bool PERM = true;
    bf16_t *Kb, *Qb, *Vt;
    __device__ __forceinline__ void operator()(const f32x4 (&acc)[2][2][4][2], const Unit& u, int wr, int wc, int fr, int fq) const {
        bf16_t* base = (u.aux == 0) ? Kb : (u.aux == 1 ? Qb : Vt); const size_t ldc = (u.aux == 2) ? (size_t)M : (size_t)D;
        const int row0 = u.pm * BM + wr * 64 + fr, col0 = u.pn * BM + wc * 32 + 8 * fq;
#pragma unroll
        for (int ai = 0; ai < 2; ++ai)
#pragma unroll
            for (int m = 0; m < 4; ++m) { bf16_t* rowp = base + (size_t)(row0 + ai * HALF + m * 16) * ldc + col0;
#pragma unroll
                for (int bj = 0; bj < 2; ++bj) { const f32x4 v0 = acc[ai][bj][m][0], v1 = acc[ai][bj][m][1];
                    u32x4 w; w.x = cvtpk(v0[0], v0[1]); w.y = cvtpk(v0[2], v0[3]); w.z = cvtpk(v1[0], v1[1]); w.w = cvtpk(v1[2], v1[3]);
                    if (u.aux == 2) { bf16_t* p16 = rowp + bj * HALF - (fq & 1) * 8 + (fq & 1) * 4;
                        *(u32x2*)p16 = (u32x2){w.x, w.y}; *(u32x2*)(p16 + 8) = (u32x2){w.z, w.w}; }
                    else *(u32x4*)(rowp + bj * HALF) = w; } }
    }
};
struct EpiProjI8 {
    static constexpr int NS = 16; static constexpr bool PERM = true;
    bf16_t *Kb, *Qb, *Vt; const float* ascale; const float* wsc  ; int qsel;
    __device__ __forceinline__ void operator()(const f32x4 (&acc)[2][2][4][2], const Unit& u, int wr, int wc, int fr, int fq) const {
        bf16_t* base = (u.aux == 0) ? Kb : (u.aux == 1 ? Qb : Vt); const size_t ldc = (u.aux == 2) ? (size_t)M : (size_t)D;
        const float* rs; const float* cs; if (u.aux == 2) { rs = wsc + 1024; cs = ascale; } else { rs = ascale; cs = wsc + u.aux * (2048 + qsel * 1024); }
        const int row0 = u.pm * BM + wr * 64 + fr, col0 = u.pn * BM + wc * 32 + 8 * fq;
        f32x4 cv[2][2];
#pragma unroll
        for (int bj = 0; bj < 2; ++bj) { cv[bj][0] = *(const f32x4*)(cs + col0 + bj * HALF); cv[bj][1] = *(const f32x4*)(cs + col0 + bj * HALF + 4); }
        float rvv[2][4];
#pragma unroll
        for (int ai = 0; ai < 2; ++ai)
#pragma unroll
            for (int m = 0; m < 4; ++m) rvv[ai][m] = rs[row0 + ai * HALF + m * 16];
#pragma unroll
        for (int ai = 0; ai < 2; ++ai)
#pragma unroll
            for (int m = 0; m < 4; ++m) { const int row = row0 + ai * HALF + m * 16; bf16_t* rowp = base + (size_t)row * ldc + col0; const float rv = rvv[ai][m];
#pragma unroll
                for (int bj = 0; bj < 2; ++bj) { const f32x4 v0 = __builtin_convertvector(__builtin_bit_cast(i32x4, acc[ai][bj][m][0]), f32x4) * (cv[bj][0] * rv), v1 = __builtin_convertvector(__builtin_bit_cast(i32x4, acc[ai][bj][m][1]), f32x4) * (cv[bj][1] * rv);
                    u32x4 w; w.x = cvtpk(v0[0], v0[1]); w.y = cvtpk(v0[2], v0[3]); w.z = cvtpk(v1[0], v1[1]); w.w = cvtpk(v1[2], v1[3]);
                    if (u.aux == 2) { bf16_t* p16 = rowp + bj * HALF - (fq & 1) * 8 + (fq & 1) * 4;
                        *(u32x2*)p16 = (u32x2){w.x, w.y}; *(u32x2*)(p16 + 8) = (u32x2){w.z, w.w}; }
                    else *(u32x4*)(rowp + bj * HALF) = w; } }
    }
};
struct EpiMoeDown {
    static constexpr int NS = 16; static constexpr bool PERM = true;
    bf16_t* Y; const float* gate; float osc;
    __device__ __forceinline__ void operator()(const f32x4 (&acc)[2][2][4][2], const Unit& u, int wr, int wc, int fr, int fq) const {
        const int row0 = u.pm * BM + wr * 64 + fr, col0 = u.pn * BM + wc * 32 + 8 * fq;
        float gtv[2][4];
#pragma unroll
        for (int ai = 0; ai < 2; ++ai)
#pragma unroll
            for (int m = 0; m < 4; ++m) gtv[ai][m] = gate[row0 + ai * HALF + m * 16];
#pragma unroll
        for (int ai = 0; ai < 2; ++ai)
#pragma unroll
            for (int m = 0; m < 4; ++m) { const int row = row0 + ai * HALF + m * 16; const float gt = gtv[ai][m] * osc; bf16_t* rowp = Y + (size_t)row * D + col0;
#pragma unroll
                for (int bj = 0; bj < 2; ++bj) { const f32x4 v0 = acc[ai][bj][m][0] * gt, v1 = acc[ai][bj][m][1] * gt;
                    u32x4 w; w.x = cvtpk(v0[0], v0[1]); w.y = cvtpk(v0[2], v0[3]); w.z = cvtpk(v1[0], v1[1]); w.w = cvtpk(v1[2], v1[3]);
                    *(u32x4*)(rowp + bj * HALF) = w; } }
    }
};
}

__device__ __forceinline__ void tr_load(float (&tv)[32], const float* W, int ldw, int k0, int n0, int lane) {
    const GAS float* wp = (const GAS float*)W + (size_t)(k0 + (lane >> 5)) * ldw + n0 + (lane & 31);
#pragma unroll
    for (int i = 0; i < 32; ++i) tv[i] = wp[(size_t)(2 * i) * ldw];
}
__device__ __forceinline__ void tr_put(const float (&tv)[32], int k0, const float* gain, float mul, int mode  , unsigned char* WT, int ldk, int drow0, LAS float* scr, int lane,
                                       const unsigned* colmax = nullptr  , int n0 = 0, float* wscale = nullptr  ) {
#pragma unroll
    for (int i = 0; i < 32; ++i) { const int kk = 2 * i + (lane >> 5); const float gv = gain ? gain[k0 + kk] * mul : mul; scr[kk * 33 + (lane & 31)] = tv[i] * gv; }
    LDS_WAIT(); asm volatile("" ::: "memory");
    const int c = lane & 7;
#pragma unroll
    for (int j = 0; j < 4; ++j) { const int n = (lane >> 3) + 8 * j; const LAS float* sp = scr + (8 * c) * 33 + n;
        const float e0 = sp[0 * 33], e1 = sp[1 * 33], e2 = sp[2 * 33], e3 = sp[3 * 33], e4 = sp[4 * 33], e5 = sp[5 * 33], e6 = sp[6 * 33], e7 = sp[7 * 33];
        if (mode == 2) { const float mx = __builtin_bit_cast(float, __hip_atomic_load(colmax + n0 + n, RLX_AGENT)); const float q = mx > 0.f ? 127.0f / mx : 0.f;
            u32x2 o; o.x = pk4_i8(e0 * q, e1 * q, e2 * q, e3 * q); o.y = pk4_i8(e4 * q, e5 * q, e6 * q, e7 * q); *(GAS u32x2*)(WT + (size_t)(drow0 + n) * ldk + k0 + 8 * c) = o;
            if (k0 == 0 && c == 0) wscale[drow0 + n] = mx * (1.0f / 127.0f); }
        else if (mode == 1) { u32x2 o; o.x = pk4_fp8(e0, e1, e2, e3); o.y = pk4_fp8(e4, e5, e6, e7); *(GAS u32x2*)(WT + (size_t)(drow0 + n) * ldk + k0 + 8 * c) = o; }
        else { u32x4 o; o.x = cvtpk(e0, e1); o.y = cvtpk(e2, e3); o.z = cvtpk(e4, e5); o.w = cvtpk(e6, e7); *(GAS u32x4*)(WT + ((size_t)(drow0 + n) * ldk + k0 + 8 * c) * 2) = o; } }
    LDS_WAIT(); asm volatile("" ::: "memory");
}
__device__ __forceinline__ void tr_mat(const float* W, int ldw, int K, int N, const float* gain, float mul, int mode, bool gu, unsigned char* WT, LAS float* scr, int first, int NGW, int lane,
                                       const unsigned* colmax = nullptr, float* wscale = nullptr, float gmul = 0.f  ) {
    const int nblk = N / 32, nitems = (K / 64) * nblk, F = N / 2;
    float tv[32], tn[32];
    int it = first; if (it >= nitems) return;
    tr_load(tv, W, ldw, (it / nblk) * 64, (it % nblk) * 32, lane);
    for (; it < nitems; it += NGW) {
        const int nx = it + NGW; if (nx < nitems) tr_load(tn, W, ldw, (nx / nblk) * 64, (nx % nblk) * 32, lane);
        const int kb = it / nblk, n0 = (it % nblk) * 32; int drow0 = n0;
        if (gu) { const int isup = n0 >= F, j = isup ? n0 - F : n0; drow0 = (j >> 7) * 256 + (isup ? 128 : 0) + (j & 127); }
        tr_put(tv, kb * 64, gain, (gu && n0 < F && gmul != 0.f) ? gmul : mul, mode, WT, K, drow0, scr, lane, colmax, n0, wscale);
#pragma unroll
        for (int i = 0; i < 32; ++i) tv[i] = tn[i];
    }
}

struct Args { const float* in[15]; float* out; unsigned char* ws; };
template <int OFF> __device__ __forceinline__ unsigned long long karg() { unsigned long long v; auto ka = __builtin_amdgcn_kernarg_segment_ptr();
    asm volatile("s_load_dwordx2 %0, %1, %2\n\ts_waitcnt lgkmcnt(0)" : "=s"(v) : "s"(ka), "n"(OFF) : "memory"); return v; }
#define ARG_IN(k) ((const float*)(const GAS float*)karg<8 * (k)>())
#define ARG_OUT() ((float*)(GAS float*)karg<120>())
#define ARG_WS() ((unsigned char*)(GAS unsigned char*)karg<128>())

template <int CTRL> __device__ __forceinline__ float dpp_mov(float s) { return __builtin_bit_cast(float, __builtin_amdgcn_update_dpp(0, __builtin_bit_cast(int, s), CTRL, 0xF, 0xF, true)); }
__device__ __forceinline__ void swap16(float& a, float& b) { asm("s_nop 1\n\tv_permlane16_swap_b32 %0, %1" : "+v"(a), "+v"(b)); }
__device__ __forceinline__ void swap32(float& a, float& b) { asm("s_nop 1\n\tv_permlane32_swap_b32 %0, %1" : "+v"(a), "+v"(b)); }
__device__ __forceinline__ float fast_wave_sum(float v) {
    v += dpp_mov<0xB1>(v); v += dpp_mov<0x4E>(v); v += dpp_mov<0x141>(v); v += dpp_mov<0x140>(v);
    { float w = v; swap16(v, w); v += w; } { float w = v; swap32(v, w); v += w; }
    return v;
}
__device__ __forceinline__ float fast_wave_max(float v) {
    v = fmaxf(v, dpp_mov<0xB1>(v)); v = fmaxf(v, dpp_mov<0x4E>(v)); v = fmaxf(v, dpp_mov<0x141>(v)); v = fmaxf(v, dpp_mov<0x140>(v));
    { float w = v; swap16(v, w); v = fmaxf(v, w); } { float w = v; swap32(v, w); v = fmaxf(v, w); }
    return v;
}
__device__ __forceinline__ float reduce8(float (&a)[8], int lane) {
    float b[4], c[2];
#pragma unroll
    for (int k = 0; k < 4; ++k) { float x = a[k], y = a[k + 4]; swap32(x, y); b[k] = x + y; }
#pragma unroll
    for (int k = 0; k < 2; ++k) { float x = b[k], y = b[k + 2]; swap16(x, y); c[k] = x + y; }
    const bool hi = (lane & 8) != 0;
    const float keep = hi ? c[1] : c[0], send = hi ? c[0] : c[1];
    float d = keep + dpp_mov<0x140>(send);
    d += dpp_mov<0x141>(d); d += dpp_mov<0xB1>(d); d += dpp_mov<0x4E>(d);
    return d;
}
template <int W, class HT>
__device__ __forceinline__ void pool_chan(const bf16_t* xp  , const HT* hp  , int s0, const LAS float* inv  , bf16_t* pp  ) {
    f32x2 hist[W]; f32x2 S = {0.f, 0.f};
#pragma unroll
    for (int j = 0; j < W; ++j) hist[j] = (f32x2){0.f, 0.f};
    if (s0 > 0) {
#pragma unroll
        for (int j = 1; j < W; ++j) { const int t = j - W; const f32x2 v = ld2(hp + (ptrdiff_t)t * D) * inv[15 + t]; hist[j] = v; S += v; }
    }
    for (int tb = 0; tb < 256; tb += 64) {
        unsigned raw[64];
#pragma unroll
        for (int j = 0; j < 64; ++j) raw[j] = *(const GAS unsigned*)(xp + (size_t)(tb + j) * D);
#pragma unroll
        for (int j = 0; j < 64; ++j) { const int t = tb + j; const f32x2 xv = (f32x2){bf_lo(raw[j]), bf_hi(raw[j])} * inv[15 + t]; S += xv - hist[j % W]; hist[j % W] = xv;
            const int pos = s0 + t + 1; const float rc = (pos >= W) ? (1.0f / W) : (1.0f / (float)pos);
            const f32x2 p = S * rc - xv; *(GAS unsigned*)(pp + (size_t)t * D) = cvtpk(p.x, p.y); }
    }
}
template <bool FIRST>
__device__ __forceinline__ void pool_prep_phase(const float* xin, bf16_t* xb, bf16_t* P, LAS unsigned char* lds, int G, int wave_s) {
    const int tid = fresh_tid(wave_s); const int lane = tid & 63, wave = __builtin_amdgcn_readfirstlane(tid >> 6);
    LAS float* inv = (LAS float*)lds;
    for (int tile = blockIdx.x; tile < M / 256; tile += G) {
        const int r0 = tile * 256, s0 = r0 % SEQ;
        const int start = (s0 > 0) ? -15 : 0;
        for (int base = start + wave; base < 256; base += 8 * NWAVES) {
            typename Raw4<float>::t vf[8][4]; typename Raw4<bf16_t>::t vb[8][4];
#pragma unroll
            for (int k = 0; k < 8; ++k) { int rr = base + k * NWAVES; rr = rr < 256 ? rr : 255;
                if (FIRST) { const float* xr = xin + (size_t)(r0 + rr) * D + 4 * lane;
#pragma unroll
                    for (int j = 0; j < 4; ++j) vf[k][j] = ldraw4(xr + 256 * j); }
                else { const bf16_t* xr = xb + (size_t)(r0 + rr) * D + 4 * lane;
#pragma unroll
                    for (int j = 0; j < 4; ++j) vb[k][j] = ldraw4(xr + 256 * j); } }
#pragma unroll
            for (int k = 0; k < 8; ++k) { const int rr = base + k * NWAVES; float s = 0.f; f32x4 v[4];
#pragma unroll
                for (int j = 0; j < 4; ++j) { if (FIRST) v[j] = cvt4(vf[k][j]); else v[j] = cvt4(vb[k][j]); s += (v[j].x * v[j].x + v[j].y * v[j].y) + (v[j].z * v[j].z + v[j].w * v[j].w); }
                s = fast_wave_sum(s);
                if (rr < 256) {
                    if (lane == 0) inv[15 + rr] = 1.0f / sqrtf(s * (1.0f / D) + RMS_EPS);
                    if (FIRST && rr >= 0) { GAS u32x2* xo = (GAS u32x2*)(xb + (size_t)(r0 + rr) * D) + lane;
#pragma unroll
                        for (int j = 0; j < 4; ++j) { u32x2 w; w.x = cvtpk(v[j].x, v[j].y); w.y = cvtpk(v[j].z, v[j].w); xo[64 * j] = w; } } } }
        }
        __syncthreads();
        const int c = 2 * tid; const bf16_t* xp = xb + (size_t)r0 * D + c; bf16_t* pp = P + (size_t)r0 * D + c;
        const int grp = wave >> 1;
        if (FIRST) { const float* hp = xin + (size_t)r0 * D + c;
            if (grp == 0) pool_chan<2, float>(xp, hp, s0, inv, pp); else if (grp == 1) pool_chan<4, float>(xp, hp, s0, inv, pp); else if (grp == 2) pool_chan<8, float>(xp, hp, s0, inv, pp); else pool_chan<16, float>(xp, hp, s0, inv, pp); }
        else { if (grp == 0) pool_chan<2, bf16_t>(xp, xp, s0, inv, pp); else if (grp == 1) pool_chan<4, bf16_t>(xp, xp, s0, inv, pp); else if (grp == 2) pool_chan<8, bf16_t>(xp, xp, s0, inv, pp); else pool_chan<16, bf16_t>(xp, xp, s0, inv, pp); }
        __syncthreads();
    }
}

template <bool COMBINE, bool ROUTER, bool FINAL, int OUTK, bool DELTA, class XT>
__device__ __forceinline__ void norm_phase(float* x, bf16_t* XN, const bf16_t* YS, const int* slot_of, const float* gvec  , const float* wr  ,
                                           int* route_e, float* route_g, int* tilecnt, LAS unsigned char* lds, LAS int* cnt_l, int G, int wave_s, float* ascale, const bf16_t* DL, const XT* xs  , bf16_t* xw  ) {
    const int tid = fresh_tid(wave_s); const int lane = tid & 63, wave = __builtin_amdgcn_readfirstlane(tid >> 6);
    f32x2 wreg[8][8];
    if (ROUTER) {
#pragma unroll
        for (int j = 0; j < 4; ++j)
#pragma unroll
            for (int k = 0; k < 4; ++k) { const int c = 4 * lane + 256 * j + k; const float gc = gvec[c]; const f32x4 w0 = *(const f32x4*)(wr + (size_t)c * 8), w1 = *(const f32x4*)(wr + (size_t)c * 8 + 4);
#pragma unroll
                for (int e = 0; e < 4; ++e) { wreg[e][2 * j + (k >> 1)][k & 1] = w0[e] * gc; wreg[e + 4][2 * j + (k >> 1)][k & 1] = w1[e] * gc; } }
    }
    f32x4 gf[4];
    if (FINAL) {
#pragma unroll
        for (int j = 0; j < 4; ++j) gf[j] = *((const f32x4*)gvec + lane + 64 * j);
    }
    for (int tile = blockIdx.x; tile < M / 256; tile += G) {
        const int rb = tile * 256 + wave * 32;
        int slv = 0; if (COMBINE) slv = slot_of[2 * rb + lane];
        u32x2 nx[2][4], na[2][4], nb[2][4];
#define NP_LOAD(u, idx) do { const GAS u32x2* p_ = (const GAS u32x2*)((const bf16_t*)xs + (size_t)(rb + (idx)) * D) + lane; \
            _Pragma("unroll") for (int j = 0; j < 4; ++j) nx[u][j] = p_[64 * j]; \
            if (COMBINE) { const int a0_ = __builtin_amdgcn_readlane(slv, 2 * (idx)), a1_ = __builtin_amdgcn_readlane(slv, 2 * (idx) + 1); \
                const GAS u32x2* y0_ = (const GAS u32x2*)(YS + (size_t)a0_ * D) + lane; const GAS u32x2* y1_ = (const GAS u32x2*)(YS + (size_t)a1_ * D) + lane; \
                _Pragma("unroll") for (int j = 0; j < 4; ++j) { na[u][j] = y0_[64 * j]; nb[u][j] = y1_[64 * j]; } } } while (0)
        NP_LOAD(0, 0); NP_LOAD(1, 1);
        for (int i = 0; i < 32; i += 2) {
            f32x4 v[2][4];
#pragma unroll
            for (int u = 0; u < 2; ++u)
#pragma unroll
                for (int j = 0; j < 4; ++j) { const u32x2 d = nx[u][j]; v[u][j] = (f32x4){bf_lo(d.x), bf_hi(d.x), bf_lo(d.y), bf_hi(d.y)}; }
            if (COMBINE) {
#pragma unroll
                for (int u = 0; u < 2; ++u)
#pragma unroll
                    for (int w = 0; w < 2; ++w) { const int sl = __builtin_amdgcn_readlane(slv, 2 * (i + u) + w);
                        if (sl < 2 * M) {
#pragma unroll
                            for (int j = 0; j < 4; ++j) { const u32x2 a = w ? nb[u][j] : na[u][j]; v[u][j] += (f32x4){bf_lo(a.x), bf_hi(a.x), bf_lo(a.y), bf_hi(a.y)}; } }
                        else {
                            for (int q = 0; q < 7; ++q) { const GAS u32x2* yq = (const GAS u32x2*)(DL + ((size_t)q * (8 * 256) + (size_t)(sl - 2 * M)) * D) + lane;
#pragma unroll
                                for (int j = 0; j < 4; ++j) { const u32x2 a = yq[64 * j]; v[u][j] += (f32x4){bf_lo(a.x), bf_hi(a.x), bf_lo(a.y), bf_hi(a.y)}; } } } } }
            if (i + 2 < 32) { NP_LOAD(0, i + 2); NP_LOAD(1, i + 3); }
#pragma unroll
            for (int u = 0; u < 2; ++u) {
                const int r = rb + i + u;
                if (COMBINE && !FINAL) { GAS u32x2* xo = (GAS u32x2*)(xw + (size_t)r * D) + lane;
#pragma unroll
                    for (int j = 0; j < 4; ++j) { u32x2 w; w.x = cvtpk(v[u][j].x, v[u][j].y); w.y = cvtpk(v[u][j].z, v[u][j].w); xo[64 * j] = w; } }
                float s = 0.f;
#pragma unroll
                for (int j = 0; j < 4; ++j) s += (v[u][j].x * v[u][j].x + v[u][j].y * v[u][j].y) + (v[u][j].z * v[u][j].z + v[u][j].w * v[u][j].w);
                float lgp[8];
                if (ROUTER) {
#pragma unroll
                    for (int e = 0; e < 8; ++e) { f32x2 a2 = {0.f, 0.f};
#pragma unroll
                        for (int j = 0; j < 4; ++j) { a2 += (f32x2){v[u][j].x, v[u][j].y} * wreg[e][2 * j] ; a2 += (f32x2){v[u][j].z, v[u][j].w} * wreg[e][2 * j + 1]; }
                        lgp[e] = a2.x + a2.y; }
                }
                const float inv = 1.0f / sqrtf(fast_wave_sum(s) * (1.0f / D) + RMS_EPS);
#pragma unroll
                for (int j = 0; j < 4; ++j) v[u][j] = v[u][j] * inv;
                if (FINAL) { GAS f32x4* xr = (GAS f32x4*)(x + (size_t)r * D) + lane;
#pragma unroll
                    for (int j = 0; j < 4; ++j) xr[64 * j] = v[u][j] * gf[j];
                } else if (OUTK == 2) {
                    float mx = 0.f;
#pragma unroll
                    for (int j = 0; j < 4; ++j) mx = fmaxf(fmaxf(mx, fmaxf(fabsf(v[u][j].x), fabsf(v[u][j].y))), fmaxf(fabsf(v[u][j].z), fabsf(v[u][j].w)));
                    mx = fast_wave_max(mx); const float q = mx > 0.f ? 127.0f / mx : 0.f;
                    GAS unsigned* o = (GAS unsigned*)((unsigned char*)XN + (size_t)r * D) + lane;
#pragma unroll
                    for (int j = 0; j < 4; ++j) o[64 * j] = pk4_i8(v[u][j].x * q, v[u][j].y * q, v[u][j].z * q, v[u][j].w * q);
                    if (lane == 0) ascale[r] = mx * (1.0f / 127.0f);
                } else if (OUTK == 1) {
                    GAS unsigned* o = (GAS unsigned*)((unsigned char*)XN + (size_t)r * D) + lane;
#pragma unroll
                    for (int j = 0; j < 4; ++j) o[64 * j] = pk4_fp8(v[u][j].x, v[u][j].y, v[u][j].z, v[u][j].w);
                } else {
                    GAS u32x2* o = (GAS u32x2*)(XN + (size_t)r * D) + lane;
#pragma unroll
                    for (int j = 0; j < 4; ++j) { u32x2 w; w.x = cvtpk(v[u][j].x, v[u][j].y); w.y = cvtpk(v[u][j].z, v[u][j].w); o[64 * j] = w; }
                }
                if (ROUTER) {
                    const float dsum = reduce8(lgp, lane) * inv;
                    float lg[8];
#pragma unroll
                    for (int e = 0; e < 8; ++e) lg[e] = __builtin_bit_cast(float, __builtin_amdgcn_readlane(__builtin_bit_cast(int, dsum), 8 * e));
                    int e0 = 0; float v0 = lg[0];
#pragma unroll
                    for (int e = 1; e < 8; ++e) if (lg[e] > v0) { v0 = lg[e]; e0 = e; }
                    int e1 = -1; float v1 = -3.0e38f;
#pragma unroll
                    for (int e = 0; e < 8; ++e) if (e != e0 && lg[e] > v1) { v1 = lg[e]; e1 = e; }
                    const float ex = __expf(v1 - v0), g0 = 1.0f / (1.0f + ex), g1 = ex * g0;
                    if (lane == 0) { route_e[r] = e0 | (e1 << 8); route_g[2 * r] = g0; route_g[2 * r + 1] = g1; atomicAdd((int*)(cnt_l + e0), 1); atomicAdd((int*)(cnt_l + e1), 1); }
                }
            }
        }
#undef NP_LOAD
        if (ROUTER) {
            __syncthreads();
            if (tid < 8) { tilecnt[tile * 8 + tid] = cnt_l[tid]; cnt_l[tid] = 0; }
            __syncthreads();
        }
    }
}

template <bool FP8>
__device__ __forceinline__ void dispatch_phase(const int* tilecnt, const int* route_e, const float* route_g, int* slot_of, float* gate_slot, const bf16_t* XN, bf16_t* XS  ,
                                               LAS unsigned char* lds, LAS int* pend, int G, int wave_s) {
    const int tid = fresh_tid(wave_s); const int lane = tid & 63, wave = __builtin_amdgcn_readfirstlane(tid >> 6);
    LAS int* lc = (LAS int*)lds;
    LAS int* tot_l = (LAS int*)(lds + 8192);
    LAS int* pst_l = (LAS int*)(lds + 8192 + 32);
    LAS int* base_l = (LAS int*)(lds + 8192 + 64);
    LAS int* slot_l = (LAS int*)(lds + 8192 + 128);
    if (tid < 256) { const i32x4 a = *((const i32x4*)tilecnt + 2 * tid), b = *((const i32x4*)tilecnt + 2 * tid + 1); *((LAS i32x4*)lc + 2 * tid) = a; *((LAS i32x4*)lc + 2 * tid + 1) = b; }
    __syncthreads();
    if (tid < 8) { int t = 0; for (int i = 0; i < 256; ++i) t += lc[i * 8 + tid]; tot_l[tid] = t; }
    __syncthreads();
    if (tid == 0) { int ps = 0; for (int e = 0; e < 8; ++e) { const int padded = (tot_l[e] + 255) & ~255; pst_l[e] = ps; ps += padded; pend[e] = ps >> 8; } }
    __syncthreads();
    if (FP8 && blockIdx.x < 8) { const int e = blockIdx.x, t0 = pst_l[e] + tot_l[e], npad = ((tot_l[e] + 255) & ~255) - tot_l[e];
        for (int i = tid; i < npad; i += NTHREADS) ((int*)XS)[t0 + i] = 0; }
    for (int tile = blockIdx.x; tile < M / 256; tile += G) {
        const int r0 = tile * 256;
        if (tid < 8) { int pre = 0; for (int i = 0; i < tile; ++i) pre += lc[i * 8 + tid]; base_l[tid] = pst_l[tid] + pre; }
        __syncthreads();
        if (wave == 0) {
            int run[8];
#pragma unroll
            for (int e = 0; e < 8; ++e) run[e] = 0;
            for (int ch = 0; ch < 8; ++ch) {
                const int i = ch * 64 + lane, tok = r0 + (i >> 1), k = i & 1;
                const int ew = __hip_atomic_load(route_e + tok, RLX_AGENT); const int e = (ew >> (8 * k)) & 0xff;
                int slot = 0;
#pragma unroll
                for (int ee = 0; ee < 8; ++ee) { const unsigned long long mask = __ballot(e == ee);
                    if (e == ee) slot = base_l[ee] + run[ee] + __popcll(mask & ((1ull << lane) - 1ull));
                    run[ee] += __popcll(mask); }
                slot_l[i] = slot; slot_of[2 * tok + k] = slot; gate_slot[slot] = __hip_atomic_load(route_g + 2 * tok + k, RLX_AGENT); if (FP8) ((int*)XS)[slot] = tok;
            }
        }
        __syncthreads();
        if constexpr (!FP8) {
        for (int ii = 0; ii < 64; ii += 4) {
            u32x4 a[4][2];
#pragma unroll
            for (int q = 0; q < 4; ++q) { const int i = wave * 64 + ii + q; const GAS u32x4* src = (const GAS u32x4*)(XN + (size_t)(r0 + (i >> 1)) * D) + lane; a[q][0] = src[0]; a[q][1] = src[64]; }
#pragma unroll
            for (int q = 0; q < 4; ++q) { const int i = wave * 64 + ii + q; GAS u32x4* dst = (GAS u32x4*)(XS + (size_t)slot_l[i] * D) + lane; dst[0] = a[q][0]; dst[64] = a[q][1]; }
        }
        }
        __syncthreads();
    }
}

#define ATT_LOAD(KF, VF, kt_) do { const int k0_ = (kt_) * 32; \
        const GAS u32x4* kp_ = (const GAS u32x4*)(Kb + (rowbase + k0_ + n) * D + h * 64 + 8 * hh); \
        _Pragma("unroll") for (int s_ = 0; s_ < 4; ++s_) KF[s_] = __builtin_bit_cast(bf16x8, kp_[2 * s_]); \
        _Pragma("unroll") for (int dt_ = 0; dt_ < 2; ++dt_) { const GAS u32x4* vp_ = (const GAS u32x4*)(Vt + (size_t)(h * 64 + dt_ * 32 + n) * M + rowbase + k0_ + 8 * hh); \
            _Pragma("unroll") for (int s_ = 0; s_ < 2; ++s_) VF[dt_][s_] = __builtin_bit_cast(bf16x8, vp_[2 * s_]); } } while (0)
constexpr float ATT_STOP = 9.0e-14f;
template <bool DIAG>
__device__ __forceinline__ void att_tile(const bf16x8 (&kf)[4], const bf16x8 (&vf)[2][2], const bf16x8 (&qf)[4], f32x16& o0, f32x16& o1, float& carry, int n, int hh) {
    f32x16 sc = __builtin_amdgcn_mfma_f32_32x32x16_bf16(kf[0], qf[0], (f32x16){0.f, 0.f, 0.f, 0.f, 0.f, 0.f, 0.f, 0.f, 0.f, 0.f, 0.f, 0.f, 0.f, 0.f, 0.f, 0.f}, 0, 0, 0);
#pragma unroll
    for (int s = 1; s < 4; ++s) sc = __builtin_amdgcn_mfma_f32_32x32x16_bf16(kf[s], qf[s], sc, 0, 0, 0);
    float be[16], kp[16];
#pragma unroll
    for (int r = 0; r < 16; r += 2) { f32x2 e; e.x = __builtin_amdgcn_exp2f(-__builtin_amdgcn_fmed3f(sc[r], -64.f, 3.0e38f)); e.y = __builtin_amdgcn_exp2f(-__builtin_amdgcn_fmed3f(sc[r + 1], -64.f, 3.0e38f));
        const f32x2 d = e + 1.0f; f32x2 b2; b2.x = __builtin_amdgcn_rcpf(d.x); b2.y = __builtin_amdgcn_rcpf(d.y); const f32x2 k2 = e * b2;
        be[r] = b2.x; be[r + 1] = b2.y; kp[r] = k2.x; kp[r + 1] = k2.y; }
    if constexpr (DIAG) {
#pragma unroll
        for (int r = 0; r < 16; ++r) { const int key = (r & 3) + 8 * (r >> 2) + 4 * hh; if (key >= n) { be[r] = 0.f; kp[r] = 1.f; } } }
    float T[4], Pp[4], p2[4], p1[4], p0[4];
#pragma unroll
    for (int g = 0; g < 4; ++g) { p2[g] = kp[4 * g + 3]; p1[g] = p2[g] * kp[4 * g + 2]; p0[g] = p1[g] * kp[4 * g + 1]; T[g] = p0[g] * kp[4 * g]; }
#pragma unroll
    for (int g = 0; g < 4; ++g) Pp[g] = __shfl_xor(T[g], 32);
    float off[4];
    { const float own2 = T[3], own1 = T[3] * T[2], own0 = own1 * T[1];
      const float pe2 = Pp[3], pe1 = Pp[3] * Pp[2], pe0 = pe1 * Pp[1];
      if (hh == 0) { off[0] = own0 * pe0 * Pp[0]; off[1] = own1 * pe1 * Pp[1]; off[2] = own2 * pe2 * Pp[2]; off[3] = Pp[3]; }
      else         { off[0] = own0 * pe0;         off[1] = own1 * pe1;         off[2] = own2 * pe2;         off[3] = 1.f; } }
    float a[16];
#pragma unroll
    for (int g = 0; g < 4; ++g) { const float base = carry * off[g];
        a[4 * g + 0] = be[4 * g + 0] * (base * p0[g]); a[4 * g + 1] = be[4 * g + 1] * (base * p1[g]); a[4 * g + 2] = be[4 * g + 2] * (base * p2[g]); a[4 * g + 3] = be[4 * g + 3] * base; }
    carry *= ((T[0] * T[1]) * (T[2] * T[3])) * ((Pp[0] * Pp[1]) * (Pp[2] * Pp[3]));
    bf16x8 pb[2];
#pragma unroll
    for (int s = 0; s < 2; ++s) { u32x4 w; w.x = cvtpk(a[8 * s + 0], a[8 * s + 1]); w.y = cvtpk(a[8 * s + 2], a[8 * s + 3]); w.z = cvtpk(a[8 * s + 4], a[8 * s + 5]); w.w = cvtpk(a[8 * s + 6], a[8 * s + 7]); pb[s] = __builtin_bit_cast(bf16x8, w); }
#pragma unroll
    for (int s = 0; s < 2; ++s) { o0 = __builtin_amdgcn_mfma_f32_32x32x16_bf16(vf[0][s], pb[s], o0, 0, 0, 0); o1 = __builtin_amdgcn_mfma_f32_32x32x16_bf16(vf[1][s], pb[s], o1, 0, 0, 0); }
}
constexpr int ATT_KROW = 144, ATT_VROW = 784, ATT_V_OFF = 384 * ATT_KROW;
static_assert(ATT_V_OFF + 64 * ATT_VROW <= STAGE_BYTES_LDS, "attention LDS image");
__device__ __forceinline__ void attn_phase(const bf16_t* Q, const bf16_t* Kb, const bf16_t* Vt, bf16_t* O, LAS unsigned char* lds, int vcu, int G, int wave_s, int u_begin, int NU  ) {
    const int tid = fresh_tid(wave_s); const int lane = tid & 63, wave = __builtin_amdgcn_readfirstlane(tid >> 6);
    const int n = lane & 31, hh = lane >> 5;
    const int per = (NU + G - 1) / G;
    const int u_lo = u_begin + vcu * per, u_hi = (vcu * per + per < NU) ? u_lo + per : u_begin + NU;
    u32x4 pk[6], pv[6];
#define ATT_FETCH(uu) do { const int bh_ = (uu) >> 3, qb_ = (uu) & 7, h_ = bh_ & 15, b_ = bh_ >> 4; const int kw0_ = qb_ > 0 ? qb_ * 256 - 128 : 0, nk_ = qb_ * 256 + 256 - kw0_; \
        const size_t rb_ = (size_t)b_ * SEQ; \
        _Pragma("unroll") for (int i_ = 0; i_ < 6; ++i_) { const int p_ = tid + i_ * NTHREADS; const int kr_ = p_ >> 3, kc_ = p_ & 7; \
            if (kr_ < nk_) pk[i_] = *(const GAS u32x4*)(Kb + (rb_ + kw0_ + kr_) * D + h_ * 64 + kc_ * 8); \
            const int vd_ = p_ / 48, vc_ = p_ - vd_ * 48; \
            if (vc_ * 8 < nk_) pv[i_] = *(const GAS u32x4*)(Vt + (size_t)(h_ * 64 + vd_) * M + rb_ + kw0_ + vc_ * 8); } } while (0)
#define ATT_PUT(uu) do { const int qb_ = (uu) & 7; const int kw0_ = qb_ > 0 ? qb_ * 256 - 128 : 0, nk_ = qb_ * 256 + 256 - kw0_; \
        _Pragma("unroll") for (int i_ = 0; i_ < 6; ++i_) { const int p_ = tid + i_ * NTHREADS; const int kr_ = p_ >> 3, kc_ = p_ & 7; \
            if (kr_ < nk_) *(LAS u32x4*)(lds + kr_ * ATT_KROW + kc_ * 16) = pk[i_]; \
            const int vd_ = p_ / 48, vc_ = p_ - vd_ * 48; \
            if (vc_ * 8 < nk_) *(LAS u32x4*)(lds + ATT_V_OFF + vd_ * ATT_VROW + vc_ * 16) = pv[i_]; } } while (0)
#define ATT_TILE_LD(KF, VF, kt_) do { const int k0_ = (kt_) * 32; if (k0_ >= kw0) { const int ko_ = k0_ - kw0; \
            _Pragma("unroll") for (int s_ = 0; s_ < 4; ++s_) KF[s_] = *(const LAS bf16x8*)(lds + (ko_ + n) * ATT_KROW + 32 * s_ + 16 * hh); \
            _Pragma("unroll") for (int dt_ = 0; dt_ < 2; ++dt_) _Pragma("unroll") for (int s_ = 0; s_ < 2; ++s_) VF[dt_][s_] = *(const LAS bf16x8*)(lds + ATT_V_OFF + (dt_ * 32 + n) * ATT_VROW + (ko_ + 16 * s_ + 8 * hh) * 2); } \
        else { ATT_LOAD(KF, VF, kt_); } } while (0)
    if (u_lo < u_hi) ATT_FETCH(u_lo);
    for (int u = u_lo; u < u_hi; ++u) {
        const int bh = u >> 3, qb = u & 7, h = bh & 15, b = bh >> 4;
        const size_t rowbase = (size_t)b * SEQ; const int kw0 = qb > 0 ? qb * 256 - 128 : 0;
        const int qt = qb * 8 + wave, q0 = qt * 32;
        bf16x8 qf[4];
        { const GAS u32x4* qp = (const GAS u32x4*)(Q + (rowbase + q0 + n) * D + h * 64 + 8 * hh);
#pragma unroll
          for (int s = 0; s < 4; ++s) qf[s] = __builtin_bit_cast(bf16x8, qp[2 * s]); }
        ATT_PUT(u);
        __syncthreads();
        if (u + 1 < u_hi) ATT_FETCH(u + 1);
        f32x16 o0, o1;
#pragma unroll
        for (int r = 0; r < 16; ++r) { o0[r] = 0.f; o1[r] = 0.f; }
        float carry = 1.f;
        bf16x8 kf[4], vf[2][2];
        ATT_TILE_LD(kf, vf, qt);
        att_tile<true>(kf, vf, qf, o0, o1, carry, n, hh);
        if (!__all(carry < ATT_STOP)) for (int kt = qt - 1; kt >= 0; --kt) {
            ATT_TILE_LD(kf, vf, kt);
            att_tile<false>(kf, vf, qf, o0, o1, carry, n, hh);
            if (__all(carry < ATT_STOP)) break;
        }
        bf16_t* op = O + (rowbase + q0 + n) * D + h * 64 + 4 * hh;
#pragma unroll
        for (int g = 0; g < 4; ++g) { u32x2 w0, w1; w0.x = cvtpk(o0[4 * g], o0[4 * g + 1]); w0.y = cvtpk(o0[4 * g + 2], o0[4 * g + 3]); w1.x = cvtpk(o1[4 * g], o1[4 * g + 1]); w1.y = cvtpk(o1[4 * g + 2], o1[4 * g + 3]);
            *(u32x2*)(op + 8 * g) = w0; *(u32x2*)(op + 32 + 8 * g) = w1; }
        __syncthreads();
    }
#undef ATT_FETCH
#undef ATT_PUT
#undef ATT_TILE_LD
}

#define WSP(T, off) ((T*)(ws + (off)))
#ifndef STAG_POOL
#define STAG_POOL 0
#define STAG_PROJ 0
#define STAG_OPROJ 0
#define STAG_DUP 0
#define STAG_MUP 0
#endif
#ifndef ATT_SPLIT
#define ATT_SPLIT 2
#endif
#ifndef PROBE_DUP
#define PROBE_DUP 0
#endif
#define DUP(k) ((PROBE_DUP >> (k)) & 1)
template <int l>
__device__ __forceinline__ void layer_body(LAS unsigned char* lds, const XcdBarrier& bar, LAS int* pend, LAS int* cnt_l, int G, int bx, int vcu, int NGW, int wave_s) {
#define SITE_POOLPREP(GRIDBAR) { { unsigned char* ws = ARG_WS(); pool_prep_phase<l == 0>(ARG_IN(0), WSP(bf16_t, WS_XB), WSP(bf16_t, WS_R), lds, G, wave_s); \
              if constexpr (l == 0 && (INT8_UP0 != 0 || INT8_PROJ != 0)) {     \
                  const int t_ = fresh_tid(wave_s); const int wv_ = __builtin_amdgcn_readfirstlane(t_ >> 6); LAS float* sc_ = (LAS float*)(lds + wv_ * 16384); const int g_ = vcu * NWAVES + wv_; int base_ = 0; \
                  for (int j_ = 0; j_ < 5; ++j_) { if ((j_ == 0 && !I8) || (j_ > 0 && !INT8_PROJ)) continue; \
                      const float* W_; const float* gn_; int ldw_, N_; float mul_ = 1.0f; bool gu_ = false; size_t dst_; const unsigned* cm_; float* wsc_; \
                      if (j_ == 0) { W_ = ARG_IN(9); gn_ = ARG_IN(2); ldw_ = 2 * DFF; N_ = 2 * DFF; gu_ = true; dst_ = WS_WFI; cm_ = WSP(unsigned, WS_COLMAX); wsc_ = WSP(float, WS_WSCALE); } \
                      else if (j_ < 3) { W_ = ARG_IN(6) + (j_ - 1) * 1024; gn_ = ARG_IN(5); ldw_ = 2048; N_ = 1024; dst_ = (j_ == 1) ? WS_WK : WS_WV; cm_ = WSP(unsigned, WS_COLMAX2) + (j_ - 1) * 1024; wsc_ = WSP(float, WS_WSCALE2) + (j_ - 1) * 1024; } \
                      else { const int b_ = j_ - 3; W_ = ARG_IN(7) + (size_t)b_ * D * D; gn_ = ARG_IN(1) + (2 + b_) * D; ldw_ = 1024; N_ = 1024; mul_ = 0.125f * 1.4426950408889634f; dst_ = WS_WQ + (size_t)b_ * D * D * 2; cm_ = WSP(unsigned, WS_COLMAX2) + (2 + b_) * 1024; wsc_ = WSP(float, WS_WSCALE2) + (2 + b_) * 1024; } \
                      int first_ = (g_ - base_) % NGW; if (first_ < 0) first_ += NGW; \
                      tr_mat(W_, ldw_, D, N_, gn_, mul_, 2, gu_, ws + dst_, sc_, first_, NGW, t_ & 63, cm_, wsc_); base_ = (base_ + (D / 64) * (N_ / 32)) % NGW; } } } \
          if (GRIDBAR) xcd_barrier(bar, wave_s); \
          else {   \
              __syncthreads(); \
              if constexpr (l == 1) { if (fresh_tid(wave_s) == 0) { unsigned* fl_ = (unsigned*)(ARG_WS() + WS_HALO_FLAGS); __hip_atomic_store(fl_ + blockIdx.x, 1u, __ATOMIC_RELEASE, __HIP_MEMORY_SCOPE_AGENT); \
                      const int nb_ = (int)blockIdx.x + 1; if (nb_ < M / 256 && (nb_ % (SEQ / 256)) != 0) { unsigned sp_ = 0; while (__hip_atomic_load(fl_ + nb_, __ATOMIC_ACQUIRE, __HIP_MEMORY_SCOPE_AGENT) == 0u) { __builtin_amdgcn_s_sleep(1); if (++sp_ > (1u << 24)) break; } } } \
                  __syncthreads(); } } }
#define SITE_POOLGEMM(MUL, GRIDBAR) { { unsigned char* ws = ARG_WS(); \
              pg8::GemmK g{256, 1024, 256}; pg8::PoolOrder S{G, bx, (const char*)WSP(bf16_t, WS_R), (const char*)(WSP(bf16_t, WS_WPOOL) + (size_t)l * 4 * 65536)}; \
              pg8::EpiResidB E{WSP(bf16_t, WS_XB), ARG_IN(4) + l * D, MUL}; \
              pg8::gemm_phase<pg8::EpiResidB, pg8::PoolOrder, true>(lds, g, S, E, wave_s, STAG_POOL); } if (GRIDBAR) xcd_barrier(bar, wave_s); else __syncthreads(); }
#define SITE_PROJ(SP) { { unsigned char* ws = ARG_WS(); \
              if constexpr (INT8_PROJ != 0) { pg8::GemmK g{512, 512, 512}; pg8::ProjOrder S{(l == 2) ? 3 : 1, G, bx, ATT_SPLIT, SP, (const char*)ws, (size_t)(l - 2) * D * D * 2, (size_t)256 * 1024}; \
                pg8::EpiProjI8 E{WSP(bf16_t, WS_K), WSP(bf16_t, WS_R), WSP(bf16_t, WS_VT), WSP(float, WS_ASCALE), WSP(float, WS_WSCALE2), l - 2}; \
                pg8::gemm_phase<pg8::EpiProjI8, pg8::ProjOrder, true, 2>(lds, g, S, E, wave_s, STAG_PROJ); } \
              else { pg8::GemmK g{1024, 1024, 1024}; pg8::ProjOrder S{(l == 2) ? 3 : 1, G, bx, ATT_SPLIT, SP, (const char*)ws, (size_t)(l - 2) * D * D * 2, (size_t)256 * 1024 * 2}; \
                pg8::EpiProj E{WSP(bf16_t, WS_K), WSP(bf16_t, WS_R), WSP(bf16_t, WS_VT)}; \
                pg8::gemm_phase<pg8::EpiProj, pg8::ProjOrder, true>(lds, g, S, E, wave_s); } } xcd_barrier(bar, wave_s); }
#define SITE_ATTN(SP) { { unsigned char* ws = ARG_WS(); attn_phase(WSP(bf16_t, WS_R), WSP(bf16_t, WS_K), WSP(bf16_t, WS_VT), WSP(bf16_t, WS_R) + (size_t)M * D, lds, vcu, G, wave_s, (SP) * (BATCH * NH * (SEQ / 256) / ATT_SPLIT), BATCH * NH * (SEQ / 256) / ATT_SPLIT); } xcd_barrier(bar, wave_s); }
#define SITE_OPROJ(MUL) { { unsigned char* ws = ARG_WS(); \
              pg8::GemmK g{1024, 1024, 1024}; pg8::DenseOrder S{M / 256, 4, G, bx, (const char*)(WSP(bf16_t, WS_R) + (size_t)M * D), (const char*)(WSP(bf16_t, WS_WO) + (size_t)(l - 2) * D * D), (size_t)256 * 1024 * 2, (size_t)256 * 1024 * 2}; \
              pg8::EpiResidB E{WSP(bf16_t, WS_XB), nullptr, MUL}; \
              pg8::gemm_phase<pg8::EpiResidB, pg8::DenseOrder, true>(lds, g, S, E, wave_s, STAG_OPROJ); } xcd_barrier(bar, wave_s); }
#define SITE_NORMX(OUTK_, DELTA_) { { unsigned char* ws = ARG_WS(); \
              norm_phase<false, false, false, OUTK_, false, bf16_t>(nullptr, WSP(bf16_t, WS_XN), nullptr, nullptr, nullptr, nullptr, nullptr, nullptr, nullptr, lds, cnt_l, G, wave_s, WSP(float, WS_ASCALE), nullptr, (const bf16_t*)WSP(bf16_t, WS_XB), nullptr); } xcd_barrier(bar, wave_s); }
#define SITE_NORMI8() { { unsigned char* ws = ARG_WS(); norm_phase<false, false, false, 2, false, bf16_t>(nullptr, WSP(bf16_t, WS_XN), nullptr, nullptr, nullptr, nullptr, nullptr, nullptr, nullptr, lds, cnt_l, G, wave_s, WSP(float, WS_ASCALE), nullptr, (const bf16_t*)WSP(bf16_t, WS_XB), nullptr); } xcd_barrier(bar, wave_s); }
#define SITE_NORM8() { { unsigned char* ws = ARG_WS(); norm_phase<false, false, false, 1, false, bf16_t>(nullptr, WSP(bf16_t, WS_XN), nullptr, nullptr, nullptr, nullptr, nullptr, nullptr, nullptr, lds, cnt_l, G, wave_s, nullptr, nullptr, (const bf16_t*)WSP(bf16_t, WS_XB), nullptr); } xcd_barrier(bar, wave_s); }
#define SITE_NORM() { { unsigned char* ws = ARG_WS(); norm_phase<false, false, false, 0, false, bf16_t>(nullptr, WSP(bf16_t, WS_XN), nullptr, nullptr, nullptr, nullptr, nullptr, nullptr, nullptr, lds, cnt_l, G, wave_s, nullptr, nullptr, (const bf16_t*)WSP(bf16_t, WS_XB), nullptr); } xcd_barrier(bar, wave_s); }
#define SITE_DUP() { { unsigned char* ws = ARG_WS(); \
              if constexpr (I8) { pg8::GemmK g{512, 512, 512}; pg8::DenseOrder S{M / 256, DFF / 128, G, bx, (const char*)WSP(unsigned char, WS_XN), (const char*)WSP(unsigned char, WS_WFI), (size_t)256 * 1024, (size_t)256 * 1024}; \
                pg8::EpiSwigluI8 E{WSP(bf16_t, WS_R), DFF, WSP(float, WS_ASCALE), WSP(float, WS_WSCALE)}; \
                pg8::gemm_phase<pg8::EpiSwigluI8, pg8::DenseOrder, true, 2>(lds, g, S, E, wave_s, STAG_DUP); } \
              else if constexpr (F8) { pg8::GemmK g{512, 512, 512}; pg8::DenseOrder S{M / 256, DFF / 128, G, bx, (const char*)WSP(unsigned char, WS_XN), (const char*)(WSP(unsigned char, WS_WFI) + (size_t)(l >> 1) * 2 * DFF * D * 2), (size_t)256 * 1024, (size_t)256 * 1024}; \
                pg8::EpiSwiglu8 E{WSP(unsigned char, WS_R), DFF, 1.0f / W8_UP}; \
                pg8::gemm_phase<pg8::EpiSwiglu8, pg8::DenseOrder, true, 1>(lds, g, S, E, wave_s, STAG_DUP); } \
              else { pg8::GemmK g{1024, 1024, 1024}; pg8::DenseOrder S{M / 256, DFF / 128, G, bx, (const char*)WSP(bf16_t, WS_XN), (const char*)(WSP(bf16_t, WS_WFI) + (size_t)(l >> 1) * 2 * DFF * D), (size_t)256 * 1024 * 2, (size_t)256 * 1024 * 2}; \
                pg8::EpiSwiglu E{WSP(bf16_t, WS_R), DFF}; \
                pg8::gemm_phase<pg8::EpiSwiglu, pg8::DenseOrder, true>(lds, g, S, E, wave_s); } } xcd_barrier(bar, wave_s); }
#define SITE_DDOWN(MUL) { { unsigned char* ws = ARG_WS(); \
              if constexpr (F8) { pg8::GemmK g{DFF / 2, DFF / 2, DFF / 2}; pg8::DenseOrder S{M / 256, 4, G, bx, (const char*)WSP(unsigned char, WS_R), (const char*)(WSP(unsigned char, WS_WFO) + (size_t)(l >> 1) * D * DFF * 2), (size_t)256 * DFF, (size_t)256 * DFF}; \
                pg8::EpiResidB E{WSP(bf16_t, WS_XB), nullptr, MUL / (W8_DN * H8_SC)}; \
                pg8::gemm_phase<pg8::EpiResidB, pg8::DenseOrder, true, 1>(lds, g, S, E, wave_s); } \
              else { pg8::GemmK g{DFF, DFF, DFF}; pg8::DenseOrder S{M / 256, 4, G, bx, (const char*)WSP(bf16_t, WS_R), (const char*)(WSP(bf16_t, WS_WFO) + (size_t)(l >> 1) * D * DFF), (size_t)256 * DFF * 2, (size_t)256 * DFF * 2}; \
                pg8::EpiResidB E{WSP(bf16_t, WS_XB), nullptr, MUL}; \
                pg8::gemm_phase<pg8::EpiResidB, pg8::DenseOrder, true>(lds, g, S, E, wave_s); } } xcd_barrier(bar, wave_s); }
#define SITE_ROUTER() { { unsigned char* ws = ARG_WS(); \
              norm_phase<false, true, false, F8 ? 1 : 0, false, bf16_t>(nullptr, WSP(bf16_t, WS_XN), nullptr, nullptr, ARG_IN(2) + l * D, ARG_IN(11) + (size_t)(l >> 1) * D * NE, WSP(int, WS_ROUTE_E), WSP(float, WS_ROUTE_G), WSP(int, WS_TILECNT), lds, cnt_l, G, wave_s, nullptr, WSP(bf16_t, WS_DELTA), (const bf16_t*)WSP(bf16_t, WS_XB), nullptr); } xcd_barrier(bar, wave_s); }
#define SITE_DISPATCH() { { unsigned char* ws = ARG_WS(); \
              dispatch_phase<F8>(WSP(int, WS_TILECNT), WSP(int, WS_ROUTE_E), WSP(float, WS_ROUTE_G), WSP(int, WS_SLOT_OF), WSP(float, WS_GATE_SLOT), WSP(bf16_t, WS_XN), F8 ? WSP(bf16_t, WS_TOS) : WSP(bf16_t, WS_XS), lds, pend, G, wave_s); } xcd_barrier(bar, wave_s); }
#define SITE_MUP() { { unsigned char* ws = ARG_WS(); \
              if constexpr (F8) { pg8::GemmK g{512, 512, 512}; \
                pg8::MoeGatherOrder S{nb, DFFE / 128, G, bx, blk0, (const char*)WSP(unsigned char, WS_XN), (const char*)(WSP(unsigned char, WS_WMI) + (size_t)(l >> 1) * 8 * 2 * DFFE * D * 2), (size_t)256 * 1024, (size_t)2 * DFFE * D, pend, WSP(int, WS_TOS), (LAS int*)(lds + LCTL_OFF + 2048)}; \
                pg8::EpiSwiglu8 E{WSP(unsigned char, WS_R), DFFE, 1.0f / W8_UP}; \
                pg8::gemm_phase<pg8::EpiSwiglu8, pg8::MoeGatherOrder, true, 1, true>(lds, g, S, E, wave_s, STAG_MUP); } \
              else { pg8::GemmK g{1024, 1024, 1024}; \
                pg8::MoeOrder S{nb, DFFE / 128, G, bx, blk0, 0, (const char*)WSP(bf16_t, WS_XS), (const char*)(WSP(bf16_t, WS_WMI) + (size_t)(l >> 1) * 8 * 2 * DFFE * D), (size_t)256 * 1024 * 2, (size_t)256 * 1024 * 2, (size_t)2 * DFFE * D * 2, pend}; \
                pg8::EpiSwiglu E{WSP(bf16_t, WS_R), DFFE}; \
                pg8::gemm_phase<pg8::EpiSwiglu, pg8::MoeOrder, true>(lds, g, S, E, wave_s); } } xcd_barrier(bar, wave_s); }
#define SITE_MDOWN() { { unsigned char* ws = ARG_WS(); \
              if constexpr (F8) { pg8::GemmK g{DFFE / 2, DFFE / 2, DFFE / 2}; \
                const int nbm = nb < pg8::TAIL_B0 ? nb : pg8::TAIL_B0;     \
                pg8::MoeOrder S{nbm, 4, G, bx, blk0, 1, (const char*)WSP(unsigned char, WS_R), (const char*)(WSP(unsigned char, WS_WMO) + (size_t)(l >> 1) * 8 * D * DFFE * 2), (size_t)256 * DFFE, (size_t)256 * DFFE, (size_t)D * DFFE, pend}; \
                pg8::EpiMoeDown E{WSP(bf16_t, WS_XS), WSP(float, WS_GATE_SLOT), 1.0f / (W8_DN * H8_SC)}; \
                pg8::gemm_phase<pg8::EpiMoeDown, pg8::MoeOrder, true, 1>(lds, g, S, E, wave_s); \
                if (nb > pg8::TAIL_B0) { pg8::GemmK g2{DFFE / (2 * pg8::TAIL_KS), DFFE / 2, DFFE / 2}; \
                  pg8::MoeTailOrder S2{nb - pg8::TAIL_B0, G, bx, (const char*)WSP(unsigned char, WS_R), (const char*)(WSP(unsigned char, WS_WMO) + (size_t)(l >> 1) * 8 * D * DFFE * 2), (size_t)256 * DFFE, (size_t)256 * DFFE, (size_t)D * DFFE, (size_t)(DFFE / pg8::TAIL_KS), pend}; \
                  pg8::EpiMoeDownT E2{WSP(bf16_t, WS_YT), WSP(float, WS_GATE_SLOT), 1.0f / (W8_DN * H8_SC)}; \
                  pg8::gemm_phase<pg8::EpiMoeDownT, pg8::MoeTailOrder, true, 1>(lds, g2, S2, E2, wave_s); } } \
              else { pg8::GemmK g{DFFE, DFFE, DFFE}; \
                pg8::MoeOrder S{nb, 4, G, bx, blk0, 1, (const char*)WSP(bf16_t, WS_R), (const char*)(WSP(bf16_t, WS_WMO) + (size_t)(l >> 1) * 8 * D * DFFE), (size_t)256 * DFFE * 2, (size_t)256 * DFFE * 2, (size_t)D * DFFE * 2, pend}; \
                pg8::EpiMoeDown E{WSP(bf16_t, WS_XS), WSP(float, WS_GATE_SLOT), 1.0f}; \
                pg8::gemm_phase<pg8::EpiMoeDown, pg8::MoeOrder, true>(lds, g, S, E, wave_s); } } xcd_barrier(bar, wave_s); }
    constexpr bool F8 = ((FP8_MASK >> l) & 1) != 0;
    constexpr bool I8 = (INT8_UP0 != 0) && l == 0 && !F8;
    if constexpr (l < 2) {
        const bool chain = (G == M / 256);
        if (DUP(5) || (DUP(7) && l == 1) || (DUP(11) && l == 0)) SITE_POOLPREP(true)
        SITE_POOLPREP(!chain)
        if (DUP(2) || DUP(12)) SITE_POOLGEMM(0.f, true)
        SITE_POOLGEMM(1.f, !chain)
    } else {
        _Pragma("unroll") for (int sp = 0; sp < ATT_SPLIT; ++sp) {
            if (DUP(2) || DUP(13)) SITE_PROJ(sp)
            SITE_PROJ(sp)
            if (DUP(3)) SITE_ATTN(sp)
            SITE_ATTN(sp)
        }
        if (DUP(2) || DUP(14)) SITE_OPROJ(0.f)
        SITE_OPROJ(1.f)
    }
    if constexpr ((l & 1) == 0) {
        if constexpr (I8) { if (DUP(5) || DUP(8)) SITE_NORMX(2, true) SITE_NORMX(2, true) } else if constexpr (F8) { if (DUP(5) || DUP(8)) SITE_NORMX(1, true) SITE_NORMX(1, true) } else { if (DUP(5)) SITE_NORMX(0, true) SITE_NORMX(0, true) }
        if (DUP(1)) SITE_DUP()
        SITE_DUP()
        if (DUP(1)) SITE_DDOWN(0.f)
        SITE_DDOWN(1.f)
        if constexpr (l == 2) { if constexpr (INT8_PROJ != 0) { if (DUP(5) || DUP(8)) SITE_NORMI8() SITE_NORMI8() } else { if (DUP(5)) SITE_NORM() SITE_NORM() } }
    } else {
        if (DUP(5) || DUP(9)) SITE_ROUTER()
        SITE_ROUTER()
        if (DUP(5) || DUP(10)) SITE_DISPATCH()
        SITE_DISPATCH()
        constexpr int CB = F8 ? CAP / 256 : CHUNK_BLKS;
        for (int ch = 0; ch < (F8 ? 1 : 2); ++ch) {
            const int nblk = pend[7];
            const int blk0 = ch * CB; int nb = nblk - blk0; nb = nb < 0 ? 0 : (nb > CB ? CB : nb); nb = __builtin_amdgcn_readfirstlane(nb);
            if (DUP(0)) SITE_MUP()
            SITE_MUP()
            if (DUP(0)) SITE_MDOWN()
            SITE_MDOWN()
        }
        if constexpr (l == 1) { { unsigned char* ws = ARG_WS(); norm_phase<true, false, false, INT8_PROJ ? 2 : 0, false, bf16_t>(nullptr, WSP(bf16_t, WS_XN), WSP(bf16_t, WS_XS), WSP(int, WS_SLOT_OF), nullptr, nullptr, nullptr, nullptr, nullptr, lds, cnt_l, G, wave_s, WSP(float, WS_ASCALE), WSP(bf16_t, WS_DELTA), (const bf16_t*)WSP(bf16_t, WS_XB), WSP(bf16_t, WS_XB)); } xcd_barrier(bar, wave_s); }
        else for (int rep_ = 0; rep_ < 1 + DUP(6); ++rep_) { unsigned char* ws = ARG_WS(); if (rep_) xcd_barrier(bar, wave_s); norm_phase<true, false, true, 0, false, bf16_t>(ARG_OUT(), WSP(bf16_t, WS_XN), WSP(bf16_t, WS_XS), WSP(int, WS_SLOT_OF), ARG_IN(14), nullptr, nullptr, nullptr, nullptr, lds, cnt_l, G, wave_s, nullptr, WSP(bf16_t, WS_DELTA), (const bf16_t*)WSP(bf16_t, WS_XB), nullptr); }
    }
}

__global__ void __launch_bounds__(NTHREADS, 2) yoco_fwd(Args args_unused) {
    extern __shared__ __attribute__((aligned(16))) unsigned char lds_raw[];
    LAS unsigned char* lds = (LAS unsigned char*)lds_raw;
    __builtin_amdgcn_s_setreg((0 << 11) | (23 << 6) | 1, 1u);
    const int G = gridDim.x; const int bx = blockIdx.x; const int wave_s = __builtin_amdgcn_readfirstlane(threadIdx.x >> 6);
    const int vcu = (G % 8 == 0) ? (bx % 8) * (G / 8) + bx / 8 : bx;
    const int NGW = G * NWAVES;
    LAS unsigned* lctl = (LAS unsigned*)(lds + LCTL_OFF);
    for (int u = threadIdx.x; u < (LDS_BYTES - LCTL_OFF) / 4; u += NTHREADS) lctl[u] = 0u;
    __syncthreads();
    volatile LAS unsigned* bar_st = (volatile LAS unsigned*)lctl;
    LAS int* pend = (LAS int*)(lctl + 16);
    LAS int* cnt_l = (LAS int*)(lctl + 32);
    XcdBarrier bar = xcd_barrier_post((unsigned*)(ARG_WS() + WS_CTL) + 1024, bar_st);

    for (int rep = 0; rep < 1 + DUP(4); ++rep) {
        unsigned char* ws = ARG_WS();
        const int tid = fresh_tid(wave_s); const int lane = tid & 63, wave = __builtin_amdgcn_readfirstlane(tid >> 6), gw = vcu * NWAVES + wave;
        LAS float* scr = (LAS float*)(lds + wave * 16384);
        int base = 0;
        for (int j = 0; j < 50; ++j) {
            const float* W; const float* gain = nullptr; int ldw, K, N; float mul = 1.0f; bool f8 = false, gu = false; size_t dst;
            if (j < 8) { W = ARG_IN(3) + (size_t)j * 65536; ldw = 256; K = 256; N = 256; gain = ARG_IN(1) + (j >> 2) * D + (j & 3) * 256; dst = WS_WPOOL + (size_t)j * 65536 * 2; }
            else if (j < 10) { W = ARG_IN(6) + (j - 8) * 1024; ldw = 2048; K = 1024; N = 1024; gain = ARG_IN(5); dst = (j == 8) ? WS_WK : WS_WV; }
            else if (j < 12) { const int b = j - 10; W = ARG_IN(7) + (size_t)b * D * D; ldw = 1024; K = 1024; N = 1024; gain = ARG_IN(1) + (2 + b) * D; mul = 0.125f * 1.4426950408889634f; dst = WS_WQ + (size_t)b * D * D * 2; }
            else if (j < 14) { const int b = j - 12; W = ARG_IN(8) + (size_t)b * D * D; ldw = 1024; K = 1024; N = 1024; dst = WS_WO + (size_t)b * D * D * 2; }
            else if (j < 16) { const int i = j - 14; f8 = ((FP8_MASK >> (2 * i)) & 1) != 0; gu = true; W = ARG_IN(9) + (size_t)i * D * 2 * DFF; ldw = 2 * DFF; K = 1024; N = 2 * DFF; gain = ARG_IN(2) + (2 * i) * D; mul = f8 ? W8_UP : 1.0f; dst = WS_WFI + (size_t)i * 2 * DFF * D * 2; }
            else if (j < 18) { const int i = j - 16; f8 = ((FP8_MASK >> (2 * i)) & 1) != 0; W = ARG_IN(10) + (size_t)i * DFF * D; ldw = 1024; K = DFF; N = 1024; mul = f8 ? W8_DN : 1.0f; dst = WS_WFO + (size_t)i * D * DFF * 2; }
            else if (j < 34) { const int ie = j - 18, li = 2 * (ie >> 3) + 1, e = ie & 7; f8 = ((FP8_MASK >> li) & 1) != 0; gu = true; W = ARG_IN(12) + (size_t)ie * D * 2 * DFFE; ldw = 2 * DFFE; K = 1024; N = 2 * DFFE; gain = ARG_IN(2) + li * D; mul = f8 ? W8_UP : 1.0f;
                               dst = WS_WMI + (size_t)(ie >> 3) * 8 * 2 * DFFE * D * 2 + (size_t)e * 2 * DFFE * D * (f8 ? 1 : 2); }
            else { const int ie = j - 34, li = 2 * (ie >> 3) + 1, e = ie & 7; f8 = ((FP8_MASK >> li) & 1) != 0; W = ARG_IN(13) + (size_t)ie * DFFE * D; ldw = 1024; K = DFFE; N = 1024; mul = f8 ? W8_DN : 1.0f;
                   dst = WS_WMO + (size_t)(ie >> 3) * 8 * D * DFFE * 2 + (size_t)e * D * DFFE * (f8 ? 1 : 2); }
            const int nitems = (K / 64) * (N / 32);
            int first = (gw - base) % NGW; if (first < 0) first += NGW;
            if ((INT8_UP0 && j == 14) || (INT8_PROJ && j >= 8 && j < 12)) continue;
            tr_mat(W, ldw, K, N, gain, mul, f8 ? 1 : 0, gu, ws + dst, scr, first, NGW, lane, nullptr, nullptr, (gu && f8) ? W8_GATE : 0.f);
            base = (base + nitems) % NGW;
        }
    }
    if (INT8_UP0 || INT8_PROJ) {
        unsigned char* ws = ARG_WS(); const int tid = fresh_tid(wave_s); const int lane = tid & 63, gw = vcu * NWAVES + __builtin_amdgcn_readfirstlane(tid >> 6);
        int base = 0;
        for (int j = 0; j < 5; ++j) {
            if ((j == 0 && !INT8_UP0) || (j > 0 && !INT8_PROJ)) continue;
            const GAS float* W; const GAS float* gn; int ldw, ncols; float mul = 1.0f; unsigned* cm;
            if (j == 0) { W = (const GAS float*)ARG_IN(9); gn = (const GAS float*)ARG_IN(2); ldw = 2 * DFF; ncols = 2 * DFF; cm = WSP(unsigned, WS_COLMAX); }
            else if (j < 3) { W = (const GAS float*)ARG_IN(6) + (j - 1) * 1024; gn = (const GAS float*)ARG_IN(5); ldw = 2048; ncols = 1024; cm = WSP(unsigned, WS_COLMAX2) + (j - 1) * 1024; }
            else { W = (const GAS float*)ARG_IN(7) + (size_t)(j - 3) * D * D; gn = (const GAS float*)ARG_IN(1) + (2 + (j - 3)) * D; ldw = 1024; ncols = 1024; mul = 0.125f * 1.4426950408889634f; cm = WSP(unsigned, WS_COLMAX2) + (2 + (j - 3)) * 1024; }
            const int nstrip = ncols / 64, ntask = nstrip * (D / 64);
            int first = (gw - base) % NGW; if (first < 0) first += NGW;
            for (int task = first; task < ntask; task += NGW) { const int strip = task % nstrip, kc = task / nstrip; const int n = strip * 64 + lane; float mx = 0.f;
#pragma unroll 16
                for (int kk = 0; kk < 64; ++kk) { const int k = kc * 64 + kk; mx = fmaxf(mx, fabsf(W[(size_t)k * ldw + n] * gn[k])); }
                const unsigned old = __hip_atomic_fetch_max(cm + n, __builtin_bit_cast(unsigned, mx * mul), __ATOMIC_RELAXED, __HIP_MEMORY_SCOPE_AGENT); asm volatile("" :: "v"(old)); }
            base = (base + ntask) % NGW;
        }
    }
    xcd_barrier(bar, wave_s);

    layer_body<0>(lds, bar, pend, cnt_l, G, bx, vcu, NGW, wave_s);
    layer_body<1>(lds, bar, pend, cnt_l, G, bx, vcu, NGW, wave_s);
    layer_body<2>(lds, bar, pend, cnt_l, G, bx, vcu, NGW, wave_s);
    layer_body<3>(lds, bar, pend, cnt_l, G, bx, vcu, NGW, wave_s);
}

extern "C" void kernel_launch(void* const* d_in, const int* in_sizes, int n_in, void* d_out, int out_size, void* d_ws, size_t ws_size, hipStream_t stream) {
    static int grid = 0;
    if (grid == 0) {
        if (n_in != 15 || out_size != M * D || ws_size < WS_END) { fprintf(stderr, "kernel_launch: unexpected shapes (n_in %d out %d ws %zu)\n", n_in, out_size, ws_size); grid = -1; return; }
        int dev = 0, cus = 0, per_cu = 0;
        if (hipGetDevice(&dev) != hipSuccess || hipDeviceGetAttribute(&cus, hipDeviceAttributeMultiprocessorCount, dev) != hipSuccess) { grid = -1; return; }
        if (hipFuncSetAttribute((const void*)yoco_fwd, hipFuncAttributeMaxDynamicSharedMemorySize, LDS_BYTES) != hipSuccess) { fprintf(stderr, "kernel_launch: hipFuncSetAttribute failed\n"); grid = -1; return; }
        if (hipOccupancyMaxActiveBlocksPerMultiprocessor(&per_cu, (const void*)yoco_fwd, NTHREADS, LDS_BYTES) != hipSuccess || per_cu < 1) { fprintf(stderr, "kernel_launch: occupancy query says %d\n", per_cu); }
        (void)hipGetLastError();
        grid = cus;
    }
    if (grid < 0) return;
    (void)hipMemsetAsync((char*)d_ws + WS_CTL, 0, CTL_ZERO_BYTES, stream);
    Args a{};
    for (int i = 0; i < 15; ++i) a.in[i] = (const float*)d_in[i];
    a.out = (float*)d_out; a.ws = (unsigned char*)d_ws;
    hipLaunchKernelGGL(yoco_fwd, dim3(grid), dim3(NTHREADS), LDS_BYTES, stream, a);
}
```

```cpp
#include <hip/hip_runtime.h>
#include <cstdio>
#include <cstdint>

#define LAS __attribute__((address_space(3)))
#define GAS __attribute__((address_space(1)))
typedef unsigned short bf16_t;
typedef short bf16x8 __attribute__((ext_vector_type(8)));
typedef float f32x2 __attribute__((ext_vector_type(2)));
typedef float f32x4 __attribute__((ext_vector_type(4)));
typedef float f32x16 __attribute__((ext_vector_type(16)));
typedef unsigned u32x2 __attribute__((ext_vector_type(2)));
typedef unsigned u32x4 __attribute__((ext_vector_type(4)));
typedef int i32x4 __attribute__((ext_vector_type(4)));
typedef __bf16 bf16x2_t __attribute__((ext_vector_type(2)));

constexpr int D = 1024, BATCH = 32, SEQ = 2048, M = BATCH * SEQ;
constexpr int DFF = 2816, DFFE = 3584, NE = 8, NH = 16;
constexpr int CAP = 2 * M + NE * 256;
constexpr int CHUNK_BLKS = 260;
constexpr float RMS_EPS = 1e-6f;
#ifndef FP8_MASK
#define FP8_MASK 14
#endif
#ifndef INT8_UP0
#define INT8_UP0 1
#endif
#ifndef L0_DOWN_FP8
#define L0_DOWN_FP8 1
#endif
#ifndef INT8_PROJ
#define INT8_PROJ 1
#endif
constexpr float W8_UP = 64.f, W8_DN = 128.f, H8_SC = 8.f;
constexpr float W8_GATE = 1.4426950408889634f;
constexpr int NWAVES = 8, NTHREADS = 512;

constexpr size_t MiB = 1u << 20;
constexpr size_t WS_CTL = 0, CTL_ZERO_BYTES = 80 * 1024;
constexpr size_t WS_COLMAX2 = 65536;
constexpr size_t WS_WSCALE2 = 1 * MiB + 40960;
constexpr size_t WS_HALO_FLAGS = 20480;
constexpr size_t WS_COLMAX = 32768;
constexpr size_t WS_WSCALE = 1 * MiB + 16384;
constexpr size_t WS_ASCALE = 3 * MiB + 786432;
constexpr size_t WS_TILECNT = 1 * MiB;
constexpr size_t WS_ROUTE_E = 1 * MiB + 65536;
constexpr size_t WS_ROUTE_G = 2 * MiB;
constexpr size_t WS_SLOT_OF = 2 * MiB + 524288;
constexpr size_t WS_GATE_SLOT = 3 * MiB;
constexpr size_t WS_WPOOL = 4 * MiB;
constexpr size_t WS_WK = 5 * MiB, WS_WV = 7 * MiB, WS_WQ = 9 * MiB, WS_WO = 13 * MiB;
constexpr size_t WS_WFI = 17 * MiB;
constexpr size_t WS_WFO = 39 * MiB;
constexpr size_t WS_WMI = 50 * MiB;
constexpr size_t WS_WMO = 274 * MiB;
constexpr size_t WS_XN = 386 * MiB;
constexpr size_t WS_K = 514 * MiB, WS_VT = 642 * MiB;
constexpr size_t WS_XS = 770 * MiB;
constexpr size_t WS_R = 1030 * MiB;
constexpr size_t WS_XS8 = 1485 * MiB;
constexpr size_t WS_XB = 1485 * MiB;
constexpr size_t WS_TOS = 386 * MiB + 64 * MiB;

constexpr size_t WS_YT = 1616 * MiB;
constexpr size_t WS_DELTA = 1616 * MiB;
constexpr size_t WS_END = 1744 * MiB;
static_assert(WS_XS8 + (size_t)CAP * D <= WS_END, "xs8");
static_assert(WS_XS + (size_t)CAP * D * 2 <= WS_R, "xs");
static_assert(WS_R + (size_t)CHUNK_BLKS * 256 * DFFE * 2 <= WS_END, "moe hidden chunk");
static_assert(WS_R + (size_t)M * DFF * 2 <= WS_END, "dense hidden");
static_assert(WS_R + (size_t)CAP * DFFE <= WS_XS8, "fp8 moe hidden, one chunk");
static_assert(WS_WMO + (size_t)2 * 8 * 1024 * 3584 * 2 <= WS_XN, "weights");

constexpr int STAGE_BYTES_LDS = 131072;
constexpr int LCTL_OFF = STAGE_BYTES_LDS;
constexpr int LDS_BYTES = 147456;

__device__ __forceinline__ unsigned cvtpk(float lo, float hi) { f32x2 v = {lo, hi}; bf16x2_t b = __builtin_convertvector(v, bf16x2_t); return __builtin_bit_cast(unsigned, b); }
__device__ __forceinline__ unsigned pk4_fp8(float a, float b, float c, float d) { int w = __builtin_amdgcn_cvt_pk_fp8_f32(a, b, 0, false); w = __builtin_amdgcn_cvt_pk_fp8_f32(c, d, w, true); return (unsigned)w; }
__device__ __forceinline__ unsigned pk4_i8(float a, float b, float c, float d) {
    const int i0 = (int)__builtin_rintf(__builtin_amdgcn_fmed3f(a, -127.f, 127.f)), i1 = (int)__builtin_rintf(__builtin_amdgcn_fmed3f(b, -127.f, 127.f));
    const int i2 = (int)__builtin_rintf(__builtin_amdgcn_fmed3f(c, -127.f, 127.f)), i3 = (int)__builtin_rintf(__builtin_amdgcn_fmed3f(d, -127.f, 127.f));
    return (unsigned)(i0 & 255) | ((unsigned)(i1 & 255) << 8) | ((unsigned)(i2 & 255) << 16) | ((unsigned)i3 << 24); }
__device__ __forceinline__ float wave_max(float v) {
#pragma unroll
    for (int o = 1; o < 64; o <<= 1) v = fmaxf(v, __shfl_xor(v, o));
    return v;
}
__device__ __forceinline__ float bf_lo(unsigned w) { return __builtin_bit_cast(float, w << 16); }
__device__ __forceinline__ float bf_hi(unsigned w) { return __builtin_bit_cast(float, w & 0xffff0000u); }
__device__ __forceinline__ f32x4 ld4(const float* p) { return *(const GAS f32x4*)p; }
__device__ __forceinline__ f32x4 ld4(const bf16_t* p) { const u32x2 w = *(const GAS u32x2*)p; return (f32x4){bf_lo(w.x), bf_hi(w.x), bf_lo(w.y), bf_hi(w.y)}; }
__device__ __forceinline__ f32x2 ld2(const float* p) { return *(const GAS f32x2*)p; }
__device__ __forceinline__ f32x2 ld2(const bf16_t* p) { const unsigned w = *(const GAS unsigned*)p; return (f32x2){bf_lo(w), bf_hi(w)}; }
__device__ __forceinline__ f32x4 ldraw4(const float* p) { return *(const GAS f32x4*)p; }
__device__ __forceinline__ u32x2 ldraw4(const bf16_t* p) { return *(const GAS u32x2*)p; }
__device__ __forceinline__ f32x4 cvt4(f32x4 v) { return v; }
__device__ __forceinline__ f32x4 cvt4(u32x2 w) { return (f32x4){bf_lo(w.x), bf_hi(w.x), bf_lo(w.y), bf_hi(w.y)}; }
template <class T> struct Raw4; template <> struct Raw4<float> { typedef f32x4 t; }; template <> struct Raw4<bf16_t> { typedef u32x2 t; };
__device__ __forceinline__ float wave_sum(float v) {
#pragma unroll
    for (int o = 1; o < 64; o <<= 1) v += __shfl_xor(v, o);
    return v;
}
#define LDS_WAIT() asm volatile("s_waitcnt lgkmcnt(0)" ::: "memory")
__device__ __forceinline__ int fresh_tid(int wave_s) { int w = wave_s, z = 0; asm volatile("" : "+s"(w), "+s"(z)); return w * 64 + (int)__builtin_amdgcn_mbcnt_hi(~0u, __builtin_amdgcn_mbcnt_lo(~0u, (unsigned)z)); }
#define RLX_AGENT __ATOMIC_RELAXED, __HIP_MEMORY_SCOPE_AGENT

#define XB_TMO      128
#define XB_XCNT(j)  (256  + 64 * (j))
#define XB_XSUB(j)  (1280 + 64 * (j))
#define XB_XGEN(j)  (2304 + 64 * (j))
#define XB_TOP      3328
#define XB_TOPGEN   3392
#define XCD_BAR_WORDS 3456
#define XB_SPIN_CAP (1u << 22)
__device__ __forceinline__ unsigned xb_ld(unsigned* p)              { return __hip_atomic_load(p, __ATOMIC_RELAXED, __HIP_MEMORY_SCOPE_AGENT); }
__device__ __forceinline__ unsigned xb_add(unsigned* p, unsigned v) { return __hip_atomic_fetch_add(p, v, __ATOMIC_RELAXED, __HIP_MEMORY_SCOPE_AGENT); }
__device__ __forceinline__ unsigned xb_xcc_id() { return (unsigned)__builtin_amdgcn_s_getreg((3 << 11) | 20) & 0xFu; }
#define XB_SPIN(cond, bar) do { unsigned _sp = 0; while (cond) { __builtin_amdgcn_s_sleep(1); \
    if ((++_sp & 255u) == 0u) { if (xb_ld(&(bar)[XB_TMO])) break; if (_sp > XB_SPIN_CAP) { atomicAdd(&(bar)[XB_TMO], 1u); break; } } } } while (0)
struct XcdBarrier { unsigned* bar; unsigned x; volatile LAS unsigned* st; };
__device__ __forceinline__ XcdBarrier xcd_barrier_post(unsigned* bar, volatile LAS unsigned* st) {
    XcdBarrier b; b.bar = bar; b.x = xb_xcc_id(); b.st = st;
    if (threadIdx.x == 0) (void)xb_add(&bar[XB_XCNT(b.x)], 1u);
    return b;
}
__device__ __forceinline__ void xcd_barrier_complete(unsigned* bar, unsigned x, unsigned& nloc, unsigned& nx) {
    const unsigned G = gridDim.x * gridDim.y * gridDim.z;
    unsigned sum, cnt, mine, sp = 0u;
    for (;;) {
        sum = 0u; cnt = 0u; mine = 0u;
#pragma unroll
        for (unsigned j = 0; j < 16; ++j) { const unsigned c = xb_ld(&bar[XB_XCNT(j)]); sum += c; cnt += (c > 0u) ? 1u : 0u; mine = (j == x) ? c : mine; }
        if (sum == G) break;
        __builtin_amdgcn_s_sleep(1);
        if ((++sp & 255u) == 0u) { if (xb_ld(&bar[XB_TMO])) break; if (sp > XB_SPIN_CAP) { atomicAdd(&bar[XB_TMO], 1u); break; } }
    }
    nloc = mine > 0u ? mine : 1u; nx = cnt > 0u ? cnt : 1u;
}
__device__ __forceinline__ void xcd_barrier(const XcdBarrier& b, int wave_s) {
    asm volatile("s_waitcnt vmcnt(0)" ::: "memory");
    __syncthreads();
    if (fresh_tid(wave_s) == 0) {
        unsigned* bar = b.bar;
        __builtin_amdgcn_s_waitcnt(0);
        unsigned nloc = b.st[0], nx = b.st[1];
        if (nloc == 0u) { xcd_barrier_complete(bar, b.x, nloc, nx); b.st[0] = nloc; b.st[1] = nx; }
        const unsigned old = xb_add(&bar[XB_XSUB(b.x)], 1u);
        const unsigned gen = old / nloc;
        if (old + 1u == (gen + 1u) * nloc) {
            __builtin_amdgcn_fence(__ATOMIC_RELEASE, "agent");
            asm volatile("s_waitcnt vmcnt(0)" ::: "memory");
            const unsigned og = xb_add(&bar[XB_TOP], 1u);
            const unsigned tg = og / nx;
            if (og + 1u == (tg + 1u) * nx) xb_add(&bar[XB_TOPGEN], 1u);
            else XB_SPIN(xb_ld(&bar[XB_TOPGEN]) == tg, bar);
            __builtin_amdgcn_fence(__ATOMIC_ACQUIRE, "agent");
            xb_add(&bar[XB_XGEN(b.x)], 1u);
            asm volatile("s_waitcnt vmcnt(0)" ::: "memory");
        } else {
            XB_SPIN(xb_ld(&bar[XB_XGEN(b.x)]) == gen, bar);
            __builtin_amdgcn_fence(__ATOMIC_ACQUIRE, "agent");
            asm volatile("s_waitcnt vmcnt(0)" ::: "memory");
        }
    }
    __syncthreads();
}

namespace pg8 {
constexpr int BM = 256, BK = 64, HALF = 128, HTB = HALF * BK * 2, NXCD = 8, WGM = 8;
__host__ __device__ __forceinline__ int lds_byte(int r, int c) { const int st = (r >> 4) * 2 + (c >> 5), rr = r & 15, cc = c & 31, ob = rr * 64 + cc * 2; return st * 1024 + (ob ^ (((ob >> 9) & 1) << 5)); }
__host__ __device__ __forceinline__ void stage_rc(int b, int& R, int& C) { const int st = b / 1024, sb = b % 1024, swz = sb ^ (((sb >> 9) & 1) << 5); R = (st >> 1) * 16 + swz / 64; C = (st & 1) * 32 + (swz % 64) / 2; }
__host__ __device__ __forceinline__ int perm32(int rho) { const int n = rho >> 4, i = rho & 15; return 8 * (i >> 2) + 4 * n + (i & 3); }

typedef int i32x8 __attribute__((ext_vector_type(8)));
__device__ __forceinline__ i32x8 cat8(bf16x8 lo, bf16x8 hi) { const i32x4 a = __builtin_bit_cast(i32x4, lo), b = __builtin_bit_cast(i32x4, hi); return __builtin_shufflevector(a, b, 0, 1, 2, 3, 4, 5, 6, 7); }
struct Unit { const char* A; const char* B; int pm, pn, aux; };
struct GemmK { int K, lda, ldb; };

__device__ __forceinline__ bool smap(long L, int nM, int nN, int& pm, int& pn) {
    const int nwg = nM * nN; if (L >= nwg) return false;
    int wgid = (int)L; { const int q = nwg / NXCD, r = nwg % NXCD, xcd = wgid % NXCD, off = wgid / NXCD; wgid = (xcd < r ? xcd * (q + 1) : r * (q + 1) + (xcd - r) * q) + off; }
    const int nig = WGM * nN, gid = wgid / nig, fm = gid * WGM, gsz = (nM - fm) < WGM ? (nM - fm) : WGM;
    pm = fm + ((wgid % nig) % gsz); pn = (wgid % nig) / gsz; return true;
}

template <class Epi, class Sched, bool ALIGN_EPI, int MODE = 0, bool GATHER = false>
__device__ __forceinline__ void gemm_phase(LAS unsigned char* lds, const GemmK g, const Sched& S, const Epi& E, int wave_s, int stag = 0  ) {
    if (stag > 0 && (blockIdx.x & 1)) { const unsigned long long t0 = __builtin_amdgcn_s_memrealtime(); while (__builtin_amdgcn_s_memrealtime() - t0 < (unsigned long long)stag) __builtin_amdgcn_s_sleep(4); }
    const int tid = fresh_tid(wave_s);
    const int wid = __builtin_amdgcn_readfirstlane(tid >> 6), lane = tid & 63, wr = wid >> 2, wc = wid & 3, fr = lane & 15, fq = lane >> 4;
    constexpr bool FP8 = (MODE == 1);
    const int K = g.K, nt = K / BK;
    unsigned voffA[2], voffB[2];
#pragma unroll
    for (int i = 0; i < 2; ++i) { int R, C; stage_rc(tid * 16 + i * 8192, R, C); const int Rb = Epi::PERM ? ((R & ~31) + perm32(R & 31)) : R;
        voffA[i] = (unsigned)(R * g.lda + C) * 2u; voffB[i] = (unsigned)(Rb * g.ldb + C) * 2u; }
    unsigned vG[2][2], vN[2][2];
    const size_t kstep = (size_t)(BK * 2);
    const size_t hstepA = (size_t)HALF * g.lda * 2, hstepB = (size_t)HALF * g.ldb * 2;
    const unsigned ldsw = (unsigned)wid * 1024u;
    const int aoff = lds_byte(wr * 64 + fr, fq * 8), boff = lds_byte(wc * 32 + fr, fq * 8);
#define PG8_SA(b, h) (((b) * 2 + (h)) * HTB)
#define PG8_SB(b, h) ((4 + (b) * 2 + (h)) * HTB)
#define PG8_STAGE(bufoff, gbase, voff) do { _Pragma("unroll") for (int _i = 0; _i < 2; ++_i) \
        __builtin_amdgcn_global_load_lds((const unsigned*)((const char*)(gbase) + (voff)[_i]), (LAS unsigned*)(lds + (bufoff) + ldsw + _i * 8192), 16, 0, 0); } while (0)
#define PG8_STAGE_A(bufoff, gbase, h, nx) do { if constexpr (GATHER) { unsigned _v[2] = { (nx) ? vN[h][0] : vG[h][0], (nx) ? vN[h][1] : vG[h][1] }; PG8_STAGE(bufoff, gbase, _v); } \
        else PG8_STAGE(bufoff, (gbase) + (h) * hstepA, voffA); } while (0)
#define PG8_LD8(p) __builtin_shufflevector(*(const LAS i32x4*)(p), *(const LAS i32x4*)((p) + 1024), 0, 1, 2, 3, 4, 5, 6, 7)
#define PG8_LDA(dst, b, h) do { if constexpr (FP8) { _Pragma("unroll") for (int m = 0; m < 4; ++m) dst##8[m] = PG8_LD8(lds + PG8_SA(b, h) + aoff + m * 2048); } \
        else { _Pragma("unroll") for (int m = 0; m < 4; ++m) _Pragma("unroll") for (int k = 0; k < 2; ++k) dst[m][k] = *(const LAS bf16x8*)(lds + PG8_SA(b, h) + aoff + m * 2048 + k * 1024); } } while (0)
#define PG8_LDB(dst, b, h) do { if constexpr (FP8) { _Pragma("unroll") for (int n = 0; n < 2; ++n) dst##8[n] = PG8_LD8(lds + PG8_SB(b, h) + boff + n * 2048); } \
        else { _Pragma("unroll") for (int n = 0; n < 2; ++n) _Pragma("unroll") for (int k = 0; k < 2; ++k) dst[n][k] = *(const LAS bf16x8*)(lds + PG8_SB(b, h) + boff + n * 2048 + k * 1024); } } while (0)
#define PG8_MFMA_ASM(INS, C, OUT, a_, b_) asm volatile(INS " %0, %1, %2, " C : OUT(acc[ai_][bj_][m][n]) : "v"(b_), "v"(a_))
#define PG8_MMA(ai, bj, At, Bt, Z) do { constexpr int ai_ = ai, bj_ = bj; __builtin_amdgcn_s_setprio(1); \
        if constexpr (FP8) { if (Z) { _Pragma("unroll") for (int m = 0; m < 4; ++m) _Pragma("unroll") for (int n = 0; n < 2; ++n) PG8_MFMA_ASM("v_mfma_f32_16x16x128_f8f6f4", "0", "=&v", At##8[m], Bt##8[n]); } \
                             else { _Pragma("unroll") for (int m = 0; m < 4; ++m) _Pragma("unroll") for (int n = 0; n < 2; ++n) PG8_MFMA_ASM("v_mfma_f32_16x16x128_f8f6f4", "%0", "+v", At##8[m], Bt##8[n]); } } \
        else if constexpr (MODE == 2) { if (Z) { _Pragma("unroll") for (int m = 0; m < 4; ++m) _Pragma("unroll") for (int n = 0; n < 2; ++n) PG8_MFMA_ASM("v_mfma_i32_16x16x64_i8", "0", "=&v", At[m][0], Bt[n][0]); } \
                             else { _Pragma("unroll") for (int m = 0; m < 4; ++m) _Pragma("unroll") for (int n = 0; n < 2; ++n) PG8_MFMA_ASM("v_mfma_i32_16x16x64_i8", "%0", "+v", At[m][0], Bt[n][0]); } \
                             _Pragma("unroll") for (int m = 0; m < 4; ++m) _Pragma("unroll") for (int n = 0; n < 2; ++n) PG8_MFMA_ASM("v_mfma_i32_16x16x64_i8", "%0", "+v", At[m][1], Bt[n][1]); } \
        else { if (Z) { _Pragma("unroll") for (int m = 0; m < 4; ++m) _Pragma("unroll") for (int n = 0; n < 2; ++n) PG8_MFMA_ASM("v_mfma_f32_16x16x32_bf16", "0", "=&v", At[m][0], Bt[n][0]); } \
               else { _Pragma("unroll") for (int m = 0; m < 4; ++m) _Pragma("unroll") for (int n = 0; n < 2; ++n) PG8_MFMA_ASM("v_mfma_f32_16x16x32_bf16", "%0", "+v", At[m][0], Bt[n][0]); } \
               _Pragma("unroll") for (int m = 0; m < 4; ++m) _Pragma("unroll") for (int n = 0; n < 2; ++n) PG8_MFMA_ASM("v_mfma_f32_16x16x32_bf16", "%0", "+v", At[m][1], Bt[n][1]); } \
        __builtin_amdgcn_s_setprio(0); } while (0)
#define PG8_WAIT_V(n) asm volatile("s_waitcnt vmcnt(" #n ")" ::: "memory")
#define PG8_WAIT_L(n) asm volatile("s_waitcnt lgkmcnt(" #n ")" ::: "memory")
#define PG8_BAR __builtin_amdgcn_s_barrier()
#define PG8_SCHED __builtin_amdgcn_sched_barrier(0)
    Unit cur, nxt; int ui = 0;
    constexpr int NS = Epi::NS;
#define PG8_WAIT_V1(n) do { if (NS > 0 && first && ui > 0) asm volatile("s_waitcnt vmcnt(%0)" :: "n"((n) + NS) : "memory"); else PG8_WAIT_V(n); } while (0)
    if (!S.next(0, cur)) return;
    f32x4 acc[2][2][4][2];
    bf16x8 At[4][2], B0[2][2], B1[2][2]; i32x8 At8[4], B08[2], B18[2];
    const char* cA = cur.A; const char* cB = cur.B;
    if constexpr (GATHER) {
#pragma unroll
        for (int i = 0; i < 2; ++i) { int R, C; stage_rc(tid * 16 + i * 8192, R, C);
#pragma unroll
            for (int h = 0; h < 2; ++h) { vG[h][i] = (unsigned)S.tos[(size_t)cur.aux * 256 + h * HALF + R] * (unsigned)(g.lda * 2) + (unsigned)C * 2u; vN[h][i] = vG[h][i]; } } }
    PG8_STAGE(PG8_SB(0, 0), cB, voffB); PG8_STAGE(PG8_SB(0, 1), cB + hstepB, voffB); PG8_STAGE_A(PG8_SA(0, 0), cA, 0, false); PG8_STAGE_A(PG8_SA(0, 1), cA, 1, false);
    if (wr == 1) PG8_BAR;
    PG8_WAIT_V(2); PG8_BAR;
    PG8_STAGE(PG8_SB(1, 0), cB + kstep, voffB); PG8_STAGE_A(PG8_SA(1, 0), cA + kstep, 0, false); PG8_STAGE(PG8_SB(1, 1), cB + hstepB + kstep, voffB);
    PG8_WAIT_V(6); PG8_BAR;
    for (;;) {
        const bool has_next = S.next(ui + 1, nxt);
        const char* nA = has_next ? nxt.A : cA; const char* nB = has_next ? nxt.B : cB;
        if constexpr (GATHER) { if (has_next && wid < 4) __builtin_amdgcn_global_load_lds((const unsigned*)(S.tos + (size_t)nxt.aux * 256 + wid * 64 + lane), (LAS unsigned*)(S.idxl + ((ui + 1) & 1) * 256 + wid * 64), 4, 0, 0); }
        for (int t = 0; t < nt; t += 2) {
            const bool last = (t == nt - 2), first = (t == 0);
            const char* a1 = cA + (size_t)(t + 1) * kstep;
            const char* a2 = last ? nA : cA + (size_t)(t + 2) * kstep; const char* b2 = last ? nB : cB + (size_t)(t + 2) * kstep;
            const char* a3 = a2 + kstep; const char* b3 = b2 + kstep;
            if constexpr (GATHER) { if (last) {
                    const LAS int* ib = S.idxl + ((ui + 1) & 1) * 256;
#pragma unroll
                    for (int i = 0; i < 2; ++i) { int R, C; stage_rc(tid * 16 + i * 8192, R, C);
#pragma unroll
                        for (int h = 0; h < 2; ++h) vN[h][i] = has_next ? (unsigned)ib[h * HALF + R] * (unsigned)(g.lda * 2) + (unsigned)C * 2u : vG[h][i]; } } }
            PG8_LDB(B0, 0, 0); PG8_LDB(B1, 0, 1); PG8_SCHED; PG8_LDA(At, 0, 0); if (!(first && ui > 0)) PG8_STAGE_A(PG8_SA(1, 1), a1, 1, false);
            PG8_WAIT_V1(8); PG8_WAIT_L(0); PG8_BAR; PG8_MMA(0, 0, At, B0, first); PG8_MMA(0, 1, At, B1, first); PG8_BAR; PG8_SCHED;
            PG8_LDA(At, 0, 1); PG8_STAGE(PG8_SB(0, 0), b2, voffB); PG8_STAGE(PG8_SB(0, 1), b2 + hstepB, voffB); PG8_STAGE_A(PG8_SA(0, 0), a2, 0, last);
            PG8_WAIT_V1(8); PG8_WAIT_L(0); PG8_BAR; PG8_MMA(1, 0, At, B0, first); PG8_MMA(1, 1, At, B1, first); PG8_BAR; PG8_SCHED;
            PG8_LDB(B0, 1, 0); PG8_LDB(B1, 1, 1); PG8_SCHED; PG8_LDA(At, 1, 0); PG8_STAGE_A(PG8_SA(0, 1), a2, 1, last);
            PG8_WAIT_V1(8); PG8_WAIT_L(0); PG8_BAR; PG8_MMA(0, 0, At, B0, false); PG8_MMA(0, 1, At, B1, false); PG8_BAR; PG8_SCHED;
            PG8_LDA(At, 1, 1); PG8_STAGE(PG8_SB(1, 0), b3, voffB); PG8_STAGE(PG8_SB(1, 1), b3 + hstepB, voffB); PG8_STAGE_A(PG8_SA(1, 0), a3, 0, last);
            PG8_WAIT_V(8); PG8_WAIT_L(0); PG8_BAR; PG8_MMA(1, 0, At, B0, false); PG8_MMA(1, 1, At, B1, false); PG8_BAR; PG8_SCHED;
        }
        if constexpr (ALIGN_EPI) { if (wr == 0) PG8_BAR; }
        if (has_next) PG8_STAGE_A(PG8_SA(1, 1), nA + kstep, 1, true);
        asm volatile("s_nop 15\n\ts_nop 15" ::: "memory");
        E(acc, cur, wr, wc, fr, fq);
        if (!has_next) break;
        cur = nxt; cA = nA; cB = nB; ++ui;
        if constexpr (GATHER) {
#pragma unroll
            for (int h = 0; h < 2; ++h) { vG[h][0] = vN[h][0]; vG[h][1] = vN[h][1]; } }
        if constexpr (ALIGN_EPI) { if (wr == 1) PG8_BAR; }
    }
    PG8_WAIT_V(0);
    if constexpr (!ALIGN_EPI) { if (wr == 0) PG8_BAR; }
    PG8_BAR;
#undef PG8_SA
#undef PG8_SB
#undef PG8_STAGE
#undef PG8_STAGE_A
#undef PG8_LDA
#undef PG8_LDB
#undef PG8_MMA
#undef PG8_WAIT_V1
#undef PG8_MFMA_ASM
#undef PG8_WAIT_V
#undef PG8_WAIT_L
#undef PG8_BAR
#undef PG8_SCHED
}

struct EpiMoeDownT {
    static constexpr int NS = 16; static constexpr bool PERM = true;
    bf16_t* Y2; const float* gate; float osc;
    __device__ __forceinline__ void operator()(const f32x4 (&acc)[2][2][4][2], const Unit& u, int wr, int wc, int fr, int fq) const {
        const int row0 = u.pm * BM + wr * 64 + fr, col0 = u.pn * BM + wc * 32 + 8 * fq;
        float gtv[2][4];
#pragma unroll
        for (int ai = 0; ai < 2; ++ai)
#pragma unroll
            for (int m = 0; m < 4; ++m) gtv[ai][m] = gate[row0 + ai * HALF + m * 16];
#pragma unroll
        for (int ai = 0; ai < 2; ++ai)
#pragma unroll
            for (int m = 0; m < 4; ++m) { const int row = row0 + ai * HALF + m * 16; const float gt = gtv[ai][m] * osc; bf16_t* rowp = Y2 + ((size_t)u.aux * (8 * 256) + (size_t)(row - 2 * M)) * D + col0;
#pragma unroll
                for (int bj = 0; bj < 2; ++bj) { const f32x4 v0 = acc[ai][bj][m][0] * gt, v1 = acc[ai][bj][m][1] * gt;
                    u32x4 w; w.x = cvtpk(v0[0], v0[1]); w.y = cvtpk(v0[2], v0[3]); w.z = cvtpk(v1[0], v1[1]); w.w = cvtpk(v1[2], v1[3]);
                    *(u32x4*)(rowp + bj * HALF) = w; } }
    }
};
struct DenseOrder {
    int nM, nN, G, c; const char* A; const char* B; size_t at, bt;
    __device__ __forceinline__ bool next(int i, Unit& u) const { int pm, pn; if (!smap((long)i * G + c, nM, nN, pm, pn)) return false;
        u.A = A + (size_t)pm * at; u.B = B + (size_t)pn * bt; u.pm = pm; u.pn = pn; u.aux = 0; return true; }
};
struct PoolOrder {
    int G, c; const char* P; const char* W;
    __device__ __forceinline__ bool next(int i, Unit& u) const { const int pm = c + (i >> 2) * G, pn = i & 3; if (pm >= M / 256) return false;
        u.A = P + (size_t)pm * (256 * 1024 * 2) + (size_t)pn * 512; u.B = W + (size_t)pn * (256 * 256 * 2); u.pm = pm; u.pn = pn; u.aux = 0; return true; }
};
struct ProjOrder {
    int njobs, G, c; const char* ws; size_t qoff, tb;
    __device__ __forceinline__ bool next(int i, Unit& u) const {
        const long L = (long)i * G + c; if (L >= (long)njobs * 1024) return false;
        const int job = (int)(L >> 10), l = (int)(L & 1023); const int kind = (njobs == 1) ? 1 : job;
        const size_t woff = WS_WK + (size_t)(kind == 1) * (WS_WQ + qoff - WS_WK) + (size_t)(kind == 2) * (WS_WV - WS_WK);
        int pm, pn;
        if (kind == 2) { smap(l, 4, 256, pm, pn); u.A = ws + woff + (size_t)pm * tb; u.B = ws + WS_XN + (size_t)pn * tb; }
        else { smap(l, 256, 4, pm, pn); u.A = ws + WS_XN + (size_t)pm * tb; u.B = ws + woff + (size_t)pn * tb; }
        u.pm = pm; u.pn = pn; u.aux = kind; return true; }
};
struct MoeOrder {
    int nM, nN, G, c, blk0, a_rel; const char* A; const char* B; size_t at, bt, be; const LAS int* pend;
    __device__ __forceinline__ bool next(int i, Unit& u) const { int pm, pn; if (!smap((long)i * G + c, nM, nN, pm, pn)) return false;
        const int b = blk0 + pm; int e = 0;
#pragma unroll
        for (int j = 0; j < 7; ++j) e += (b >= pend[j]) ? 1 : 0;
        e = __builtin_amdgcn_readfirstlane(e);
        u.A = A + (size_t)(a_rel ? pm : b) * at; u.B = B + (size_t)e * be + (size_t)pn * bt; u.pm = a_rel ? b : pm; u.pn = pn; u.aux = 0; return true; }
};

constexpr int TAIL_B0 = 2 * M / 256, TAIL_KS = 7;
struct MoeTailOrder {
    int nT, G, c; const char* A; const char* B; size_t at, bt, be, kq; const LAS int* pend;
    __device__ __forceinline__ bool next(int i, Unit& u) const { const int L = i * G + c; if (L >= nT * 4 * TAIL_KS) return false;
        const int q = L % TAIL_KS, r = L / TAIL_KS, pn = r & 3, b = TAIL_B0 + (r >> 2); int e = 0;
#pragma unroll
        for (int j = 0; j < 7; ++j) e += (b >= pend[j]) ? 1 : 0;
        e = __builtin_amdgcn_readfirstlane(e);
        u.A = A + (size_t)b * at + (size_t)q * kq; u.B = B + (size_t)e * be + (size_t)pn * bt + (size_t)q * kq; u.pm = b; u.pn = pn; u.aux = q; return true; }
};
struct MoeGatherOrder {
    int nM, nN, G, c, blk0; const char* A; const char* B; size_t bt, be; const LAS int* pend; const int* tos; LAS int* idxl;
    __device__ __forceinline__ bool next(int i, Unit& u) const { int pm, pn; if (!smap((long)i * G + c, nM, nN, pm, pn)) return false;
        const int b = blk0 + pm; int e = 0;
#pragma unroll
        for (int j = 0; j < 7; ++j) e += (b >= pend[j]) ? 1 : 0;
        e = __builtin_amdgcn_readfirstlane(e);
        u.A = A; u.B = B + (size_t)e * be + (size_t)pn * bt; u.pm = pm; u.pn = pn; u.aux = b; return true; }
};
struct EpiPool {
    static constexpr int NS = 0; static constexpr bool PERM = false;
    const float* xin; float* out; const float* scale; float mul;
    __device__ __forceinline__ void operator()(const f32x4 (&acc)[2][2][4][2], const Unit& u, int wr, int wc, int fr, int fq) const {
        const int row0 = u.pm * BM + wr * 64 + fr, col0 = u.pn * BM + wc * 32 + 4 * fq;
        f32x4 sv[2][2];
#pragma unroll
        for (int bj = 0; bj < 2; ++bj)
#pragma unroll
            for (int n = 0; n < 2; ++n) sv[bj][n] = *(const f32x4*)(scale + col0 + bj * HALF + n * 16) * mul;
#pragma unroll
        for (int ai = 0; ai < 2; ++ai)
#pragma unroll
            for (int m = 0; m < 4; ++m) { const size_t off = (size_t)(row0 + ai * HALF + m * 16) * D + col0;
#pragma unroll
                for (int bj = 0; bj < 2; ++bj)
#pragma unroll
                    for (int n = 0; n < 2; ++n) { const f32x4 xv = *(const f32x4*)(xin + off + bj * HALF + n * 16); *(f32x4*)(out + off + bj * HALF + n * 16) = xv + sv[bj][n] * acc[ai][bj][m][n]; }
                asm volatile("" ::: "memory"); }
    }
};
struct EpiDelta {
    static constexpr int NS = 0; static constexpr bool PERM = true;
    bf16_t* DL; const float* scale;
    __device__ __forceinline__ void operator()(const f32x4 (&acc)[2][2][4][2], const Unit& u, int wr, int wc, int fr, int fq) const {
        const int row0 = u.pm * BM + wr * 64 + fr, col0 = u.pn * BM + wc * 32 + 8 * fq;
        f32x4 sv[2][2];
#pragma unroll
        for (int bj = 0; bj < 2; ++bj) { sv[bj][0] = scale ? *(const f32x4*)(scale + col0 + bj * HALF) : (f32x4){1.f, 1.f, 1.f, 1.f}; sv[bj][1] = scale ? *(const f32x4*)(scale + col0 + bj * HALF + 4) : (f32x4){1.f, 1.f, 1.f, 1.f}; }
#pragma unroll
        for (int ai = 0; ai < 2; ++ai)
#pragma unroll
            for (int m = 0; m < 4; ++m) { bf16_t* rowp = DL + (size_t)(row0 + ai * HALF + m * 16) * D + col0;
#pragma unroll
                for (int bj = 0; bj < 2; ++bj) { const f32x4 v0 = acc[ai][bj][m][0] * sv[bj][0], v1 = acc[ai][bj][m][1] * sv[bj][1];
                    u32x4 w; w.x = cvtpk(v0[0], v0[1]); w.y = cvtpk(v0[2], v0[3]); w.z = cvtpk(v1[0], v1[1]); w.w = cvtpk(v1[2], v1[3]);
                    *(u32x4*)(rowp + bj * HALF) = w; } }
    }
};
struct EpiResidB {
    static constexpr int NS = 16; static constexpr bool PERM = true; static constexpr bool SPLIT = false;
    bf16_t* xb; const float* scale; float mul;
    __device__ __forceinline__ void operator()(const f32x4 (&acc)[2][2][4][2], const Unit& u, int wr, int wc, int fr, int fq) const {
        const int row0 = u.pm * BM + wr * 64 + fr, col0 = u.pn * BM + wc * 32 + 8 * fq;
        u32x4 d[2][4][2];
#pragma unroll
        for (int ai = 0; ai < 2; ++ai)
#pragma unroll
            for (int m = 0; m < 4; ++m) { const GAS bf16_t* rowp = (const GAS bf16_t*)xb + (size_t)(row0 + ai * HALF + m * 16) * D + col0;
#pragma unroll
                for (int bj = 0; bj < 2; ++bj) d[ai][m][bj] = *(const GAS u32x4*)(rowp + bj * HALF); }
        f32x4 sv[2][2];
#pragma unroll
        for (int bj = 0; bj < 2; ++bj) { sv[bj][0] = (scale ? *(const f32x4*)(scale + col0 + bj * HALF) : (f32x4){1.f, 1.f, 1.f, 1.f}) * mul; sv[bj][1] = (scale ? *(const f32x4*)(scale + col0 + bj * HALF + 4) : (f32x4){1.f, 1.f, 1.f, 1.f}) * mul; }
#pragma unroll
        for (int ai = 0; ai < 2; ++ai)
#pragma unroll
            for (int m = 0; m < 4; ++m) { GAS bf16_t* rowp = (GAS bf16_t*)xb + (size_t)(row0 + ai * HALF + m * 16) * D + col0;
#pragma unroll
                for (int bj = 0; bj < 2; ++bj) { const u32x4 dd = d[ai][m][bj];
                    const f32x4 o0 = (f32x4){bf_lo(dd.x), bf_hi(dd.x), bf_lo(dd.y), bf_hi(dd.y)} + acc[ai][bj][m][0] * sv[bj][0], o1 = (f32x4){bf_lo(dd.z), bf_hi(dd.z), bf_lo(dd.w), bf_hi(dd.w)} + acc[ai][bj][m][1] * sv[bj][1];
                    u32x4 w; w.x = cvtpk(o0[0], o0[1]); w.y = cvtpk(o0[2], o0[3]); w.z = cvtpk(o1[0], o1[1]); w.w = cvtpk(o1[2], o1[3]); *(GAS u32x4*)(rowp + bj * HALF) = w; } }
    }
};
template <class XT>
struct EpiResidD {
    static constexpr int NS = 0; static constexpr bool PERM = true;
    const XT* xsrc; bf16_t* out; const bf16_t* DL; float mul;
    __device__ __forceinline__ void operator()(const f32x4 (&acc)[2][2][4][2], const Unit& u, int wr, int wc, int fr, int fq) const {
        const int row0 = u.pm * BM + wr * 64 + fr, col0 = u.pn * BM + wc * 32 + 8 * fq;
#pragma unroll
        for (int ai = 0; ai < 2; ++ai)
#pragma unroll
            for (int m = 0; m < 4; ++m) { const size_t off0 = (size_t)(row0 + ai * HALF + m * 16) * D + col0;
#pragma unroll
                for (int bj = 0; bj < 2; ++bj) { const size_t off = off0 + bj * HALF; const f32x4 x0 = ld4(xsrc + off), x1 = ld4(xsrc + off + 4); const u32x4 d = *(const u32x4*)(DL + off);
                    const f32x4 d0 = {bf_lo(d.x), bf_hi(d.x), bf_lo(d.y), bf_hi(d.y)}, d1 = {bf_lo(d.z), bf_hi(d.z), bf_lo(d.w), bf_hi(d.w)};
                    const f32x4 o0 = x0 + d0 + acc[ai][bj][m][0] * mul, o1 = x1 + d1 + acc[ai][bj][m][1] * mul;
                    u32x4 w; w.x = cvtpk(o0[0], o0[1]); w.y = cvtpk(o0[2], o0[3]); w.z = cvtpk(o1[0], o1[1]); w.w = cvtpk(o1[2], o1[3]); *(u32x4*)(out + off) = w; }
                asm volatile("" ::: "memory"); }
    }
};
struct EpiResid {
    static constexpr int NS = 0; static constexpr bool PERM = false;
    float* x; float mul;
    __device__ __forceinline__ void operator()(const f32x4 (&acc)[2][2][4][2], const Unit& u, int wr, int wc, int fr, int fq) const {
        const int row0 = u.pm * BM + wr * 64 + fr, col0 = u.pn * BM + wc * 32 + 4 * fq;
#pragma unroll
        for (int ai = 0; ai < 2; ++ai)
#pragma unroll
            for (int m = 0; m < 4; ++m) { float* p = x + (size_t)(row0 + ai * HALF + m * 16) * D + col0;
#pragma unroll
                for (int bj = 0; bj < 2; ++bj)
#pragma unroll
                    for (int n = 0; n < 2; ++n) { const f32x4 xv = *(const f32x4*)(p + bj * HALF + n * 16); *(f32x4*)(p + bj * HALF + n * 16) = xv + acc[ai][bj][m][n] * mul; }
                asm volatile("" ::: "memory"); }
    }
};
__device__ __forceinline__ f32x2 swiglu2(f32x2 g, f32x2 u, float c1  , float kinv  ) {
    const f32x2 t = g * c1; f32x2 e; e.x = __builtin_amdgcn_exp2f(t.x); e.y = __builtin_amdgcn_exp2f(t.y);
    const f32x2 d = e * kinv + kinv; f32x2 r; r.x = __builtin_amdgcn_rcpf(d.x); r.y = __builtin_amdgcn_rcpf(d.y);
    return (g * u) * r;
}
__device__ __forceinline__ f32x2 swiglu2n(f32x2 gl, f32x2 us, float k) {
    f32x2 e; e.x = __builtin_amdgcn_exp2f(-gl.x); e.y = __builtin_amdgcn_exp2f(-gl.y);
    const f32x2 d = e * k + k; f32x2 r; r.x = __builtin_amdgcn_rcpf(d.x); r.y = __builtin_amdgcn_rcpf(d.y);
    return (gl * us) * r;
}
__device__ __forceinline__ float silu_mul(float g, float u) { return g * u * __builtin_amdgcn_rcpf(1.0f + __builtin_amdgcn_exp2f(-1.4426950408889634f * g)); }
struct EpiSwiglu {
    static constexpr int NS = 0; static constexpr bool PERM = true;
    bf16_t* H; int ldc;
    __device__ __forceinline__ void operator()(const f32x4 (&acc)[2][2][4][2], const Unit& u, int wr, int wc, int fr, int fq) const {
        const int row0 = u.pm * BM + wr * 64 + fr, col0 = u.pn * HALF + wc * 32 + 8 * fq;
#pragma unroll
        for (int ai = 0; ai < 2; ++ai)
#pragma unroll
            for (int m = 0; m < 4; ++m) { bf16_t* rowp = H + (size_t)(row0 + ai * HALF + m * 16) * ldc + col0;
                const f32x4 g0 = acc[ai][0][m][0], g1 = acc[ai][0][m][1], u0 = acc[ai][1][m][0], u1 = acc[ai][1][m][1];
                const f32x2 h0 = swiglu2((f32x2){g0[0], g0[1]}, (f32x2){u0[0], u0[1]}, -1.4426950408889634f, 1.0f), h1 = swiglu2((f32x2){g0[2], g0[3]}, (f32x2){u0[2], u0[3]}, -1.4426950408889634f, 1.0f);
                const f32x2 h2 = swiglu2((f32x2){g1[0], g1[1]}, (f32x2){u1[0], u1[1]}, -1.4426950408889634f, 1.0f), h3 = swiglu2((f32x2){g1[2], g1[3]}, (f32x2){u1[2], u1[3]}, -1.4426950408889634f, 1.0f);
                u32x4 w; w.x = cvtpk(h0.x, h0.y); w.y = cvtpk(h1.x, h1.y); w.z = cvtpk(h2.x, h2.y); w.w = cvtpk(h3.x, h3.y);
                *(u32x4*)rowp = w; }
    }
};
template <bool OUT8>
struct EpiSwigluI8 {
    static constexpr int NS = 8; static constexpr bool PERM = true;
    bf16_t* H; int ldc; const float* ascale; const float* wscale;
    __device__ __forceinline__ void operator()(const f32x4 (&acc)[2][2][4][2], const Unit& u, int wr, int wc, int fr, int fq) const {
        const int row0 = u.pm * BM + wr * 64 + fr, col0 = u.pn * HALF + wc * 32 + 8 * fq;
        const float* wsp = wscale + u.pn * BM + wc * 32 + 8 * fq;
        const f32x4 sg0 = *(const f32x4*)wsp, sg1 = *(const f32x4*)(wsp + 4), su0 = *(const f32x4*)(wsp + HALF), su1 = *(const f32x4*)(wsp + HALF + 4);
        float sav[2][4];
#pragma unroll
        for (int ai = 0; ai < 2; ++ai)
#pragma unroll
            for (int m = 0; m < 4; ++m) sav[ai][m] = ascale[row0 + ai * HALF + m * 16];
#pragma unroll
        for (int ai = 0; ai < 2; ++ai)
#pragma unroll
            for (int m = 0; m < 4; ++m) { const int row = row0 + ai * HALF + m * 16; bf16_t* rowp = H + (size_t)row * ldc + col0; const float sa = sav[ai][m];
                const i32x4 ig0 = __builtin_bit_cast(i32x4, acc[ai][0][m][0]), ig1 = __builtin_bit_cast(i32x4, acc[ai][0][m][1]), iu0 = __builtin_bit_cast(i32x4, acc[ai][1][m][0]), iu1 = __builtin_bit_cast(i32x4, acc[ai][1][m][1]);
                const f32x4 g0 = __builtin_convertvector(ig0, f32x4) * (sg0 * sa), g1 = __builtin_convertvector(ig1, f32x4) * (sg1 * sa), u0 = __builtin_convertvector(iu0, f32x4) * (su0 * sa), u1 = __builtin_convertvector(iu1, f32x4) * (su1 * sa);
                const f32x2 h0 = swiglu2((f32x2){g0[0], g0[1]}, (f32x2){u0[0], u0[1]}, -1.4426950408889634f, 1.0f), h1 = swiglu2((f32x2){g0[2], g0[3]}, (f32x2){u0[2], u0[3]}, -1.4426950408889634f, 1.0f);
                const f32x2 h2 = swiglu2((f32x2){g1[0], g1[1]}, (f32x2){u1[0], u1[1]}, -1.4426950408889634f, 1.0f), h3 = swiglu2((f32x2){g1[2], g1[3]}, (f32x2){u1[2], u1[3]}, -1.4426950408889634f, 1.0f);
                if constexpr (OUT8) { u32x2 w; w.x = pk4_fp8(h0.x * H8_SC, h0.y * H8_SC, h1.x * H8_SC, h1.y * H8_SC); w.y = pk4_fp8(h2.x * H8_SC, h2.y * H8_SC, h3.x * H8_SC, h3.y * H8_SC);
                    *(u32x2*)((unsigned char*)H + (size_t)row * ldc + col0) = w; }
                else { u32x4 w; w.x = cvtpk(h0.x, h0.y); w.y = cvtpk(h1.x, h1.y); w.z = cvtpk(h2.x, h2.y); w.w = cvtpk(h3.x, h3.y);
                *(u32x4*)rowp = w; } }
    }
};
struct EpiSwiglu8 {
    static constexpr int NS = 8; static constexpr bool PERM = true;
    unsigned char* H; int ldc; float gsc;
    __device__ __forceinline__ void operator()(const f32x4 (&acc)[2][2][4][2], const Unit& u, int wr, int wc, int fr, int fq) const {
        const int row0 = u.pm * BM + wr * 64 + fr, col0 = u.pn * HALF + wc * 32 + 8 * fq;
#pragma unroll
        for (int ai = 0; ai < 2; ++ai)
#pragma unroll
            for (int m = 0; m < 4; ++m) { unsigned char* rowp = H + (size_t)(row0 + ai * HALF + m * 16) * ldc + col0;
                const f32x4 g0 = acc[ai][0][m][0], g1 = acc[ai][0][m][1], u0 = acc[ai][1][m][0], u1 = acc[ai][1][m][1];
                const float kk = W8_GATE / (gsc * H8_SC);
                const f32x2 h0 = swiglu2n((f32x2){g0[0], g0[1]}, (f32x2){u0[0], u0[1]}, kk), h1 = swiglu2n((f32x2){g0[2], g0[3]}, (f32x2){u0[2], u0[3]}, kk);
                const f32x2 h2 = swiglu2n((f32x2){g1[0], g1[1]}, (f32x2){u1[0], u1[1]}, kk), h3 = swiglu2n((f32x2){g1[2], g1[3]}, (f32x2){u1[2], u1[3]}, kk);
                u32x2 w; w.x = pk4_fp8(h0.x, h0.y, h1.x, h1.y); w.y = pk4_fp8(h2.x, h2.y, h3.x, h3.y);
                *(u32x2*)rowp = w; }
    }
};
struct EpiProj {
    static constexpr int NS = 0; static constexpr bool PERM = true;
    bf16_t *Kb, *Qb, *Vt;
    __device__ __forceinline__ void operator()(const f32x4 (&acc)[2][2][4][2], const Unit& u, int wr, int wc, int fr, int fq) const {
        bf16_t* base = (u.aux == 0) ? Kb : (u.aux == 1 ? Qb : Vt); const size_t ldc = (u.aux == 2) ? (size_t)M : (size_t)D;
        const int row0 = u.pm * BM + wr * 64 + fr, col0 = u.pn * BM + wc * 32 + 8 * fq;
#pragma unroll
        for (int ai = 0; ai < 2; ++ai)
#pragma unroll
            for (int m = 0; m < 4; ++m) { bf16_t* rowp = base + (size_t)(row0 + ai * HALF + m * 16) * ldc + col0;
#pragma unroll
                for (int bj = 0; bj < 2; ++bj) { const f32x4 v0 = acc[ai][bj][m][0], v1 = acc[ai][bj][m][1];
                    u32x4 w; w.x = cvtpk(v0[0], v0[1]); w.y = cvtpk(v0[2], v0[3]); w.z = cvtpk(v1[0], v1[1]); w.w = cvtpk(v1[2], v1[3]);
                    if (u.aux == 2) { bf16_t* p16 = rowp + bj * HALF - (fq & 1) * 8 + (fq & 1) * 4;
                        *(u32x2*)p16 = (u32x2){w.x, w.y}; *(u32x2*)(p16 + 8) = (u32x2){w.z, w.w}; }
                    else *(u32x4*)(rowp + bj * HALF) = w; } }
    }
};
struct EpiProjI8 {
    static constexpr int NS = 16; static constexpr bool PERM = true;
    bf16_t *Kb, *Qb, *Vt; const float* ascale; const float* wsc  ; int qsel;
    __device__ __forceinline__ void operator()(const f32x4 (&acc)[2][2][4][2], const Unit& u, int wr, int wc, int fr, int fq) const {
        bf16_t* base = (u.aux == 0) ? Kb : (u.aux == 1 ? Qb : Vt); const size_t ldc = (u.aux == 2) ? (size_t)M : (size_t)D;
        const float* rs; const float* cs; if (u.aux == 2) { rs = wsc + 1024; cs = ascale; } else { rs = ascale; cs = wsc + u.aux * (2048 + qsel * 1024); }
        const int row0 = u.pm * BM + wr * 64 + fr, col0 = u.pn * BM + wc * 32 + 8 * fq;
        f32x4 cv[2][2];
#pragma unroll
        for (int bj = 0; bj < 2; ++bj) { cv[bj][0] = *(const f32x4*)(cs + col0 + bj * HALF); cv[bj][1] = *(const f32x4*)(cs + col0 + bj * HALF + 4); }
        float rvv[2][4];
#pragma unroll
        for (int ai = 0; ai < 2; ++ai)
#pragma unroll
            for (int m = 0; m < 4; ++m) rvv[ai][m] = rs[row0 + ai * HALF + m * 16];
#pragma unroll
        for (int ai = 0; ai < 2; ++ai)
#pragma unroll
            for (int m = 0; m < 4; ++m) { const int row = row0 + ai * HALF + m * 16; bf16_t* rowp = base + (size_t)row * ldc + col0; const float rv = rvv[ai][m];
#pragma unroll
                for (int bj = 0; bj < 2; ++bj) { const f32x4 v0 = __builtin_convertvector(__builtin_bit_cast(i32x4, acc[ai][bj][m][0]), f32x4) * (cv[bj][0] * rv), v1 = __builtin_convertvector(__builtin_bit_cast(i32x4, acc[ai][bj][m][1]), f32x4) * (cv[bj][1] * rv);
                    u32x4 w; w.x = cvtpk(v0[0], v0[1]); w.y = cvtpk(v0[2], v0[3]); w.z = cvtpk(v1[0], v1[1]); w.w = cvtpk(v1[2], v1[3]);
                    if (u.aux == 2) { bf16_t* p16 = rowp + bj * HALF - (fq & 1) * 8 + (fq & 1) * 4;
                        *(u32x2*)p16 = (u32x2){w.x, w.y}; *(u32x2*)(p16 + 8) = (u32x2){w.z, w.w}; }
                    else *(u32x4*)(rowp + bj * HALF) = w; } }
    }
};
struct EpiMoeDown {
    static constexpr int NS = 16; static constexpr bool PERM = true;
    bf16_t* Y; const float* gate; float osc;
    __device__ __forceinline__ void operator()(const f32x4 (&acc)[2][2][4][2], const Unit& u, int wr, int wc, int fr, int fq) const {
        const int row0 = u.pm * BM + wr * 64 + fr, col0 = u.pn * BM + wc * 32 + 8 * fq;
        float gtv[2][4];
#pragma unroll
        for (int ai = 0; ai < 2; ++ai)
#pragma unroll
            for (int m = 0; m < 4; ++m) gtv[ai][m] = gate[row0 + ai * HALF + m * 16];
#pragma unroll
        for (int ai = 0; ai < 2; ++ai)
#pragma unroll
            for (int m = 0; m < 4; ++m) { const int row = row0 + ai * HALF + m * 16; const float gt = gtv[ai][m] * osc; bf16_t* rowp = Y + (size_t)row * D + col0;
#pragma unroll
                for (int bj = 0; bj < 2; ++bj) { const f32x4 v0 = acc[ai][bj][m][0] * gt, v1 = acc[ai][bj][m][1] * gt;
                    u32x4 w; w.x = cvtpk(v0[0], v0[1]); w.y = cvtpk(v0[2], v0[3]); w.z = cvtpk(v1[0], v1[1]); w.w = cvtpk(v1[2], v1[3]);
                    *(u32x4*)(rowp + bj * HALF) = w; } }
    }
};
}

__device__ __forceinline__ void tr_load(float (&tv)[32], const float* W, int ldw, int k0, int n0, int lane) {
    const GAS float* wp = (const GAS float*)W + (size_t)(k0 + (lane >> 5)) * ldw + n0 + (lane & 31);
#pragma unroll
    for (int i = 0; i < 32; ++i) tv[i] = wp[(size_t)(2 * i) * ldw];
}
__device__ __forceinline__ void tr_put(const float (&tv)[32], int k0, const float* gain, float mul, int mode  , unsigned char* WT, int ldk, int drow0, LAS float* scr, int lane,
                                       const unsigned* colmax = nullptr  , int n0 = 0, float* wscale = nullptr  ) {
#pragma unroll
    for (int i = 0; i < 32; ++i) { const int kk = 2 * i + (lane >> 5); const float gv = gain ? gain[k0 + kk] * mul : mul; scr[kk * 33 + (lane & 31)] = tv[i] * gv; }
    LDS_WAIT(); asm volatile("" ::: "memory");
    const int c = lane & 7;
#pragma unroll
    for (int j = 0; j < 4; ++j) { const int n = (lane >> 3) + 8 * j; const LAS float* sp = scr + (8 * c) * 33 + n;
        const float e0 = sp[0 * 33], e1 = sp[1 * 33], e2 = sp[2 * 33], e3 = sp[3 * 33], e4 = sp[4 * 33], e5 = sp[5 * 33], e6 = sp[6 * 33], e7 = sp[7 * 33];
        if (mode == 2) { const float mx = __builtin_bit_cast(float, __hip_atomic_load(colmax + n0 + n, RLX_AGENT)); const float q = mx > 0.f ? 127.0f / mx : 0.f;
            u32x2 o; o.x = pk4_i8(e0 * q, e1 * q, e2 * q, e3 * q); o.y = pk4_i8(e4 * q, e5 * q, e6 * q, e7 * q); *(GAS u32x2*)(WT + (size_t)(drow0 + n) * ldk + k0 + 8 * c) = o;
            if (k0 == 0 && c == 0) wscale[drow0 + n] = mx * (1.0f / 127.0f); }
        else if (mode == 1) { u32x2 o; o.x = pk4_fp8(e0, e1, e2, e3); o.y = pk4_fp8(e4, e5, e6, e7); *(GAS u32x2*)(WT + (size_t)(drow0 + n) * ldk + k0 + 8 * c) = o; }
        else { u32x4 o; o.x = cvtpk(e0, e1); o.y = cvtpk(e2, e3); o.z = cvtpk(e4, e5); o.w = cvtpk(e6, e7); *(GAS u32x4*)(WT + ((size_t)(drow0 + n) * ldk + k0 + 8 * c) * 2) = o; } }
    LDS_WAIT(); asm volatile("" ::: "memory");
}
__device__ __forceinline__ void tr_mat(const float* W, int ldw, int K, int N, const float* gain, float mul, int mode, bool gu, unsigned char* WT, LAS float* scr, int first, int NGW, int lane,
                                       const unsigned* colmax = nullptr, float* wscale = nullptr, float gmul = 0.f  ) {
    const int nblk = N / 32, nitems = (K / 64) * nblk, F = N / 2;
    float tv[32], tn[32];
    int it = first; if (it >= nitems) return;
    tr_load(tv, W, ldw, (it / nblk) * 64, (it % nblk) * 32, lane);
    for (; it < nitems; it += NGW) {
        const int nx = it + NGW; if (nx < nitems) tr_load(tn, W, ldw, (nx / nblk) * 64, (nx % nblk) * 32, lane);
        const int kb = it / nblk, n0 = (it % nblk) * 32; int drow0 = n0;
        if (gu) { const int isup = n0 >= F, j = isup ? n0 - F : n0; drow0 = (j >> 7) * 256 + (isup ? 128 : 0) + (j & 127); }
        tr_put(tv, kb * 64, gain, (gu && n0 < F && gmul != 0.f) ? gmul : mul, mode, WT, K, drow0, scr, lane, colmax, n0, wscale);
#pragma unroll
        for (int i = 0; i < 32; ++i) tv[i] = tn[i];
    }
}

struct Args { const float* in[15]; float* out; unsigned char* ws; };
template <int OFF> __device__ __forceinline__ unsigned long long karg() { unsigned long long v; auto ka = __builtin_amdgcn_kernarg_segment_ptr();
    asm volatile("s_load_dwordx2 %0, %1, %2\n\ts_waitcnt lgkmcnt(0)" : "=s"(v) : "s"(ka), "n"(OFF) : "memory"); return v; }
#define ARG_IN(k) ((const float*)(const GAS float*)karg<8 * (k)>())
#define ARG_OUT() ((float*)(GAS float*)karg<120>())
#define ARG_WS() ((unsigned char*)(GAS unsigned char*)karg<128>())

template <int CTRL> __device__ __forceinline__ float dpp_mov(float s) { return __builtin_bit_cast(float, __builtin_amdgcn_update_dpp(0, __builtin_bit_cast(int, s), CTRL, 0xF, 0xF, true)); }
__device__ __forceinline__ void swap16(float& a, float& b) { asm("s_nop 1\n\tv_permlane16_swap_b32 %0, %1" : "+v"(a), "+v"(b)); }
__device__ __forceinline__ void swap32(float& a, float& b) { asm("s_nop 1\n\tv_permlane32_swap_b32 %0, %1" : "+v"(a), "+v"(b)); }
__device__ __forceinline__ float fast_wave_sum(float v) {
    v += dpp_mov<0xB1>(v); v += dpp_mov<0x4E>(v); v += dpp_mov<0x141>(v); v += dpp_mov<0x140>(v);
    { float w = v; swap16(v, w); v += w; } { float w = v; swap32(v, w); v += w; }
    return v;
}
__device__ __forceinline__ float fast_wave_max(float v) {
    v = fmaxf(v, dpp_mov<0xB1>(v)); v = fmaxf(v, dpp_mov<0x4E>(v)); v = fmaxf(v, dpp_mov<0x141>(v)); v = fmaxf(v, dpp_mov<0x140>(v));
    { float w = v; swap16(v, w); v = fmaxf(v, w); } { float w = v; swap32(v, w); v = fmaxf(v, w); }
    return v;
}
__device__ __forceinline__ float reduce8(float (&a)[8], int lane) {
    float b[4], c[2];
#pragma unroll
    for (int k = 0; k < 4; ++k) { float x = a[k], y = a[k + 4]; swap32(x, y); b[k] = x + y; }
#pragma unroll
    for (int k = 0; k < 2; ++k) { float x = b[k], y = b[k + 2]; swap16(x, y); c[k] = x + y; }
    const bool hi = (lane & 8) != 0;
    const float keep = hi ? c[1] : c[0], send = hi ? c[0] : c[1];
    float d = keep + dpp_mov<0x140>(send);
    d += dpp_mov<0x141>(d); d += dpp_mov<0xB1>(d); d += dpp_mov<0x4E>(d);
    return d;
}
template <int W, class HT>
__device__ __forceinline__ void pool_chan(const bf16_t* xp  , const HT* hp  , int s0, const LAS float* inv  , bf16_t* pp  ) {
    f32x2 hist[W]; f32x2 S = {0.f, 0.f};
#pragma unroll
    for (int j = 0; j < W; ++j) hist[j] = (f32x2){0.f, 0.f};
    if (s0 > 0) {
#pragma unroll
        for (int j = 1; j < W; ++j) { const int t = j - W; const f32x2 v = ld2(hp + (ptrdiff_t)t * D) * inv[15 + t]; hist[j] = v; S += v; }
    }
    for (int tb = 0; tb < 256; tb += 64) {
        unsigned raw[64];
#pragma unroll
        for (int j = 0; j < 64; ++j) raw[j] = *(const GAS unsigned*)(xp + (size_t)(tb + j) * D);
#pragma unroll
        for (int j = 0; j < 64; ++j) { const int t = tb + j; const f32x2 xv = (f32x2){bf_lo(raw[j]), bf_hi(raw[j])} * inv[15 + t]; S += xv - hist[j % W]; hist[j % W] = xv;
            const int pos = s0 + t + 1; const float rc = (pos >= W) ? (1.0f / W) : (1.0f / (float)pos);
            const f32x2 p = S * rc - xv; *(GAS unsigned*)(pp + (size_t)t * D) = cvtpk(p.x, p.y); }
    }
}
template <bool FIRST>
__device__ __forceinline__ void pool_prep_phase(const float* xin, bf16_t* xb, bf16_t* P, LAS unsigned char* lds, int G, int wave_s) {
    const int tid = fresh_tid(wave_s); const int lane = tid & 63, wave = __builtin_amdgcn_readfirstlane(tid >> 6);
    LAS float* inv = (LAS float*)lds;
    for (int tile = blockIdx.x; tile < M / 256; tile += G) {
        const int r0 = tile * 256, s0 = r0 % SEQ;
        const int start = (s0 > 0) ? -15 : 0;
        for (int base = start + wave; base < 256; base += 8 * NWAVES) {
            typename Raw4<float>::t vf[8][4]; typename Raw4<bf16_t>::t vb[8][4];
#pragma unroll
            for (int k = 0; k < 8; ++k) { int rr = base + k * NWAVES; rr = rr < 256 ? rr : 255;
                if (FIRST) { const float* xr = xin + (size_t)(r0 + rr) * D + 4 * lane;
#pragma unroll
                    for (int j = 0; j < 4; ++j) vf[k][j] = ldraw4(xr + 256 * j); }
                else { const bf16_t* xr = xb + (size_t)(r0 + rr) * D + 4 * lane;
#pragma unroll
                    for (int j = 0; j < 4; ++j) vb[k][j] = ldraw4(xr + 256 * j); } }
#pragma unroll
            for (int k = 0; k < 8; ++k) { const int rr = base + k * NWAVES; float s = 0.f; f32x4 v[4];
#pragma unroll
                for (int j = 0; j < 4; ++j) { if (FIRST) v[j] = cvt4(vf[k][j]); else v[j] = cvt4(vb[k][j]); s += (v[j].x * v[j].x + v[j].y * v[j].y) + (v[j].z * v[j].z + v[j].w * v[j].w); }
                s = fast_wave_sum(s);
                if (rr < 256) {
                    if (lane == 0) inv[15 + rr] = 1.0f / sqrtf(s * (1.0f / D) + RMS_EPS);
                    if (FIRST && rr >= 0) { GAS u32x2* xo = (GAS u32x2*)(xb + (size_t)(r0 + rr) * D) + lane;
#pragma unroll
                        for (int j = 0; j < 4; ++j) { u32x2 w; w.x = cvtpk(v[j].x, v[j].y); w.y = cvtpk(v[j].z, v[j].w); xo[64 * j] = w; } } } }
        }
        __syncthreads();
        const int c = 2 * tid; const bf16_t* xp = xb + (size_t)r0 * D + c; bf16_t* pp = P + (size_t)r0 * D + c;
        const int grp = wave >> 1;
        if (FIRST) { const float* hp = xin + (size_t)r0 * D + c;
            if (grp == 0) pool_chan<2, float>(xp, hp, s0, inv, pp); else if (grp == 1) pool_chan<4, float>(xp, hp, s0, inv, pp); else if (grp == 2) pool_chan<8, float>(xp, hp, s0, inv, pp); else pool_chan<16, float>(xp, hp, s0, inv, pp); }
        else { if (grp == 0) pool_chan<2, bf16_t>(xp, xp, s0, inv, pp); else if (grp == 1) pool_chan<4, bf16_t>(xp, xp, s0, inv, pp); else if (grp == 2) pool_chan<8, bf16_t>(xp, xp, s0, inv, pp); else pool_chan<16, bf16_t>(xp, xp, s0, inv, pp); }
        __syncthreads();
    }
}

template <bool COMBINE, bool ROUTER, bool FINAL, int OUTK, bool DELTA, class XT>
__device__ __forceinline__ void norm_phase(float* x, bf16_t* XN, const bf16_t* YS, const int* slot_of, const float* gvec  , const float* wr  ,
                                           int* route_e, float* route_g, int* tilecnt, LAS unsigned char* lds, LAS int* cnt_l, int G, int wave_s, float* ascale, const bf16_t* DL, const XT* xs  , bf16_t* xw  ) {
    const int tid = fresh_tid(wave_s); const int lane = tid & 63, wave = __builtin_amdgcn_readfirstlane(tid >> 6);
    f32x2 wreg[8][8];
    if (ROUTER) {
#pragma unroll
        for (int j = 0; j < 4; ++j)
#pragma unroll
            for (int k = 0; k < 4; ++k) { const int c = 4 * lane + 256 * j + k; const float gc = gvec[c]; const f32x4 w0 = *(const f32x4*)(wr + (size_t)c * 8), w1 = *(const f32x4*)(wr + (size_t)c * 8 + 4);
#pragma unroll
                for (int e = 0; e < 4; ++e) { wreg[e][2 * j + (k >> 1)][k & 1] = w0[e] * gc; wreg[e + 4][2 * j + (k >> 1)][k & 1] = w1[e] * gc; } }
    }
    f32x4 gf[4];
    if (FINAL) {
#pragma unroll
        for (int j = 0; j < 4; ++j) gf[j] = *((const f32x4*)gvec + lane + 64 * j);
    }
    for (int tile = blockIdx.x; tile < M / 256; tile += G) {
        const int rb = tile * 256 + wave * 32;
        int slv = 0; if (COMBINE) slv = slot_of[2 * rb + lane];
        u32x2 nx[2][4], na[2][4], nb[2][4];
#define NP_LOAD(u, idx) do { const GAS u32x2* p_ = (const GAS u32x2*)((const bf16_t*)xs + (size_t)(rb + (idx)) * D) + lane; \
            _Pragma("unroll") for (int j = 0; j < 4; ++j) nx[u][j] = p_[64 * j]; \
            if (COMBINE) { const int a0_ = __builtin_amdgcn_readlane(slv, 2 * (idx)), a1_ = __builtin_amdgcn_readlane(slv, 2 * (idx) + 1); \
                const GAS u32x2* y0_ = (const GAS u32x2*)(YS + (size_t)a0_ * D) + lane; const GAS u32x2* y1_ = (const GAS u32x2*)(YS + (size_t)a1_ * D) + lane; \
                _Pragma("unroll") for (int j = 0; j < 4; ++j) { na[u][j] = y0_[64 * j]; nb[u][j] = y1_[64 * j]; } } } while (0)
        NP_LOAD(0, 0); NP_LOAD(1, 1);
        for (int i = 0; i < 32; i += 2) {
            f32x4 v[2][4];
#pragma unroll
            for (int u = 0; u < 2; ++u)
#pragma unroll
                for (int j = 0; j < 4; ++j) { const u32x2 d = nx[u][j]; v[u][j] = (f32x4){bf_lo(d.x), bf_hi(d.x), bf_lo(d.y), bf_hi(d.y)}; }
            if (COMBINE) {
#pragma unroll
                for (int u = 0; u < 2; ++u)
#pragma unroll
                    for (int w = 0; w < 2; ++w) { const int sl = __builtin_amdgcn_readlane(slv, 2 * (i + u) + w);
                        if (sl < 2 * M) {
#pragma unroll
                            for (int j = 0; j < 4; ++j) { const u32x2 a = w ? nb[u][j] : na[u][j]; v[u][j] += (f32x4){bf_lo(a.x), bf_hi(a.x), bf_lo(a.y), bf_hi(a.y)}; } }
                        else {
                            for (int q = 0; q < 7; ++q) { const GAS u32x2* yq = (const GAS u32x2*)(DL + ((size_t)q * (8 * 256) + (size_t)(sl - 2 * M)) * D) + lane;
#pragma unroll
                                for (int j = 0; j < 4; ++j) { const u32x2 a = yq[64 * j]; v[u][j] += (f32x4){bf_lo(a.x), bf_hi(a.x), bf_lo(a.y), bf_hi(a.y)}; } } } } }
            if (i + 2 < 32) { NP_LOAD(0, i + 2); NP_LOAD(1, i + 3); }
#pragma unroll
            for (int u = 0; u < 2; ++u) {
                const int r = rb + i + u;
                if (COMBINE && !FINAL) { GAS u32x2* xo = (GAS u32x2*)(xw + (size_t)r * D) + lane;
#pragma unroll
                    for (int j = 0; j < 4; ++j) { u32x2 w; w.x = cvtpk(v[u][j].x, v[u][j].y); w.y = cvtpk(v[u][j].z, v[u][j].w); xo[64 * j] = w; } }
                float s = 0.f;
#pragma unroll
                for (int j = 0; j < 4; ++j) s += (v[u][j].x * v[u][j].x + v[u][j].y * v[u][j].y) + (v[u][j].z * v[u][j].z + v[u][j].w * v[u][j].w);
                float lgp[8];
                if (ROUTER) {
#pragma unroll
                    for (int e = 0; e < 8; ++e) { f32x2 a2 = {0.f, 0.f};
#pragma unroll
                        for (int j = 0; j < 4; ++j) { a2 += (f32x2){v[u][j].x, v[u][j].y} * wreg[e][2 * j] ; a2 += (f32x2){v[u][j].z, v[u][j].w} * wreg[e][2 * j + 1]; }
                        lgp[e] = a2.x + a2.y; }
                }
                const float inv = 1.0f / sqrtf(fast_wave_sum(s) * (1.0f / D) + RMS_EPS);
#pragma unroll
                for (int j = 0; j < 4; ++j) v[u][j] = v[u][j] * inv;
                if (FINAL) { GAS f32x4* xr = (GAS f32x4*)(x + (size_t)r * D) + lane;
#pragma unroll
                    for (int j = 0; j < 4; ++j) xr[64 * j] = v[u][j] * gf[j];
                } else if (OUTK == 2) {
                    float mx = 0.f;
#pragma unroll
                    for (int j = 0; j < 4; ++j) mx = fmaxf(fmaxf(mx, fmaxf(fabsf(v[u][j].x), fabsf(v[u][j].y))), fmaxf(fabsf(v[u][j].z), fabsf(v[u][j].w)));
                    mx = fast_wave_max(mx); const float q = mx > 0.f ? 127.0f / mx : 0.f;
                    GAS unsigned* o = (GAS unsigned*)((unsigned char*)XN + (size_t)r * D) + lane;
#pragma unroll
                    for (int j = 0; j < 4; ++j) o[64 * j] = pk4_i8(v[u][j].x * q, v[u][j].y * q, v[u][j].z * q, v[u][j].w * q);
                    if (lane == 0) ascale[r] = mx * (1.0f / 127.0f);
                } else if (OUTK == 1) {
                    GAS unsigned* o = (GAS unsigned*)((unsigned char*)XN + (size_t)r * D) + lane;
#pragma unroll
                    for (int j = 0; j < 4; ++j) o[64 * j] = pk4_fp8(v[u][j].x, v[u][j].y, v[u][j].z, v[u][j].w);
                } else {
                    GAS u32x2* o = (GAS u32x2*)(XN + (size_t)r * D) + lane;
#pragma unroll
                    for (int j = 0; j < 4; ++j) { u32x2 w; w.x = cvtpk(v[u][j].x, v[u][j].y); w.y = cvtpk(v[u][j].z, v[u][j].w); o[64 * j] = w; }
                }
                if (ROUTER) {
                    const float dsum = reduce8(lgp, lane) * inv;
                    float lg[8];
#pragma unroll
                    for (int e = 0; e < 8; ++e) lg[e] = __builtin_bit_cast(float, __builtin_amdgcn_readlane(__builtin_bit_cast(int, dsum), 8 * e));
                    int e0 = 0; float v0 = lg[0];
#pragma unroll
                    for (int e = 1; e < 8; ++e) if (lg[e] > v0) { v0 = lg[e]; e0 = e; }
                    int e1 = -1; float v1 = -3.0e38f;
#pragma unroll
                    for (int e = 0; e < 8; ++e) if (e != e0 && lg[e] > v1) { v1 = lg[e]; e1 = e; }
                    const float ex = __expf(v1 - v0), g0 = 1.0f / (1.0f + ex), g1 = ex * g0;
                    if (lane == 0) { route_e[r] = e0 | (e1 << 8); route_g[2 * r] = g0; route_g[2 * r + 1] = g1; atomicAdd((int*)(cnt_l + e0), 1); atomicAdd((int*)(cnt_l + e1), 1); }
                }
            }
        }
#undef NP_LOAD
        if (ROUTER) {
            __syncthreads();
            if (tid < 8) { tilecnt[tile * 8 + tid] = cnt_l[tid]; cnt_l[tid] = 0; }
            __syncthreads();
        }
    }
}

template <bool FP8>
__device__ __forceinline__ void dispatch_phase(const int* tilecnt, const int* route_e, const float* route_g, int* slot_of, float* gate_slot, const bf16_t* XN, bf16_t* XS  ,
                                               LAS unsigned char* lds, LAS int* pend, int G, int wave_s) {
    const int tid = fresh_tid(wave_s); const int lane = tid & 63, wave = __builtin_amdgcn_readfirstlane(tid >> 6);
    LAS int* lc = (LAS int*)lds;
    LAS int* tot_l = (LAS int*)(lds + 8192);
    LAS int* pst_l = (LAS int*)(lds + 8192 + 32);
    LAS int* base_l = (LAS int*)(lds + 8192 + 64);
    LAS int* slot_l = (LAS int*)(lds + 8192 + 128);
    if (tid < 256) { const i32x4 a = *((const i32x4*)tilecnt + 2 * tid), b = *((const i32x4*)tilecnt + 2 * tid + 1); *((LAS i32x4*)lc + 2 * tid) = a; *((LAS i32x4*)lc + 2 * tid + 1) = b; }
    __syncthreads();
    if (tid < 8) { int t = 0; for (int i = 0; i < 256; ++i) t += lc[i * 8 + tid]; tot_l[tid] = t; }
    __syncthreads();
    if (tid == 0) { int ps = 0; for (int e = 0; e < 8; ++e) { const int padded = (tot_l[e] + 255) & ~255; pst_l[e] = ps; ps += padded; pend[e] = ps >> 8; } }
    __syncthreads();
    if (FP8 && blockIdx.x < 8) { const int e = blockIdx.x, t0 = pst_l[e] + tot_l[e], npad = ((tot_l[e] + 255) & ~255) - tot_l[e];
        for (int i = tid; i < npad; i += NTHREADS) ((int*)XS)[t0 + i] = 0; }
    for (int tile = blockIdx.x; tile < M / 256; tile += G) {
        const int r0 = tile * 256;
        if (tid < 8) { int pre = 0; for (int i = 0; i < tile; ++i) pre += lc[i * 8 + tid]; base_l[tid] = pst_l[tid] + pre; }
        __syncthreads();
        if (wave == 0) {
            int run[8];
#pragma unroll
            for (int e = 0; e < 8; ++e) run[e] = 0;
            for (int ch = 0; ch < 8; ++ch) {
                const int i = ch * 64 + lane, tok = r0 + (i >> 1), k = i & 1;
                const int ew = __hip_atomic_load(route_e + tok, RLX_AGENT); const int e = (ew >> (8 * k)) & 0xff;
                int slot = 0;
#pragma unroll
                for (int ee = 0; ee < 8; ++ee) { const unsigned long long mask = __ballot(e == ee);
                    if (e == ee) slot = base_l[ee] + run[ee] + __popcll(mask & ((1ull << lane) - 1ull));
                    run[ee] += __popcll(mask); }
                slot_l[i] = slot; slot_of[2 * tok + k] = slot; gate_slot[slot] = __hip_atomic_load(route_g + 2 * tok + k, RLX_AGENT); if (FP8) ((int*)XS)[slot] = tok;
            }
        }
        __syncthreads();
        if constexpr (!FP8) {
        for (int ii = 0; ii < 64; ii += 4) {
            u32x4 a[4][2];
#pragma unroll
            for (int q = 0; q < 4; ++q) { const int i = wave * 64 + ii + q; const GAS u32x4* src = (const GAS u32x4*)(XN + (size_t)(r0 + (i >> 1)) * D) + lane; a[q][0] = src[0]; a[q][1] = src[64]; }
#pragma unroll
            for (int q = 0; q < 4; ++q) { const int i = wave * 64 + ii + q; GAS u32x4* dst = (GAS u32x4*)(XS + (size_t)slot_l[i] * D) + lane; dst[0] = a[q][0]; dst[64] = a[q][1]; }
        }
        }
        __syncthreads();
    }
}

#define ATT_LOAD(KF, VF, kt_) do { const int k0_ = (kt_) * 32; \
        const GAS u32x4* kp_ = (const GAS u32x4*)(Kb + (rowbase + k0_ + n) * D + h * 64 + 8 * hh); \
        _Pragma("unroll") for (int s_ = 0; s_ < 4; ++s_) KF[s_] = __builtin_bit_cast(bf16x8, kp_[2 * s_]); \
        _Pragma("unroll") for (int dt_ = 0; dt_ < 2; ++dt_) { const GAS u32x4* vp_ = (const GAS u32x4*)(Vt + (size_t)(h * 64 + dt_ * 32 + n) * M + rowbase + k0_ + 8 * hh); \
            _Pragma("unroll") for (int s_ = 0; s_ < 2; ++s_) VF[dt_][s_] = __builtin_bit_cast(bf16x8, vp_[2 * s_]); } } while (0)
constexpr float ATT_STOP = 9.0e-14f;
template <bool DIAG>
__device__ __forceinline__ void att_tile(const bf16x8 (&kf)[4], const bf16x8 (&vf)[2][2], const bf16x8 (&qf)[4], f32x16& o0, f32x16& o1, float& carry, int n, int hh) {
    f32x16 sc = __builtin_amdgcn_mfma_f32_32x32x16_bf16(kf[0], qf[0], (f32x16){0.f, 0.f, 0.f, 0.f, 0.f, 0.f, 0.f, 0.f, 0.f, 0.f, 0.f, 0.f, 0.f, 0.f, 0.f, 0.f}, 0, 0, 0);
#pragma unroll
    for (int s = 1; s < 4; ++s) sc = __builtin_amdgcn_mfma_f32_32x32x16_bf16(kf[s], qf[s], sc, 0, 0, 0);
    float be[16], kp[16];
#pragma unroll
    for (int r = 0; r < 16; r += 2) { f32x2 e; e.x = __builtin_amdgcn_exp2f(-__builtin_amdgcn_fmed3f(sc[r], -64.f, 3.0e38f)); e.y = __builtin_amdgcn_exp2f(-__builtin_amdgcn_fmed3f(sc[r + 1], -64.f, 3.0e38f));
        const f32x2 d = e + 1.0f; f32x2 b2; b2.x = __builtin_amdgcn_rcpf(d.x); b2.y = __builtin_amdgcn_rcpf(d.y); const f32x2 k2 = e * b2;
        be[r] = b2.x; be[r + 1] = b2.y; kp[r] = k2.x; kp[r + 1] = k2.y; }
    if constexpr (DIAG) {
#pragma unroll
        for (int r = 0; r < 16; ++r) { const int key = (r & 3) + 8 * (r >> 2) + 4 * hh; if (key >= n) { be[r] = 0.f; kp[r] = 1.f; } } }
    float T[4], Pp[4], p2[4], p1[4], p0[4];
#pragma unroll
    for (int g = 0; g < 4; ++g) { p2[g] = kp[4 * g + 3]; p1[g] = p2[g] * kp[4 * g + 2]; p0[g] = p1[g] * kp[4 * g + 1]; T[g] = p0[g] * kp[4 * g]; }
#pragma unroll
    for (int g = 0; g < 4; ++g) Pp[g] = __shfl_xor(T[g], 32);
    float off[4];
    { const float own2 = T[3], own1 = T[3] * T[2], own0 = own1 * T[1];
      const float pe2 = Pp[3], pe1 = Pp[3] * Pp[2], pe0 = pe1 * Pp[1];
      if (hh == 0) { off[0] = own0 * pe0 * Pp[0]; off[1] = own1 * pe1 * Pp[1]; off[2] = own2 * pe2 * Pp[2]; off[3] = Pp[3]; }
      else         { off[0] = own0 * pe0;         off[1] = own1 * pe1;         off[2] = own2 * pe2;         off[3] = 1.f; } }
    float a[16];
#pragma unroll
    for (int g = 0; g < 4; ++g) { const float base = carry * off[g];
        a[4 * g + 0] = be[4 * g + 0] * (base * p0[g]); a[4 * g + 1] = be[4 * g + 1] * (base * p1[g]); a[4 * g + 2] = be[4 * g + 2] * (base * p2[g]); a[4 * g + 3] = be[4 * g + 3] * base; }
    carry *= ((T[0] * T[1]) * (T[2] * T[3])) * ((Pp[0] * Pp[1]) * (Pp[2] * Pp[3]));
    bf16x8 pb[2];
#pragma unroll
    for (int s = 0; s < 2; ++s) { u32x4 w; w.x = cvtpk(a[8 * s + 0], a[8 * s + 1]); w.y = cvtpk(a[8 * s + 2], a[8 * s + 3]); w.z = cvtpk(a[8 * s + 4], a[8 * s + 5]); w.w = cvtpk(a[8 * s + 6], a[8 * s + 7]); pb[s] = __builtin_bit_cast(bf16x8, w); }
#pragma unroll
    for (int s = 0; s < 2; ++s) { o0 = __builtin_amdgcn_mfma_f32_32x32x16_bf16(vf[0][s], pb[s], o0, 0, 0, 0); o1 = __builtin_amdgcn_mfma_f32_32x32x16_bf16(vf[1][s], pb[s], o1, 0, 0, 0); }
}
constexpr int ATT_KROW = 144, ATT_VROW = 784, ATT_V_OFF = 384 * ATT_KROW;
static_assert(ATT_V_OFF + 64 * ATT_VROW <= STAGE_BYTES_LDS, "attention LDS image");
__device__ __forceinline__ void attn_phase(const bf16_t* Q, const bf16_t* Kb, const bf16_t* Vt, bf16_t* O, LAS unsigned char* lds, int vcu, int G, int wave_s) {
    const int tid = fresh_tid(wave_s); const int lane = tid & 63, wave = __builtin_amdgcn_readfirstlane(tid >> 6);
    const int n = lane & 31, hh = lane >> 5;
    const int NU = BATCH * NH * (SEQ / 256), per = (NU + G - 1) / G;
    const int u_lo = vcu * per, u_hi = (u_lo + per < NU) ? u_lo + per : NU;
    u32x4 pk[6], pv[6];
#define ATT_FETCH(uu) do { const int bh_ = (uu) >> 3, qb_ = (uu) & 7, h_ = bh_ & 15, b_ = bh_ >> 4; const int kw0_ = qb_ > 0 ? qb_ * 256 - 128 : 0, nk_ = qb_ * 256 + 256 - kw0_; \
        const size_t rb_ = (size_t)b_ * SEQ; \
        _Pragma("unroll") for (int i_ = 0; i_ < 6; ++i_) { const int p_ = tid + i_ * NTHREADS; const int kr_ = p_ >> 3, kc_ = p_ & 7; \
            if (kr_ < nk_) pk[i_] = *(const GAS u32x4*)(Kb + (rb_ + kw0_ + kr_) * D + h_ * 64 + kc_ * 8); \
            const int vd_ = p_ / 48, vc_ = p_ - vd_ * 48; \
            if (vc_ * 8 < nk_) pv[i_] = *(const GAS u32x4*)(Vt + (size_t)(h_ * 64 + vd_) * M + rb_ + kw0_ + vc_ * 8); } } while (0)
#define ATT_PUT(uu) do { const int qb_ = (uu) & 7; const int kw0_ = qb_ > 0 ? qb_ * 256 - 128 : 0, nk_ = qb_ * 256 + 256 - kw0_; \
        _Pragma("unroll") for (int i_ = 0; i_ < 6; ++i_) { const int p_ = tid + i_ * NTHREADS; const int kr_ = p_ >> 3, kc_ = p_ & 7; \
            if (kr_ < nk_) *(LAS u32x4*)(lds + kr_ * ATT_KROW + kc_ * 16) = pk[i_]; \
            const int vd_ = p_ / 48, vc_ = p_ - vd_ * 48; \
            if (vc_ * 8 < nk_) *(LAS u32x4*)(lds + ATT_V_OFF + vd_ * ATT_VROW + vc_ * 16) = pv[i_]; } } while (0)
#define ATT_TILE_LD(KF, VF, kt_) do { const int k0_ = (kt_) * 32; if (k0_ >= kw0) { const int ko_ = k0_ - kw0; \
            _Pragma("unroll") for (int s_ = 0; s_ < 4; ++s_) KF[s_] = *(const LAS bf16x8*)(lds + (ko_ + n) * ATT_KROW + 32 * s_ + 16 * hh); \
            _Pragma("unroll") for (int dt_ = 0; dt_ < 2; ++dt_) _Pragma("unroll") for (int s_ = 0; s_ < 2; ++s_) VF[dt_][s_] = *(const LAS bf16x8*)(lds + ATT_V_OFF + (dt_ * 32 + n) * ATT_VROW + (ko_ + 16 * s_ + 8 * hh) * 2); } \
        else { ATT_LOAD(KF, VF, kt_); } } while (0)
    if (u_lo < u_hi) ATT_FETCH(u_lo);
    for (int u = u_lo; u < u_hi; ++u) {
        const int bh = u >> 3, qb = u & 7, h = bh & 15, b = bh >> 4;
        const size_t rowbase = (size_t)b * SEQ; const int kw0 = qb > 0 ? qb * 256 - 128 : 0;
        const int qt = qb * 8 + wave, q0 = qt * 32;
        bf16x8 qf[4];
        { const GAS u32x4* qp = (const GAS u32x4*)(Q + (rowbase + q0 + n) * D + h * 64 + 8 * hh);
#pragma unroll
          for (int s = 0; s < 4; ++s) qf[s] = __builtin_bit_cast(bf16x8, qp[2 * s]); }
        ATT_PUT(u);
        __syncthreads();
        if (u + 1 < u_hi) ATT_FETCH(u + 1);
        f32x16 o0, o1;
#pragma unroll
        for (int r = 0; r < 16; ++r) { o0[r] = 0.f; o1[r] = 0.f; }
        float carry = 1.f;
        bf16x8 kf[4], vf[2][2];
        ATT_TILE_LD(kf, vf, qt);
        att_tile<true>(kf, vf, qf, o0, o1, carry, n, hh);
        if (!__all(carry < ATT_STOP)) for (int kt = qt - 1; kt >= 0; --kt) {
            ATT_TILE_LD(kf, vf, kt);
            att_tile<false>(kf, vf, qf, o0, o1, carry, n, hh);
            if (__all(carry < ATT_STOP)) break;
        }
        bf16_t* op = O + (rowbase + q0 + n) * D + h * 64 + 4 * hh;
#pragma unroll
        for (int g = 0; g < 4; ++g) { u32x2 w0, w1; w0.x = cvtpk(o0[4 * g], o0[4 * g + 1]); w0.y = cvtpk(o0[4 * g + 2], o0[4 * g + 3]); w1.x = cvtpk(o1[4 * g], o1[4 * g + 1]); w1.y = cvtpk(o1[4 * g + 2], o1[4 * g + 3]);
            *(u32x2*)(op + 8 * g) = w0; *(u32x2*)(op + 32 + 8 * g) = w1; }
        __syncthreads();
    }
#undef ATT_FETCH
#undef ATT_PUT
#undef ATT_TILE_LD
}

#define WSP(T, off) ((T*)(ws + (off)))
#ifndef STAG_POOL
#define STAG_POOL 0
#define STAG_PROJ 0
#define STAG_OPROJ 0
#define STAG_DUP 0
#define STAG_MUP 0
#endif
#ifndef PROBE_DUP
#define PROBE_DUP 0
#endif
#define DUP(k) ((PROBE_DUP >> (k)) & 1)
template <int l>
__device__ __forceinline__ void layer_body(LAS unsigned char* lds, const XcdBarrier& bar, LAS int* pend, LAS int* cnt_l, int G, int bx, int vcu, int NGW, int wave_s) {
#define SITE_POOLPREP(GRIDBAR) { { unsigned char* ws = ARG_WS(); pool_prep_phase<l == 0>(ARG_IN(0), WSP(bf16_t, WS_XB), WSP(bf16_t, WS_R), lds, G, wave_s); \
              if constexpr (l == 0 && (INT8_UP0 != 0 || INT8_PROJ != 0)) {     \
                  const int t_ = fresh_tid(wave_s); const int wv_ = __builtin_amdgcn_readfirstlane(t_ >> 6); LAS float* sc_ = (LAS float*)(lds + wv_ * 16384); const int g_ = vcu * NWAVES + wv_; int base_ = 0; \
                  for (int j_ = 0; j_ < 5; ++j_) { if ((j_ == 0 && !I8) || (j_ > 0 && !INT8_PROJ)) continue; \
                      const float* W_; const float* gn_; int ldw_, N_; float mul_ = 1.0f; bool gu_ = false; size_t dst_; const unsigned* cm_; float* wsc_; \
                      if (j_ == 0) { W_ = ARG_IN(9); gn_ = ARG_IN(2); ldw_ = 2 * DFF; N_ = 2 * DFF; gu_ = true; dst_ = WS_WFI; cm_ = WSP(unsigned, WS_COLMAX); wsc_ = WSP(float, WS_WSCALE); } \
                      else if (j_ < 3) { W_ = ARG_IN(6) + (j_ - 1) * 1024; gn_ = ARG_IN(5); ldw_ = 2048; N_ = 1024; dst_ = (j_ == 1) ? WS_WK : WS_WV; cm_ = WSP(unsigned, WS_COLMAX2) + (j_ - 1) * 1024; wsc_ = WSP(float, WS_WSCALE2) + (j_ - 1) * 1024; } \
                      else { const int b_ = j_ - 3; W_ = ARG_IN(7) + (size_t)b_ * D * D; gn_ = ARG_IN(1) + (2 + b_) * D; ldw_ = 1024; N_ = 1024; mul_ = 0.125f * 1.4426950408889634f; dst_ = WS_WQ + (size_t)b_ * D * D * 2; cm_ = WSP(unsigned, WS_COLMAX2) + (2 + b_) * 1024; wsc_ = WSP(float, WS_WSCALE2) + (2 + b_) * 1024; } \
                      int first_ = (g_ - base_) % NGW; if (first_ < 0) first_ += NGW; \
                      tr_mat(W_, ldw_, D, N_, gn_, mul_, 2, gu_, ws + dst_, sc_, first_, NGW, t_ & 63, cm_, wsc_); base_ = (base_ + (D / 64) * (N_ / 32)) % NGW; } } } \
          if (GRIDBAR) xcd_barrier(bar, wave_s); \
          else {   \
              __syncthreads(); \
              if constexpr (l == 1) { if (fresh_tid(wave_s) == 0) { unsigned* fl_ = (unsigned*)(ARG_WS() + WS_HALO_FLAGS); __hip_atomic_store(fl_ + blockIdx.x, 1u, __ATOMIC_RELEASE, __HIP_MEMORY_SCOPE_AGENT); \
                      const int nb_ = (int)blockIdx.x + 1; if (nb_ < M / 256 && (nb_ % (SEQ / 256)) != 0) { unsigned sp_ = 0; while (__hip_atomic_load(fl_ + nb_, __ATOMIC_ACQUIRE, __HIP_MEMORY_SCOPE_AGENT) == 0u) { __builtin_amdgcn_s_sleep(1); if (++sp_ > (1u << 24)) break; } } } \
                  __syncthreads(); } } }
#define SITE_POOLGEMM(MUL, GRIDBAR) { { unsigned char* ws = ARG_WS(); \
              pg8::GemmK g{256, 1024, 256}; pg8::PoolOrder S{G, bx, (const char*)WSP(bf16_t, WS_R), (const char*)(WSP(bf16_t, WS_WPOOL) + (size_t)l * 4 * 65536)}; \
              pg8::EpiResidB E{WSP(bf16_t, WS_XB), ARG_IN(4) + l * D, MUL}; \
              pg8::gemm_phase<pg8::EpiResidB, pg8::PoolOrder, true>(lds, g, S, E, wave_s, STAG_POOL); } if (GRIDBAR) xcd_barrier(bar, wave_s); else __syncthreads(); }
#define SITE_PROJ() { { unsigned char* ws = ARG_WS(); \
              if constexpr (INT8_PROJ != 0) { pg8::GemmK g{512, 512, 512}; pg8::ProjOrder S{(l == 2) ? 3 : 1, G, bx, (const char*)ws, (size_t)(l - 2) * D * D * 2, (size_t)256 * 1024}; \
                pg8::EpiProjI8 E{WSP(bf16_t, WS_K), WSP(bf16_t, WS_R), WSP(bf16_t, WS_VT), WSP(float, WS_ASCALE), WSP(float, WS_WSCALE2), l - 2}; \
                pg8::gemm_phase<pg8::EpiProjI8, pg8::ProjOrder, true, 2>(lds, g, S, E, wave_s, STAG_PROJ); } \
              else { pg8::GemmK g{1024, 1024, 1024}; pg8::ProjOrder S{(l == 2) ? 3 : 1, G, bx, (const char*)ws, (size_t)(l - 2) * D * D * 2, (size_t)256 * 1024 * 2}; \
                pg8::EpiProj E{WSP(bf16_t, WS_K), WSP(bf16_t, WS_R), WSP(bf16_t, WS_VT)}; \
                pg8::gemm_phase<pg8::EpiProj, pg8::ProjOrder, true>(lds, g, S, E, wave_s); } } xcd_barrier(bar, wave_s); }
#define SITE_ATTN() { { unsigned char* ws = ARG_WS(); attn_phase(WSP(bf16_t, WS_R), WSP(bf16_t, WS_K), WSP(bf16_t, WS_VT), WSP(bf16_t, WS_R) + (size_t)M * D, lds, vcu, G, wave_s); } xcd_barrier(bar, wave_s); }
#define SITE_OPROJ(MUL) { { unsigned char* ws = ARG_WS(); \
              pg8::GemmK g{1024, 1024, 1024}; pg8::DenseOrder S{M / 256, 4, G, bx, (const char*)(WSP(bf16_t, WS_R) + (size_t)M * D), (const char*)(WSP(bf16_t, WS_WO) + (size_t)(l - 2) * D * D), (size_t)256 * 1024 * 2, (size_t)256 * 1024 * 2}; \
              pg8::EpiResidB E{WSP(bf16_t, WS_XB), nullptr, MUL}; \
              pg8::gemm_phase<pg8::EpiResidB, pg8::DenseOrder, true>(lds, g, S, E, wave_s, STAG_OPROJ); } xcd_barrier(bar, wave_s); }
#define SITE_NORMX(OUTK_, DELTA_) { { unsigned char* ws = ARG_WS(); \
              norm_phase<false, false, false, OUTK_, false, bf16_t>(nullptr, WSP(bf16_t, WS_XN), nullptr, nullptr, nullptr, nullptr, nullptr, nullptr, nullptr, lds, cnt_l, G, wave_s, WSP(float, WS_ASCALE), nullptr, (const bf16_t*)WSP(bf16_t, WS_XB), nullptr); } xcd_barrier(bar, wave_s); }
#define SITE_NORMI8() { { unsigned char* ws = ARG_WS(); norm_phase<false, false, false, 2, false, bf16_t>(nullptr, WSP(bf16_t, WS_XN), nullptr, nullptr, nullptr, nullptr, nullptr, nullptr, nullptr, lds, cnt_l, G, wave_s, WSP(float, WS_ASCALE), nullptr, (const bf16_t*)WSP(bf16_t, WS_XB), nullptr); } xcd_barrier(bar, wave_s); }
#define SITE_NORM8() { { unsigned char* ws = ARG_WS(); norm_phase<false, false, false, 1, false, bf16_t>(nullptr, WSP(bf16_t, WS_XN), nullptr, nullptr, nullptr, nullptr, nullptr, nullptr, nullptr, lds, cnt_l, G, wave_s, nullptr, nullptr, (const bf16_t*)WSP(bf16_t, WS_XB), nullptr); } xcd_barrier(bar, wave_s); }
#define SITE_NORM() { { unsigned char* ws = ARG_WS(); norm_phase<false, false, false, 0, false, bf16_t>(nullptr, WSP(bf16_t, WS_XN), nullptr, nullptr, nullptr, nullptr, nullptr, nullptr, nullptr, lds, cnt_l, G, wave_s, nullptr, nullptr, (const bf16_t*)WSP(bf16_t, WS_XB), nullptr); } xcd_barrier(bar, wave_s); }
#define SITE_DUP() { { unsigned char* ws = ARG_WS(); \
              if constexpr (I8) { pg8::GemmK g{512, 512, 512}; pg8::DenseOrder S{M / 256, DFF / 128, G, bx, (const char*)WSP(unsigned char, WS_XN), (const char*)WSP(unsigned char, WS_WFI), (size_t)256 * 1024, (size_t)256 * 1024}; \
                pg8::EpiSwigluI8<L0_DOWN_FP8 != 0> E{WSP(bf16_t, WS_R), DFF, WSP(float, WS_ASCALE), WSP(float, WS_WSCALE)}; \
                pg8::gemm_phase<pg8::EpiSwigluI8<L0_DOWN_FP8 != 0>, pg8::DenseOrder, true, 2>(lds, g, S, E, wave_s, STAG_DUP); } \
              else if constexpr (F8) { pg8::GemmK g{512, 512, 512}; pg8::DenseOrder S{M / 256, DFF / 128, G, bx, (const char*)WSP(unsigned char, WS_XN), (const char*)(WSP(unsigned char, WS_WFI) + (size_t)(l >> 1) * 2 * DFF * D * 2), (size_t)256 * 1024, (size_t)256 * 1024}; \
                pg8::EpiSwiglu8 E{WSP(unsigned char, WS_R), DFF, 1.0f / W8_UP}; \
                pg8::gemm_phase<pg8::EpiSwiglu8, pg8::DenseOrder, true, 1>(lds, g, S, E, wave_s, STAG_DUP); } \
              else { pg8::GemmK g{1024, 1024, 1024}; pg8::DenseOrder S{M / 256, DFF / 128, G, bx, (const char*)WSP(bf16_t, WS_XN), (const char*)(WSP(bf16_t, WS_WFI) + (size_t)(l >> 1) * 2 * DFF * D), (size_t)256 * 1024 * 2, (size_t)256 * 1024 * 2}; \
                pg8::EpiSwiglu E{WSP(bf16_t, WS_R), DFF}; \
                pg8::gemm_phase<pg8::EpiSwiglu, pg8::DenseOrder, true>(lds, g, S, E, wave_s); } } xcd_barrier(bar, wave_s); }
#define SITE_DDOWN(MUL) { { unsigned char* ws = ARG_WS(); \
              if constexpr (F8 || (l == 0 && L0_DOWN_FP8 != 0)) { pg8::GemmK g{DFF / 2, DFF / 2, DFF / 2}; pg8::DenseOrder S{M / 256, 4, G, bx, (const char*)WSP(unsigned char, WS_R), (const char*)(WSP(unsigned char, WS_WFO) + (size_t)(l >> 1) * D * DFF * 2), (size_t)256 * DFF, (size_t)256 * DFF}; \
                pg8::EpiResidB E{WSP(bf16_t, WS_XB), nullptr, MUL / (W8_DN * H8_SC)}; \
                pg8::gemm_phase<pg8::EpiResidB, pg8::DenseOrder, true, 1>(lds, g, S, E, wave_s); } \
              else { pg8::GemmK g{DFF, DFF, DFF}; pg8::DenseOrder S{M / 256, 4, G, bx, (const char*)WSP(bf16_t, WS_R), (const char*)(WSP(bf16_t, WS_WFO) + (size_t)(l >> 1) * D * DFF), (size_t)256 * DFF * 2, (size_t)256 * DFF * 2}; \
                pg8::EpiResidB E{WSP(bf16_t, WS_XB), nullptr, MUL}; \
                pg8::gemm_phase<pg8::EpiResidB, pg8::DenseOrder, true>(lds, g, S, E, wave_s); } } xcd_barrier(bar, wave_s); }
#define SITE_ROUTER() { { unsigned char* ws = ARG_WS(); \
              norm_phase<false, true, false, F8 ? 1 : 0, false, bf16_t>(nullptr, WSP(bf16_t, WS_XN), nullptr, nullptr, ARG_IN(2) + l * D, ARG_IN(11) + (size_t)(l >> 1) * D * NE, WSP(int, WS_ROUTE_E), WSP(float, WS_ROUTE_G), WSP(int, WS_TILECNT), lds, cnt_l, G, wave_s, nullptr, WSP(bf16_t, WS_DELTA), (const bf16_t*)WSP(bf16_t, WS_XB), nullptr); } xcd_barrier(bar, wave_s); }
#define SITE_DISPATCH() { { unsigned char* ws = ARG_WS(); \
              dispatch_phase<F8>(WSP(int, WS_TILECNT), WSP(int, WS_ROUTE_E), WSP(float, WS_ROUTE_G), WSP(int, WS_SLOT_OF), WSP(float, WS_GATE_SLOT), WSP(bf16_t, WS_XN), F8 ? WSP(bf16_t, WS_TOS) : WSP(bf16_t, WS_XS), lds, pend, G, wave_s); } xcd_barrier(bar, wave_s); }
#define SITE_MUP() { { unsigned char* ws = ARG_WS(); \
              if constexpr (F8) { pg8::GemmK g{512, 512, 512}; \
                pg8::MoeGatherOrder S{nb, DFFE / 128, G, bx, blk0, (const char*)WSP(unsigned char, WS_XN), (const char*)(WSP(unsigned char, WS_WMI) + (size_t)(l >> 1) * 8 * 2 * DFFE * D * 2), (size_t)256 * 1024, (size_t)2 * DFFE * D, pend, WSP(int, WS_TOS), (LAS int*)(lds + LCTL_OFF + 2048)}; \
                pg8::EpiSwiglu8 E{WSP(unsigned char, WS_R), DFFE, 1.0f / W8_UP}; \
                pg8::gemm_phase<pg8::EpiSwiglu8, pg8::MoeGatherOrder, true, 1, true>(lds, g, S, E, wave_s, STAG_MUP); } \
              else { pg8::GemmK g{1024, 1024, 1024}; \
                pg8::MoeOrder S{nb, DFFE / 128, G, bx, blk0, 0, (const char*)WSP(bf16_t, WS_XS), (const char*)(WSP(bf16_t, WS_WMI) + (size_t)(l >> 1) * 8 * 2 * DFFE * D), (size_t)256 * 1024 * 2, (size_t)256 * 1024 * 2, (size_t)2 * DFFE * D * 2, pend}; \
                pg8::EpiSwiglu E{WSP(bf16_t, WS_R), DFFE}; \
                pg8::gemm_phase<pg8::EpiSwiglu, pg8::MoeOrder, true>(lds, g, S, E, wave_s); } } xcd_barrier(bar, wave_s); }
#define SITE_MDOWN() { { unsigned char* ws = ARG_WS(); \
              if constexpr (F8) { pg8::GemmK g{DFFE / 2, DFFE / 2, DFFE / 2}; \
                const int nbm = nb < pg8::TAIL_B0 ? nb : pg8::TAIL_B0;     \
                pg8::MoeOrder S{nbm, 4, G, bx, blk0, 1, (const char*)WSP(unsigned char, WS_R), (const char*)(WSP(unsigned char, WS_WMO) + (size_t)(l >> 1) * 8 * D * DFFE * 2), (size_t)256 * DFFE, (size_t)256 * DFFE, (size_t)D * DFFE, pend}; \
                pg8::EpiMoeDown E{WSP(bf16_t, WS_XS), WSP(float, WS_GATE_SLOT), 1.0f / (W8_DN * H8_SC)}; \
                pg8::gemm_phase<pg8::EpiMoeDown, pg8::MoeOrder, true, 1>(lds, g, S, E, wave_s); \
                if (nb > pg8::TAIL_B0) { pg8::GemmK g2{DFFE / (2 * pg8::TAIL_KS), DFFE / 2, DFFE / 2}; \
                  pg8::MoeTailOrder S2{nb - pg8::TAIL_B0, G, bx, (const char*)WSP(unsigned char, WS_R), (const char*)(WSP(unsigned char, WS_WMO) + (size_t)(l >> 1) * 8 * D * DFFE * 2), (size_t)256 * DFFE, (size_t)256 * DFFE, (size_t)D * DFFE, (size_t)(DFFE / pg8::TAIL_KS), pend}; \
                  pg8::EpiMoeDownT E2{WSP(bf16_t, WS_YT), WSP(float, WS_GATE_SLOT), 1.0f / (W8_DN * H8_SC)}; \
                  pg8::gemm_phase<pg8::EpiMoeDownT, pg8::MoeTailOrder, true, 1>(lds, g2, S2, E2, wave_s); } } \
              else { pg8::GemmK g{DFFE, DFFE, DFFE}; \
                pg8::MoeOrder S{nb, 4, G, bx, blk0, 1, (const char*)WSP(bf16_t, WS_R), (const char*)(WSP(bf16_t, WS_WMO) + (size_t)(l >> 1) * 8 * D * DFFE), (size_t)256 * DFFE * 2, (size_t)256 * DFFE * 2, (size_t)D * DFFE * 2, pend}; \
                pg8::EpiMoeDown E{WSP(bf16_t, WS_XS), WSP(float, WS_GATE_SLOT), 1.0f}; \
                pg8::gemm_phase<pg8::EpiMoeDown, pg8::MoeOrder, true>(lds, g, S, E, wave_s); } } xcd_barrier(bar, wave_s); }
    constexpr bool F8 = ((FP8_MASK >> l) & 1) != 0;
    constexpr bool I8 = (INT8_UP0 != 0) && l == 0 && !F8;
    if constexpr (l < 2) {
        const bool chain = (G == M / 256);
        if (DUP(5) || (DUP(7) && l == 1) || (DUP(11) && l == 0)) SITE_POOLPREP(true)
        SITE_POOLPREP(!chain)
        if (DUP(2) || DUP(12)) SITE_POOLGEMM(0.f, true)
        SITE_POOLGEMM(1.f, !chain)
    } else {
        if (DUP(2) || DUP(13)) SITE_PROJ()
        SITE_PROJ()
        if (DUP(3)) SITE_ATTN()
        SITE_ATTN()
        if (DUP(2) || DUP(14)) SITE_OPROJ(0.f)
        SITE_OPROJ(1.f)
    }
    if constexpr ((l & 1) == 0) {
        if constexpr (I8) { if (DUP(5) || DUP(8)) SITE_NORMX(2, true) SITE_NORMX(2, true) } else if constexpr (F8) { if (DUP(5) || DUP(8)) SITE_NORMX(1, true) SITE_NORMX(1, true) } else { if (DUP(5)) SITE_NORMX(0, true) SITE_NORMX(0, true) }
        if (DUP(1)) SITE_DUP()
        SITE_DUP()
        if (DUP(1)) SITE_DDOWN(0.f)
        SITE_DDOWN(1.f)
        if constexpr (l == 2) { if constexpr (INT8_PROJ != 0) { if (DUP(5) || DUP(8)) SITE_NORMI8() SITE_NORMI8() } else { if (DUP(5)) SITE_NORM() SITE_NORM() } }
    } else {
        if (DUP(5) || DUP(9)) SITE_ROUTER()
        SITE_ROUTER()
        if (DUP(5) || DUP(10)) SITE_DISPATCH()
        SITE_DISPATCH()
        constexpr int CB = F8 ? CAP / 256 : CHUNK_BLKS;
        for (int ch = 0; ch < (F8 ? 1 : 2); ++ch) {
            const int nblk = pend[7];
            const int blk0 = ch * CB; int nb = nblk - blk0; nb = nb < 0 ? 0 : (nb > CB ? CB : nb); nb = __builtin_amdgcn_readfirstlane(nb);
            if (DUP(0)) SITE_MUP()
            SITE_MUP()
            if (DUP(0)) SITE_MDOWN()
            SITE_MDOWN()
        }
        if constexpr (l == 1) { { unsigned char* ws = ARG_WS(); norm_phase<true, false, false, INT8_PROJ ? 2 : 0, false, bf16_t>(nullptr, WSP(bf16_t, WS_XN), WSP(bf16_t, WS_XS), WSP(int, WS_SLOT_OF), nullptr, nullptr, nullptr, nullptr, nullptr, lds, cnt_l, G, wave_s, WSP(float, WS_ASCALE), WSP(bf16_t, WS_DELTA), (const bf16_t*)WSP(bf16_t, WS_XB), WSP(bf16_t, WS_XB)); } xcd_barrier(bar, wave_s); }
        else for (int rep_ = 0; rep_ < 1 + DUP(6); ++rep_) { unsigned char* ws = ARG_WS(); if (rep_) xcd_barrier(bar, wave_s); norm_phase<true, false, true, 0, false, bf16_t>(ARG_OUT(), WSP(bf16_t, WS_XN), WSP(bf16_t, WS_XS), WSP(int, WS_SLOT_OF), ARG_IN(14), nullptr, nullptr, nullptr, nullptr, lds, cnt_l, G, wave_s, nullptr, WSP(bf16_t, WS_DELTA), (const bf16_t*)WSP(bf16_t, WS_XB), nullptr); }
    }
}

__global__ void __launch_bounds__(NTHREADS, 2) yoco_fwd(Args args_unused) {
    extern __shared__ __attribute__((aligned(16))) unsigned char lds_raw[];
    LAS unsigned char* lds = (LAS unsigned char*)lds_raw;
    __builtin_amdgcn_s_setreg((0 << 11) | (23 << 6) | 1, 1u);
    const int G = gridDim.x; const int bx = blockIdx.x; const int wave_s = __builtin_amdgcn_readfirstlane(threadIdx.x >> 6);
    const int vcu = (G % 8 == 0) ? (bx % 8) * (G / 8) + bx / 8 : bx;
    const int NGW = G * NWAVES;
    LAS unsigned* lctl = (LAS unsigned*)(lds + LCTL_OFF);
    for (int u = threadIdx.x; u < (LDS_BYTES - LCTL_OFF) / 4; u += NTHREADS) lctl[u] = 0u;
    __syncthreads();
    volatile LAS unsigned* bar_st = (volatile LAS unsigned*)lctl;
    LAS int* pend = (LAS int*)(lctl + 16);
    LAS int* cnt_l = (LAS int*)(lctl + 32);
    XcdBarrier bar = xcd_barrier_post((unsigned*)(ARG_WS() + WS_CTL) + 1024, bar_st);

    for (int rep = 0; rep < 1 + DUP(4); ++rep) {
        unsigned char* ws = ARG_WS();
        const int tid = fresh_tid(wave_s); const int lane = tid & 63, wave = __builtin_amdgcn_readfirstlane(tid >> 6), gw = vcu * NWAVES + wave;
        LAS float* scr = (LAS float*)(lds + wave * 16384);
        int base = 0;
        for (int j = 0; j < 50; ++j) {
            const float* W; const float* gain = nullptr; int ldw, K, N; float mul = 1.0f; bool f8 = false, gu = false; size_t dst;
            if (j < 8) { W = ARG_IN(3) + (size_t)j * 65536; ldw = 256; K = 256; N = 256; gain = ARG_IN(1) + (j >> 2) * D + (j & 3) * 256; dst = WS_WPOOL + (size_t)j * 65536 * 2; }
            else if (j < 10) { W = ARG_IN(6) + (j - 8) * 1024; ldw = 2048; K = 1024; N = 1024; gain = ARG_IN(5); dst = (j == 8) ? WS_WK : WS_WV; }
            else if (j < 12) { const int b = j - 10; W = ARG_IN(7) + (size_t)b * D * D; ldw = 1024; K = 1024; N = 1024; gain = ARG_IN(1) + (2 + b) * D; mul = 0.125f * 1.4426950408889634f; dst = WS_WQ + (size_t)b * D * D * 2; }
            else if (j < 14) { const int b = j - 12; W = ARG_IN(8) + (size_t)b * D * D; ldw = 1024; K = 1024; N = 1024; dst = WS_WO + (size_t)b * D * D * 2; }
            else if (j < 16) { const int i = j - 14; f8 = ((FP8_MASK >> (2 * i)) & 1) != 0; gu = true; W = ARG_IN(9) + (size_t)i * D * 2 * DFF; ldw = 2 * DFF; K = 1024; N = 2 * DFF; gain = ARG_IN(2) + (2 * i) * D; mul = f8 ? W8_UP : 1.0f; dst = WS_WFI + (size_t)i * 2 * DFF * D * 2; }
            else if (j < 18) { const int i = j - 16; f8 = ((FP8_MASK >> (2 * i)) & 1) != 0 || (i == 0 && L0_DOWN_FP8 != 0); W = ARG_IN(10) + (size_t)i * DFF * D; ldw = 1024; K = DFF; N = 1024; mul = f8 ? W8_DN : 1.0f; dst = WS_WFO + (size_t)i * D * DFF * 2; }
            else if (j < 34) { const int ie = j - 18, li = 2 * (ie >> 3) + 1, e = ie & 7; f8 = ((FP8_MASK >> li) & 1) != 0; gu = true; W = ARG_IN(12) + (size_t)ie * D * 2 * DFFE; ldw = 2 * DFFE; K = 1024; N = 2 * DFFE; gain = ARG_IN(2) + li * D; mul = f8 ? W8_UP : 1.0f;
                               dst = WS_WMI + (size_t)(ie >> 3) * 8 * 2 * DFFE * D * 2 + (size_t)e * 2 * DFFE * D * (f8 ? 1 : 2); }
            else { const int ie = j - 34, li = 2 * (ie >> 3) + 1, e = ie & 7; f8 = ((FP8_MASK >> li) & 1) != 0; W = ARG_IN(13) + (size_t)ie * DFFE * D; ldw = 1024; K = DFFE; N = 1024; mul = f8 ? W8_DN : 1.0f;
                   dst = WS_WMO + (size_t)(ie >> 3) * 8 * D * DFFE * 2 + (size_t)e * D * DFFE * (f8 ? 1 : 2); }
            const int nitems = (K / 64) * (N / 32);
            int first = (gw - base) % NGW; if (first < 0) first += NGW;
            if ((INT8_UP0 && j == 14) || (INT8_PROJ && j >= 8 && j < 12)) continue;
            tr_mat(W, ldw, K, N, gain, mul, f8 ? 1 : 0, gu, ws + dst, scr, first, NGW, lane, nullptr, nullptr, (gu && f8) ? W8_GATE : 0.f);
            base = (base + nitems) % NGW;
        }
    }
    if (INT8_UP0 || INT8_PROJ) {
        unsigned char* ws = ARG_WS(); const int tid = fresh_tid(wave_s); const int lane = tid & 63, gw = vcu * NWAVES + __builtin_amdgcn_readfirstlane(tid >> 6);
        int base = 0;
        for (int j = 0; j < 5; ++j) {
            if ((j == 0 && !INT8_UP0) || (j > 0 && !INT8_PROJ)) continue;
            const GAS float* W; const GAS float* gn; int ldw, ncols; float mul = 1.0f; unsigned* cm;
            if (j == 0) { W = (const GAS float*)ARG_IN(9); gn = (const GAS float*)ARG_IN(2); ldw = 2 * DFF; ncols = 2 * DFF; cm = WSP(unsigned, WS_COLMAX); }
            else if (j < 3) { W = (const GAS float*)ARG_IN(6) + (j - 1) * 1024; gn = (const GAS float*)ARG_IN(5); ldw = 2048; ncols = 1024; cm = WSP(unsigned, WS_COLMAX2) + (j - 1) * 1024; }
            else { W = (const GAS float*)ARG_IN(7) + (size_t)(j - 3) * D * D; gn = (const GAS float*)ARG_IN(1) + (2 + (j - 3)) * D; ldw = 1024; ncols = 1024; mul = 0.125f * 1.4426950408889634f; cm = WSP(unsigned, WS_COLMAX2) + (2 + (j - 3)) * 1024; }
            const int nstrip = ncols / 64, ntask = nstrip * (D / 64);
            int first = (gw - base) % NGW; if (first < 0) first += NGW;
            for (int task = first; task < ntask; task += NGW) { const int strip = task % nstrip, kc = task / nstrip; const int n = strip * 64 + lane; float mx = 0.f;
#pragma unroll 16
                for (int kk = 0; kk < 64; ++kk) { const int k = kc * 64 + kk; mx = fmaxf(mx, fabsf(W[(size_t)k * ldw + n] * gn[k])); }
                const unsigned old = __hip_atomic_fetch_max(cm + n, __builtin_bit_cast(unsigned, mx * mul), __ATOMIC_RELAXED, __HIP_MEMORY_SCOPE_AGENT); asm volatile("" :: "v"(old)); }
            base = (base + ntask) % NGW;
        }
    }
    xcd_barrier(bar, wave_s);

    layer_body<0>(lds, bar, pend, cnt_l, G, bx, vcu, NGW, wave_s);
    layer_body<1>(lds, bar, pend, cnt_l, G, bx, vcu, NGW, wave_s);
    layer_body<2>(lds, bar, pend, cnt_l, G, bx, vcu, NGW, wave_s);
    layer_body<3>(lds, bar, pend, cnt_l, G, bx, vcu, NGW, wave_s);
}

extern "C" void kernel_launch(void* const* d_in, const int* in_sizes, int n_in, void* d_out, int out_size, void* d_ws, size_t ws_size, hipStream_t stream) {
    static int grid = 0;
    if (grid == 0) {
        if (n_in != 15 || out_size != M * D || ws_size < WS_END) { fprintf(stderr, "kernel_launch: unexpected shapes (n_in %d out %d ws %zu)\n", n_in, out_size, ws_size); grid = -1; return; }
        int dev = 0, cus = 0, per_cu = 0;
        if (hipGetDevice(&dev) != hipSuccess || hipDeviceGetAttribute(&cus, hipDeviceAttributeMultiprocessorCount, dev) != hipSuccess) { grid = -1; return; }
        if (hipFuncSetAttribute((const void*)yoco_fwd, hipFuncAttributeMaxDynamicSharedMemorySize, LDS_BYTES) != hipSuccess) { fprintf(stderr, "kernel_launch: hipFuncSetAttribute failed\n"); grid = -1; return; }
        if (hipOccupancyMaxActiveBlocksPerMultiprocessor(&per_cu, (const void*)yoco_fwd, NTHREADS, LDS_BYTES) != hipSuccess || per_cu < 1) { fprintf(stderr, "kernel_launch: occupancy query says %d\n", per_cu); }
        (void)hipGetLastError();
        grid = cus;
    }
    if (grid < 0) return;
    (void)hipMemsetAsync((char*)d_ws + WS_CTL, 0, CTL_ZERO_BYTES, stream);
    Args a{};
    for (int i = 0; i < 15; ++i) a.in[i] = (const float*)d_in[i];
    a.out = (float*)d_out; a.ws = (unsigned char*)d_ws;
    hipLaunchKernelGGL(yoco_fwd, dim3(grid), dim3(NTHREADS), LDS_BYTES, stream, a);
}
```

```cpp
#include <hip/hip_runtime.h>
#include <cstdio>
#include <cstdint>

#define LAS __attribute__((address_space(3)))
#define GAS __attribute__((address_space(1)))
typedef unsigned short bf16_t;
typedef short bf16x8 __attribute__((ext_vector_type(8)));
typedef float f32x2 __attribute__((ext_vector_type(2)));
typedef float f32x4 __attribute__((ext_vector_type(4)));
typedef float f32x16 __attribute__((ext_vector_type(16)));
typedef unsigned u32x2 __attribute__((ext_vector_type(2)));
typedef unsigned u32x4 __attribute__((ext_vector_type(4)));
typedef int i32x4 __attribute__((ext_vector_type(4)));
typedef __bf16 bf16x2_t __attribute__((ext_vector_type(2)));

constexpr int D = 1024, BATCH = 32, SEQ = 2048, M = BATCH * SEQ;
constexpr int DFF = 2816, DFFE = 3584, NE = 8, NH = 16;
constexpr int CAP = 2 * M + NE * 256;
constexpr int CHUNK_BLKS = 260;
constexpr float RMS_EPS = 1e-6f;
#ifndef FP8_MASK
#define FP8_MASK 14
#endif
#ifndef INT8_UP0
#define INT8_UP0 1
#endif
#ifndef L0_DOWN_FP8
#define L0_DOWN_FP8 1
#endif
#ifndef INT8_PROJ
#define INT8_PROJ 1
#endif
constexpr float W8_UP = 64.f, W8_DN = 128.f, H8_SC = 8.f;
constexpr float W8_GATE = 1.4426950408889634f;
constexpr int NWAVES = 8, NTHREADS = 512;

constexpr size_t MiB = 1u << 20;
constexpr size_t WS_CTL = 0, CTL_ZERO_BYTES = 80 * 1024;
constexpr size_t WS_COLMAX2 = 65536;
constexpr size_t WS_WSCALE2 = 1 * MiB + 40960;
constexpr size_t WS_HALO_FLAGS = 20480;
constexpr size_t WS_COLMAX = 32768;
constexpr size_t WS_WSCALE = 1 * MiB + 16384;
constexpr size_t WS_ASCALE = 3 * MiB + 786432;
constexpr size_t WS_TILECNT = 1 * MiB;
constexpr size_t WS_ROUTE_E = 1 * MiB + 65536;
constexpr size_t WS_ROUTE_G = 2 * MiB;
constexpr size_t WS_SLOT_OF = 2 * MiB + 524288;
constexpr size_t WS_GATE_SLOT = 3 * MiB;
constexpr size_t WS_WPOOL = 4 * MiB;
constexpr size_t WS_WK = 5 * MiB, WS_WV = 7 * MiB, WS_WQ = 9 * MiB, WS_WO = 13 * MiB;
constexpr size_t WS_WFI = 17 * MiB;
constexpr size_t WS_WFO = 39 * MiB;
constexpr size_t WS_WMI = 50 * MiB;
constexpr size_t WS_WMO = 274 * MiB;
constexpr size_t WS_XN = 386 * MiB;
constexpr size_t WS_K = 514 * MiB, WS_VT = 642 * MiB;
constexpr size_t WS_XS = 770 * MiB;
constexpr size_t WS_R = 1030 * MiB;
constexpr size_t WS_XS8 = 1485 * MiB;
constexpr size_t WS_XB = 1485 * MiB;
constexpr size_t WS_TOS = 386 * MiB + 64 * MiB;

constexpr size_t WS_YT = 1616 * MiB;
constexpr size_t WS_DELTA = 1616 * MiB;
constexpr size_t WS_END = 1744 * MiB;
static_assert(WS_XS8 + (size_t)CAP * D <= WS_END, "xs8");
static_assert(WS_XS + (size_t)CAP * D * 2 <= WS_R, "xs");
static_assert(WS_R + (size_t)CHUNK_BLKS * 256 * DFFE * 2 <= WS_END, "moe hidden chunk");
static_assert(WS_R + (size_t)M * DFF * 2 <= WS_END, "dense hidden");
static_assert(WS_R + (size_t)CAP * DFFE <= WS_XS8, "fp8 moe hidden, one chunk");
static_assert(WS_WMO + (size_t)2 * 8 * 1024 * 3584 * 2 <= WS_XN, "weights");

constexpr int STAGE_BYTES_LDS = 131072;
constexpr int LCTL_OFF = STAGE_BYTES_LDS;
constexpr int LDS_BYTES = 147456;

__device__ __forceinline__ unsigned cvtpk(float lo, float hi) { f32x2 v = {lo, hi}; bf16x2_t b = __builtin_convertvector(v, bf16x2_t); return __builtin_bit_cast(unsigned, b); }
__device__ __forceinline__ unsigned pk4_fp8(float a, float b, float c, float d) { int w = __builtin_amdgcn_cvt_pk_fp8_f32(a, b, 0, false); w = __builtin_amdgcn_cvt_pk_fp8_f32(c, d, w, true); return (unsigned)w; }
__device__ __forceinline__ unsigned pk4_i8(float a, float b, float c, float d) {
    const int i0 = (int)__builtin_rintf(__builtin_amdgcn_fmed3f(a, -127.f, 127.f)), i1 = (int)__builtin_rintf(__builtin_amdgcn_fmed3f(b, -127.f, 127.f));
    const int i2 = (int)__builtin_rintf(__builtin_amdgcn_fmed3f(c, -127.f, 127.f)), i3 = (int)__builtin_rintf(__builtin_amdgcn_fmed3f(d, -127.f, 127.f));
    return (unsigned)(i0 & 255) | ((unsigned)(i1 & 255) << 8) | ((unsigned)(i2 & 255) << 16) | ((unsigned)i3 << 24); }
__device__ __forceinline__ float wave_max(float v) {
#pragma unroll
    for (int o = 1; o < 64; o <<= 1) v = fmaxf(v, __shfl_xor(v, o));
    return v;
}
__device__ __forceinline__ float bf_lo(unsigned w) { return __builtin_bit_cast(float, w << 16); }
__device__ __forceinline__ float bf_hi(unsigned w) { return __builtin_bit_cast(float, w & 0xffff0000u); }
__device__ __forceinline__ f32x4 ld4(const float* p) { return *(const GAS f32x4*)p; }
__device__ __forceinline__ f32x4 ld4(const bf16_t* p) { const u32x2 w = *(const GAS u32x2*)p; return (f32x4){bf_lo(w.x), bf_hi(w.x), bf_lo(w.y), bf_hi(w.y)}; }
__device__ __forceinline__ f32x2 ld2(const float* p) { return *(const GAS f32x2*)p; }
__device__ __forceinline__ f32x2 ld2(const bf16_t* p) { const unsigned w = *(const GAS unsigned*)p; return (f32x2){bf_lo(w), bf_hi(w)}; }
__device__ __forceinline__ f32x4 ldraw4(const float* p) { return *(const GAS f32x4*)p; }
__device__ __forceinline__ u32x2 ldraw4(const bf16_t* p) { return *(const GAS u32x2*)p; }
__device__ __forceinline__ f32x4 cvt4(f32x4 v) { return v; }
__device__ __forceinline__ f32x4 cvt4(u32x2 w) { return (f32x4){bf_lo(w.x), bf_hi(w.x), bf_lo(w.y), bf_hi(w.y)}; }
template <class T> struct Raw4; template <> struct Raw4<float> { typedef f32x4 t; }; template <> struct Raw4<bf16_t> { typedef u32x2 t; };
__device__ __forceinline__ float wave_sum(float v) {
#pragma unroll
    for (int o = 1; o < 64; o <<= 1) v += __shfl_xor(v, o);
    return v;
}
#define LDS_WAIT() asm volatile("s_waitcnt lgkmcnt(0)" ::: "memory")
__device__ __forceinline__ int fresh_tid(int wave_s) { int w = wave_s, z = 0; asm volatile("" : "+s"(w), "+s"(z)); return w * 64 + (int)__builtin_amdgcn_mbcnt_hi(~0u, __builtin_amdgcn_mbcnt_lo(~0u, (unsigned)z)); }
#define RLX_AGENT __ATOMIC_RELAXED, __HIP_MEMORY_SCOPE_AGENT

#define XB_TMO      128
#define XB_XCNT(j)  (256  + 64 * (j))
#define XB_XSUB(j)  (1280 + 64 * (j))
#define XB_XGEN(j)  (2304 + 64 * (j))
#define XB_TOP      3328
#define XB_TOPGEN   3392
#define XCD_BAR_WORDS 3456
#define XB_SPIN_CAP (1u << 22)
__device__ __forceinline__ unsigned xb_ld(unsigned* p)              { return __hip_atomic_load(p, __ATOMIC_RELAXED, __HIP_MEMORY_SCOPE_AGENT); }
__device__ __forceinline__ unsigned xb_add(unsigned* p, unsigned v) { return __hip_atomic_fetch_add(p, v, __ATOMIC_RELAXED, __HIP_MEMORY_SCOPE_AGENT); }
__device__ __forceinline__ unsigned xb_xcc_id() { return (unsigned)__builtin_amdgcn_s_getreg((3 << 11) | 20) & 0xFu; }
#define XB_SPIN(cond, bar) do { unsigned _sp = 0; while (cond) { __builtin_amdgcn_s_sleep(1); \
    if ((++_sp & 255u) == 0u) { if (xb_ld(&(bar)[XB_TMO])) break; if (_sp > XB_SPIN_CAP) { atomicAdd(&(bar)[XB_TMO], 1u); break; } } } } while (0)
struct XcdBarrier { unsigned* bar; unsigned x; volatile LAS unsigned* st; };
__device__ __forceinline__ XcdBarrier xcd_barrier_post(unsigned* bar, volatile LAS unsigned* st) {
    XcdBarrier b; b.bar = bar; b.x = xb_xcc_id(); b.st = st;
    if (threadIdx.x == 0) (void)xb_add(&bar[XB_XCNT(b.x)], 1u);
    return b;
}
__device__ __forceinline__ void xcd_barrier_complete(unsigned* bar, unsigned x, unsigned& nloc, unsigned& nx) {
    const unsigned G = gridDim.x * gridDim.y * gridDim.z;
    unsigned sum, cnt, mine, sp = 0u;
    for (;;) {
        sum = 0u; cnt = 0u; mine = 0u;
#pragma unroll
        for (unsigned j = 0; j < 16; ++j) { const unsigned c = xb_ld(&bar[XB_XCNT(j)]); sum += c; cnt += (c > 0u) ? 1u : 0u; mine = (j == x) ? c : mine; }
        if (sum == G) break;
        __builtin_amdgcn_s_sleep(1);
        if ((++sp & 255u) == 0u) { if (xb_ld(&bar[XB_TMO])) break; if (sp > XB_SPIN_CAP) { atomicAdd(&bar[XB_TMO], 1u); break; } }
    }
    nloc = mine > 0u ? mine : 1u; nx = cnt > 0u ? cnt : 1u;
}
__device__ __forceinline__ void xcd_barrier(const XcdBarrier& b, int wave_s) {
    asm volatile("s_waitcnt vmcnt(0)" ::: "memory");
    __syncthreads();
    if (fresh_tid(wave_s) == 0) {
        unsigned* bar = b.bar;
        __builtin_amdgcn_s_waitcnt(0);
        unsigned nloc = b.st[0], nx = b.st[1];
        if (nloc == 0u) { xcd_barrier_complete(bar, b.x, nloc, nx); b.st[0] = nloc; b.st[1] = nx; }
        const unsigned old = xb_add(&bar[XB_XSUB(b.x)], 1u);
        const unsigned gen = old / nloc;
        if (old + 1u == (gen + 1u) * nloc) {
            __builtin_amdgcn_fence(__ATOMIC_RELEASE, "agent");
            asm volatile("s_waitcnt vmcnt(0)" ::: "memory");
            const unsigned og = xb_add(&bar[XB_TOP], 1u);
            const unsigned tg = og / nx;
            if (og + 1u == (tg + 1u) * nx) xb_add(&bar[XB_TOPGEN], 1u);
            else XB_SPIN(xb_ld(&bar[XB_TOPGEN]) == tg, bar);
            __builtin_amdgcn_fence(__ATOMIC_ACQUIRE, "agent");
            xb_add(&bar[XB_XGEN(b.x)], 1u);
            asm volatile("s_waitcnt vmcnt(0)" ::: "memory");
        } else {
            XB_SPIN(xb_ld(&bar[XB_XGEN(b.x)]) == gen, bar);
            __builtin_amdgcn_fence(__ATOMIC_ACQUIRE, "agent");
            asm volatile("s_waitcnt vmcnt(0)" ::: "memory");
        }
    }
    __syncthreads();
}

namespace pg8 {
constexpr int BM = 256, BK = 64, HALF = 128, HTB = HALF * BK * 2, NXCD = 8, WGM = 8;
__host__ __device__ __forceinline__ int lds_byte(int r, int c) { const int st = (r >> 4) * 2 + (c >> 5), rr = r & 15, cc = c & 31, ob = rr * 64 + cc * 2; return st * 1024 + (ob ^ (((ob >> 9) & 1) << 5)); }
__host__ __device__ __forceinline__ void stage_rc(int b, int& R, int& C) { const int st = b / 1024, sb = b % 1024, swz = sb ^ (((sb >> 9) & 1) << 5); R = (st >> 1) * 16 + swz / 64; C = (st & 1) * 32 + (swz % 64) / 2; }
__host__ __device__ __forceinline__ int perm32(int rho) { const int n = rho >> 4, i = rho & 15; return 8 * (i >> 2) + 4 * n + (i & 3); }

typedef int i32x8 __attribute__((ext_vector_type(8)));
__device__ __forceinline__ i32x8 cat8(bf16x8 lo, bf16x8 hi) { const i32x4 a = __builtin_bit_cast(i32x4, lo), b = __builtin_bit_cast(i32x4, hi); return __builtin_shufflevector(a, b, 0, 1, 2, 3, 4, 5, 6, 7); }
struct Unit { const char* A; const char* B; int pm, pn, aux; };
struct GemmK { int K, lda, ldb; };

__device__ __forceinline__ bool smap(long L, int nM, int nN, int& pm, int& pn) {
    const int nwg = nM * nN; if (L >= nwg) return false;
    int wgid = (int)L; { const int q = nwg / NXCD, r = nwg % NXCD, xcd = wgid % NXCD, off = wgid / NXCD; wgid = (xcd < r ? xcd * (q + 1) : r * (q + 1) + (xcd - r) * q) + off; }
    const int nig = WGM * nN, gid = wgid / nig, fm = gid * WGM, gsz = (nM - fm) < WGM ? (nM - fm) : WGM;
    pm = fm + ((wgid % nig) % gsz); pn = (wgid % nig) / gsz; return true;
}

template <class Epi, class Sched, bool ALIGN_EPI, int MODE = 0, bool GATHER = false>
__device__ __forceinline__ void gemm_phase(LAS unsigned char* lds, const GemmK g, const Sched& S, const Epi& E, int wave_s, int stag = 0  ) {
    if (stag > 0 && (blockIdx.x & 1)) { const unsigned long long t0 = __builtin_amdgcn_s_memrealtime(); while (__builtin_amdgcn_s_memrealtime() - t0 < (unsigned long long)stag) __builtin_amdgcn_s_sleep(4); }
    const int tid = fresh_tid(wave_s);
    const int wid = __builtin_amdgcn_readfirstlane(tid >> 6), lane = tid & 63, wr = wid >> 2, wc = wid & 3, fr = lane & 15, fq = lane >> 4;
    constexpr bool FP8 = (MODE == 1);
    const int K = g.K, nt = K / BK;
    unsigned voffA[2], voffB[2];
#pragma unroll
    for (int i = 0; i < 2; ++i) { int R, C; stage_rc(tid * 16 + i * 8192, R, C); const int Rb = Epi::PERM ? ((R & ~31) + perm32(R & 31)) : R;
        voffA[i] = (unsigned)(R * g.lda + C) * 2u; voffB[i] = (unsigned)(Rb * g.ldb + C) * 2u; }
    unsigned vG[2][2], vN[2][2];
    const size_t kstep = (size_t)(BK * 2);
    const size_t hstepA = (size_t)HALF * g.lda * 2, hstepB = (size_t)HALF * g.ldb * 2;
    const unsigned ldsw = (unsigned)wid * 1024u;
    const int aoff = lds_byte(wr * 64 + fr, fq * 8), boff = lds_byte(wc * 32 + fr, fq * 8);
#define PG8_SA(b, h) (((b) * 2 + (h)) * HTB)
#define PG8_SB(b, h) ((4 + (b) * 2 + (h)) * HTB)
#define PG8_STAGE(bufoff, gbase, voff) do { _Pragma("unroll") for (int _i = 0; _i < 2; ++_i) \
        __builtin_amdgcn_global_load_lds((const unsigned*)((const char*)(gbase) + (voff)[_i]), (LAS unsigned*)(lds + (bufoff) + ldsw + _i * 8192), 16, 0, 0); } while (0)
#define PG8_STAGE_A(bufoff, gbase, h, nx) do { if constexpr (GATHER) { unsigned _v[2] = { (nx) ? vN[h][0] : vG[h][0], (nx) ? vN[h][1] : vG[h][1] }; PG8_STAGE(bufoff, gbase, _v); } \
        else PG8_STAGE(bufoff, (gbase) + (h) * hstepA, voffA); } while (0)
#define PG8_LD8(p) __builtin_shufflevector(*(const LAS i32x4*)(p), *(const LAS i32x4*)((p) + 1024), 0, 1, 2, 3, 4, 5, 6, 7)
#define PG8_LDA(dst, b, h) do { if constexpr (FP8) { _Pragma("unroll") for (int m = 0; m < 4; ++m) dst##8[m] = PG8_LD8(lds + PG8_SA(b, h) + aoff + m * 2048); } \
        else { _Pragma("unroll") for (int m = 0; m < 4; ++m) _Pragma("unroll") for (int k = 0; k < 2; ++k) dst[m][k] = *(const LAS bf16x8*)(lds + PG8_SA(b, h) + aoff + m * 2048 + k * 1024); } } while (0)
#define PG8_LDB(dst, b, h) do { if constexpr (FP8) { _Pragma("unroll") for (int n = 0; n < 2; ++n) dst##8[n] = PG8_LD8(lds + PG8_SB(b, h) + boff + n * 2048); } \
        else { _Pragma("unroll") for (int n = 0; n < 2; ++n) _Pragma("unroll") for (int k = 0; k < 2; ++k) dst[n][k] = *(const LAS bf16x8*)(lds + PG8_SB(b, h) + boff + n * 2048 + k * 1024); } } while (0)
#define PG8_MFMA_ASM(INS, C, OUT, a_, b_) asm volatile(INS " %0, %1, %2, " C : OUT(acc[ai_][bj_][m][n]) : "v"(b_), "v"(a_))
#define PG8_MMA(ai, bj, At, Bt, Z) do { constexpr int ai_ = ai, bj_ = bj; __builtin_amdgcn_s_setprio(1); \
        if constexpr (FP8) { if (Z) { _Pragma("unroll") for (int m = 0; m < 4; ++m) _Pragma("unroll") for (int n = 0; n < 2; ++n) PG8_MFMA_ASM("v_mfma_f32_16x16x128_f8f6f4", "0", "=&v", At##8[m], Bt##8[n]); } \
                             else { _Pragma("unroll") for (int m = 0; m < 4; ++m) _Pragma("unroll") for (int n = 0; n < 2; ++n) PG8_MFMA_ASM("v_mfma_f32_16x16x128_f8f6f4", "%0", "+v", At##8[m], Bt##8[n]); } } \
        else if constexpr (MODE == 2) { if (Z) { _Pragma("unroll") for (int m = 0; m < 4; ++m) _Pragma("unroll") for (int n = 0; n < 2; ++n) PG8_MFMA_ASM("v_mfma_i32_16x16x64_i8", "0", "=&v", At[m][0], Bt[n][0]); } \
                             else { _Pragma("unroll") for (int m = 0; m < 4; ++m) _Pragma("unroll") for (int n = 0; n < 2; ++n) PG8_MFMA_ASM("v_mfma_i32_16x16x64_i8", "%0", "+v", At[m][0], Bt[n][0]); } \
                             _Pragma("unroll") for (int m = 0; m < 4; ++m) _Pragma("unroll") for (int n = 0; n < 2; ++n) PG8_MFMA_ASM("v_mfma_i32_16x16x64_i8", "%0", "+v", At[m][1], Bt[n][1]); } \
        else { if (Z) { _Pragma("unroll") for (int m = 0; m < 4; ++m) _Pragma("unroll") for (int n = 0; n < 2; ++n) PG8_MFMA_ASM("v_mfma_f32_16x16x32_bf16", "0", "=&v", At[m][0], Bt[n][0]); } \
               else { _Pragma("unroll") for (int m = 0; m < 4; ++m) _Pragma("unroll") for (int n = 0; n < 2; ++n) PG8_MFMA_ASM("v_mfma_f32_16x16x32_bf16", "%0", "+v", At[m][0], Bt[n][0]); } \
               _Pragma("unroll") for (int m = 0; m < 4; ++m) _Pragma("unroll") for (int n = 0; n < 2; ++n) PG8_MFMA_ASM("v_mfma_f32_16x16x32_bf16", "%0", "+v", At[m][1], Bt[n][1]); } \
        __builtin_amdgcn_s_setprio(0); } while (0)
#define PG8_WAIT_V(n) asm volatile("s_waitcnt vmcnt(" #n ")" ::: "memory")
#define PG8_WAIT_L(n) asm volatile("s_waitcnt lgkmcnt(" #n ")" ::: "memory")
#define PG8_BAR __builtin_amdgcn_s_barrier()
#define PG8_SCHED __builtin_amdgcn_sched_barrier(0)
    Unit cur, nxt; int ui = 0;
    constexpr int NS = Epi::NS;
#define PG8_WAIT_V1(n) do { if (NS > 0 && first && ui > 0) asm volatile("s_waitcnt vmcnt(%0)" :: "n"((n) + NS) : "memory"); else PG8_WAIT_V(n); } while (0)
    if (!S.next(0, cur)) return;
    f32x4 acc[2][2][4][2];
    bf16x8 At[4][2], B0[2][2], B1[2][2]; i32x8 At8[4], B08[2], B18[2];
    const char* cA = cur.A; const char* cB = cur.B;
    if constexpr (GATHER) {
#pragma unroll
        for (int i = 0; i < 2; ++i) { int R, C; stage_rc(tid * 16 + i * 8192, R, C);
#pragma unroll
            for (int h = 0; h < 2; ++h) { vG[h][i] = (unsigned)S.tos[(size_t)cur.aux * 256 + h * HALF + R] * (unsigned)(g.lda * 2) + (unsigned)C * 2u; vN[h][i] = vG[h][i]; } } }
    PG8_STAGE(PG8_SB(0, 0), cB, voffB); PG8_STAGE(PG8_SB(0, 1), cB + hstepB, voffB); PG8_STAGE_A(PG8_SA(0, 0), cA, 0, false); PG8_STAGE_A(PG8_SA(0, 1), cA, 1, false);
    if (wr == 1) PG8_BAR;
    PG8_WAIT_V(2); PG8_BAR;
    PG8_STAGE(PG8_SB(1, 0), cB + kstep, voffB); PG8_STAGE_A(PG8_SA(1, 0), cA + kstep, 0, false); PG8_STAGE(PG8_SB(1, 1), cB + hstepB + kstep, voffB);
    PG8_WAIT_V(6); PG8_BAR;
    for (;;) {
        const bool has_next = S.next(ui + 1, nxt);
        const char* nA = has_next ? nxt.A : cA; const char* nB = has_next ? nxt.B : cB;
        if constexpr (GATHER) { if (has_next && wid < 4) __builtin_amdgcn_global_load_lds((const unsigned*)(S.tos + (size_t)nxt.aux * 256 + wid * 64 + lane), (LAS unsigned*)(S.idxl + ((ui + 1) & 1) * 256 + wid * 64), 4, 0, 0); }
        for (int t = 0; t < nt; t += 2) {
            const bool last = (t == nt - 2), first = (t == 0);
            const char* a1 = cA + (size_t)(t + 1) * kstep;
            const char* a2 = last ? nA : cA + (size_t)(t + 2) * kstep; const char* b2 = last ? nB : cB + (size_t)(t + 2) * kstep;
            const char* a3 = a2 + kstep; const char* b3 = b2 + kstep;
            if constexpr (GATHER) { if (last) {
                    const LAS int* ib = S.idxl + ((ui + 1) & 1) * 256;
#pragma unroll
                    for (int i = 0; i < 2; ++i) { int R, C; stage_rc(tid * 16 + i * 8192, R, C);
#pragma unroll
                        for (int h = 0; h < 2; ++h) vN[h][i] = has_next ? (unsigned)ib[h * HALF + R] * (unsigned)(g.lda * 2) + (unsigned)C * 2u : vG[h][i]; } } }
            PG8_LDB(B0, 0, 0); PG8_LDB(B1, 0, 1); PG8_SCHED; PG8_LDA(At, 0, 0); if (!(first && ui > 0)) PG8_STAGE_A(PG8_SA(1, 1), a1, 1, false);
            PG8_WAIT_V1(8); PG8_WAIT_L(0); PG8_BAR; PG8_MMA(0, 0, At, B0, first); PG8_MMA(0, 1, At, B1, first); PG8_BAR; PG8_SCHED;
            PG8_LDA(At, 0, 1); PG8_STAGE(PG8_SB(0, 0), b2, voffB); PG8_STAGE(PG8_SB(0, 1), b2 + hstepB, voffB); PG8_STAGE_A(PG8_SA(0, 0), a2, 0, last);
            PG8_WAIT_V1(8); PG8_WAIT_L(0); PG8_BAR; PG8_MMA(1, 0, At, B0, first); PG8_MMA(1, 1, At, B1, first); PG8_BAR; PG8_SCHED;
            PG8_LDB(B0, 1, 0); PG8_LDB(B1, 1, 1); PG8_SCHED; PG8_LDA(At, 1, 0); PG8_STAGE_A(PG8_SA(0, 1), a2, 1, last);
            PG8_WAIT_V1(8); PG8_WAIT_L(0); PG8_BAR; PG8_MMA(0, 0, At, B0, false); PG8_MMA(0, 1, At, B1, false); PG8_BAR; PG8_SCHED;
            PG8_LDA(At, 1, 1); PG8_STAGE(PG8_SB(1, 0), b3, voffB); PG8_STAGE(PG8_SB(1, 1), b3 + hstepB, voffB); PG8_STAGE_A(PG8_SA(1, 0), a3, 0, last);
            PG8_WAIT_V(8); PG8_WAIT_L(0); PG8_BAR; PG8_MMA(1, 0, At, B0, false); PG8_MMA(1, 1, At, B1, false); PG8_BAR; PG8_SCHED;
        }
        if constexpr (ALIGN_EPI) { if (wr == 0) PG8_BAR; }
        if (has_next) PG8_STAGE_A(PG8_SA(1, 1), nA + kstep, 1, true);
        asm volatile("s_nop 15\n\ts_nop 15" ::: "memory");
        E(acc, cur, wr, wc, fr, fq);
        if (!has_next) break;
        cur = nxt; cA = nA; cB = nB; ++ui;
        if constexpr (GATHER) {
#pragma unroll
            for (int h = 0; h < 2; ++h) { vG[h][0] = vN[h][0]; vG[h][1] = vN[h][1]; } }
        if constexpr (ALIGN_EPI) { if (wr == 1) PG8_BAR; }
    }
    PG8_WAIT_V(0);
    if constexpr (!ALIGN_EPI) { if (wr == 0) PG8_BAR; }
    PG8_BAR;
#undef PG8_SA
#undef PG8_SB
#undef PG8_STAGE
#undef PG8_STAGE_A
#undef PG8_LDA
#undef PG8_LDB
#undef PG8_MMA
#undef PG8_WAIT_V1
#undef PG8_MFMA_ASM
#undef PG8_WAIT_V
#undef PG8_WAIT_L
#undef PG8_BAR
#undef PG8_SCHED
}

struct EpiMoeDownT {
    static constexpr int NS = 16; static constexpr bool PERM = true;
    bf16_t* Y2; const float* gate; float osc;
    __device__ __forceinline__ void operator()(const f32x4 (&acc)[2][2][4][2], const Unit& u, int wr, int wc, int fr, int fq) const {
        const int row0 = u.pm * BM + wr * 64 + fr, col0 = u.pn * BM + wc * 32 + 8 * fq;
        float gtv[2][4];
#pragma unroll
        for (int ai = 0; ai < 2; ++ai)
#pragma unroll
            for (int m = 0; m < 4; ++m) gtv[ai][m] = gate[row0 + ai * HALF + m * 16];
#pragma unroll
        for (int ai = 0; ai < 2; ++ai)
#pragma unroll
            for (int m = 0; m < 4; ++m) { const int row = row0 + ai * HALF + m * 16; const float gt = gtv[ai][m] * osc; bf16_t* rowp = Y2 + ((size_t)u.aux * (8 * 256) + (size_t)(row - 2 * M)) * D + col0;
#pragma unroll
                for (int bj = 0; bj < 2; ++bj) { const f32x4 v0 = acc[ai][bj][m][0] * gt, v1 = acc[ai][bj][m][1] * gt;
                    u32x4 w; w.x = cvtpk(v0[0], v0[1]); w.y = cvtpk(v0[2], v0[3]); w.z = cvtpk(v1[0], v1[1]); w.w = cvtpk(v1[2], v1[3]);
                    *(u32x4*)(rowp + bj * HALF) = w; } }
    }
};
struct DenseOrder {
    int nM, nN, G, c; const char* A; const char* B; size_t at, bt;
    __device__ __forceinline__ bool next(int i, Unit& u) const { int pm, pn; if (!smap((long)i * G + c, nM, nN, pm, pn)) return false;
        u.A = A + (size_t)pm * at; u.B = B + (size_t)pn * bt; u.pm = pm; u.pn = pn; u.aux = 0; return true; }
};
struct PoolOrder {
    int G, c; const char* P; const char* W;
    __device__ __forceinline__ bool next(int i, Unit& u) const { const int pm = c + (i >> 2) * G, pn = i & 3; if (pm >= M / 256) return false;
        u.A = P + (size_t)pm * (256 * 1024 * 2) + (size_t)pn * 512; u.B = W + (size_t)pn * (256 * 256 * 2); u.pm = pm; u.pn = pn; u.aux = 0; return true; }
};
struct ProjOrder {
    int njobs, G, c; const char* ws; size_t qoff, tb;
    __device__ __forceinline__ bool next(int i, Unit& u) const {
        const long L = (long)i * G + c; if (L >= (long)njobs * 1024) return false;
        const int job = (int)(L >> 10), l = (int)(L & 1023); const int kind = (njobs == 1) ? 1 : job;
        const size_t woff = WS_WK + (size_t)(kind == 1) * (WS_WQ + qoff - WS_WK) + (size_t)(kind == 2) * (WS_WV - WS_WK);
        int pm, pn;
        if (kind == 2) { smap(l, 4, 256, pm, pn); u.A = ws + woff + (size_t)pm * tb; u.B = ws + WS_XN + (size_t)pn * tb; }
        else { smap(l, 256, 4, pm, pn); u.A = ws + WS_XN + (size_t)pm * tb; u.B = ws + woff + (size_t)pn * tb; }
        u.pm = pm; u.pn = pn; u.aux = kind; return true; }
};
struct MoeOrder {
    int nM, nN, G, c, blk0, a_rel; const char* A; const char* B; size_t at, bt, be; const LAS int* pend;
    __device__ __forceinline__ bool next(int i, Unit& u) const { int pm, pn; if (!smap((long)i * G + c, nM, nN, pm, pn)) return false;
        const int b = blk0 + pm; int e = 0;
#pragma unroll
        for (int j = 0; j < 7; ++j) e += (b >= pend[j]) ? 1 : 0;
        e = __builtin_amdgcn_readfirstlane(e);
        u.A = A + (size_t)(a_rel ? pm : b) * at; u.B = B + (size_t)e * be + (size_t)pn * bt; u.pm = a_rel ? b : pm; u.pn = pn; u.aux = 0; return true; }
};

constexpr int TAIL_B0 = 2 * M / 256, TAIL_KS = 7;
struct MoeTailOrder {
    int nT, G, c; const char* A; const char* B; size_t at, bt, be, kq; const LAS int* pend;
    __device__ __forceinline__ bool next(int i, Unit& u) const { const int L = i * G + c; if (L >= nT * 4 * TAIL_KS) return false;
        const int q = L % TAIL_KS, r = L / TAIL_KS, pn = r & 3, b = TAIL_B0 + (r >> 2); int e = 0;
#pragma unroll
        for (int j = 0; j < 7; ++j) e += (b >= pend[j]) ? 1 : 0;
        e = __builtin_amdgcn_readfirstlane(e);
        u.A = A + (size_t)b * at + (size_t)q * kq; u.B = B + (size_t)e * be + (size_t)pn * bt + (size_t)q * kq; u.pm = b; u.pn = pn; u.aux = q; return true; }
};
struct MoeGatherOrder {
    int nM, nN, G, c, blk0; const char* A; const char* B; size_t bt, be; const LAS int* pend; const int* tos; LAS int* idxl;
    __device__ __forceinline__ bool next(int i, Unit& u) const { int pm, pn; if (!smap((long)i * G + c, nM, nN, pm, pn)) return false;
        const int b = blk0 + pm; int e = 0;
#pragma unroll
        for (int j = 0; j < 7; ++j) e += (b >= pend[j]) ? 1 : 0;
        e = __builtin_amdgcn_readfirstlane(e);
        u.A = A; u.B = B + (size_t)e * be + (size_t)pn * bt; u.pm = pm; u.pn = pn; u.aux = b; return true; }
};
struct EpiPool {
    static constexpr int NS = 0; static constexpr bool PERM = false;
    const float* xin; float* out; const float* scale; float mul;
    __device__ __forceinline__ void operator()(const f32x4 (&acc)[2][2][4][2], const Unit& u, int wr, int wc, int fr, int fq) const {
        const int row0 = u.pm * BM + wr * 64 + fr, col0 = u.pn * BM + wc * 32 + 4 * fq;
        f32x4 sv[2][2];
#pragma unroll
        for (int bj = 0; bj < 2; ++bj)
#pragma unroll
            for (int n = 0; n < 2; ++n) sv[bj][n] = *(const f32x4*)(scale + col0 + bj * HALF + n * 16) * mul;
#pragma unroll
        for (int ai = 0; ai < 2; ++ai)
#pragma unroll
            for (int m = 0; m < 4; ++m) { const size_t off = (size_t)(row0 + ai * HALF + m * 16) * D + col0;
#pragma unroll
                for (int bj = 0; bj < 2; ++bj)
#pragma unroll
                    for (int n = 0; n < 2; ++n) { const f32x4 xv = *(const f32x4*)(xin + off + bj * HALF + n * 16); *(f32x4*)(out + off + bj * HALF + n * 16) = xv + sv[bj][n] * acc[ai][bj][m][n]; }
                asm volatile("" ::: "memory"); }
    }
};
struct EpiDelta {
    static constexpr int NS = 0; static constexpr bool PERM = true;
    bf16_t* DL; const float* scale;
    __device__ __forceinline__ void operator()(const f32x4 (&acc)[2][2][4][2], const Unit& u, int wr, int wc, int fr, int fq) const {
        const int row0 = u.pm * BM + wr * 64 + fr, col0 = u.pn * BM + wc * 32 + 8 * fq;
        f32x4 sv[2][2];
#pragma unroll
        for (int bj = 0; bj < 2; ++bj) { sv[bj][0] = scale ? *(const f32x4*)(scale + col0 + bj * HALF) : (f32x4){1.f, 1.f, 1.f, 1.f}; sv[bj][1] = scale ? *(const f32x4*)(scale + col0 + bj * HALF + 4) : (f32x4){1.f, 1.f, 1.f, 1.f}; }
#pragma unroll
        for (int ai = 0; ai < 2; ++ai)
#pragma unroll
            for (int m = 0; m < 4; ++m) { bf16_t* rowp = DL + (size_t)(row0 + ai * HALF + m * 16) * D + col0;
#pragma unroll
                for (int bj = 0; bj < 2; ++bj) { const f32x4 v0 = acc[ai][bj][m][0] * sv[bj][0], v1 = acc[ai][bj][m][1] * sv[bj][1];
                    u32x4 w; w.x = cvtpk(v0[0], v0[1]); w.y = cvtpk(v0[2], v0[3]); w.z = cvtpk(v1[0], v1[1]); w.w = cvtpk(v1[2], v1[3]);
                    *(u32x4*)(rowp + bj * HALF) = w; } }
    }
};
struct EpiResidB {
    static constexpr int NS = 16; static constexpr bool PERM = true; static constexpr bool SPLIT = false;
    bf16_t* xb; const float* scale; float mul;
    __device__ __forceinline__ void operator()(const f32x4 (&acc)[2][2][4][2], const Unit& u, int wr, int wc, int fr, int fq) const {
        const int row0 = u.pm * BM + wr * 64 + fr, col0 = u.pn * BM + wc * 32 + 8 * fq;
        u32x4 d[2][4][2];
#pragma unroll
        for (int ai = 0; ai < 2; ++ai)
#pragma unroll
            for (int m = 0; m < 4; ++m) { const GAS bf16_t* rowp = (const GAS bf16_t*)xb + (size_t)(row0 + ai * HALF + m * 16) * D + col0;
#pragma unroll
                for (int bj = 0; bj < 2; ++bj) d[ai][m][bj] = *(const GAS u32x4*)(rowp + bj * HALF); }
        f32x4 sv[2][2];
#pragma unroll
        for (int bj = 0; bj < 2; ++bj) { sv[bj][0] = (scale ? *(const f32x4*)(scale + col0 + bj * HALF) : (f32x4){1.f, 1.f, 1.f, 1.f}) * mul; sv[bj][1] = (scale ? *(const f32x4*)(scale + col0 + bj * HALF + 4) : (f32x4){1.f, 1.f, 1.f, 1.f}) * mul; }
#pragma unroll
        for (int ai = 0; ai < 2; ++ai)
#pragma unroll
            for (int m = 0; m < 4; ++m) { GAS bf16_t* rowp = (GAS bf16_t*)xb + (size_t)(row0 + ai * HALF + m * 16) * D + col0;
#pragma unroll
                for (int bj = 0; bj < 2; ++bj) { const u32x4 dd = d[ai][m][bj];
                    const f32x4 o0 = (f32x4){bf_lo(dd.x), bf_hi(dd.x), bf_lo(dd.y), bf_hi(dd.y)} + acc[ai][bj][m][0] * sv[bj][0], o1 = (f32x4){bf_lo(dd.z), bf_hi(dd.z), bf_lo(dd.w), bf_hi(dd.w)} + acc[ai][bj][m][1] * sv[bj][1];
                    u32x4 w; w.x = cvtpk(o0[0], o0[1]); w.y = cvtpk(o0[2], o0[3]); w.z = cvtpk(o1[0], o1[1]); w.w = cvtpk(o1[2], o1[3]); *(GAS u32x4*)(rowp + bj * HALF) = w; } }
    }
};
template <class XT>
struct EpiResidD {
    static constexpr int NS = 0; static constexpr bool PERM = true;
    const XT* xsrc; bf16_t* out; const bf16_t* DL; float mul;
    __device__ __forceinline__ void operator()(const f32x4 (&acc)[2][2][4][2], const Unit& u, int wr, int wc, int fr, int fq) const {
        const int row0 = u.pm * BM + wr * 64 + fr, col0 = u.pn * BM + wc * 32 + 8 * fq;
#pragma unroll
        for (int ai = 0; ai < 2; ++ai)
#pragma unroll
            for (int m = 0; m < 4; ++m) { const size_t off0 = (size_t)(row0 + ai * HALF + m * 16) * D + col0;
#pragma unroll
                for (int bj = 0; bj < 2; ++bj) { const size_t off = off0 + bj * HALF; const f32x4 x0 = ld4(xsrc + off), x1 = ld4(xsrc + off + 4); const u32x4 d = *(const u32x4*)(DL + off);
                    const f32x4 d0 = {bf_lo(d.x), bf_hi(d.x), bf_lo(d.y), bf_hi(d.y)}, d1 = {bf_lo(d.z), bf_hi(d.z), bf_lo(d.w), bf_hi(d.w)};
                    const f32x4 o0 = x0 + d0 + acc[ai][bj][m][0] * mul, o1 = x1 + d1 + acc[ai][bj][m][1] * mul;
                    u32x4 w; w.x = cvtpk(o0[0], o0[1]); w.y = cvtpk(o0[2], o0[3]); w.z = cvtpk(o1[0], o1[1]); w.w = cvtpk(o1[2], o1[3]); *(u32x4*)(out + off) = w; }
                asm volatile("" ::: "memory"); }
    }
};
struct EpiResid {
    static constexpr int NS = 0; static constexpr bool PERM = false;
    float* x; float mul;
    __device__ __forceinline__ void operator()(const f32x4 (&acc)[2][2][4][2], const Unit& u, int wr, int wc, int fr, int fq) const {
        const int row0 = u.pm * BM + wr * 64 + fr, col0 = u.pn * BM + wc * 32 + 4 * fq;
#pragma unroll
        for (int ai = 0; ai < 2; ++ai)
#pragma unroll
            for (int m = 0; m < 4; ++m) { float* p = x + (size_t)(row0 + ai * HALF + m * 16) * D + col0;
#pragma unroll
                for (int bj = 0; bj < 2; ++bj)
#pragma unroll
                    for (int n = 0; n < 2; ++n) { const f32x4 xv = *(const f32x4*)(p + bj * HALF + n * 16); *(f32x4*)(p + bj * HALF + n * 16) = xv + acc[ai][bj][m][n] * mul; }
                asm volatile("" ::: "memory"); }
    }
};
__device__ __forceinline__ f32x2 swiglu2(f32x2 g, f32x2 u, float c1  , float kinv  ) {
    const f32x2 t = g * c1; f32x2 e; e.x = __builtin_amdgcn_exp2f(t.x); e.y = __builtin_amdgcn_exp2f(t.y);
    const f32x2 d = e * kinv + kinv; f32x2 r; r.x = __builtin_amdgcn_rcpf(d.x); r.y = __builtin_amdgcn_rcpf(d.y);
    return (g * u) * r;
}
__device__ __forceinline__ f32x2 swiglu2n(f32x2 gl, f32x2 us, float k) {
    f32x2 e; e.x = __builtin_amdgcn_exp2f(-gl.x); e.y = __builtin_amdgcn_exp2f(-gl.y);
    const f32x2 d = e * k + k; f32x2 r; r.x = __builtin_amdgcn_rcpf(d.x); r.y = __builtin_amdgcn_rcpf(d.y);
    return (gl * us) * r;
}
__device__ __forceinline__ float silu_mul(float g, float u) { return g * u * __builtin_amdgcn_rcpf(1.0f + __builtin_amdgcn_exp2f(-1.4426950408889634f * g)); }
struct EpiSwiglu {
    static constexpr int NS = 0; static constexpr bool PERM = true;
    bf16_t* H; int ldc;
    __device__ __forceinline__ void operator()(const f32x4 (&acc)[2][2][4][2], const Unit& u, int wr, int wc, int fr, int fq) const {
        const int row0 = u.pm * BM + wr * 64 + fr, col0 = u.pn * HALF + wc * 32 + 8 * fq;
#pragma unroll
        for (int ai = 0; ai < 2; ++ai)
#pragma unroll
            for (int m = 0; m < 4; ++m) { bf16_t* rowp = H + (size_t)(row0 + ai * HALF + m * 16) * ldc + col0;
                const f32x4 g0 = acc[ai][0][m][0], g1 = acc[ai][0][m][1], u0 = acc[ai][1][m][0], u1 = acc[ai][1][m][1];
                const f32x2 h0 = swiglu2((f32x2){g0[0], g0[1]}, (f32x2){u0[0], u0[1]}, -1.4426950408889634f, 1.0f), h1 = swiglu2((f32x2){g0[2], g0[3]}, (f32x2){u0[2], u0[3]}, -1.4426950408889634f, 1.0f);
                const f32x2 h2 = swiglu2((f32x2){g1[0], g1[1]}, (f32x2){u1[0], u1[1]}, -1.4426950408889634f, 1.0f), h3 = swiglu2((f32x2){g1[2], g1[3]}, (f32x2){u1[2], u1[3]}, -1.4426950408889634f, 1.0f);
                u32x4 w; w.x = cvtpk(h0.x, h0.y); w.y = cvtpk(h1.x, h1.y); w.z = cvtpk(h2.x, h2.y); w.w = cvtpk(h3.x, h3.y);
                *(u32x4*)rowp = w; }
    }
};
template <bool OUT8>
struct EpiSwigluI8 {
    static constexpr int NS = 8; static constexpr bool PERM = true;
    bf16_t* H; int ldc; const float* ascale; const float* wscale;
    __device__ __forceinline__ void operator()(const f32x4 (&acc)[2][2][4][2], const Unit& u, int wr, int wc, int fr, int fq) const {
        const int row0 = u.pm * BM + wr * 64 + fr, col0 = u.pn * HALF + wc * 32 + 8 * fq;
        const float* wsp = wscale + u.pn * BM + wc * 32 + 8 * fq;
        const f32x4 sg0 = *(const f32x4*)wsp * W8_GATE, sg1 = *(const f32x4*)(wsp + 4) * W8_GATE, su0 = *(const f32x4*)(wsp + HALF), su1 = *(const f32x4*)(wsp + HALF + 4);
        constexpr float kk = W8_GATE / (OUT8 ? H8_SC : 1.0f);
        float sav[2][4];
#pragma unroll
        for (int ai = 0; ai < 2; ++ai)
#pragma unroll
            for (int m = 0; m < 4; ++m) sav[ai][m] = ascale[row0 + ai * HALF + m * 16];
#pragma unroll
        for (int ai = 0; ai < 2; ++ai)
#pragma unroll
            for (int m = 0; m < 4; ++m) { const int row = row0 + ai * HALF + m * 16; bf16_t* rowp = H + (size_t)row * ldc + col0; const float sa = sav[ai][m];
                const i32x4 ig0 = __builtin_bit_cast(i32x4, acc[ai][0][m][0]), ig1 = __builtin_bit_cast(i32x4, acc[ai][0][m][1]), iu0 = __builtin_bit_cast(i32x4, acc[ai][1][m][0]), iu1 = __builtin_bit_cast(i32x4, acc[ai][1][m][1]);
                const f32x4 g0 = __builtin_convertvector(ig0, f32x4) * (sg0 * sa), g1 = __builtin_convertvector(ig1, f32x4) * (sg1 * sa), u0 = __builtin_convertvector(iu0, f32x4) * (su0 * sa), u1 = __builtin_convertvector(iu1, f32x4) * (su1 * sa);
                const f32x2 h0 = swiglu2n((f32x2){g0[0], g0[1]}, (f32x2){u0[0], u0[1]}, kk), h1 = swiglu2n((f32x2){g0[2], g0[3]}, (f32x2){u0[2], u0[3]}, kk);
                const f32x2 h2 = swiglu2n((f32x2){g1[0], g1[1]}, (f32x2){u1[0], u1[1]}, kk), h3 = swiglu2n((f32x2){g1[2], g1[3]}, (f32x2){u1[2], u1[3]}, kk);
                if constexpr (OUT8) { u32x2 w; w.x = pk4_fp8(h0.x, h0.y, h1.x, h1.y); w.y = pk4_fp8(h2.x, h2.y, h3.x, h3.y);
                    *(u32x2*)((unsigned char*)H + (size_t)row * ldc + col0) = w; }
                else { u32x4 w; w.x = cvtpk(h0.x, h0.y); w.y = cvtpk(h1.x, h1.y); w.z = cvtpk(h2.x, h2.y); w.w = cvtpk(h3.x, h3.y);
                *(u32x4*)rowp = w; } }
    }
};
struct EpiSwiglu8 {
    static constexpr int NS = 8; static constexpr bool PERM = true;
    unsigned char* H; int ldc; float gsc;
    __device__ __forceinline__ void operator()(const f32x4 (&acc)[2][2][4][2], const Unit& u, int wr, int wc, int fr, int fq) const {
        const int row0 = u.pm * BM + wr * 64 + fr, col0 = u.pn * HALF + wc * 32 + 8 * fq;
#pragma unroll
        for (int ai = 0; ai < 2; ++ai)
#pragma unroll
            for (int m = 0; m < 4; ++m) { unsigned char* rowp = H + (size_t)(row0 + ai * HALF + m * 16) * ldc + col0;
                const f32x4 g0 = acc[ai][0][m][0], g1 = acc[ai][0][m][1], u0 = acc[ai][1][m][0], u1 = acc[ai][1][m][1];
                const float kk = W8_GATE / (gsc * H8_SC);
                const f32x2 h0 = swiglu2n((f32x2){g0[0], g0[1]}, (f32x2){u0[0], u0[1]}, kk), h1 = swiglu2n((f32x2){g0[2], g0[3]}, (f32x2){u0[2], u0[3]}, kk);
                const f32x2 h2 = swiglu2n((f32x2){g1[0], g1[1]}, (f32x2){u1[0], u1[1]}, kk), h3 = swiglu2n((f32x2){g1[2], g1[3]}, (f32x2){u1[2], u1[3]}, kk);
                u32x2 w; w.x = pk4_fp8(h0.x, h0.y, h1.x, h1.y); w.y = pk4_fp8(h2.x, h2.y, h3.x, h3.y);
                *(u32x2*)rowp = w; }
    }
};
struct EpiProj {
    static constexpr int NS = 0; static constexpr bool PERM = true;
    bf16_t *Kb, *Qb, *Vt;
    __device__ __forceinline__ void operator()(const f32x4 (&acc)[2][2][4][2], const Unit& u, int wr, int wc, int fr, int fq) const {
        bf16_t* base = (u.aux == 0) ? Kb : (u.aux == 1 ? Qb : Vt); const size_t ldc = (u.aux == 2) ? (size_t)M : (size_t)D;
        const int row0 = u.pm * BM + wr * 64 + fr, col0 = u.pn * BM + wc * 32 + 8 * fq;
#pragma unroll
        for (int ai = 0; ai < 2; ++ai)
#pragma unroll
            for (int m = 0; m < 4; ++m) { bf16_t* rowp = base + (size_t)(row0 + ai * HALF + m * 16) * ldc + col0;
#pragma unroll
                for (int bj = 0; bj < 2; ++bj) { const f32x4 v0 = acc[ai][bj][m][0], v1 = acc[ai][bj][m][1];
                    u32x4 w; w.x = cvtpk(v0[0], v0[1]); w.y = cvtpk(v0[2], v0[3]); w.z = cvtpk(v1[0], v1[1]); w.w = cvtpk(v1[2], v1[3]);
                    if (u.aux == 2) { bf16_t* p16 = rowp + bj * HALF - (fq & 1) * 8 + (fq & 1) * 4;
                        *(u32x2*)p16 = (u32x2){w.x, w.y}; *(u32x2*)(p16 + 8) = (u32x2){w.z, w.w}; }
                    else *(u32x4*)(rowp + bj * HALF) = w; } }
    }
};
struct EpiProjI8 {
    static constexpr int NS = 16; static constexpr bool PERM = true;
    bf16_t *Kb, *Qb, *Vt; const float* ascale; const float* wsc  ; int qsel;
    __device__ __forceinline__ void operator()(const f32x4 (&acc)[2][2][4][2], const Unit& u, int wr, int wc, int fr, int fq) const {
        bf16_t* base = (u.aux == 0) ? Kb : (u.aux == 1 ? Qb : Vt); const size_t ldc = (u.aux == 2) ? (size_t)M : (size_t)D;
        const float* rs; const float* cs; if (u.aux == 2) { rs = wsc + 1024; cs = ascale; } else { rs = ascale; cs = wsc + u.aux * (2048 + qsel * 1024); }
        const int row0 = u.pm * BM + wr * 64 + fr, col0 = u.pn * BM + wc * 32 + 8 * fq;
        f32x4 cv[2][2];
#pragma unroll
        for (int bj = 0; bj < 2; ++bj) { cv[bj][0] = *(const f32x4*)(cs + col0 + bj * HALF); cv[bj][1] = *(const f32x4*)(cs + col0 + bj * HALF + 4); }
        float rvv[2][4];
#pragma unroll
        for (int ai = 0; ai < 2; ++ai)
#pragma unroll
            for (int m = 0; m < 4; ++m) rvv[ai][m] = rs[row0 + ai * HALF + m * 16];
#pragma unroll
        for (int ai = 0; ai < 2; ++ai)
#pragma unroll
            for (int m = 0; m < 4; ++m) { const int row = row0 + ai * HALF + m * 16; bf16_t* rowp = base + (size_t)row * ldc + col0; const float rv = rvv[ai][m];
#pragma unroll
                for (int bj = 0; bj < 2; ++bj) { const f32x4 v0 = __builtin_convertvector(__builtin_bit_cast(i32x4, acc[ai][bj][m][0]), f32x4) * (cv[bj][0] * rv), v1 = __builtin_convertvector(__builtin_bit_cast(i32x4, acc[ai][bj][m][1]), f32x4) * (cv[bj][1] * rv);
                    u32x4 w; w.x = cvtpk(v0[0], v0[1]); w.y = cvtpk(v0[2], v0[3]); w.z = cvtpk(v1[0], v1[1]); w.w = cvtpk(v1[2], v1[3]);
                    if (u.aux == 2) { bf16_t* p16 = rowp + bj * HALF - (fq & 1) * 8 + (fq & 1) * 4;
                        *(u32x2*)p16 = (u32x2){w.x, w.y}; *(u32x2*)(p16 + 8) = (u32x2){w.z, w.w}; }
                    else *(u32x4*)(rowp + bj * HALF) = w; } }
    }
};
struct EpiMoeDown {
    static constexpr int NS = 16; static constexpr bool PERM = true;
    bf16_t* Y; const float* gate; float osc;
    __device__ __forceinline__ void operator()(const f32x4 (&acc)[2][2][4][2], const Unit& u, int wr, int wc, int fr, int fq) const {
        const int row0 = u.pm * BM + wr * 64 + fr, col0 = u.pn * BM + wc * 32 + 8 * fq;
        float gtv[2][4];
#pragma unroll
        for (int ai = 0; ai < 2; ++ai)
#pragma unroll
            for (int m = 0; m < 4; ++m) gtv[ai][m] = gate[row0 + ai * HALF + m * 16];
#pragma unroll
        for (int ai = 0; ai < 2; ++ai)
#pragma unroll
            for (int m = 0; m < 4; ++m) { const int row = row0 + ai * HALF + m * 16; const float gt = gtv[ai][m] * osc; bf16_t* rowp = Y + (size_t)row * D + col0;
#pragma unroll
                for (int bj = 0; bj < 2; ++bj) { const f32x4 v0 = acc[ai][bj][m][0] * gt, v1 = acc[ai][bj][m][1] * gt;
                    u32x4 w; w.x = cvtpk(v0[0], v0[1]); w.y = cvtpk(v0[2], v0[3]); w.z = cvtpk(v1[0], v1[1]); w.w = cvtpk(v1[2], v1[3]);
                    *(u32x4*)(rowp + bj * HALF) = w; } }
    }
};
}

__device__ __forceinline__ void tr_load(float (&tv)[32], const float* W, int ldw, int k0, int n0, int lane) {
    const GAS float* wp = (const GAS float*)W + (size_t)(k0 + (lane >> 5)) * ldw + n0 + (lane & 31);
#pragma unroll
    for (int i = 0; i < 32; ++i) tv[i] = wp[(size_t)(2 * i) * ldw];
}
__device__ __forceinline__ void tr_put(const float (&tv)[32], int k0, const float* gain, float mul, int mode  , unsigned char* WT, int ldk, int drow0, LAS float* scr, int lane,
                                       const unsigned* colmax = nullptr  , int n0 = 0, float* wscale = nullptr  ) {
#pragma unroll
    for (int i = 0; i < 32; ++i) { const int kk = 2 * i + (lane >> 5); const float gv = gain ? gain[k0 + kk] * mul : mul; scr[kk * 33 + (lane & 31)] = tv[i] * gv; }
    LDS_WAIT(); asm volatile("" ::: "memory");
    const int c = lane & 7;
#pragma unroll
    for (int j = 0; j < 4; ++j) { const int n = (lane >> 3) + 8 * j; const LAS float* sp = scr + (8 * c) * 33 + n;
        const float e0 = sp[0 * 33], e1 = sp[1 * 33], e2 = sp[2 * 33], e3 = sp[3 * 33], e4 = sp[4 * 33], e5 = sp[5 * 33], e6 = sp[6 * 33], e7 = sp[7 * 33];
        if (mode == 2) { const float mx = __builtin_bit_cast(float, __hip_atomic_load(colmax + n0 + n, RLX_AGENT)); const float q = mx > 0.f ? 127.0f / mx : 0.f;
            u32x2 o; o.x = pk4_i8(e0 * q, e1 * q, e2 * q, e3 * q); o.y = pk4_i8(e4 * q, e5 * q, e6 * q, e7 * q); *(GAS u32x2*)(WT + (size_t)(drow0 + n) * ldk + k0 + 8 * c) = o;
            if (k0 == 0 && c == 0) wscale[drow0 + n] = mx * (1.0f / 127.0f); }
        else if (mode == 1) { u32x2 o; o.x = pk4_fp8(e0, e1, e2, e3); o.y = pk4_fp8(e4, e5, e6, e7); *(GAS u32x2*)(WT + (size_t)(drow0 + n) * ldk + k0 + 8 * c) = o; }
        else { u32x4 o; o.x = cvtpk(e0, e1); o.y = cvtpk(e2, e3); o.z = cvtpk(e4, e5); o.w = cvtpk(e6, e7); *(GAS u32x4*)(WT + ((size_t)(drow0 + n) * ldk + k0 + 8 * c) * 2) = o; } }
    LDS_WAIT(); asm volatile("" ::: "memory");
}
__device__ __forceinline__ void tr_mat(const float* W, int ldw, int K, int N, const float* gain, float mul, int mode, bool gu, unsigned char* WT, LAS float* scr, int first, int NGW, int lane,
                                       const unsigned* colmax = nullptr, float* wscale = nullptr, float gmul = 0.f  ) {
    const int nblk = N / 32, nitems = (K / 64) * nblk, F = N / 2;
    float tv[32], tn[32];
    int it = first; if (it >= nitems) return;
    tr_load(tv, W, ldw, (it / nblk) * 64, (it % nblk) * 32, lane);
    for (; it < nitems; it += NGW) {
        const int nx = it + NGW; if (nx < nitems) tr_load(tn, W, ldw, (nx / nblk) * 64, (nx % nblk) * 32, lane);
        const int kb = it / nblk, n0 = (it % nblk) * 32; int drow0 = n0;
        if (gu) { const int isup = n0 >= F, j = isup ? n0 - F : n0; drow0 = (j >> 7) * 256 + (isup ? 128 : 0) + (j & 127); }
        tr_put(tv, kb * 64, gain, (gu && n0 < F && gmul != 0.f) ? gmul : mul, mode, WT, K, drow0, scr, lane, colmax, n0, wscale);
#pragma unroll
        for (int i = 0; i < 32; ++i) tv[i] = tn[i];
    }
}

struct Args { const float* in[15]; float* out; unsigned char* ws; };
template <int OFF> __device__ __forceinline__ unsigned long long karg() { unsigned long long v; auto ka = __builtin_amdgcn_kernarg_segment_ptr();
    asm volatile("s_load_dwordx2 %0, %1, %2\n\ts_waitcnt lgkmcnt(0)" : "=s"(v) : "s"(ka), "n"(OFF) : "memory"); return v; }
#define ARG_IN(k) ((const float*)(const GAS float*)karg<8 * (k)>())
#define ARG_OUT() ((float*)(GAS float*)karg<120>())
#define ARG_WS() ((unsigned char*)(GAS unsigned char*)karg<128>())

template <int CTRL> __device__ __forceinline__ float dpp_mov(float s) { return __builtin_bit_cast(float, __builtin_amdgcn_update_dpp(0, __builtin_bit_cast(int, s), CTRL, 0xF, 0xF, true)); }
__device__ __forceinline__ void swap16(float& a, float& b) { asm("s_nop 1\n\tv_permlane16_swap_b32 %0, %1" : "+v"(a), "+v"(b)); }
__device__ __forceinline__ void swap32(float& a, float& b) { asm("s_nop 1\n\tv_permlane32_swap_b32 %0, %1" : "+v"(a), "+v"(b)); }
__device__ __forceinline__ float fast_wave_sum(float v) {
    v += dpp_mov<0xB1>(v); v += dpp_mov<0x4E>(v); v += dpp_mov<0x141>(v); v += dpp_mov<0x140>(v);
    { float w = v; swap16(v, w); v += w; } { float w = v; swap32(v, w); v += w; }
    return v;
}
__device__ __forceinline__ float fast_wave_max(float v) {
    v = fmaxf(v, dpp_mov<0xB1>(v)); v = fmaxf(v, dpp_mov<0x4E>(v)); v = fmaxf(v, dpp_mov<0x141>(v)); v = fmaxf(v, dpp_mov<0x140>(v));
    { float w = v; swap16(v, w); v = fmaxf(v, w); } { float w = v; swap32(v, w); v = fmaxf(v, w); }
    return v;
}
__device__ __forceinline__ float reduce8(float (&a)[8], int lane) {
    float b[4], c[2];
#pragma unroll
    for (int k = 0; k < 4; ++k) { float x = a[k], y = a[k + 4]; swap32(x, y); b[k] = x + y; }
#pragma unroll
    for (int k = 0; k < 2; ++k) { float x = b[k], y = b[k + 2]; swap16(x, y); c[k] = x + y; }
    const bool hi = (lane & 8) != 0;
    const float keep = hi ? c[1] : c[0], send = hi ? c[0] : c[1];
    float d = keep + dpp_mov<0x140>(send);
    d += dpp_mov<0x141>(d); d += dpp_mov<0xB1>(d); d += dpp_mov<0x4E>(d);
    return d;
}
template <int W, class HT>
__device__ __forceinline__ void pool_chan(const bf16_t* xp  , const HT* hp  , int s0, const LAS float* inv  , bf16_t* pp  ) {
    f32x2 hist[W]; f32x2 S = {0.f, 0.f};
#pragma unroll
    for (int j = 0; j < W; ++j) hist[j] = (f32x2){0.f, 0.f};
    if (s0 > 0) {
#pragma unroll
        for (int j = 1; j < W; ++j) { const int t = j - W; const f32x2 v = ld2(hp + (ptrdiff_t)t * D) * inv[15 + t]; hist[j] = v; S += v; }
    }
    for (int tb = 0; tb < 256; tb += 64) {
        unsigned raw[64];
#pragma unroll
        for (int j = 0; j < 64; ++j) raw[j] = *(const GAS unsigned*)(xp + (size_t)(tb + j) * D);
#pragma unroll
        for (int j = 0; j < 64; ++j) { const int t = tb + j; const f32x2 xv = (f32x2){bf_lo(raw[j]), bf_hi(raw[j])} * inv[15 + t]; S += xv - hist[j % W]; hist[j % W] = xv;
            const int pos = s0 + t + 1; const float rc = (pos >= W) ? (1.0f / W) : (1.0f / (float)pos);
            const f32x2 p = S * rc - xv; *(GAS unsigned*)(pp + (size_t)t * D) = cvtpk(p.x, p.y); }
    }
}
template <bool FIRST>
__device__ __forceinline__ void pool_prep_phase(const float* xin, bf16_t* xb, bf16_t* P, LAS unsigned char* lds, int G, int wave_s) {
    const int tid = fresh_tid(wave_s); const int lane = tid & 63, wave = __builtin_amdgcn_readfirstlane(tid >> 6);
    LAS float* inv = (LAS float*)lds;
    for (int tile = blockIdx.x; tile < M / 256; tile += G) {
        const int r0 = tile * 256, s0 = r0 % SEQ;
        const int start = (s0 > 0) ? -15 : 0;
        for (int base = start + wave; base < 256; base += 8 * NWAVES) {
            typename Raw4<float>::t vf[8][4]; typename Raw4<bf16_t>::t vb[8][4];
#pragma unroll
            for (int k = 0; k < 8; ++k) { int rr = base + k * NWAVES; rr = rr < 256 ? rr : 255;
                if (FIRST) { const float* xr = xin + (size_t)(r0 + rr) * D + 4 * lane;
#pragma unroll
                    for (int j = 0; j < 4; ++j) vf[k][j] = ldraw4(xr + 256 * j); }
                else { const bf16_t* xr = xb + (size_t)(r0 + rr) * D + 4 * lane;
#pragma unroll
                    for (int j = 0; j < 4; ++j) vb[k][j] = ldraw4(xr + 256 * j); } }
#pragma unroll
            for (int k = 0; k < 8; ++k) { const int rr = base + k * NWAVES; float s = 0.f; f32x4 v[4];
#pragma unroll
                for (int j = 0; j < 4; ++j) { if (FIRST) v[j] = cvt4(vf[k][j]); else v[j] = cvt4(vb[k][j]); s += (v[j].x * v[j].x + v[j].y * v[j].y) + (v[j].z * v[j].z + v[j].w * v[j].w); }
                s = fast_wave_sum(s);
                if (rr < 256) {
                    if (lane == 0) inv[15 + rr] = 1.0f / sqrtf(s * (1.0f / D) + RMS_EPS);
                    if (FIRST && rr >= 0) { GAS u32x2* xo = (GAS u32x2*)(xb + (size_t)(r0 + rr) * D) + lane;
#pragma unroll
                        for (int j = 0; j < 4; ++j) { u32x2 w; w.x = cvtpk(v[j].x, v[j].y); w.y = cvtpk(v[j].z, v[j].w); xo[64 * j] = w; } } } }
        }
        __syncthreads();
        const int c = 2 * tid; const bf16_t* xp = xb + (size_t)r0 * D + c; bf16_t* pp = P + (size_t)r0 * D + c;
        const int grp = wave >> 1;
        if (FIRST) { const float* hp = xin + (size_t)r0 * D + c;
            if (grp == 0) pool_chan<2, float>(xp, hp, s0, inv, pp); else if (grp == 1) pool_chan<4, float>(xp, hp, s0, inv, pp); else if (grp == 2) pool_chan<8, float>(xp, hp, s0, inv, pp); else pool_chan<16, float>(xp, hp, s0, inv, pp); }
        else { if (grp == 0) pool_chan<2, bf16_t>(xp, xp, s0, inv, pp); else if (grp == 1) pool_chan<4, bf16_t>(xp, xp, s0, inv, pp); else if (grp == 2) pool_chan<8, bf16_t>(xp, xp, s0, inv, pp); else pool_chan<16, bf16_t>(xp, xp, s0, inv, pp); }
        __syncthreads();
    }
}

template <bool COMBINE, bool ROUTER, bool FINAL, int OUTK, bool DELTA, class XT>
__device__ __forceinline__ void norm_phase(float* x, bf16_t* XN, const bf16_t* YS, const int* slot_of, const float* gvec  , const float* wr  ,
                                           int* route_e, float* route_g, int* tilecnt, LAS unsigned char* lds, LAS int* cnt_l, int G, int wave_s, float* ascale, const bf16_t* DL, const XT* xs  , bf16_t* xw  ) {
    const int tid = fresh_tid(wave_s); const int lane = tid & 63, wave = __builtin_amdgcn_readfirstlane(tid >> 6);
    f32x2 wreg[8][8];
    if (ROUTER) {
#pragma unroll
        for (int j = 0; j < 4; ++j)
#pragma unroll
            for (int k = 0; k < 4; ++k) { const int c = 4 * lane + 256 * j + k; const float gc = gvec[c]; const f32x4 w0 = *(const f32x4*)(wr + (size_t)c * 8), w1 = *(const f32x4*)(wr + (size_t)c * 8 + 4);
#pragma unroll
                for (int e = 0; e < 4; ++e) { wreg[e][2 * j + (k >> 1)][k & 1] = w0[e] * gc; wreg[e + 4][2 * j + (k >> 1)][k & 1] = w1[e] * gc; } }
    }
    f32x4 gf[4];
    if (FINAL) {
#pragma unroll
        for (int j = 0; j < 4; ++j) gf[j] = *((const f32x4*)gvec + lane + 64 * j);
    }
    for (int tile = blockIdx.x; tile < M / 256; tile += G) {
        const int rb = tile * 256 + wave * 32;
        int slv = 0; if (COMBINE) slv = slot_of[2 * rb + lane];
        u32x2 nx[2][4], na[2][4], nb[2][4];
#define NP_LOAD(u, idx) do { const GAS u32x2* p_ = (const GAS u32x2*)((const bf16_t*)xs + (size_t)(rb + (idx)) * D) + lane; \
            _Pragma("unroll") for (int j = 0; j < 4; ++j) nx[u][j] = p_[64 * j]; \
            if (COMBINE) { const int a0_ = __builtin_amdgcn_readlane(slv, 2 * (idx)), a1_ = __builtin_amdgcn_readlane(slv, 2 * (idx) + 1); \
                const GAS u32x2* y0_ = (const GAS u32x2*)(YS + (size_t)a0_ * D) + lane; const GAS u32x2* y1_ = (const GAS u32x2*)(YS + (size_t)a1_ * D) + lane; \
                _Pragma("unroll") for (int j = 0; j < 4; ++j) { na[u][j] = y0_[64 * j]; nb[u][j] = y1_[64 * j]; } } } while (0)
        NP_LOAD(0, 0); NP_LOAD(1, 1);
        for (int i = 0; i < 32; i += 2) {
            f32x4 v[2][4];
#pragma unroll
            for (int u = 0; u < 2; ++u)
#pragma unroll
                for (int j = 0; j < 4; ++j) { const u32x2 d = nx[u][j]; v[u][j] = (f32x4){bf_lo(d.x), bf_hi(d.x), bf_lo(d.y), bf_hi(d.y)}; }
            if (COMBINE) {
#pragma unroll
                for (int u = 0; u < 2; ++u)
#pragma unroll
                    for (int w = 0; w < 2; ++w) { const int sl = __builtin_amdgcn_readlane(slv, 2 * (i + u) + w);
                        if (sl < 2 * M) {
#pragma unroll
                            for (int j = 0; j < 4; ++j) { const u32x2 a = w ? nb[u][j] : na[u][j]; v[u][j] += (f32x4){bf_lo(a.x), bf_hi(a.x), bf_lo(a.y), bf_hi(a.y)}; } }
                        else {
                            for (int q = 0; q < 7; ++q) { const GAS u32x2* yq = (const GAS u32x2*)(DL + ((size_t)q * (8 * 256) + (size_t)(sl - 2 * M)) * D) + lane;
#pragma unroll
                                for (int j = 0; j < 4; ++j) { const u32x2 a = yq[64 * j]; v[u][j] += (f32x4){bf_lo(a.x), bf_hi(a.x), bf_lo(a.y), bf_hi(a.y)}; } } } } }
            if (i + 2 < 32) { NP_LOAD(0, i + 2); NP_LOAD(1, i + 3); }
#pragma unroll
            for (int u = 0; u < 2; ++u) {
                const int r = rb + i + u;
                if (COMBINE && !FINAL) { GAS u32x2* xo = (GAS u32x2*)(xw + (size_t)r * D) + lane;
#pragma unroll
                    for (int j = 0; j < 4; ++j) { u32x2 w; w.x = cvtpk(v[u][j].x, v[u][j].y); w.y = cvtpk(v[u][j].z, v[u][j].w); xo[64 * j] = w; } }
                float s = 0.f;
#pragma unroll
                for (int j = 0; j < 4; ++j) s += (v[u][j].x * v[u][j].x + v[u][j].y * v[u][j].y) + (v[u][j].z * v[u][j].z + v[u][j].w * v[u][j].w);
                float lgp[8];
                if (ROUTER) {
#pragma unroll
                    for (int e = 0; e < 8; ++e) { f32x2 a2 = {0.f, 0.f};
#pragma unroll
                        for (int j = 0; j < 4; ++j) { a2 += (f32x2){v[u][j].x, v[u][j].y} * wreg[e][2 * j] ; a2 += (f32x2){v[u][j].z, v[u][j].w} * wreg[e][2 * j + 1]; }
                        lgp[e] = a2.x + a2.y; }
                }
                const float inv = 1.0f / sqrtf(fast_wave_sum(s) * (1.0f / D) + RMS_EPS);
#pragma unroll
                for (int j = 0; j < 4; ++j) v[u][j] = v[u][j] * inv;
                if (FINAL) { GAS f32x4* xr = (GAS f32x4*)(x + (size_t)r * D) + lane;
#pragma unroll
                    for (int j = 0; j < 4; ++j) xr[64 * j] = v[u][j] * gf[j];
                } else if (OUTK == 2) {
                    float mx = 0.f;
#pragma unroll
                    for (int j = 0; j < 4; ++j) mx = fmaxf(fmaxf(mx, fmaxf(fabsf(v[u][j].x), fabsf(v[u][j].y))), fmaxf(fabsf(v[u][j].z), fabsf(v[u][j].w)));
                    mx = fast_wave_max(mx); const float q = mx > 0.f ? 127.0f / mx : 0.f;
                    GAS unsigned* o = (GAS unsigned*)((unsigned char*)XN + (size_t)r * D) + lane;
#pragma unroll
                    for (int j = 0; j < 4; ++j) o[64 * j] = pk4_i8(v[u][j].x * q, v[u][j].y * q, v[u][j].z * q, v[u][j].w * q);
                    if (lane == 0) ascale[r] = mx * (1.0f / 127.0f);
                } else if (OUTK == 1) {
                    GAS unsigned* o = (GAS unsigned*)((unsigned char*)XN + (size_t)r * D) + lane;
#pragma unroll
                    for (int j = 0; j < 4; ++j) o[64 * j] = pk4_fp8(v[u][j].x, v[u][j].y, v[u][j].z, v[u][j].w);
                } else {
                    GAS u32x2* o = (GAS u32x2*)(XN + (size_t)r * D) + lane;
#pragma unroll
                    for (int j = 0; j < 4; ++j) { u32x2 w; w.x = cvtpk(v[u][j].x, v[u][j].y); w.y = cvtpk(v[u][j].z, v[u][j].w); o[64 * j] = w; }
                }
                if (ROUTER) {
                    const float dsum = reduce8(lgp, lane) * inv;
                    float lg[8];
#pragma unroll
                    for (int e = 0; e < 8; ++e) lg[e] = __builtin_bit_cast(float, __builtin_amdgcn_readlane(__builtin_bit_cast(int, dsum), 8 * e));
                    int e0 = 0; float v0 = lg[0];
#pragma unroll
                    for (int e = 1; e < 8; ++e) if (lg[e] > v0) { v0 = lg[e]; e0 = e; }
                    int e1 = -1; float v1 = -3.0e38f;
#pragma unroll
                    for (int e = 0; e < 8; ++e) if (e != e0 && lg[e] > v1) { v1 = lg[e]; e1 = e; }
                    const float ex = __expf(v1 - v0), g0 = 1.0f / (1.0f + ex), g1 = ex * g0;
                    if (lane == 0) { route_e[r] = e0 | (e1 << 8); route_g[2 * r] = g0; route_g[2 * r + 1] = g1; atomicAdd((int*)(cnt_l + e0), 1); atomicAdd((int*)(cnt_l + e1), 1); }
                }
            }
        }
#undef NP_LOAD
        if (ROUTER) {
            __syncthreads();
            if (tid < 8) { tilecnt[tile * 8 + tid] = cnt_l[tid]; cnt_l[tid] = 0; }
            __syncthreads();
        }
    }
}

template <bool FP8>
__device__ __forceinline__ void dispatch_phase(const int* tilecnt, const int* route_e, const float* route_g, int* slot_of, float* gate_slot, const bf16_t* XN, bf16_t* XS  ,
                                               LAS unsigned char* lds, LAS int* pend, int G, int wave_s) {
    const int tid = fresh_tid(wave_s); const int lane = tid & 63, wave = __builtin_amdgcn_readfirstlane(tid >> 6);
    LAS int* lc = (LAS int*)lds;
    LAS int* tot_l = (LAS int*)(lds + 8192);
    LAS int* pst_l = (LAS int*)(lds + 8192 + 32);
    LAS int* base_l = (LAS int*)(lds + 8192 + 64);
    LAS int* slot_l = (LAS int*)(lds + 8192 + 128);
    if (tid < 256) { const i32x4 a = *((const i32x4*)tilecnt + 2 * tid), b = *((const i32x4*)tilecnt + 2 * tid + 1); *((LAS i32x4*)lc + 2 * tid) = a; *((LAS i32x4*)lc + 2 * tid + 1) = b; }
    __syncthreads();
    if (tid < 8) { int t = 0; for (int i = 0; i < 256; ++i) t += lc[i * 8 + tid]; tot_l[tid] = t; }
    __syncthreads();
    if (tid == 0) { int ps = 0; for (int e = 0; e < 8; ++e) { const int padded = (tot_l[e] + 255) & ~255; pst_l[e] = ps; ps += padded; pend[e] = ps >> 8; } }
    __syncthreads();
    if (FP8 && blockIdx.x < 8) { const int e = blockIdx.x, t0 = pst_l[e] + tot_l[e], npad = ((tot_l[e] + 255) & ~255) - tot_l[e];
        for (int i = tid; i < npad; i += NTHREADS) ((int*)XS)[t0 + i] = 0; }
    for (int tile = blockIdx.x; tile < M / 256; tile += G) {
        const int r0 = tile * 256;
        if (tid < 8) { int pre = 0; for (int i = 0; i < tile; ++i) pre += lc[i * 8 + tid]; base_l[tid] = pst_l[tid] + pre; }
        __syncthreads();
        if (wave == 0) {
            int run[8];
#pragma unroll
            for (int e = 0; e < 8; ++e) run[e] = 0;
            for (int ch = 0; ch < 8; ++ch) {
                const int i = ch * 64 + lane, tok = r0 + (i >> 1), k = i & 1;
                const int ew = __hip_atomic_load(route_e + tok, RLX_AGENT); const int e = (ew >> (8 * k)) & 0xff;
                int slot = 0;
#pragma unroll
                for (int ee = 0; ee < 8; ++ee) { const unsigned long long mask = __ballot(e == ee);
                    if (e == ee) slot = base_l[ee] + run[ee] + __popcll(mask & ((1ull << lane) - 1ull));
                    run[ee] += __popcll(mask); }
                slot_l[i] = slot; slot_of[2 * tok + k] = slot; gate_slot[slot] = __hip_atomic_load(route_g + 2 * tok + k, RLX_AGENT); if (FP8) ((int*)XS)[slot] = tok;
            }
        }
        __syncthreads();
        if constexpr (!FP8) {
        for (int ii = 0; ii < 64; ii += 4) {
            u32x4 a[4][2];
#pragma unroll
            for (int q = 0; q < 4; ++q) { const int i = wave * 64 + ii + q; const GAS u32x4* src = (const GAS u32x4*)(XN + (size_t)(r0 + (i >> 1)) * D) + lane; a[q][0] = src[0]; a[q][1] = src[64]; }
#pragma unroll
            for (int q = 0; q < 4; ++q) { const int i = wave * 64 + ii + q; GAS u32x4* dst = (GAS u32x4*)(XS + (size_t)slot_l[i] * D) + lane; dst[0] = a[q][0]; dst[64] = a[q][1]; }
        }
        }
        __syncthreads();
    }
}

#define ATT_LOAD(KF, VF, kt_) do { const int k0_ = (kt_) * 32; \
        const GAS u32x4* kp_ = (const GAS u32x4*)(Kb + (rowbase + k0_ + n) * D + h * 64 + 8 * hh); \
        _Pragma("unroll") for (int s_ = 0; s_ < 4; ++s_) KF[s_] = __builtin_bit_cast(bf16x8, kp_[2 * s_]); \
        _Pragma("unroll") for (int dt_ = 0; dt_ < 2; ++dt_) { const GAS u32x4* vp_ = (const GAS u32x4*)(Vt + (size_t)(h * 64 + dt_ * 32 + n) * M + rowbase + k0_ + 8 * hh); \
            _Pragma("unroll") for (int s_ = 0; s_ < 2; ++s_) VF[dt_][s_] = __builtin_bit_cast(bf16x8, vp_[2 * s_]); } } while (0)
constexpr float ATT_STOP = 9.0e-14f;
template <bool DIAG>
__device__ __forceinline__ void att_tile(const bf16x8 (&kf)[4], const bf16x8 (&vf)[2][2], const bf16x8 (&qf)[4], f32x16& o0, f32x16& o1, float& carry, int n, int hh) {
    f32x16 sc = __builtin_amdgcn_mfma_f32_32x32x16_bf16(kf[0], qf[0], (f32x16){0.f, 0.f, 0.f, 0.f, 0.f, 0.f, 0.f, 0.f, 0.f, 0.f, 0.f, 0.f, 0.f, 0.f, 0.f, 0.f}, 0, 0, 0);
#pragma unroll
    for (int s = 1; s < 4; ++s) sc = __builtin_amdgcn_mfma_f32_32x32x16_bf16(kf[s], qf[s], sc, 0, 0, 0);
    float be[16], kp[16];
#pragma unroll
    for (int r = 0; r < 16; r += 2) { f32x2 e; e.x = __builtin_amdgcn_exp2f(-__builtin_amdgcn_fmed3f(sc[r], -64.f, 3.0e38f)); e.y = __builtin_amdgcn_exp2f(-__builtin_amdgcn_fmed3f(sc[r + 1], -64.f, 3.0e38f));
        const f32x2 d = e + 1.0f; f32x2 b2; b2.x = __builtin_amdgcn_rcpf(d.x); b2.y = __builtin_amdgcn_rcpf(d.y); const f32x2 k2 = e * b2;
        be[r] = b2.x; be[r + 1] = b2.y; kp[r] = k2.x; kp[r + 1] = k2.y; }
    if constexpr (DIAG) {
#pragma unroll
        for (int r = 0; r < 16; ++r) { const int key = (r & 3) + 8 * (r >> 2) + 4 * hh; if (key >= n) { be[r] = 0.f; kp[r] = 1.f; } } }
    float T[4], Pp[4], p2[4], p1[4], p0[4];
#pragma unroll
    for (int g = 0; g < 4; ++g) { p2[g] = kp[4 * g + 3]; p1[g] = p2[g] * kp[4 * g + 2]; p0[g] = p1[g] * kp[4 * g + 1]; T[g] = p0[g] * kp[4 * g]; }
#pragma unroll
    for (int g = 0; g < 4; ++g) Pp[g] = __shfl_xor(T[g], 32);
    float off[4];
    { const float own2 = T[3], own1 = T[3] * T[2], own0 = own1 * T[1];
      const float pe2 = Pp[3], pe1 = Pp[3] * Pp[2], pe0 = pe1 * Pp[1];
      if (hh == 0) { off[0] = own0 * pe0 * Pp[0]; off[1] = own1 * pe1 * Pp[1]; off[2] = own2 * pe2 * Pp[2]; off[3] = Pp[3]; }
      else         { off[0] = own0 * pe0;         off[1] = own1 * pe1;         off[2] = own2 * pe2;         off[3] = 1.f; } }
    float a[16];
#pragma unroll
    for (int g = 0; g < 4; ++g) { const float base = carry * off[g];
        a[4 * g + 0] = be[4 * g + 0] * (base * p0[g]); a[4 * g + 1] = be[4 * g + 1] * (base * p1[g]); a[4 * g + 2] = be[4 * g + 2] * (base * p2[g]); a[4 * g + 3] = be[4 * g + 3] * base; }
    carry *= ((T[0] * T[1]) * (T[2] * T[3])) * ((Pp[0] * Pp[1]) * (Pp[2] * Pp[3]));
    bf16x8 pb[2];
#pragma unroll
    for (int s = 0; s < 2; ++s) { u32x4 w; w.x = cvtpk(a[8 * s + 0], a[8 * s + 1]); w.y = cvtpk(a[8 * s + 2], a[8 * s + 3]); w.z = cvtpk(a[8 * s + 4], a[8 * s + 5]); w.w = cvtpk(a[8 * s + 6], a[8 * s + 7]); pb[s] = __builtin_bit_cast(bf16x8, w); }
#pragma unroll
    for (int s = 0; s < 2; ++s) { o0 = __builtin_amdgcn_mfma_f32_32x32x16_bf16(vf[0][s], pb[s], o0, 0, 0, 0); o1 = __builtin_amdgcn_mfma_f32_32x32x16_bf16(vf[1][s], pb[s], o1, 0, 0, 0); }
}
constexpr int ATT_KROW = 144, ATT_VROW = 784, ATT_V_OFF = 384 * ATT_KROW;
static_assert(ATT_V_OFF + 64 * ATT_VROW <= STAGE_BYTES_LDS, "attention LDS image");
__device__ __forceinline__ void attn_phase(const bf16_t* Q, const bf16_t* Kb, const bf16_t* Vt, bf16_t* O, LAS unsigned char* lds, int vcu, int G, int wave_s) {
    const int tid = fresh_tid(wave_s); const int lane = tid & 63, wave = __builtin_amdgcn_readfirstlane(tid >> 6);
    const int n = lane & 31, hh = lane >> 5;
    const int NU = BATCH * NH * (SEQ / 256), per = (NU + G - 1) / G;
    const int u_lo = vcu * per, u_hi = (u_lo + per < NU) ? u_lo + per : NU;
    u32x4 pk[6], pv[6];
#define ATT_FETCH(uu) do { const int bh_ = (uu) >> 3, qb_ = (uu) & 7, h_ = bh_ & 15, b_ = bh_ >> 4; const int kw0_ = qb_ > 0 ? qb_ * 256 - 128 : 0, nk_ = qb_ * 256 + 256 - kw0_; \
        const size_t rb_ = (size_t)b_ * SEQ; \
        _Pragma("unroll") for (int i_ = 0; i_ < 6; ++i_) { const int p_ = tid + i_ * NTHREADS; const int kr_ = p_ >> 3, kc_ = p_ & 7; \
            if (kr_ < nk_) pk[i_] = *(const GAS u32x4*)(Kb + (rb_ + kw0_ + kr_) * D + h_ * 64 + kc_ * 8); \
            const int vd_ = p_ / 48, vc_ = p_ - vd_ * 48; \
            if (vc_ * 8 < nk_) pv[i_] = *(const GAS u32x4*)(Vt + (size_t)(h_ * 64 + vd_) * M + rb_ + kw0_ + vc_ * 8); } } while (0)
#define ATT_PUT(uu) do { const int qb_ = (uu) & 7; const int kw0_ = qb_ > 0 ? qb_ * 256 - 128 : 0, nk_ = qb_ * 256 + 256 - kw0_; \
        _Pragma("unroll") for (int i_ = 0; i_ < 6; ++i_) { const int p_ = tid + i_ * NTHREADS; const int kr_ = p_ >> 3, kc_ = p_ & 7; \
            if (kr_ < nk_) *(LAS u32x4*)(lds + kr_ * ATT_KROW + kc_ * 16) = pk[i_]; \
            const int vd_ = p_ / 48, vc_ = p_ - vd_ * 48; \
            if (vc_ * 8 < nk_) *(LAS u32x4*)(lds + ATT_V_OFF + vd_ * ATT_VROW + vc_ * 16) = pv[i_]; } } while (0)
#define ATT_TILE_LD(KF, VF, kt_) do { const int k0_ = (kt_) * 32; if (k0_ >= kw0) { const int ko_ = k0_ - kw0; \
            _Pragma("unroll") for (int s_ = 0; s_ < 4; ++s_) KF[s_] = *(const LAS bf16x8*)(lds + (ko_ + n) * ATT_KROW + 32 * s_ + 16 * hh); \
            _Pragma("unroll") for (int dt_ = 0; dt_ < 2; ++dt_) _Pragma("unroll") for (int s_ = 0; s_ < 2; ++s_) VF[dt_][s_] = *(const LAS bf16x8*)(lds + ATT_V_OFF + (dt_ * 32 + n) * ATT_VROW + (ko_ + 16 * s_ + 8 * hh) * 2); } \
        else { ATT_LOAD(KF, VF, kt_); } } while (0)
    if (u_lo < u_hi) ATT_FETCH(u_lo);
    for (int u = u_lo; u < u_hi; ++u) {
        const int bh = u >> 3, qb = u & 7, h = bh & 15, b = bh >> 4;
        const size_t rowbase = (size_t)b * SEQ; const int kw0 = qb > 0 ? qb * 256 - 128 : 0;
        const int qt = qb * 8 + wave, q0 = qt * 32;
        bf16x8 qf[4];
        { const GAS u32x4* qp = (const GAS u32x4*)(Q + (rowbase + q0 + n) * D + h * 64 + 8 * hh);
#pragma unroll
          for (int s = 0; s < 4; ++s) qf[s] = __builtin_bit_cast(bf16x8, qp[2 * s]); }
        ATT_PUT(u);
        __syncthreads();
        if (u + 1 < u_hi) ATT_FETCH(u + 1);
        f32x16 o0, o1;
#pragma unroll
        for (int r = 0; r < 16; ++r) { o0[r] = 0.f; o1[r] = 0.f; }
        float carry = 1.f;
        bf16x8 kf[4], vf[2][2];
        ATT_TILE_LD(kf, vf, qt);
        att_tile<true>(kf, vf, qf, o0, o1, carry, n, hh);
        if (!__all(carry < ATT_STOP)) for (int kt = qt - 1; kt >= 0; --kt) {
            ATT_TILE_LD(kf, vf, kt);
            att_tile<false>(kf, vf, qf, o0, o1, carry, n, hh);
            if (__all(carry < ATT_STOP)) break;
        }
        bf16_t* op = O + (rowbase + q0 + n) * D + h * 64 + 4 * hh;
#pragma unroll
        for (int g = 0; g < 4; ++g) { u32x2 w0, w1; w0.x = cvtpk(o0[4 * g], o0[4 * g + 1]); w0.y = cvtpk(o0[4 * g + 2], o0[4 * g + 3]); w1.x = cvtpk(o1[4 * g], o1[4 * g + 1]); w1.y = cvtpk(o1[4 * g + 2], o1[4 * g + 3]);
            *(u32x2*)(op + 8 * g) = w0; *(u32x2*)(op + 32 + 8 * g) = w1; }
        __syncthreads();
    }
#undef ATT_FETCH
#undef ATT_PUT
#undef ATT_TILE_LD
}

#define WSP(T, off) ((T*)(ws + (off)))
#ifndef STAG_POOL
#define STAG_POOL 0
#define STAG_PROJ 0
#define STAG_OPROJ 0
#define STAG_DUP 0
#define STAG_MUP 0
#endif
#ifndef PROBE_DUP
#define PROBE_DUP 0
#endif
#define DUP(k) ((PROBE_DUP >> (k)) & 1)
template <int l>
__device__ __forceinline__ void layer_body(LAS unsigned char* lds, const XcdBarrier& bar, LAS int* pend, LAS int* cnt_l, int G, int bx, int vcu, int NGW, int wave_s) {
#define SITE_POOLPREP(GRIDBAR) { { unsigned char* ws = ARG_WS(); pool_prep_phase<l == 0>(ARG_IN(0), WSP(bf16_t, WS_XB), WSP(bf16_t, WS_R), lds, G, wave_s); \
              if constexpr (l == 0 && (INT8_UP0 != 0 || INT8_PROJ != 0)) {     \
                  const int t_ = fresh_tid(wave_s); const int wv_ = __builtin_amdgcn_readfirstlane(t_ >> 6); LAS float* sc_ = (LAS float*)(lds + wv_ * 16384); const int g_ = vcu * NWAVES + wv_; int base_ = 0; \
                  for (int j_ = 0; j_ < 5; ++j_) { if ((j_ == 0 && !I8) || (j_ > 0 && !INT8_PROJ)) continue; \
                      const float* W_; const float* gn_; int ldw_, N_; float mul_ = 1.0f; bool gu_ = false; size_t dst_; const unsigned* cm_; float* wsc_; \
                      if (j_ == 0) { W_ = ARG_IN(9); gn_ = ARG_IN(2); ldw_ = 2 * DFF; N_ = 2 * DFF; gu_ = true; dst_ = WS_WFI; cm_ = WSP(unsigned, WS_COLMAX); wsc_ = WSP(float, WS_WSCALE); } \
                      else if (j_ < 3) { W_ = ARG_IN(6) + (j_ - 1) * 1024; gn_ = ARG_IN(5); ldw_ = 2048; N_ = 1024; dst_ = (j_ == 1) ? WS_WK : WS_WV; cm_ = WSP(unsigned, WS_COLMAX2) + (j_ - 1) * 1024; wsc_ = WSP(float, WS_WSCALE2) + (j_ - 1) * 1024; } \
                      else { const int b_ = j_ - 3; W_ = ARG_IN(7) + (size_t)b_ * D * D; gn_ = ARG_IN(1) + (2 + b_) * D; ldw_ = 1024; N_ = 1024; mul_ = 0.125f * 1.4426950408889634f; dst_ = WS_WQ + (size_t)b_ * D * D * 2; cm_ = WSP(unsigned, WS_COLMAX2) + (2 + b_) * 1024; wsc_ = WSP(float, WS_WSCALE2) + (2 + b_) * 1024; } \
                      int first_ = (g_ - base_) % NGW; if (first_ < 0) first_ += NGW; \
                      tr_mat(W_, ldw_, D, N_, gn_, mul_, 2, gu_, ws + dst_, sc_, first_, NGW, t_ & 63, cm_, wsc_); base_ = (base_ + (D / 64) * (N_ / 32)) % NGW; } } } \
          if (GRIDBAR) xcd_barrier(bar, wave_s); \
          else {   \
              __syncthreads(); \
              if constexpr (l == 1) { if (fresh_tid(wave_s) == 0) { unsigned* fl_ = (unsigned*)(ARG_WS() + WS_HALO_FLAGS); __hip_atomic_store(fl_ + blockIdx.x, 1u, __ATOMIC_RELEASE, __HIP_MEMORY_SCOPE_AGENT); \
                      const int nb_ = (int)blockIdx.x + 1; if (nb_ < M / 256 && (nb_ % (SEQ / 256)) != 0) { unsigned sp_ = 0; while (__hip_atomic_load(fl_ + nb_, __ATOMIC_ACQUIRE, __HIP_MEMORY_SCOPE_AGENT) == 0u) { __builtin_amdgcn_s_sleep(1); if (++sp_ > (1u << 24)) break; } } } \
                  __syncthreads(); } } }
#define SITE_POOLGEMM(MUL, GRIDBAR) { { unsigned char* ws = ARG_WS(); \
              pg8::GemmK g{256, 1024, 256}; pg8::PoolOrder S{G, bx, (const char*)WSP(bf16_t, WS_R), (const char*)(WSP(bf16_t, WS_WPOOL) + (size_t)l * 4 * 65536)}; \
              pg8::EpiResidB E{WSP(bf16_t, WS_XB), ARG_IN(4) + l * D, MUL}; \
              pg8::gemm_phase<pg8::EpiResidB, pg8::PoolOrder, true>(lds, g, S, E, wave_s, STAG_POOL); } if (GRIDBAR) xcd_barrier(bar, wave_s); else __syncthreads(); }
#define SITE_PROJ() { { unsigned char* ws = ARG_WS(); \
              if constexpr (INT8_PROJ != 0) { pg8::GemmK g{512, 512, 512}; pg8::ProjOrder S{(l == 2) ? 3 : 1, G, bx, (const char*)ws, (size_t)(l - 2) * D * D * 2, (size_t)256 * 1024}; \
                pg8::EpiProjI8 E{WSP(bf16_t, WS_K), WSP(bf16_t, WS_R), WSP(bf16_t, WS_VT), WSP(float, WS_ASCALE), WSP(float, WS_WSCALE2), l - 2}; \
                pg8::gemm_phase<pg8::EpiProjI8, pg8::ProjOrder, true, 2>(lds, g, S, E, wave_s, STAG_PROJ); } \
              else { pg8::GemmK g{1024, 1024, 1024}; pg8::ProjOrder S{(l == 2) ? 3 : 1, G, bx, (const char*)ws, (size_t)(l - 2) * D * D * 2, (size_t)256 * 1024 * 2}; \
                pg8::EpiProj E{WSP(bf16_t, WS_K), WSP(bf16_t, WS_R), WSP(bf16_t, WS_VT)}; \
                pg8::gemm_phase<pg8::EpiProj, pg8::ProjOrder, true>(lds, g, S, E, wave_s); } } xcd_barrier(bar, wave_s); }
#define SITE_ATTN() { { unsigned char* ws = ARG_WS(); attn_phase(WSP(bf16_t, WS_R), WSP(bf16_t, WS_K), WSP(bf16_t, WS_VT), WSP(bf16_t, WS_R) + (size_t)M * D, lds, vcu, G, wave_s); } xcd_barrier(bar, wave_s); }
#define SITE_OPROJ(MUL) { { unsigned char* ws = ARG_WS(); \
              pg8::GemmK g{1024, 1024, 1024}; pg8::DenseOrder S{M / 256, 4, G, bx, (const char*)(WSP(bf16_t, WS_R) + (size_t)M * D), (const char*)(WSP(bf16_t, WS_WO) + (size_t)(l - 2) * D * D), (size_t)256 * 1024 * 2, (size_t)256 * 1024 * 2}; \
              pg8::EpiResidB E{WSP(bf16_t, WS_XB), nullptr, MUL}; \
              pg8::gemm_phase<pg8::EpiResidB, pg8::DenseOrder, true>(lds, g, S, E, wave_s, STAG_OPROJ); } xcd_barrier(bar, wave_s); }
#define SITE_NORMX(OUTK_, DELTA_) { { unsigned char* ws = ARG_WS(); \
              norm_phase<false, false, false, OUTK_, false, bf16_t>(nullptr, WSP(bf16_t, WS_XN), nullptr, nullptr, nullptr, nullptr, nullptr, nullptr, nullptr, lds, cnt_l, G, wave_s, WSP(float, WS_ASCALE), nullptr, (const bf16_t*)WSP(bf16_t, WS_XB), nullptr); } xcd_barrier(bar, wave_s); }
#define SITE_NORMI8() { { unsigned char* ws = ARG_WS(); norm_phase<false, false, false, 2, false, bf16_t>(nullptr, WSP(bf16_t, WS_XN), nullptr, nullptr, nullptr, nullptr, nullptr, nullptr, nullptr, lds, cnt_l, G, wave_s, WSP(float, WS_ASCALE), nullptr, (const bf16_t*)WSP(bf16_t, WS_XB), nullptr); } xcd_barrier(bar, wave_s); }
#define SITE_NORM8() { { unsigned char* ws = ARG_WS(); norm_phase<false, false, false, 1, false, bf16_t>(nullptr, WSP(bf16_t, WS_XN), nullptr, nullptr, nullptr, nullptr, nullptr, nullptr, nullptr, lds, cnt_l, G, wave_s, nullptr, nullptr, (const bf16_t*)WSP(bf16_t, WS_XB), nullptr); } xcd_barrier(bar, wave_s); }
#define SITE_NORM() { { unsigned char* ws = ARG_WS(); norm_phase<false, false, false, 0, false, bf16_t>(nullptr, WSP(bf16_t, WS_XN), nullptr, nullptr, nullptr, nullptr, nullptr, nullptr, nullptr, lds, cnt_l, G, wave_s, nullptr, nullptr, (const bf16_t*)WSP(bf16_t, WS_XB), nullptr); } xcd_barrier(bar, wave_s); }
#define SITE_DUP() { { unsigned char* ws = ARG_WS(); \
              if constexpr (I8) { pg8::GemmK g{512, 512, 512}; pg8::DenseOrder S{M / 256, DFF / 128, G, bx, (const char*)WSP(unsigned char, WS_XN), (const char*)WSP(unsigned char, WS_WFI), (size_t)256 * 1024, (size_t)256 * 1024}; \
                pg8::EpiSwigluI8<L0_DOWN_FP8 != 0> E{WSP(bf16_t, WS_R), DFF, WSP(float, WS_ASCALE), WSP(float, WS_WSCALE)}; \
                pg8::gemm_phase<pg8::EpiSwigluI8<L0_DOWN_FP8 != 0>, pg8::DenseOrder, true, 2>(lds, g, S, E, wave_s, STAG_DUP); } \
              else if constexpr (F8) { pg8::GemmK g{512, 512, 512}; pg8::DenseOrder S{M / 256, DFF / 128, G, bx, (const char*)WSP(unsigned char, WS_XN), (const char*)(WSP(unsigned char, WS_WFI) + (size_t)(l >> 1) * 2 * DFF * D * 2), (size_t)256 * 1024, (size_t)256 * 1024}; \
                pg8::EpiSwiglu8 E{WSP(unsigned char, WS_R), DFF, 1.0f / W8_UP}; \
                pg8::gemm_phase<pg8::EpiSwiglu8, pg8::DenseOrder, true, 1>(lds, g, S, E, wave_s, STAG_DUP); } \
              else { pg8::GemmK g{1024, 1024, 1024}; pg8::DenseOrder S{M / 256, DFF / 128, G, bx, (const char*)WSP(bf16_t, WS_XN), (const char*)(WSP(bf16_t, WS_WFI) + (size_t)(l >> 1) * 2 * DFF * D), (size_t)256 * 1024 * 2, (size_t)256 * 1024 * 2}; \
                pg8::EpiSwiglu E{WSP(bf16_t, WS_R), DFF}; \
                pg8::gemm_phase<pg8::EpiSwiglu, pg8::DenseOrder, true>(lds, g, S, E, wave_s); } } xcd_barrier(bar, wave_s); }
#define SITE_DDOWN(MUL) { { unsigned char* ws = ARG_WS(); \
              if constexpr (F8 || (l == 0 && L0_DOWN_FP8 != 0)) { pg8::GemmK g{DFF / 2, DFF / 2, DFF / 2}; pg8::DenseOrder S{M / 256, 4, G, bx, (const char*)WSP(unsigned char, WS_R), (const char*)(WSP(unsigned char, WS_WFO) + (size_t)(l >> 1) * D * DFF * 2), (size_t)256 * DFF, (size_t)256 * DFF}; \
                pg8::EpiResidB E{WSP(bf16_t, WS_XB), nullptr, MUL / (W8_DN * H8_SC)}; \
                pg8::gemm_phase<pg8::EpiResidB, pg8::DenseOrder, true, 1>(lds, g, S, E, wave_s); } \
              else { pg8::GemmK g{DFF, DFF, DFF}; pg8::DenseOrder S{M / 256, 4, G, bx, (const char*)WSP(bf16_t, WS_R), (const char*)(WSP(bf16_t, WS_WFO) + (size_t)(l >> 1) * D * DFF), (size_t)256 * DFF * 2, (size_t)256 * DFF * 2}; \
                pg8::EpiResidB E{WSP(bf16_t, WS_XB), nullptr, MUL}; \
                pg8::gemm_phase<pg8::EpiResidB, pg8::DenseOrder, true>(lds, g, S, E, wave_s); } } xcd_barrier(bar, wave_s); }
#define SITE_ROUTER() { { unsigned char* ws = ARG_WS(); \
              norm_phase<false, true, false, F8 ? 1 : 0, false, bf16_t>(nullptr, WSP(bf16_t, WS_XN), nullptr, nullptr, ARG_IN(2) + l * D, ARG_IN(11) + (size_t)(l >> 1) * D * NE, WSP(int, WS_ROUTE_E), WSP(float, WS_ROUTE_G), WSP(int, WS_TILECNT), lds, cnt_l, G, wave_s, nullptr, WSP(bf16_t, WS_DELTA), (const bf16_t*)WSP(bf16_t, WS_XB), nullptr); } xcd_barrier(bar, wave_s); }
#define SITE_DISPATCH() { { unsigned char* ws = ARG_WS(); \
              dispatch_phase<F8>(WSP(int, WS_TILECNT), WSP(int, WS_ROUTE_E), WSP(float, WS_ROUTE_G), WSP(int, WS_SLOT_OF), WSP(float, WS_GATE_SLOT), WSP(bf16_t, WS_XN), F8 ? WSP(bf16_t, WS_TOS) : WSP(bf16_t, WS_XS), lds, pend, G, wave_s); } xcd_barrier(bar, wave_s); }
#define SITE_MUP() { { unsigned char* ws = ARG_WS(); \
              if constexpr (F8) { pg8::GemmK g{512, 512, 512}; \
                pg8::MoeGatherOrder S{nb, DFFE / 128, G, bx, blk0, (const char*)WSP(unsigned char, WS_XN), (const char*)(WSP(unsigned char, WS_WMI) + (size_t)(l >> 1) * 8 * 2 * DFFE * D * 2), (size_t)256 * 1024, (size_t)2 * DFFE * D, pend, WSP(int, WS_TOS), (LAS int*)(lds + LCTL_OFF + 2048)}; \
                pg8::EpiSwiglu8 E{WSP(unsigned char, WS_R), DFFE, 1.0f / W8_UP}; \
                pg8::gemm_phase<pg8::EpiSwiglu8, pg8::MoeGatherOrder, true, 1, true>(lds, g, S, E, wave_s, STAG_MUP); } \
              else { pg8::GemmK g{1024, 1024, 1024}; \
                pg8::MoeOrder S{nb, DFFE / 128, G, bx, blk0, 0, (const char*)WSP(bf16_t, WS_XS), (const char*)(WSP(bf16_t, WS_WMI) + (size_t)(l >> 1) * 8 * 2 * DFFE * D), (size_t)256 * 1024 * 2, (size_t)256 * 1024 * 2, (size_t)2 * DFFE * D * 2, pend}; \
                pg8::EpiSwiglu E{WSP(bf16_t, WS_R), DFFE}; \
                pg8::gemm_phase<pg8::EpiSwiglu, pg8::MoeOrder, true>(lds, g, S, E, wave_s); } } xcd_barrier(bar, wave_s); }
#define SITE_MDOWN() { { unsigned char* ws = ARG_WS(); \
              if constexpr (F8) { pg8::GemmK g{DFFE / 2, DFFE / 2, DFFE / 2}; \
                const int nbm = nb < pg8::TAIL_B0 ? nb : pg8::TAIL_B0;     \
                pg8::MoeOrder S{nbm, 4, G, bx, blk0, 1, (const char*)WSP(unsigned char, WS_R), (const char*)(WSP(unsigned char, WS_WMO) + (size_t)(l >> 1) * 8 * D * DFFE * 2), (size_t)256 * DFFE, (size_t)256 * DFFE, (size_t)D * DFFE, pend}; \
                pg8::EpiMoeDown E{WSP(bf16_t, WS_XS), WSP(float, WS_GATE_SLOT), 1.0f / (W8_DN * H8_SC)}; \
                pg8::gemm_phase<pg8::EpiMoeDown, pg8::MoeOrder, true, 1>(lds, g, S, E, wave_s); \
                if (nb > pg8::TAIL_B0) { pg8::GemmK g2{DFFE / (2 * pg8::TAIL_KS), DFFE / 2, DFFE / 2}; \
                  pg8::MoeTailOrder S2{nb - pg8::TAIL_B0, G, bx, (const char*)WSP(unsigned char, WS_R), (const char*)(WSP(unsigned char, WS_WMO) + (size_t)(l >> 1) * 8 * D * DFFE * 2), (size_t)256 * DFFE, (size_t)256 * DFFE, (size_t)D * DFFE, (size_t)(DFFE / pg8::TAIL_KS), pend}; \
                  pg8::EpiMoeDownT E2{WSP(bf16_t, WS_YT), WSP(float, WS_GATE_SLOT), 1.0f / (W8_DN * H8_SC)}; \
                  pg8::gemm_phase<pg8::EpiMoeDownT, pg8::MoeTailOrder, true, 1>(lds, g2, S2, E2, wave_s); } } \
              else { pg8::GemmK g{DFFE, DFFE, DFFE}; \
                pg8::MoeOrder S{nb, 4, G, bx, blk0, 1, (const char*)WSP(bf16_t, WS_R), (const char*)(WSP(bf16_t, WS_WMO) + (size_t)(l >> 1) * 8 * D * DFFE), (size_t)256 * DFFE * 2, (size_t)256 * DFFE * 2, (size_t)D * DFFE * 2, pend}; \
                pg8::EpiMoeDown E{WSP(bf16_t, WS_XS), WSP(float, WS_GATE_SLOT), 1.0f}; \
                pg8::gemm_phase<pg8::EpiMoeDown, pg8::MoeOrder, true>(lds, g, S, E, wave_s); } } xcd_barrier(bar, wave_s); }
    constexpr bool F8 = ((FP8_MASK >> l) & 1) != 0;
    constexpr bool I8 = (INT8_UP0 != 0) && l == 0 && !F8;
    if constexpr (l < 2) {
        const bool chain = (G == M / 256);
        if (DUP(5) || (DUP(7) && l == 1) || (DUP(11) && l == 0)) SITE_POOLPREP(true)
        SITE_POOLPREP(!chain)
        if (DUP(2) || DUP(12)) SITE_POOLGEMM(0.f, true)
        SITE_POOLGEMM(1.f, !chain)
    } else {
        if (DUP(2) || DUP(13)) SITE_PROJ()
        SITE_PROJ()
        if (DUP(3)) SITE_ATTN()
        SITE_ATTN()
        if (DUP(2) || DUP(14)) SITE_OPROJ(0.f)
        SITE_OPROJ(1.f)
    }
    if constexpr ((l & 1) == 0) {
        if constexpr (I8) { if (DUP(5) || DUP(8)) SITE_NORMX(2, true) SITE_NORMX(2, true) } else if constexpr (F8) { if (DUP(5) || DUP(8)) SITE_NORMX(1, true) SITE_NORMX(1, true) } else { if (DUP(5)) SITE_NORMX(0, true) SITE_NORMX(0, true) }
        if (DUP(1)) SITE_DUP()
        SITE_DUP()
        if (DUP(1)) SITE_DDOWN(0.f)
        SITE_DDOWN(1.f)
        if constexpr (l == 2) { if constexpr (INT8_PROJ != 0) { if (DUP(5) || DUP(8)) SITE_NORMI8() SITE_NORMI8() } else { if (DUP(5)) SITE_NORM() SITE_NORM() } }
    } else {
        if (DUP(5) || DUP(9)) SITE_ROUTER()
        SITE_ROUTER()
        if (DUP(5) || DUP(10)) SITE_DISPATCH()
        SITE_DISPATCH()
        constexpr int CB = F8 ? CAP / 256 : CHUNK_BLKS;
        for (int ch = 0; ch < (F8 ? 1 : 2); ++ch) {
            const int nblk = pend[7];
            const int blk0 = ch * CB; int nb = nblk - blk0; nb = nb < 0 ? 0 : (nb > CB ? CB : nb); nb = __builtin_amdgcn_readfirstlane(nb);
            if (DUP(0)) SITE_MUP()
            SITE_MUP()
            if (DUP(0)) SITE_MDOWN()
            SITE_MDOWN()
        }
        if constexpr (l == 1) { { unsigned char* ws = ARG_WS(); norm_phase<true, false, false, INT8_PROJ ? 2 : 0, false, bf16_t>(nullptr, WSP(bf16_t, WS_XN), WSP(bf16_t, WS_XS), WSP(int, WS_SLOT_OF), nullptr, nullptr, nullptr, nullptr, nullptr, lds, cnt_l, G, wave_s, WSP(float, WS_ASCALE), WSP(bf16_t, WS_DELTA), (const bf16_t*)WSP(bf16_t, WS_XB), WSP(bf16_t, WS_XB)); } xcd_barrier(bar, wave_s); }
        else for (int rep_ = 0; rep_ < 1 + DUP(6); ++rep_) { unsigned char* ws = ARG_WS(); if (rep_) xcd_barrier(bar, wave_s); norm_phase<true, false, true, 0, false, bf16_t>(ARG_OUT(), WSP(bf16_t, WS_XN), WSP(bf16_t, WS_XS), WSP(int, WS_SLOT_OF), ARG_IN(14), nullptr, nullptr, nullptr, nullptr, lds, cnt_l, G, wave_s, nullptr, WSP(bf16_t, WS_DELTA), (const bf16_t*)WSP(bf16_t, WS_XB), nullptr); }
    }
}

__global__ void __launch_bounds__(NTHREADS, 2) yoco_fwd(Args args_unused) {
    extern __shared__ __attribute__((aligned(16))) unsigned char lds_raw[];
    LAS unsigned char* lds = (LAS unsigned char*)lds_raw;
    __builtin_amdgcn_s_setreg((0 << 11) | (23 << 6) | 1, 1u);
    const int G = gridDim.x; const int bx = blockIdx.x; const int wave_s = __builtin_amdgcn_readfirstlane(threadIdx.x >> 6);
    const int vcu = (G % 8 == 0) ? (bx % 8) * (G / 8) + bx / 8 : bx;
    const int NGW = G * NWAVES;
    LAS unsigned* lctl = (LAS unsigned*)(lds + LCTL_OFF);
    for (int u = threadIdx.x; u < (LDS_BYTES - LCTL_OFF) / 4; u += NTHREADS) lctl[u] = 0u;
    __syncthreads();
    volatile LAS unsigned* bar_st = (volatile LAS unsigned*)lctl;
    LAS int* pend = (LAS int*)(lctl + 16);
    LAS int* cnt_l = (LAS int*)(lctl + 32);
    XcdBarrier bar = xcd_barrier_post((unsigned*)(ARG_WS() + WS_CTL) + 1024, bar_st);

    for (int rep = 0; rep < 1 + DUP(4); ++rep) {
        unsigned char* ws = ARG_WS();
        const int tid = fresh_tid(wave_s); const int lane = tid & 63, wave = __builtin_amdgcn_readfirstlane(tid >> 6), gw = vcu * NWAVES + wave;
        LAS float* scr = (LAS float*)(lds + wave * 16384);
        int base = 0;
        for (int j = 0; j < 50; ++j) {
            const float* W; const float* gain = nullptr; int ldw, K, N; float mul = 1.0f; bool f8 = false, gu = false; size_t dst;
            if (j < 8) { W = ARG_IN(3) + (size_t)j * 65536; ldw = 256; K = 256; N = 256; gain = ARG_IN(1) + (j >> 2) * D + (j & 3) * 256; dst = WS_WPOOL + (size_t)j * 65536 * 2; }
            else if (j < 10) { W = ARG_IN(6) + (j - 8) * 1024; ldw = 2048; K = 1024; N = 1024; gain = ARG_IN(5); dst = (j == 8) ? WS_WK : WS_WV; }
            else if (j < 12) { const int b = j - 10; W = ARG_IN(7) + (size_t)b * D * D; ldw = 1024; K = 1024; N = 1024; gain = ARG_IN(1) + (2 + b) * D; mul = 0.125f * 1.4426950408889634f; dst = WS_WQ + (size_t)b * D * D * 2; }
            else if (j < 14) { const int b = j - 12; W = ARG_IN(8) + (size_t)b * D * D; ldw = 1024; K = 1024; N = 1024; dst = WS_WO + (size_t)b * D * D * 2; }
            else if (j < 16) { const int i = j - 14; f8 = ((FP8_MASK >> (2 * i)) & 1) != 0; gu = true; W = ARG_IN(9) + (size_t)i * D * 2 * DFF; ldw = 2 * DFF; K = 1024; N = 2 * DFF; gain = ARG_IN(2) + (2 * i) * D; mul = f8 ? W8_UP : 1.0f; dst = WS_WFI + (size_t)i * 2 * DFF * D * 2; }
            else if (j < 18) { const int i = j - 16; f8 = ((FP8_MASK >> (2 * i)) & 1) != 0 || (i == 0 && L0_DOWN_FP8 != 0); W = ARG_IN(10) + (size_t)i * DFF * D; ldw = 1024; K = DFF; N = 1024; mul = f8 ? W8_DN : 1.0f; dst = WS_WFO + (size_t)i * D * DFF * 2; }
            else if (j < 34) { const int ie = j - 18, li = 2 * (ie >> 3) + 1, e = ie & 7; f8 = ((FP8_MASK >> li) & 1) != 0; gu = true; W = ARG_IN(12) + (size_t)ie * D * 2 * DFFE; ldw = 2 * DFFE; K = 1024; N = 2 * DFFE; gain = ARG_IN(2) + li * D; mul = f8 ? W8_UP : 1.0f;
                               dst = WS_WMI + (size_t)(ie >> 3) * 8 * 2 * DFFE * D * 2 + (size_t)e * 2 * DFFE * D * (f8 ? 1 : 2); }
            else { const int ie = j - 34, li = 2 * (ie >> 3) + 1, e = ie & 7; f8 = ((FP8_MASK >> li) & 1) != 0; W = ARG_IN(13) + (size_t)ie * DFFE * D; ldw = 1024; K = DFFE; N = 1024; mul = f8 ? W8_DN : 1.0f;
                   dst = WS_WMO + (size_t)(ie >> 3) * 8 * D * DFFE * 2 + (size_t)e * D * DFFE * (f8 ? 1 : 2); }
            const int nitems = (K / 64) * (N / 32);
            int first = (gw - base) % NGW; if (first < 0) first += NGW;
            if ((INT8_UP0 && j == 14) || (INT8_PROJ && j >= 8 && j < 12)) continue;
            tr_mat(W, ldw, K, N, gain, mul, f8 ? 1 : 0, gu, ws + dst, scr, first, NGW, lane, nullptr, nullptr, (gu && f8) ? W8_GATE : 0.f);
            base = (base + nitems) % NGW;
        }
    }
    if (INT8_UP0 || INT8_PROJ) {
        unsigned char* ws = ARG_WS(); const int tid = fresh_tid(wave_s); const int lane = tid & 63, gw = vcu * NWAVES + __builtin_amdgcn_readfirstlane(tid >> 6);
        int base = 0;
        for (int j = 0; j < 5; ++j) {
            if ((j == 0 && !INT8_UP0) || (j > 0 && !INT8_PROJ)) continue;
            const GAS float* W; const GAS float* gn; int ldw, ncols; float mul = 1.0f; unsigned* cm;
            if (j == 0) { W = (const GAS float*)ARG_IN(9); gn = (const GAS float*)ARG_IN(2); ldw = 2 * DFF; ncols = 2 * DFF; cm = WSP(unsigned, WS_COLMAX); }
            else if (j < 3) { W = (const GAS float*)ARG_IN(6) + (j - 1) * 1024; gn = (const GAS float*)ARG_IN(5); ldw = 2048; ncols = 1024; cm = WSP(unsigned, WS_COLMAX2) + (j - 1) * 1024; }
            else { W = (const GAS float*)ARG_IN(7) + (size_t)(j - 3) * D * D; gn = (const GAS float*)ARG_IN(1) + (2 + (j - 3)) * D; ldw = 1024; ncols = 1024; mul = 0.125f * 1.4426950408889634f; cm = WSP(unsigned, WS_COLMAX2) + (2 + (j - 3)) * 1024; }
            const int nstrip = ncols / 64, ntask = nstrip * (D / 64);
            int first = (gw - base) % NGW; if (first < 0) first += NGW;
            for (int task = first; task < ntask; task += NGW) { const int strip = task % nstrip, kc = task / nstrip; const int n = strip * 64 + lane; float mx = 0.f;
#pragma unroll 16
                for (int kk = 0; kk < 64; ++kk) { const int k = kc * 64 + kk; mx = fmaxf(mx, fabsf(W[(size_t)k * ldw + n] * gn[k])); }
                const unsigned old = __hip_atomic_fetch_max(cm + n, __builtin_bit_cast(unsigned, mx * mul), __ATOMIC_RELAXED, __HIP_MEMORY_SCOPE_AGENT); asm volatile("" :: "v"(old)); }
            base = (base + ntask) % NGW;
        }
    }
    xcd_barrier(bar, wave_s);

    layer_body<0>(lds, bar, pend, cnt_l, G, bx, vcu, NGW, wave_s);
    layer_body<1>(lds, bar, pend, cnt_l, G, bx, vcu, NGW, wave_s);
    layer_body<2>(lds, bar, pend, cnt_l, G, bx, vcu, NGW, wave_s);
    layer_body<3>(lds, bar, pend, cnt_l, G, bx, vcu, NGW, wave_s);
}

extern "C" void kernel_launch(void* const* d_in, const int* in_sizes, int n_in, void* d_out, int out_size, void* d_ws, size_t ws_size, hipStream_t stream) {
    static int grid = 0;
    if (grid == 0) {
        if (n_in != 15 || out_size != M * D || ws_size < WS_END) { fprintf(stderr, "kernel_launch: unexpected shapes (n_in %d out %d ws %zu)\n", n_in, out_size, ws_size); grid = -1; return; }
        int dev = 0, cus = 0, per_cu = 0;
        if (hipGetDevice(&dev) != hipSuccess || hipDeviceGetAttribute(&cus, hipDeviceAttributeMultiprocessorCount, dev) != hipSuccess) { grid = -1; return; }
        if (hipFuncSetAttribute((const void*)yoco_fwd, hipFuncAttributeMaxDynamicSharedMemorySize, LDS_BYTES) != hipSuccess) { fprintf(stderr, "kernel_launch: hipFuncSetAttribute failed\n"); grid = -1; return; }
        if (hipOccupancyMaxActiveBlocksPerMultiprocessor(&per_cu, (const void*)yoco_fwd, NTHREADS, LDS_BYTES) != hipSuccess || per_cu < 1) { fprintf(stderr, "kernel_launch: occupancy query says %d\n", per_cu); }
        (void)hipGetLastError();
        grid = cus;
    }
    if (grid < 0) return;
    (void)hipMemsetAsync((char*)d_ws + WS_CTL, 0, CTL_ZERO_BYTES, stream);
    Args a{};
    for (int i = 0; i < 15; ++i) a.in[i] = (const float*)d_in[i];
    a.out = (float*)d_out; a.ws = (unsigned char*)d_ws;
    hipLaunchKernelGGL(yoco_fwd, dim3(grid), dim3(NTHREADS), LDS_BYTES, stream, a);
}
```

```cpp
#include <hip/hip_runtime.h>
#include <cstdio>
#include <cstdint>

#define LAS __attribute__((address_space(3)))
#define GAS __attribute__((address_space(1)))
typedef unsigned short bf16_t;
typedef short bf16x8 __attribute__((ext_vector_type(8)));
typedef float f32x2 __attribute__((ext_vector_type(2)));
typedef float f32x4 __attribute__((ext_vector_type(4)));
typedef float f32x16 __attribute__((ext_vector_type(16)));
typedef unsigned u32x2 __attribute__((ext_vector_type(2)));
typedef unsigned u32x4 __attribute__((ext_vector_type(4)));
typedef int i32x4 __attribute__((ext_vector_type(4)));
typedef __bf16 bf16x2_t __attribute__((ext_vector_type(2)));

constexpr int D = 1024, BATCH = 32, SEQ = 2048, M = BATCH * SEQ;
constexpr int DFF = 2816, DFFE = 3584, NE = 8, NH = 16;
constexpr int CAP = 2 * M + NE * 256;
constexpr int CHUNK_BLKS = 260;
constexpr float RMS_EPS = 1e-6f;
#ifndef FP8_MASK
#define FP8_MASK 14
#endif
#ifndef INT8_UP0
#define INT8_UP0 1
#endif
#ifndef L0_DOWN_FP8
#define L0_DOWN_FP8 1
#endif
#ifndef INT8_PROJ
#define INT8_PROJ 1
#endif
constexpr float W8_UP = 64.f, W8_DN = 128.f, H8_SC = 8.f;
constexpr float W8_GATE = 1.4426950408889634f;
constexpr int NWAVES = 8, NTHREADS = 512;

constexpr size_t MiB = 1u << 20;
constexpr size_t WS_CTL = 0, CTL_ZERO_BYTES = 80 * 1024;
constexpr size_t WS_COLMAX2 = 65536;
constexpr size_t WS_WSCALE2 = 1 * MiB + 40960;
constexpr size_t WS_HALO_FLAGS = 28672;
constexpr size_t WS_COLMAX = 32768;
constexpr size_t WS_WSCALE = 1 * MiB + 16384;
constexpr size_t WS_ASCALE = 3 * MiB + 786432;
constexpr size_t WS_TILECNT = 1 * MiB;
constexpr size_t WS_ROUTE_E = 1 * MiB + 65536;
constexpr size_t WS_ROUTE_G = 2 * MiB;
constexpr size_t WS_SLOT_OF = 2 * MiB + 524288;
constexpr size_t WS_GATE_SLOT = 3 * MiB;
constexpr size_t WS_WPOOL = 4 * MiB;
constexpr size_t WS_WK = 5 * MiB, WS_WV = 7 * MiB, WS_WQ = 9 * MiB, WS_WO = 13 * MiB;
constexpr size_t WS_WFI = 17 * MiB;
constexpr size_t WS_WFO = 39 * MiB;
constexpr size_t WS_WMI = 50 * MiB;
constexpr size_t WS_WMO = 274 * MiB;
constexpr size_t WS_XN = 386 * MiB;
constexpr size_t WS_K = 514 * MiB, WS_VT = 642 * MiB;
constexpr size_t WS_XS = 770 * MiB;
constexpr size_t WS_R = 1030 * MiB;
constexpr size_t WS_HD = WS_R + 256 * MiB;
constexpr size_t WS_XS8 = 1485 * MiB;
constexpr size_t WS_XB = 1485 * MiB;
constexpr size_t WS_TOS = 386 * MiB + 64 * MiB;

constexpr size_t WS_YT = 1616 * MiB;
constexpr size_t WS_DELTA = 1616 * MiB;
constexpr size_t WS_P = 1648 * MiB;
constexpr size_t WS_END = 1776 * MiB;
static_assert(WS_XS8 + (size_t)CAP * D <= WS_END, "xs8");
static_assert(WS_XS + (size_t)CAP * D * 2 <= WS_R, "xs");
static_assert(WS_R + (size_t)CHUNK_BLKS * 256 * DFFE * 2 <= WS_END, "moe hidden chunk");
static_assert(WS_HD + (size_t)M * DFF <= 1485 * MiB && L0_DOWN_FP8 != 0 && (FP8_MASK & 4) != 0, "dense hidden (e4m3) behind Q | O");
static_assert(WS_R + (size_t)CAP * DFFE <= WS_XS8, "fp8 moe hidden, one chunk");
static_assert(WS_WMO + (size_t)2 * 8 * 1024 * 3584 * 2 <= WS_XN, "weights");

constexpr int STAGE_BYTES_LDS = 131072;
constexpr int LCTL_OFF = STAGE_BYTES_LDS;
constexpr int LDS_BYTES = 147456;

__device__ __forceinline__ unsigned cvtpk(float lo, float hi) { f32x2 v = {lo, hi}; bf16x2_t b = __builtin_convertvector(v, bf16x2_t); return __builtin_bit_cast(unsigned, b); }
__device__ __forceinline__ unsigned pk4_fp8(float a, float b, float c, float d) { int w = __builtin_amdgcn_cvt_pk_fp8_f32(a, b, 0, false); w = __builtin_amdgcn_cvt_pk_fp8_f32(c, d, w, true); return (unsigned)w; }
__device__ __forceinline__ unsigned pk4_i8(float a, float b, float c, float d) {
    const int i0 = (int)__builtin_rintf(__builtin_amdgcn_fmed3f(a, -127.f, 127.f)), i1 = (int)__builtin_rintf(__builtin_amdgcn_fmed3f(b, -127.f, 127.f));
    const int i2 = (int)__builtin_rintf(__builtin_amdgcn_fmed3f(c, -127.f, 127.f)), i3 = (int)__builtin_rintf(__builtin_amdgcn_fmed3f(d, -127.f, 127.f));
    return (unsigned)(i0 & 255) | ((unsigned)(i1 & 255) << 8) | ((unsigned)(i2 & 255) << 16) | ((unsigned)i3 << 24); }
__device__ __forceinline__ float wave_max(float v) {
#pragma unroll
    for (int o = 1; o < 64; o <<= 1) v = fmaxf(v, __shfl_xor(v, o));
    return v;
}
__device__ __forceinline__ float bf_lo(unsigned w) { return __builtin_bit_cast(float, w << 16); }
__device__ __forceinline__ float bf_hi(unsigned w) { return __builtin_bit_cast(float, w & 0xffff0000u); }
__device__ __forceinline__ f32x4 ld4(const float* p) { return *(const GAS f32x4*)p; }
__device__ __forceinline__ f32x4 ld4(const bf16_t* p) { const u32x2 w = *(const GAS u32x2*)p; return (f32x4){bf_lo(w.x), bf_hi(w.x), bf_lo(w.y), bf_hi(w.y)}; }
__device__ __forceinline__ f32x2 ld2(const float* p) { return *(const GAS f32x2*)p; }
__device__ __forceinline__ f32x2 ld2(const bf16_t* p) { const unsigned w = *(const GAS unsigned*)p; return (f32x2){bf_lo(w), bf_hi(w)}; }
__device__ __forceinline__ f32x4 ldraw4(const float* p) { return *(const GAS f32x4*)p; }
__device__ __forceinline__ u32x2 ldraw4(const bf16_t* p) { return *(const GAS u32x2*)p; }
__device__ __forceinline__ f32x4 cvt4(f32x4 v) { return v; }
__device__ __forceinline__ f32x4 cvt4(u32x2 w) { return (f32x4){bf_lo(w.x), bf_hi(w.x), bf_lo(w.y), bf_hi(w.y)}; }
template <class T> struct Raw4; template <> struct Raw4<float> { typedef f32x4 t; }; template <> struct Raw4<bf16_t> { typedef u32x2 t; };
__device__ __forceinline__ float wave_sum(float v) {
#pragma unroll
    for (int o = 1; o < 64; o <<= 1) v += __shfl_xor(v, o);
    return v;
}
#define LDS_WAIT() asm volatile("s_waitcnt lgkmcnt(0)" ::: "memory")
__device__ __forceinline__ int fresh_tid(int wave_s) { int w = wave_s, z = 0; asm volatile("" : "+s"(w), "+s"(z)); return w * 64 + (int)__builtin_amdgcn_mbcnt_hi(~0u, __builtin_amdgcn_mbcnt_lo(~0u, (unsigned)z)); }
#define RLX_AGENT __ATOMIC_RELAXED, __HIP_MEMORY_SCOPE_AGENT

#define XB_TMO      128
#define XB_XCNT(j)  (256  + 64 * (j))
#define XB_XSUB(j)  (1280 + 64 * (j))
#define XB_XGEN(j)  (2304 + 64 * (j))
#define XB_TOP      3328
#define XB_TOPGEN   3392
#define XCD_BAR_WORDS 3456
#define XB_SPIN_CAP (1u << 22)
__device__ __forceinline__ unsigned xb_ld(unsigned* p)              { return __hip_atomic_load(p, __ATOMIC_RELAXED, __HIP_MEMORY_SCOPE_AGENT); }
__device__ __forceinline__ unsigned xb_add(unsigned* p, unsigned v) { return __hip_atomic_fetch_add(p, v, __ATOMIC_RELAXED, __HIP_MEMORY_SCOPE_AGENT); }
__device__ __forceinline__ unsigned xb_xcc_id() { return (unsigned)__builtin_amdgcn_s_getreg((3 << 11) | 20) & 0xFu; }
#define XB_SPIN(cond, bar) do { unsigned _sp = 0; while (cond) { __builtin_amdgcn_s_sleep(1); \
    if ((++_sp & 255u) == 0u) { if (xb_ld(&(bar)[XB_TMO])) break; if (_sp > XB_SPIN_CAP) { atomicAdd(&(bar)[XB_TMO], 1u); break; } } } } while (0)
struct XcdBarrier { unsigned* bar; unsigned x; volatile LAS unsigned* st; };
__device__ __forceinline__ XcdBarrier xcd_barrier_post(unsigned* bar, volatile LAS unsigned* st) {
    XcdBarrier b; b.bar = bar; b.x = xb_xcc_id(); b.st = st;
    if (threadIdx.x == 0) st[3] = xb_add(&bar[XB_XCNT(b.x)], 1u);
    return b;
}
__device__ __forceinline__ void xcd_barrier_complete(unsigned* bar, unsigned x, unsigned& nloc, unsigned& nx, unsigned& uni) {
    const unsigned G = gridDim.x * gridDim.y * gridDim.z;
    unsigned sum, cnt, mine, sp = 0u;
    for (;;) {
        sum = 0u; cnt = 0u; mine = 0u; uni = 1u;
#pragma unroll
        for (unsigned j = 0; j < 16; ++j) { const unsigned c = xb_ld(&bar[XB_XCNT(j)]); sum += c; cnt += (c > 0u) ? 1u : 0u; mine = (j == x) ? c : mine; uni = (j < 8u ? c == G / 8u : c == 0u) ? uni : 0u; }
        if (sum == G) break;
        __builtin_amdgcn_s_sleep(1);
        if ((++sp & 255u) == 0u) { if (xb_ld(&bar[XB_TMO])) break; if (sp > XB_SPIN_CAP) { atomicAdd(&bar[XB_TMO], 1u); break; } }
    }
    nloc = mine > 0u ? mine : 1u; nx = cnt > 0u ? cnt : 1u;
}
__device__ __forceinline__ void xcd_barrier(const XcdBarrier& b, int wave_s) {
    asm volatile("s_waitcnt vmcnt(0)" ::: "memory");
    __syncthreads();
    if (fresh_tid(wave_s) == 0) {
        unsigned* bar = b.bar;
        __builtin_amdgcn_s_waitcnt(0);
        unsigned nloc = b.st[0], nx = b.st[1];
        if (nloc == 0u) { unsigned uni; xcd_barrier_complete(bar, b.x, nloc, nx, uni); b.st[0] = nloc; b.st[1] = nx; b.st[2] = (uni != 0u && b.x < 8u) ? 1u : 0u; }
        const unsigned old = xb_add(&bar[XB_XSUB(b.x)], 1u);
        const unsigned gen = old / nloc;
        if (old + 1u == (gen + 1u) * nloc) {
            __builtin_amdgcn_fence(__ATOMIC_RELEASE, "agent");
            asm volatile("s_waitcnt vmcnt(0)" ::: "memory");
            const unsigned og = xb_add(&bar[XB_TOP], 1u);
            const unsigned tg = og / nx;
            if (og + 1u == (tg + 1u) * nx) xb_add(&bar[XB_TOPGEN], 1u);
            else XB_SPIN(xb_ld(&bar[XB_TOPGEN]) == tg, bar);
            __builtin_amdgcn_fence(__ATOMIC_ACQUIRE, "agent");
            xb_add(&bar[XB_XGEN(b.x)], 1u);
            asm volatile("s_waitcnt vmcnt(0)" ::: "memory");
        } else {
            XB_SPIN(xb_ld(&bar[XB_XGEN(b.x)]) == gen, bar);
            __builtin_amdgcn_fence(__ATOMIC_ACQUIRE, "agent");
            asm volatile("s_waitcnt vmcnt(0)" ::: "memory");
        }
    }
    __syncthreads();
}

#define LB_SUB(j) (XCD_BAR_WORDS + 64 * (j))
#define LB_GEN(j) (XCD_BAR_WORDS + 1024 + 64 * (j))
__device__ __forceinline__ void xcd_local_barrier(const XcdBarrier& b, int wave_s) {
    asm volatile("s_waitcnt vmcnt(0)" ::: "memory");
    __syncthreads();
    if (fresh_tid(wave_s) == 0) {
        unsigned* bar = b.bar;
        __builtin_amdgcn_s_waitcnt(0);
        const unsigned nloc = b.st[0];
        const unsigned old = xb_add(&bar[LB_SUB(b.x)], 1u);
        const unsigned gen = old / nloc;
        if (old + 1u == (gen + 1u) * nloc) xb_add(&bar[LB_GEN(b.x)], 1u);
        else XB_SPIN(xb_ld(&bar[LB_GEN(b.x)]) == gen, bar);
        __builtin_amdgcn_fence(__ATOMIC_ACQUIRE, "agent");
        asm volatile("s_waitcnt vmcnt(0)" ::: "memory");
    }
    __syncthreads();
}

namespace pg8 {
constexpr int BM = 256, BK = 64, HALF = 128, HTB = HALF * BK * 2, NXCD = 8, WGM = 8;
__host__ __device__ __forceinline__ int lds_byte(int r, int c) { const int st = (r >> 4) * 2 + (c >> 5), rr = r & 15, cc = c & 31, ob = rr * 64 + cc * 2; return st * 1024 + (ob ^ (((ob >> 9) & 1) << 5)); }
__host__ __device__ __forceinline__ void stage_rc(int b, int& R, int& C) { const int st = b / 1024, sb = b % 1024, swz = sb ^ (((sb >> 9) & 1) << 5); R = (st >> 1) * 16 + swz / 64; C = (st & 1) * 32 + (swz % 64) / 2; }
__host__ __device__ __forceinline__ int perm32(int rho) { const int n = rho >> 4, i = rho & 15; return 8 * (i >> 2) + 4 * n + (i & 3); }

typedef int i32x8 __attribute__((ext_vector_type(8)));
__device__ __forceinline__ i32x8 cat8(bf16x8 lo, bf16x8 hi) { const i32x4 a = __builtin_bit_cast(i32x4, lo), b = __builtin_bit_cast(i32x4, hi); return __builtin_shufflevector(a, b, 0, 1, 2, 3, 4, 5, 6, 7); }
struct Unit { const char* A; const char* B; int pm, pn, aux; };
struct GemmK { int K, lda, ldb; };

__device__ __forceinline__ bool smap(long L, int nM, int nN, int& pm, int& pn) {
    const int nwg = nM * nN; if (L >= nwg) return false;
    int wgid = (int)L; { const int q = nwg / NXCD, r = nwg % NXCD, xcd = wgid % NXCD, off = wgid / NXCD; wgid = (xcd < r ? xcd * (q + 1) : r * (q + 1) + (xcd - r) * q) + off; }
    const int nig = WGM * nN, gid = wgid / nig, fm = gid * WGM, gsz = (nM - fm) < WGM ? (nM - fm) : WGM;
    pm = fm + ((wgid % nig) % gsz); pn = (wgid % nig) / gsz; return true;
}

template <class Epi, class Sched, bool ALIGN_EPI, int MODE = 0, bool GATHER = false>
__device__ __forceinline__ void gemm_phase(LAS unsigned char* lds, const GemmK g, const Sched& S, const Epi& E, int wave_s, int stag = 0  ) {
    if (stag > 0 && (blockIdx.x & 1)) { const unsigned long long t0 = __builtin_amdgcn_s_memrealtime(); while (__builtin_amdgcn_s_memrealtime() - t0 < (unsigned long long)stag) __builtin_amdgcn_s_sleep(4); }
    const int tid = fresh_tid(wave_s);
    const int wid = __builtin_amdgcn_readfirstlane(tid >> 6), lane = tid & 63, wr = wid >> 2, wc = wid & 3, fr = lane & 15, fq = lane >> 4;
    constexpr bool FP8 = (MODE == 1);
    const int K = g.K, nt = K / BK;
    unsigned voffA[2], voffB[2];
#pragma unroll
    for (int i = 0; i < 2; ++i) { int R, C; stage_rc(tid * 16 + i * 8192, R, C); const int Rb = Epi::PERM ? ((R & ~31) + perm32(R & 31)) : R;
        voffA[i] = (unsigned)(R * g.lda + C) * 2u; voffB[i] = (unsigned)(Rb * g.ldb + C) * 2u; }
    unsigned vG[2][2], vN[2][2];
    const size_t kstep = (size_t)(BK * 2);
    const size_t hstepA = (size_t)HALF * g.lda * 2, hstepB = (size_t)HALF * g.ldb * 2;
    const unsigned ldsw = (unsigned)wid * 1024u;
    const int aoff = lds_byte(wr * 64 + fr, fq * 8), boff = lds_byte(wc * 32 + fr, fq * 8);
#define PG8_SA(b, h) (((b) * 2 + (h)) * HTB)
#define PG8_SB(b, h) ((4 + (b) * 2 + (h)) * HTB)
#define PG8_STAGE(bufoff, gbase, voff) do { _Pragma("unroll") for (int _i = 0; _i < 2; ++_i) \
        __builtin_amdgcn_global_load_lds((const unsigned*)((const char*)(gbase) + (voff)[_i]), (LAS unsigned*)(lds + (bufoff) + ldsw + _i * 8192), 16, 0, 0); } while (0)
#define PG8_STAGE_A(bufoff, gbase, h, nx) do { if constexpr (GATHER) { unsigned _v[2] = { (nx) ? vN[h][0] : vG[h][0], (nx) ? vN[h][1] : vG[h][1] }; PG8_STAGE(bufoff, gbase, _v); } \
        else PG8_STAGE(bufoff, (gbase) + (h) * hstepA, voffA); } while (0)
#define PG8_LD8(p) __builtin_shufflevector(*(const LAS i32x4*)(p), *(const LAS i32x4*)((p) + 1024), 0, 1, 2, 3, 4, 5, 6, 7)
#define PG8_LDA(dst, b, h) do { if constexpr (FP8) { _Pragma("unroll") for (int m = 0; m < 4; ++m) dst##8[m] = PG8_LD8(lds + PG8_SA(b, h) + aoff + m * 2048); } \
        else { _Pragma("unroll") for (int m = 0; m < 4; ++m) _Pragma("unroll") for (int k = 0; k < 2; ++k) dst[m][k] = *(const LAS bf16x8*)(lds + PG8_SA(b, h) + aoff + m * 2048 + k * 1024); } } while (0)
#define PG8_LDB(dst, b, h) do { if constexpr (FP8) { _Pragma("unroll") for (int n = 0; n < 2; ++n) dst##8[n] = PG8_LD8(lds + PG8_SB(b, h) + boff + n * 2048); } \
        else { _Pragma("unroll") for (int n = 0; n < 2; ++n) _Pragma("unroll") for (int k = 0; k < 2; ++k) dst[n][k] = *(const LAS bf16x8*)(lds + PG8_SB(b, h) + boff + n * 2048 + k * 1024); } } while (0)
#define PG8_MFMA_ASM(INS, C, OUT, a_, b_) asm volatile(INS " %0, %1, %2, " C : OUT(acc[ai_][bj_][m][n]) : "v"(b_), "v"(a_))
#define PG8_MMA(ai, bj, At, Bt, Z) do { constexpr int ai_ = ai, bj_ = bj; __builtin_amdgcn_s_setprio(1); \
        if constexpr (FP8) { if (Z) { _Pragma("unroll") for (int m = 0; m < 4; ++m) _Pragma("unroll") for (int n = 0; n < 2; ++n) PG8_MFMA_ASM("v_mfma_f32_16x16x128_f8f6f4", "0", "=&v", At##8[m], Bt##8[n]); } \
                             else { _Pragma("unroll") for (int m = 0; m < 4; ++m) _Pragma("unroll") for (int n = 0; n < 2; ++n) PG8_MFMA_ASM("v_mfma_f32_16x16x128_f8f6f4", "%0", "+v", At##8[m], Bt##8[n]); } } \
        else if constexpr (MODE == 2) { if (Z) { _Pragma("unroll") for (int m = 0; m < 4; ++m) _Pragma("unroll") for (int n = 0; n < 2; ++n) PG8_MFMA_ASM("v_mfma_i32_16x16x64_i8", "0", "=&v", At[m][0], Bt[n][0]); } \
                             else { _Pragma("unroll") for (int m = 0; m < 4; ++m) _Pragma("unroll") for (int n = 0; n < 2; ++n) PG8_MFMA_ASM("v_mfma_i32_16x16x64_i8", "%0", "+v", At[m][0], Bt[n][0]); } \
                             _Pragma("unroll") for (int m = 0; m < 4; ++m) _Pragma("unroll") for (int n = 0; n < 2; ++n) PG8_MFMA_ASM("v_mfma_i32_16x16x64_i8", "%0", "+v", At[m][1], Bt[n][1]); } \
        else { if (Z) { _Pragma("unroll") for (int m = 0; m < 4; ++m) _Pragma("unroll") for (int n = 0; n < 2; ++n) PG8_MFMA_ASM("v_mfma_f32_16x16x32_bf16", "0", "=&v", At[m][0], Bt[n][0]); } \
               else { _Pragma("unroll") for (int m = 0; m < 4; ++m) _Pragma("unroll") for (int n = 0; n < 2; ++n) PG8_MFMA_ASM("v_mfma_f32_16x16x32_bf16", "%0", "+v", At[m][0], Bt[n][0]); } \
               _Pragma("unroll") for (int m = 0; m < 4; ++m) _Pragma("unroll") for (int n = 0; n < 2; ++n) PG8_MFMA_ASM("v_mfma_f32_16x16x32_bf16", "%0", "+v", At[m][1], Bt[n][1]); } \
        __builtin_amdgcn_s_setprio(0); } while (0)
#define PG8_WAIT_V(n) asm volatile("s_waitcnt vmcnt(" #n ")" ::: "memory")
#define PG8_WAIT_L(n) asm volatile("s_waitcnt lgkmcnt(" #n ")" ::: "memory")
#define PG8_BAR __builtin_amdgcn_s_barrier()
#define PG8_SCHED __builtin_amdgcn_sched_barrier(0)
    Unit cur, nxt; int ui = 0;
    constexpr int NS = Epi::NS;
#define PG8_WAIT_V1(n) do { if (NS > 0 && first && ui > 0) asm volatile("s_waitcnt vmcnt(%0)" :: "n"((n) + NS) : "memory"); else PG8_WAIT_V(n); } while (0)
    if (!S.next(0, cur)) return;
    f32x4 acc[2][2][4][2];
    bf16x8 At[4][2], B0[2][2], B1[2][2]; i32x8 At8[4], B08[2], B18[2];
    const char* cA = cur.A; const char* cB = cur.B;
    if constexpr (GATHER) {
#pragma unroll
        for (int i = 0; i < 2; ++i) { int R, C; stage_rc(tid * 16 + i * 8192, R, C);
#pragma unroll
            for (int h = 0; h < 2; ++h) { vG[h][i] = (unsigned)S.tos[(size_t)cur.aux * 256 + h * HALF + R] * (unsigned)(g.lda * 2) + (unsigned)C * 2u; vN[h][i] = vG[h][i]; } } }
    PG8_STAGE(PG8_SB(0, 0), cB, voffB); PG8_STAGE(PG8_SB(0, 1), cB + hstepB, voffB); PG8_STAGE_A(PG8_SA(0, 0), cA, 0, false); PG8_STAGE_A(PG8_SA(0, 1), cA, 1, false);
    if (wr == 1) PG8_BAR;
    PG8_WAIT_V(2); PG8_BAR;
    PG8_STAGE(PG8_SB(1, 0), cB + kstep, voffB); PG8_STAGE_A(PG8_SA(1, 0), cA + kstep, 0, false); PG8_STAGE(PG8_SB(1, 1), cB + hstepB + kstep, voffB);
    PG8_WAIT_V(6); PG8_BAR;
    for (;;) {
        const bool has_next = S.next(ui + 1, nxt);
        const char* nA = has_next ? nxt.A : cA; const char* nB = has_next ? nxt.B : cB;
        if constexpr (GATHER) { if (has_next && wid < 4) __builtin_amdgcn_global_load_lds((const unsigned*)(S.tos + (size_t)nxt.aux * 256 + wid * 64 + lane), (LAS unsigned*)(S.idxl + ((ui + 1) & 1) * 256 + wid * 64), 4, 0, 0); }
        for (int t = 0; t < nt; t += 2) {
            const bool last = (t == nt - 2), first = (t == 0);
            const char* a1 = cA + (size_t)(t + 1) * kstep;
            const char* a2 = last ? nA : cA + (size_t)(t + 2) * kstep; const char* b2 = last ? nB : cB + (size_t)(t + 2) * kstep;
            const char* a3 = a2 + kstep; const char* b3 = b2 + kstep;
            if constexpr (GATHER) { if (last) {
                    const LAS int* ib = S.idxl + ((ui + 1) & 1) * 256;
#pragma unroll
                    for (int i = 0; i < 2; ++i) { int R, C; stage_rc(tid * 16 + i * 8192, R, C);
#pragma unroll
                        for (int h = 0; h < 2; ++h) vN[h][i] = has_next ? (unsigned)ib[h * HALF + R] * (unsigned)(g.lda * 2) + (unsigned)C * 2u : vG[h][i]; } } }
            PG8_LDB(B0, 0, 0); PG8_LDB(B1, 0, 1); PG8_SCHED; PG8_LDA(At, 0, 0); if (!(first && ui > 0)) PG8_STAGE_A(PG8_SA(1, 1), a1, 1, false);
            PG8_WAIT_V1(8); PG8_WAIT_L(0); PG8_BAR; PG8_MMA(0, 0, At, B0, first); PG8_MMA(0, 1, At, B1, first); PG8_BAR; PG8_SCHED;
            PG8_LDA(At, 0, 1); PG8_STAGE(PG8_SB(0, 0), b2, voffB); PG8_STAGE(PG8_SB(0, 1), b2 + hstepB, voffB); PG8_STAGE_A(PG8_SA(0, 0), a2, 0, last);
            PG8_WAIT_V1(8); PG8_WAIT_L(0); PG8_BAR; PG8_MMA(1, 0, At, B0, first); PG8_MMA(1, 1, At, B1, first); PG8_BAR; PG8_SCHED;
            PG8_LDB(B0, 1, 0); PG8_LDB(B1, 1, 1); PG8_SCHED; PG8_LDA(At, 1, 0); PG8_STAGE_A(PG8_SA(0, 1), a2, 1, last);
            PG8_WAIT_V1(8); PG8_WAIT_L(0); PG8_BAR; PG8_MMA(0, 0, At, B0, false); PG8_MMA(0, 1, At, B1, false); PG8_BAR; PG8_SCHED;
            PG8_LDA(At, 1, 1); PG8_STAGE(PG8_SB(1, 0), b3, voffB); PG8_STAGE(PG8_SB(1, 1), b3 + hstepB, voffB); PG8_STAGE_A(PG8_SA(1, 0), a3, 0, last);
            PG8_WAIT_V(8); PG8_WAIT_L(0); PG8_BAR; PG8_MMA(1, 0, At, B0, false); PG8_MMA(1, 1, At, B1, false); PG8_BAR; PG8_SCHED;
        }
        if constexpr (ALIGN_EPI) { if (wr == 0) PG8_BAR; }
        if (has_next) PG8_STAGE_A(PG8_SA(1, 1), nA + kstep, 1, true);
        asm volatile("s_nop 15\n\ts_nop 15" ::: "memory");
        E(acc, cur, wr, wc, fr, fq);
        if (!has_next) break;
        cur = nxt; cA = nA; cB = nB; ++ui;
        if constexpr (GATHER) {
#pragma unroll
            for (int h = 0; h < 2; ++h) { vG[h][0] = vN[h][0]; vG[h][1] = vN[h][1]; } }
        if constexpr (ALIGN_EPI) { if (wr == 1) PG8_BAR; }
    }
    PG8_WAIT_V(0);
    if constexpr (!ALIGN_EPI) { if (wr == 0) PG8_BAR; }
    PG8_BAR;
#undef PG8_SA
#undef PG8_SB
#undef PG8_STAGE
#undef PG8_STAGE_A
#undef PG8_LDA
#undef PG8_LDB
#undef PG8_MMA
#undef PG8_WAIT_V1
#undef PG8_MFMA_ASM
#undef PG8_WAIT_V
#undef PG8_WAIT_L
#undef PG8_BAR
#undef PG8_SCHED
}

struct EpiMoeDownT {
    static constexpr int NS = 16; static constexpr bool PERM = true;
    bf16_t* Y2; const float* gate; float osc;
    __device__ __forceinline__ void operator()(const f32x4 (&acc)[2][2][4][2], const Unit& u, int wr, int wc, int fr, int fq) const {
        const int row0 = u.pm * BM + wr * 64 + fr, col0 = u.pn * BM + wc * 32 + 8 * fq;
        float gtv[2][4];
#pragma unroll
        for (int ai = 0; ai < 2; ++ai)
#pragma unroll
            for (int m = 0; m < 4; ++m) gtv[ai][m] = gate[row0 + ai * HALF + m * 16];
#pragma unroll
        for (int ai = 0; ai < 2; ++ai)
#pragma unroll
            for (int m = 0; m < 4; ++m) { const int row = row0 + ai * HALF + m * 16; const float gt = gtv[ai][m] * osc; bf16_t* rowp = Y2 + ((size_t)u.aux * (8 * 256) + (size_t)(row - 2 * M)) * D + col0;
#pragma unroll
                for (int bj = 0; bj < 2; ++bj) { const f32x4 v0 = acc[ai][bj][m][0] * gt, v1 = acc[ai][bj][m][1] * gt;
                    u32x4 w; w.x = cvtpk(v0[0], v0[1]); w.y = cvtpk(v0[2], v0[3]); w.z = cvtpk(v1[0], v1[1]); w.w = cvtpk(v1[2], v1[3]);
                    *(u32x4*)(rowp + bj * HALF) = w; } }
    }
};
struct DenseOrder {
    int nM, nN, G, c; const char* A; const char* B; size_t at, bt;
    __device__ __forceinline__ bool next(int i, Unit& u) const { int pm, pn; if (!smap((long)i * G + c, nM, nN, pm, pn)) return false;
        u.A = A + (size_t)pm * at; u.B = B + (size_t)pn * bt; u.pm = pm; u.pn = pn; u.aux = 0; return true; }
};
struct PoolOrder {
    int G, c; const char* P; const char* W;
    __device__ __forceinline__ bool next(int i, Unit& u) const { const int pm = c + (i >> 2) * G, pn = i & 3; if (pm >= M / 256) return false;
        u.A = P + (size_t)pm * (256 * 1024 * 2) + (size_t)pn * 512; u.B = W + (size_t)pn * (256 * 256 * 2); u.pm = pm; u.pn = pn; u.aux = 0; return true; }
};
struct ProjOrder {
    int njobs, G, c; const char* ws; size_t qoff, tb;
    __device__ __forceinline__ bool next(int i, Unit& u) const {
        const long L = (long)i * G + c; if (L >= (long)njobs * 1024) return false;
        const int job = (int)(L >> 10), l = (int)(L & 1023); const int kind = (njobs == 1) ? 1 : job;
        const size_t woff = WS_WK + (size_t)(kind == 1) * (WS_WQ + qoff - WS_WK) + (size_t)(kind == 2) * (WS_WV - WS_WK);
        int pm, pn;
        if (kind == 2) { smap(l, 4, 256, pm, pn); u.A = ws + woff + (size_t)pm * tb; u.B = ws + WS_XN + (size_t)pn * tb; }
        else { smap(l, 256, 4, pm, pn); u.A = ws + WS_XN + (size_t)pm * tb; u.B = ws + woff + (size_t)pn * tb; }
        u.pm = pm; u.pn = pn; u.aux = kind; return true; }
};
struct MoeOrder {
    int nM, nN, G, c, blk0, a_rel; const char* A; const char* B; size_t at, bt, be; const LAS int* pend;
    __device__ __forceinline__ bool next(int i, Unit& u) const { int pm, pn; if (!smap((long)i * G + c, nM, nN, pm, pn)) return false;
        const int b = blk0 + pm; int e = 0;
#pragma unroll
        for (int j = 0; j < 7; ++j) e += (b >= pend[j]) ? 1 : 0;
        e = __builtin_amdgcn_readfirstlane(e);
        u.A = A + (size_t)(a_rel ? pm : b) * at; u.B = B + (size_t)e * be + (size_t)pn * bt; u.pm = a_rel ? b : pm; u.pn = pn; u.aux = 0; return true; }
};

constexpr int TAIL_B0 = 2 * M / 256, TAIL_KS = 7;
struct MoeTailOrder {
    int nT, G, c; const char* A; const char* B; size_t at, bt, be, kq; const LAS int* pend;
    __device__ __forceinline__ bool next(int i, Unit& u) const { const int L = i * G + c; if (L >= nT * 4 * TAIL_KS) return false;
        const int q = L % TAIL_KS, r = L / TAIL_KS, pn = r & 3, b = TAIL_B0 + (r >> 2); int e = 0;
#pragma unroll
        for (int j = 0; j < 7; ++j) e += (b >= pend[j]) ? 1 : 0;
        e = __builtin_amdgcn_readfirstlane(e);
        u.A = A + (size_t)b * at + (size_t)q * kq; u.B = B + (size_t)e * be + (size_t)pn * bt + (size_t)q * kq; u.pm = b; u.pn = pn; u.aux = q; return true; }
};
struct MoeGatherOrder {
    int nM, nN, G, c, blk0; const char* A; const char* B; size_t bt, be; const LAS int* pend; const int* tos; LAS int* idxl;
    __device__ __forceinline__ bool next(int i, Unit& u) const { int pm, pn; if (!smap((long)i * G + c, nM, nN, pm, pn)) return false;
        const int b = blk0 + pm; int e = 0;
#pragma unroll
        for (int j = 0; j < 7; ++j) e += (b >= pend[j]) ? 1 : 0;
        e = __builtin_amdgcn_readfirstlane(e);
        u.A = A; u.B = B + (size_t)e * be + (size_t)pn * bt; u.pm = pm; u.pn = pn; u.aux = b; return true; }
};
struct EpiPool {
    static constexpr int NS = 0; static constexpr bool PERM = false;
    const float* xin; float* out; const float* scale; float mul;
    __device__ __forceinline__ void operator()(const f32x4 (&acc)[2][2][4][2], const Unit& u, int wr, int wc, int fr, int fq) const {
        const int row0 = u.pm * BM + wr * 64 + fr, col0 = u.pn * BM + wc * 32 + 4 * fq;
        f32x4 sv[2][2];
#pragma unroll
        for (int bj = 0; bj < 2; ++bj)
#pragma unroll
            for (int n = 0; n < 2; ++n) sv[bj][n] = *(const f32x4*)(scale + col0 + bj * HALF + n * 16) * mul;
#pragma unroll
        for (int ai = 0; ai < 2; ++ai)
#pragma unroll
            for (int m = 0; m < 4; ++m) { const size_t off = (size_t)(row0 + ai * HALF + m * 16) * D + col0;
#pragma unroll
                for (int bj = 0; bj < 2; ++bj)
#pragma unroll
                    for (int n = 0; n < 2; ++n) { const f32x4 xv = *(const f32x4*)(xin + off + bj * HALF + n * 16); *(f32x4*)(out + off + bj * HALF + n * 16) = xv + sv[bj][n] * acc[ai][bj][m][n]; }
                asm volatile("" ::: "memory"); }
    }
};
struct EpiDelta {
    static constexpr int NS = 0; static constexpr bool PERM = true;
    bf16_t* DL; const float* scale;
    __device__ __forceinline__ void operator()(const f32x4 (&acc)[2][2][4][2], const Unit& u, int wr, int wc, int fr, int fq) const {
        const int row0 = u.pm * BM + wr * 64 + fr, col0 = u.pn * BM + wc * 32 + 8 * fq;
        f32x4 sv[2][2];
#pragma unroll
        for (int bj = 0; bj < 2; ++bj) { sv[bj][0] = scale ? *(const f32x4*)(scale + col0 + bj * HALF) : (f32x4){1.f, 1.f, 1.f, 1.f}; sv[bj][1] = scale ? *(const f32x4*)(scale + col0 + bj * HALF + 4) : (f32x4){1.f, 1.f, 1.f, 1.f}; }
#pragma unroll
        for (int ai = 0; ai < 2; ++ai)
#pragma unroll
            for (int m = 0; m < 4; ++m) { bf16_t* rowp = DL + (size_t)(row0 + ai * HALF + m * 16) * D + col0;
#pragma unroll
                for (int bj = 0; bj < 2; ++bj) { const f32x4 v0 = acc[ai][bj][m][0] * sv[bj][0], v1 = acc[ai][bj][m][1] * sv[bj][1];
                    u32x4 w; w.x = cvtpk(v0[0], v0[1]); w.y = cvtpk(v0[2], v0[3]); w.z = cvtpk(v1[0], v1[1]); w.w = cvtpk(v1[2], v1[3]);
                    *(u32x4*)(rowp + bj * HALF) = w; } }
    }
};
struct EpiResidB {
    static constexpr int NS = 16; static constexpr bool PERM = true; static constexpr bool SPLIT = false;
    bf16_t* xb; const float* scale; float mul;
    __device__ __forceinline__ void operator()(const f32x4 (&acc)[2][2][4][2], const Unit& u, int wr, int wc, int fr, int fq) const {
        const int row0 = u.pm * BM + wr * 64 + fr, col0 = u.pn * BM + wc * 32 + 8 * fq;
        u32x4 d[2][4][2];
#pragma unroll
        for (int ai = 0; ai < 2; ++ai)
#pragma unroll
            for (int m = 0; m < 4; ++m) { const GAS bf16_t* rowp = (const GAS bf16_t*)xb + (size_t)(row0 + ai * HALF + m * 16) * D + col0;
#pragma unroll
                for (int bj = 0; bj < 2; ++bj) d[ai][m][bj] = *(const GAS u32x4*)(rowp + bj * HALF); }
        f32x4 sv[2][2];
#pragma unroll
        for (int bj = 0; bj < 2; ++bj) { sv[bj][0] = (scale ? *(const f32x4*)(scale + col0 + bj * HALF) : (f32x4){1.f, 1.f, 1.f, 1.f}) * mul; sv[bj][1] = (scale ? *(const f32x4*)(scale + col0 + bj * HALF + 4) : (f32x4){1.f, 1.f, 1.f, 1.f}) * mul; }
#pragma unroll
        for (int ai = 0; ai < 2; ++ai)
#pragma unroll
            for (int m = 0; m < 4; ++m) { GAS bf16_t* rowp = (GAS bf16_t*)xb + (size_t)(row0 + ai * HALF + m * 16) * D + col0;
#pragma unroll
                for (int bj = 0; bj < 2; ++bj) { const u32x4 dd = d[ai][m][bj];
                    const f32x4 o0 = (f32x4){bf_lo(dd.x), bf_hi(dd.x), bf_lo(dd.y), bf_hi(dd.y)} + acc[ai][bj][m][0] * sv[bj][0], o1 = (f32x4){bf_lo(dd.z), bf_hi(dd.z), bf_lo(dd.w), bf_hi(dd.w)} + acc[ai][bj][m][1] * sv[bj][1];
                    u32x4 w; w.x = cvtpk(o0[0], o0[1]); w.y = cvtpk(o0[2], o0[3]); w.z = cvtpk(o1[0], o1[1]); w.w = cvtpk(o1[2], o1[3]); *(GAS u32x4*)(rowp + bj * HALF) = w; } }
    }
};
template <class XT>
struct EpiResidD {
    static constexpr int NS = 0; static constexpr bool PERM = true;
    const XT* xsrc; bf16_t* out; const bf16_t* DL; float mul;
    __device__ __forceinline__ void operator()(const f32x4 (&acc)[2][2][4][2], const Unit& u, int wr, int wc, int fr, int fq) const {
        const int row0 = u.pm * BM + wr * 64 + fr, col0 = u.pn * BM + wc * 32 + 8 * fq;
#pragma unroll
        for (int ai = 0; ai < 2; ++ai)
#pragma unroll
            for (int m = 0; m < 4; ++m) { const size_t off0 = (size_t)(row0 + ai * HALF + m * 16) * D + col0;
#pragma unroll
                for (int bj = 0; bj < 2; ++bj) { const size_t off = off0 + bj * HALF; const f32x4 x0 = ld4(xsrc + off), x1 = ld4(xsrc + off + 4); const u32x4 d = *(const u32x4*)(DL + off);
                    const f32x4 d0 = {bf_lo(d.x), bf_hi(d.x), bf_lo(d.y), bf_hi(d.y)}, d1 = {bf_lo(d.z), bf_hi(d.z), bf_lo(d.w), bf_hi(d.w)};
                    const f32x4 o0 = x0 + d0 + acc[ai][bj][m][0] * mul, o1 = x1 + d1 + acc[ai][bj][m][1] * mul;
                    u32x4 w; w.x = cvtpk(o0[0], o0[1]); w.y = cvtpk(o0[2], o0[3]); w.z = cvtpk(o1[0], o1[1]); w.w = cvtpk(o1[2], o1[3]); *(u32x4*)(out + off) = w; }
                asm volatile("" ::: "memory"); }
    }
};
struct EpiResid {
    static constexpr int NS = 0; static constexpr bool PERM = false;
    float* x; float mul;
    __device__ __forceinline__ void operator()(const f32x4 (&acc)[2][2][4][2], const Unit& u, int wr, int wc, int fr, int fq) const {
        const int row0 = u.pm * BM + wr * 64 + fr, col0 = u.pn * BM + wc * 32 + 4 * fq;
#pragma unroll
        for (int ai = 0; ai < 2; ++ai)
#pragma unroll
            for (int m = 0; m < 4; ++m) { float* p = x + (size_t)(row0 + ai * HALF + m * 16) * D + col0;
#pragma unroll
                for (int bj = 0; bj < 2; ++bj)
#pragma unroll
                    for (int n = 0; n < 2; ++n) { const f32x4 xv = *(const f32x4*)(p + bj * HALF + n * 16); *(f32x4*)(p + bj * HALF + n * 16) = xv + acc[ai][bj][m][n] * mul; }
                asm volatile("" ::: "memory"); }
    }
};
__device__ __forceinline__ f32x2 swiglu2(f32x2 g, f32x2 u, float c1  , float kinv  ) {
    const f32x2 t = g * c1; f32x2 e; e.x = __builtin_amdgcn_exp2f(t.x); e.y = __builtin_amdgcn_exp2f(t.y);
    const f32x2 d = e * kinv + kinv; f32x2 r; r.x = __builtin_amdgcn_rcpf(d.x); r.y = __builtin_amdgcn_rcpf(d.y);
    return (g * u) * r;
}
__device__ __forceinline__ f32x2 swiglu2n(f32x2 gl, f32x2 us, float k) {
    f32x2 e; e.x = __builtin_amdgcn_exp2f(-gl.x); e.y = __builtin_amdgcn_exp2f(-gl.y);
    const f32x2 d = e * k + k; f32x2 r; r.x = __builtin_amdgcn_rcpf(d.x); r.y = __builtin_amdgcn_rcpf(d.y);
    return (gl * us) * r;
}
__device__ __forceinline__ float silu_mul(float g, float u) { return g * u * __builtin_amdgcn_rcpf(1.0f + __builtin_amdgcn_exp2f(-1.4426950408889634f * g)); }
struct EpiSwiglu {
    static constexpr int NS = 0; static constexpr bool PERM = true;
    bf16_t* H; int ldc;
    __device__ __forceinline__ void operator()(const f32x4 (&acc)[2][2][4][2], const Unit& u, int wr, int wc, int fr, int fq) const {
        const int row0 = u.pm * BM + wr * 64 + fr, col0 = u.pn * HALF + wc * 32 + 8 * fq;
#pragma unroll
        for (int ai = 0; ai < 2; ++ai)
#pragma unroll
            for (int m = 0; m < 4; ++m) { bf16_t* rowp = H + (size_t)(row0 + ai * HALF + m * 16) * ldc + col0;
                const f32x4 g0 = acc[ai][0][m][0], g1 = acc[ai][0][m][1], u0 = acc[ai][1][m][0], u1 = acc[ai][1][m][1];
                const f32x2 h0 = swiglu2((f32x2){g0[0], g0[1]}, (f32x2){u0[0], u0[1]}, -1.4426950408889634f, 1.0f), h1 = swiglu2((f32x2){g0[2], g0[3]}, (f32x2){u0[2], u0[3]}, -1.4426950408889634f, 1.0f);
                const f32x2 h2 = swiglu2((f32x2){g1[0], g1[1]}, (f32x2){u1[0], u1[1]}, -1.4426950408889634f, 1.0f), h3 = swiglu2((f32x2){g1[2], g1[3]}, (f32x2){u1[2], u1[3]}, -1.4426950408889634f, 1.0f);
                u32x4 w; w.x = cvtpk(h0.x, h0.y); w.y = cvtpk(h1.x, h1.y); w.z = cvtpk(h2.x, h2.y); w.w = cvtpk(h3.x, h3.y);
                *(u32x4*)rowp = w; }
    }
};
template <bool OUT8>
struct EpiSwigluI8 {
    static constexpr int NS = 8; static constexpr bool PERM = true;
    bf16_t* H; int ldc; const float* ascale; const float* wscale;
    __device__ __forceinline__ void operator()(const f32x4 (&acc)[2][2][4][2], const Unit& u, int wr, int wc, int fr, int fq) const {
        const int row0 = u.pm * BM + wr * 64 + fr, col0 = u.pn * HALF + wc * 32 + 8 * fq;
        const float* wsp = wscale + u.pn * BM + wc * 32 + 8 * fq;
        const f32x4 sg0 = *(const f32x4*)wsp * W8_GATE, sg1 = *(const f32x4*)(wsp + 4) * W8_GATE, su0 = *(const f32x4*)(wsp + HALF), su1 = *(const f32x4*)(wsp + HALF + 4);
        constexpr float kk = W8_GATE / (OUT8 ? H8_SC : 1.0f);
        float sav[2][4];
#pragma unroll
        for (int ai = 0; ai < 2; ++ai)
#pragma unroll
            for (int m = 0; m < 4; ++m) sav[ai][m] = ascale[row0 + ai * HALF + m * 16];
#pragma unroll
        for (int ai = 0; ai < 2; ++ai)
#pragma unroll
            for (int m = 0; m < 4; ++m) { const int row = row0 + ai * HALF + m * 16; bf16_t* rowp = H + (size_t)row * ldc + col0; const float sa = sav[ai][m];
                const i32x4 ig0 = __builtin_bit_cast(i32x4, acc[ai][0][m][0]), ig1 = __builtin_bit_cast(i32x4, acc[ai][0][m][1]), iu0 = __builtin_bit_cast(i32x4, acc[ai][1][m][0]), iu1 = __builtin_bit_cast(i32x4, acc[ai][1][m][1]);
                const f32x4 g0 = __builtin_convertvector(ig0, f32x4) * (sg0 * sa), g1 = __builtin_convertvector(ig1, f32x4) * (sg1 * sa), u0 = __builtin_convertvector(iu0, f32x4) * (su0 * sa), u1 = __builtin_convertvector(iu1, f32x4) * (su1 * sa);
                const f32x2 h0 = swiglu2n((f32x2){g0[0], g0[1]}, (f32x2){u0[0], u0[1]}, kk), h1 = swiglu2n((f32x2){g0[2], g0[3]}, (f32x2){u0[2], u0[3]}, kk);
                const f32x2 h2 = swiglu2n((f32x2){g1[0], g1[1]}, (f32x2){u1[0], u1[1]}, kk), h3 = swiglu2n((f32x2){g1[2], g1[3]}, (f32x2){u1[2], u1[3]}, kk);
                if constexpr (OUT8) { u32x2 w; w.x = pk4_fp8(h0.x, h0.y, h1.x, h1.y); w.y = pk4_fp8(h2.x, h2.y, h3.x, h3.y);
                    *(u32x2*)((unsigned char*)H + (size_t)row * ldc + col0) = w; }
                else { u32x4 w; w.x = cvtpk(h0.x, h0.y); w.y = cvtpk(h1.x, h1.y); w.z = cvtpk(h2.x, h2.y); w.w = cvtpk(h3.x, h3.y);
                *(u32x4*)rowp = w; } }
    }
};
struct EpiSwiglu8 {
    static constexpr int NS = 8; static constexpr bool PERM = true;
    unsigned char* H; int ldc; float gsc;
    __device__ __forceinline__ void operator()(const f32x4 (&acc)[2][2][4][2], const Unit& u, int wr, int wc, int fr, int fq) const {
        const int row0 = u.pm * BM + wr * 64 + fr, col0 = u.pn * HALF + wc * 32 + 8 * fq;
#pragma unroll
        for (int ai = 0; ai < 2; ++ai)
#pragma unroll
            for (int m = 0; m < 4; ++m) { unsigned char* rowp = H + (size_t)(row0 + ai * HALF + m * 16) * ldc + col0;
                const f32x4 g0 = acc[ai][0][m][0], g1 = acc[ai][0][m][1], u0 = acc[ai][1][m][0], u1 = acc[ai][1][m][1];
                const float kk = W8_GATE / (gsc * H8_SC);
                const f32x2 h0 = swiglu2n((f32x2){g0[0], g0[1]}, (f32x2){u0[0], u0[1]}, kk), h1 = swiglu2n((f32x2){g0[2], g0[3]}, (f32x2){u0[2], u0[3]}, kk);
                const f32x2 h2 = swiglu2n((f32x2){g1[0], g1[1]}, (f32x2){u1[0], u1[1]}, kk), h3 = swiglu2n((f32x2){g1[2], g1[3]}, (f32x2){u1[2], u1[3]}, kk);
                u32x2 w; w.x = pk4_fp8(h0.x, h0.y, h1.x, h1.y); w.y = pk4_fp8(h2.x, h2.y, h3.x, h3.y);
                *(u32x2*)rowp = w; }
    }
};
struct EpiProj {
    static constexpr int NS = 0; static constexpr bool PERM = true;
    bf16_t *Kb, *Qb, *Vt;
    __device__ __forceinline__ void operator()(const f32x4 (&acc)[2][2][4][2], const Unit& u, int wr, int wc, int fr, int fq) const {
        bf16_t* base = (u.aux == 0) ? Kb : (u.aux == 1 ? Qb : Vt); const size_t ldc = (u.aux == 2) ? (size_t)M : (size_t)D;
        const int row0 = u.pm * BM + wr * 64 + fr, col0 = u.pn * BM + wc * 32 + 8 * fq;
#pragma unroll
        for (int ai = 0; ai < 2; ++ai)
#pragma unroll
            for (int m = 0; m < 4; ++m) { bf16_t* rowp = base + (size_t)(row0 + ai * HALF + m * 16) * ldc + col0;
#pragma unroll
                for (int bj = 0; bj < 2; ++bj) { const f32x4 v0 = acc[ai][bj][m][0], v1 = acc[ai][bj][m][1];
                    u32x4 w; w.x = cvtpk(v0[0], v0[1]); w.y = cvtpk(v0[2], v0[3]); w.z = cvtpk(v1[0], v1[1]); w.w = cvtpk(v1[2], v1[3]);
                    if (u.aux == 2) { bf16_t* p16 = rowp + bj * HALF - (fq & 1) * 8 + (fq & 1) * 4;
                        *(u32x2*)p16 = (u32x2){w.x, w.y}; *(u32x2*)(p16 + 8) = (u32x2){w.z, w.w}; }
                    else *(u32x4*)(rowp + bj * HALF) = w; } }
    }
};
struct EpiProjI8 {
    static constexpr int NS = 16; static constexpr bool PERM = true;
    bf16_t *Kb, *Qb, *Vt; const float* ascale; const float* wsc  ; int qsel;
    __device__ __forceinline__ void operator()(const f32x4 (&acc)[2][2][4][2], const Unit& u, int wr, int wc, int fr, int fq) const {
        bf16_t* base = (u.aux == 0) ? Kb : (u.aux == 1 ? Qb : Vt); const size_t ldc = (u.aux == 2) ? (size_t)M : (size_t)D;
        const float* rs; const float* cs; if (u.aux == 2) { rs = wsc + 1024; cs = ascale; } else { rs = ascale; cs = wsc + u.aux * (2048 + qsel * 1024); }
        const int row0 = u.pm * BM + wr * 64 + fr, col0 = u.pn * BM + wc * 32 + 8 * fq;
        f32x4 cv[2][2];
#pragma unroll
        for (int bj = 0; bj < 2; ++bj) { cv[bj][0] = *(const f32x4*)(cs + col0 + bj * HALF); cv[bj][1] = *(const f32x4*)(cs + col0 + bj * HALF + 4); }
        float rvv[2][4];
#pragma unroll
        for (int ai = 0; ai < 2; ++ai)
#pragma unroll
            for (int m = 0; m < 4; ++m) rvv[ai][m] = rs[row0 + ai * HALF + m * 16];
#pragma unroll
        for (int ai = 0; ai < 2; ++ai)
#pragma unroll
            for (int m = 0; m < 4; ++m) { const int row = row0 + ai * HALF + m * 16; bf16_t* rowp = base + (size_t)row * ldc + col0; const float rv = rvv[ai][m];
#pragma unroll
                for (int bj = 0; bj < 2; ++bj) { const f32x4 v0 = __builtin_convertvector(__builtin_bit_cast(i32x4, acc[ai][bj][m][0]), f32x4) * (cv[bj][0] * rv), v1 = __builtin_convertvector(__builtin_bit_cast(i32x4, acc[ai][bj][m][1]), f32x4) * (cv[bj][1] * rv);
                    u32x4 w; w.x = cvtpk(v0[0], v0[1]); w.y = cvtpk(v0[2], v0[3]); w.z = cvtpk(v1[0], v1[1]); w.w = cvtpk(v1[2], v1[3]);
                    if (u.aux == 2) { bf16_t* p16 = rowp + bj * HALF - (fq & 1) * 8 + (fq & 1) * 4;
                        *(u32x2*)p16 = (u32x2){w.x, w.y}; *(u32x2*)(p16 + 8) = (u32x2){w.z, w.w}; }
                    else *(u32x4*)(rowp + bj * HALF) = w; } }
    }
};
struct EpiMoeDown {
    static constexpr int NS = 16; static constexpr bool PERM = true;
    bf16_t* Y; const float* gate; float osc;
    __device__ __forceinline__ void operator()(const f32x4 (&acc)[2][2][4][2], const Unit& u, int wr, int wc, int fr, int fq) const {
        const int row0 = u.pm * BM + wr * 64 + fr, col0 = u.pn * BM + wc * 32 + 8 * fq;
        float gtv[2][4];
#pragma unroll
        for (int ai = 0; ai < 2; ++ai)
#pragma unroll
            for (int m = 0; m < 4; ++m) gtv[ai][m] = gate[row0 + ai * HALF + m * 16];
#pragma unroll
        for (int ai = 0; ai < 2; ++ai)
#pragma unroll
            for (int m = 0; m < 4; ++m) { const int row = row0 + ai * HALF + m * 16; const float gt = gtv[ai][m] * osc; bf16_t* rowp = Y + (size_t)row * D + col0;
#pragma unroll
                for (int bj = 0; bj < 2; ++bj) { const f32x4 v0 = acc[ai][bj][m][0] * gt, v1 = acc[ai][bj][m][1] * gt;
                    u32x4 w; w.x = cvtpk(v0[0], v0[1]); w.y = cvtpk(v0[2], v0[3]); w.z = cvtpk(v1[0], v1[1]); w.w = cvtpk(v1[2], v1[3]);
                    *(u32x4*)(rowp + bj * HALF) = w; } }
    }
};
}

__device__ __forceinline__ void tr_load(float (&tv)[32], float (&tg)[8], const float* gain, const float* W, int ldw, int k0, int n0, int lane) {
    const GAS float* wp = (const GAS float*)W + (size_t)(k0 + (lane >> 3)) * ldw + n0 + 4 * (lane & 7);
#pragma unroll
    for (int i = 0; i < 8; ++i) { const f32x4 q = *(const GAS f32x4*)(wp + (size_t)(8 * i) * ldw); tv[4 * i] = q.x; tv[4 * i + 1] = q.y; tv[4 * i + 2] = q.z; tv[4 * i + 3] = q.w; }
#pragma unroll
    for (int i = 0; i < 8; ++i) tg[i] = gain ? ((const GAS float*)gain)[k0 + 8 * i + (lane >> 3)] : 1.0f;
}
__device__ __forceinline__ void tr_put(const float (&tv)[32], const float (&tg)[8], int k0, float mul, int mode  , unsigned char* WT, int ldk, int drow0, LAS float* scr, int lane,
                                       const unsigned* colmax = nullptr  , int n0 = 0, float* wscale = nullptr  ) {
#pragma unroll
    for (int i = 0; i < 8; ++i) { const int kk = 8 * i + (lane >> 3); const float gv = tg[i] * mul;
#pragma unroll
        for (int j = 0; j < 4; ++j) scr[kk * 33 + 4 * (lane & 7) + j] = tv[4 * i + j] * gv; }
    LDS_WAIT(); asm volatile("" ::: "memory");
    const int c = lane & 7;
#pragma unroll
    for (int j = 0; j < 4; ++j) { const int n = (lane >> 3) + 8 * j; const LAS float* sp = scr + (8 * c) * 33 + n;
        const float e0 = sp[0 * 33], e1 = sp[1 * 33], e2 = sp[2 * 33], e3 = sp[3 * 33], e4 = sp[4 * 33], e5 = sp[5 * 33], e6 = sp[6 * 33], e7 = sp[7 * 33];
        if (mode == 2) { const float mx = __builtin_bit_cast(float, __hip_atomic_load(colmax + n0 + n, RLX_AGENT)); const float q = mx > 0.f ? 127.0f / mx : 0.f;
            u32x2 o; o.x = pk4_i8(e0 * q, e1 * q, e2 * q, e3 * q); o.y = pk4_i8(e4 * q, e5 * q, e6 * q, e7 * q); *(GAS u32x2*)(WT + (size_t)(drow0 + n) * ldk + k0 + 8 * c) = o;
            if (k0 == 0 && c == 0) wscale[drow0 + n] = mx * (1.0f / 127.0f); }
        else if (mode == 1) { u32x2 o; o.x = pk4_fp8(e0, e1, e2, e3); o.y = pk4_fp8(e4, e5, e6, e7); *(GAS u32x2*)(WT + (size_t)(drow0 + n) * ldk + k0 + 8 * c) = o; }
        else { u32x4 o; o.x = cvtpk(e0, e1); o.y = cvtpk(e2, e3); o.z = cvtpk(e4, e5); o.w = cvtpk(e6, e7); *(GAS u32x4*)(WT + ((size_t)(drow0 + n) * ldk + k0 + 8 * c) * 2) = o; } }
    LDS_WAIT(); asm volatile("" ::: "memory");
}
__device__ __forceinline__ void tr_mat(const float* W, int ldw, int K, int N, const float* gain, float mul, int mode, bool gu, unsigned char* WT, LAS float* scr, int first, int NGW, int lane,
                                       const unsigned* colmax = nullptr, float* wscale = nullptr, float gmul = 0.f  ) {
    const int nblk = N / 32, nitems = (K / 64) * nblk, F = N / 2;
    float tv[32], tn[32], tg[8], tgn[8];
    int it = first; if (it >= nitems) return;
    tr_load(tv, tg, gain, W, ldw, (it / nblk) * 64, (it % nblk) * 32, lane);
    for (; it < nitems; it += NGW) {
        const int nx = it + NGW; if (nx < nitems) tr_load(tn, tgn, gain, W, ldw, (nx / nblk) * 64, (nx % nblk) * 32, lane);
        const int kb = it / nblk, n0 = (it % nblk) * 32; int drow0 = n0;
        if (gu) { const int isup = n0 >= F, j = isup ? n0 - F : n0; drow0 = (j >> 7) * 256 + (isup ? 128 : 0) + (j & 127); }
        tr_put(tv, tg, kb * 64, (gu && n0 < F && gmul != 0.f) ? gmul : mul, mode, WT, K, drow0, scr, lane, colmax, n0, wscale);
#pragma unroll
        for (int i = 0; i < 32; ++i) tv[i] = tn[i];
#pragma unroll
        for (int i = 0; i < 8; ++i) tg[i] = tgn[i];
    }
}

struct Args { const float* in[15]; float* out; unsigned char* ws; };
template <int OFF> __device__ __forceinline__ unsigned long long karg() { unsigned long long v; auto ka = __builtin_amdgcn_kernarg_segment_ptr();
    asm volatile("s_load_dwordx2 %0, %1, %2\n\ts_waitcnt lgkmcnt(0)" : "=s"(v) : "s"(ka), "n"(OFF) : "memory"); return v; }
#define ARG_IN(k) ((const float*)(const GAS float*)karg<8 * (k)>())
#define ARG_OUT() ((float*)(GAS float*)karg<120>())
#define ARG_WS() ((unsigned char*)(GAS unsigned char*)karg<128>())

template <int CTRL> __device__ __forceinline__ float dpp_mov(float s) { return __builtin_bit_cast(float, __builtin_amdgcn_update_dpp(0, __builtin_bit_cast(int, s), CTRL, 0xF, 0xF, true)); }
__device__ __forceinline__ void swap16(float& a, float& b) { asm("s_nop 1\n\tv_permlane16_swap_b32 %0, %1" : "+v"(a), "+v"(b)); }
__device__ __forceinline__ void swap32(float& a, float& b) { asm("s_nop 1\n\tv_permlane32_swap_b32 %0, %1" : "+v"(a), "+v"(b)); }
__device__ __forceinline__ float fast_wave_sum(float v) {
    v += dpp_mov<0xB1>(v); v += dpp_mov<0x4E>(v); v += dpp_mov<0x141>(v); v += dpp_mov<0x140>(v);
    { float w = v; swap16(v, w); v += w; } { float w = v; swap32(v, w); v += w; }
    return v;
}
__device__ __forceinline__ float fast_wave_max(float v) {
    v = fmaxf(v, dpp_mov<0xB1>(v)); v = fmaxf(v, dpp_mov<0x4E>(v)); v = fmaxf(v, dpp_mov<0x141>(v)); v = fmaxf(v, dpp_mov<0x140>(v));
    { float w = v; swap16(v, w); v = fmaxf(v, w); } { float w = v; swap32(v, w); v = fmaxf(v, w); }
    return v;
}
__device__ __forceinline__ float reduce8(float (&a)[8], int lane) {
    float b[4], c[2];
#pragma unroll
    for (int k = 0; k < 4; ++k) { float x = a[k], y = a[k + 4]; swap32(x, y); b[k] = x + y; }
#pragma unroll
    for (int k = 0; k < 2; ++k) { float x = b[k], y = b[k + 2]; swap16(x, y); c[k] = x + y; }
    const bool hi = (lane & 8) != 0;
    const float keep = hi ? c[1] : c[0], send = hi ? c[0] : c[1];
    float d = keep + dpp_mov<0x140>(send);
    d += dpp_mov<0x141>(d); d += dpp_mov<0xB1>(d); d += dpp_mov<0x4E>(d);
    return d;
}
template <int W, class HT>
__device__ __forceinline__ void pool_chan(const bf16_t* xp  , const HT* hp  , int s0, const LAS float* inv  , bf16_t* pp  ) {
    f32x2 hist[W]; f32x2 S = {0.f, 0.f};
#pragma unroll
    for (int j = 0; j < W; ++j) hist[j] = (f32x2){0.f, 0.f};
    if (s0 > 0) {
#pragma unroll
        for (int j = 1; j < W; ++j) { const int t = j - W; const f32x2 v = ld2(hp + (ptrdiff_t)t * D) * inv[15 + t]; hist[j] = v; S += v; }
    }
    for (int tb = 0; tb < 256; tb += 64) {
        unsigned raw[64];
#pragma unroll
        for (int j = 0; j < 64; ++j) raw[j] = *(const GAS unsigned*)(xp + (size_t)(tb + j) * D);
#pragma unroll
        for (int j = 0; j < 64; ++j) { const int t = tb + j; const f32x2 xv = (f32x2){bf_lo(raw[j]), bf_hi(raw[j])} * inv[15 + t]; S += xv - hist[j % W]; hist[j % W] = xv;
            const int pos = s0 + t + 1; const float rc = (pos >= W) ? (1.0f / W) : (1.0f / (float)pos);
            const f32x2 p = S * rc - xv; *(GAS unsigned*)(pp + (size_t)t * D) = cvtpk(p.x, p.y); }
    }
}
template <bool FIRST>
__device__ __forceinline__ void pool_prep_phase(const float* xin, bf16_t* xb, bf16_t* P, LAS unsigned char* lds, int G, int wave_s, int tix  ) {
    const int tid = fresh_tid(wave_s); const int lane = tid & 63, wave = __builtin_amdgcn_readfirstlane(tid >> 6);
    LAS float* inv = (LAS float*)lds;
    for (int tile = tix; tile < M / 256; tile += G) {
        const int r0 = tile * 256, s0 = r0 % SEQ;
        const int start = (s0 > 0) ? -15 : 0;
        for (int base = start + wave; base < 256; base += 8 * NWAVES) {
            typename Raw4<float>::t vf[8][4]; typename Raw4<bf16_t>::t vb[8][4];
#pragma unroll
            for (int k = 0; k < 8; ++k) { int rr = base + k * NWAVES; rr = rr < 256 ? rr : 255;
                if (FIRST) { const float* xr = xin + (size_t)(r0 + rr) * D + 4 * lane;
#pragma unroll
                    for (int j = 0; j < 4; ++j) vf[k][j] = ldraw4(xr + 256 * j); }
                else { const bf16_t* xr = xb + (size_t)(r0 + rr) * D + 4 * lane;
#pragma unroll
                    for (int j = 0; j < 4; ++j) vb[k][j] = ldraw4(xr + 256 * j); } }
#pragma unroll
            for (int k = 0; k < 8; ++k) { const int rr = base + k * NWAVES; float s = 0.f; f32x4 v[4];
#pragma unroll
                for (int j = 0; j < 4; ++j) { if (FIRST) v[j] = cvt4(vf[k][j]); else v[j] = cvt4(vb[k][j]); s += (v[j].x * v[j].x + v[j].y * v[j].y) + (v[j].z * v[j].z + v[j].w * v[j].w); }
                s = fast_wave_sum(s);
                if (rr < 256) {
                    if (lane == 0) inv[15 + rr] = 1.0f / sqrtf(s * (1.0f / D) + RMS_EPS);
                    if (FIRST && rr >= 0) { GAS u32x2* xo = (GAS u32x2*)(xb + (size_t)(r0 + rr) * D) + lane;
#pragma unroll
                        for (int j = 0; j < 4; ++j) { u32x2 w; w.x = cvtpk(v[j].x, v[j].y); w.y = cvtpk(v[j].z, v[j].w); xo[64 * j] = w; } } } }
        }
        __syncthreads();
        const int c = 2 * tid; const bf16_t* xp = xb + (size_t)r0 * D + c; bf16_t* pp = P + (size_t)r0 * D + c;
        const int grp = wave >> 1;
        if (FIRST) { const float* hp = xin + (size_t)r0 * D + c;
            if (grp == 0) pool_chan<2, float>(xp, hp, s0, inv, pp); else if (grp == 1) pool_chan<4, float>(xp, hp, s0, inv, pp); else if (grp == 2) pool_chan<8, float>(xp, hp, s0, inv, pp); else pool_chan<16, float>(xp, hp, s0, inv, pp); }
        else { if (grp == 0) pool_chan<2, bf16_t>(xp, xp, s0, inv, pp); else if (grp == 1) pool_chan<4, bf16_t>(xp, xp, s0, inv, pp); else if (grp == 2) pool_chan<8, bf16_t>(xp, xp, s0, inv, pp); else pool_chan<16, bf16_t>(xp, xp, s0, inv, pp); }
        __syncthreads();
    }
}

template <bool COMBINE, bool ROUTER, bool FINAL, int OUTK, bool DELTA, class XT>
__device__ __forceinline__ void norm_phase(float* x, bf16_t* XN, const bf16_t* YS, const int* slot_of, const float* gvec  , const float* wr  ,
                                           int* route_e, float* route_g, int* tilecnt, LAS unsigned char* lds, LAS int* cnt_l, int G, int wave_s, float* ascale, const bf16_t* DL, const XT* xs  , bf16_t* xw  , int tix  ) {
    const int tid = fresh_tid(wave_s); const int lane = tid & 63, wave = __builtin_amdgcn_readfirstlane(tid >> 6);
    f32x2 wreg[8][8];
    if (ROUTER) {
#pragma unroll
        for (int j = 0; j < 4; ++j)
#pragma unroll
            for (int k = 0; k < 4; ++k) { const int c = 4 * lane + 256 * j + k; const float gc = gvec[c]; const f32x4 w0 = *(const f32x4*)(wr + (size_t)c * 8), w1 = *(const f32x4*)(wr + (size_t)c * 8 + 4);
#pragma unroll
                for (int e = 0; e < 4; ++e) { wreg[e][2 * j + (k >> 1)][k & 1] = w0[e] * gc; wreg[e + 4][2 * j + (k >> 1)][k & 1] = w1[e] * gc; } }
    }
    f32x4 gf[4];
    if (FINAL) {
#pragma unroll
        for (int j = 0; j < 4; ++j) gf[j] = *((const f32x4*)gvec + lane + 64 * j);
    }
    for (int tile = tix; tile < M / 256; tile += G) {
        const int rb = tile * 256 + wave * 32;
        int slv = 0; if (COMBINE) slv = slot_of[2 * rb + lane];
        u32x2 nx[2][4], na[2][4], nb[2][4];
#define NP_LOAD(u, idx) do { const GAS u32x2* p_ = (const GAS u32x2*)((const bf16_t*)xs + (size_t)(rb + (idx)) * D) + lane; \
            _Pragma("unroll") for (int j = 0; j < 4; ++j) nx[u][j] = p_[64 * j]; \
            if (COMBINE) { const int a0_ = __builtin_amdgcn_readlane(slv, 2 * (idx)), a1_ = __builtin_amdgcn_readlane(slv, 2 * (idx) + 1); \
                const GAS u32x2* y0_ = (const GAS u32x2*)(YS + (size_t)a0_ * D) + lane; const GAS u32x2* y1_ = (const GAS u32x2*)(YS + (size_t)a1_ * D) + lane; \
                _Pragma("unroll") for (int j = 0; j < 4; ++j) { na[u][j] = y0_[64 * j]; nb[u][j] = y1_[64 * j]; } } } while (0)
        NP_LOAD(0, 0); NP_LOAD(1, 1);
        for (int i = 0; i < 32; i += 2) {
            f32x4 v[2][4];
#pragma unroll
            for (int u = 0; u < 2; ++u)
#pragma unroll
                for (int j = 0; j < 4; ++j) { const u32x2 d = nx[u][j]; v[u][j] = (f32x4){bf_lo(d.x), bf_hi(d.x), bf_lo(d.y), bf_hi(d.y)}; }
            if (COMBINE) {
#pragma unroll
                for (int u = 0; u < 2; ++u)
#pragma unroll
                    for (int w = 0; w < 2; ++w) { const int sl = __builtin_amdgcn_readlane(slv, 2 * (i + u) + w);
                        if (sl < 2 * M) {
#pragma unroll
                            for (int j = 0; j < 4; ++j) { const u32x2 a = w ? nb[u][j] : na[u][j]; v[u][j] += (f32x4){bf_lo(a.x), bf_hi(a.x), bf_lo(a.y), bf_hi(a.y)}; } }
                        else {
                            for (int q = 0; q < 7; ++q) { const GAS u32x2* yq = (const GAS u32x2*)(DL + ((size_t)q * (8 * 256) + (size_t)(sl - 2 * M)) * D) + lane;
#pragma unroll
                                for (int j = 0; j < 4; ++j) { const u32x2 a = yq[64 * j]; v[u][j] += (f32x4){bf_lo(a.x), bf_hi(a.x), bf_lo(a.y), bf_hi(a.y)}; } } } } }
            if (i + 2 < 32) { NP_LOAD(0, i + 2); NP_LOAD(1, i + 3); }
#pragma unroll
            for (int u = 0; u < 2; ++u) {
                const int r = rb + i + u;
                if (COMBINE && !FINAL) { GAS u32x2* xo = (GAS u32x2*)(xw + (size_t)r * D) + lane;
#pragma unroll
                    for (int j = 0; j < 4; ++j) { u32x2 w; w.x = cvtpk(v[u][j].x, v[u][j].y); w.y = cvtpk(v[u][j].z, v[u][j].w); xo[64 * j] = w; } }
                float s = 0.f;
#pragma unroll
                for (int j = 0; j < 4; ++j) s += (v[u][j].x * v[u][j].x + v[u][j].y * v[u][j].y) + (v[u][j].z * v[u][j].z + v[u][j].w * v[u][j].w);
                float lgp[8];
                if (ROUTER) {
#pragma unroll
                    for (int e = 0; e < 8; ++e) { f32x2 a2 = {0.f, 0.f};
#pragma unroll
                        for (int j = 0; j < 4; ++j) { a2 += (f32x2){v[u][j].x, v[u][j].y} * wreg[e][2 * j] ; a2 += (f32x2){v[u][j].z, v[u][j].w} * wreg[e][2 * j + 1]; }
                        lgp[e] = a2.x + a2.y; }
                }
                const float inv = 1.0f / sqrtf(fast_wave_sum(s) * (1.0f / D) + RMS_EPS);
#pragma unroll
                for (int j = 0; j < 4; ++j) v[u][j] = v[u][j] * inv;
                if (FINAL) { GAS f32x4* xr = (GAS f32x4*)(x + (size_t)r * D) + lane;
#pragma unroll
                    for (int j = 0; j < 4; ++j) xr[64 * j] = v[u][j] * gf[j];
                } else if (OUTK == 2) {
                    float mx = 0.f;
#pragma unroll
                    for (int j = 0; j < 4; ++j) mx = fmaxf(fmaxf(mx, fmaxf(fabsf(v[u][j].x), fabsf(v[u][j].y))), fmaxf(fabsf(v[u][j].z), fabsf(v[u][j].w)));
                    mx = fast_wave_max(mx); const float q = mx > 0.f ? 127.0f / mx : 0.f;
                    GAS unsigned* o = (GAS unsigned*)((unsigned char*)XN + (size_t)r * D) + lane;
#pragma unroll
                    for (int j = 0; j < 4; ++j) o[64 * j] = pk4_i8(v[u][j].x * q, v[u][j].y * q, v[u][j].z * q, v[u][j].w * q);
                    if (lane == 0) ascale[r] = mx * (1.0f / 127.0f);
                } else if (OUTK == 1) {
                    GAS unsigned* o = (GAS unsigned*)((unsigned char*)XN + (size_t)r * D) + lane;
#pragma unroll
                    for (int j = 0; j < 4; ++j) o[64 * j] = pk4_fp8(v[u][j].x, v[u][j].y, v[u][j].z, v[u][j].w);
                } else {
                    GAS u32x2* o = (GAS u32x2*)(XN + (size_t)r * D) + lane;
#pragma unroll
                    for (int j = 0; j < 4; ++j) { u32x2 w; w.x = cvtpk(v[u][j].x, v[u][j].y); w.y = cvtpk(v[u][j].z, v[u][j].w); o[64 * j] = w; }
                }
                if (ROUTER) {
                    const float dsum = reduce8(lgp, lane) * inv;
                    float lg[8];
#pragma unroll
                    for (int e = 0; e < 8; ++e) lg[e] = __builtin_bit_cast(float, __builtin_amdgcn_readlane(__builtin_bit_cast(int, dsum), 8 * e));
                    int e0 = 0; float v0 = lg[0];
#pragma unroll
                    for (int e = 1; e < 8; ++e) if (lg[e] > v0) { v0 = lg[e]; e0 = e; }
                    int e1 = -1; float v1 = -3.0e38f;
#pragma unroll
                    for (int e = 0; e < 8; ++e) if (e != e0 && lg[e] > v1) { v1 = lg[e]; e1 = e; }
                    const float ex = __expf(v1 - v0), g0 = 1.0f / (1.0f + ex), g1 = ex * g0;
                    if (lane == 0) { route_e[r] = e0 | (e1 << 8); route_g[2 * r] = g0; route_g[2 * r + 1] = g1; atomicAdd((int*)(cnt_l + e0), 1); atomicAdd((int*)(cnt_l + e1), 1); }
                }
            }
        }
#undef NP_LOAD
        if (ROUTER) {
            __syncthreads();
            if (tid < 8) { tilecnt[tile * 8 + tid] = cnt_l[tid]; cnt_l[tid] = 0; }
            __syncthreads();
        }
    }
}

template <bool FP8>
__device__ __forceinline__ void dispatch_phase(const int* tilecnt, const int* route_e, const float* route_g, int* slot_of, float* gate_slot, const bf16_t* XN, bf16_t* XS  ,
                                               LAS unsigned char* lds, LAS int* pend, int G, int wave_s) {
    const int tid = fresh_tid(wave_s); const int lane = tid & 63, wave = __builtin_amdgcn_readfirstlane(tid >> 6);
    LAS int* lc = (LAS int*)lds;
    LAS int* tot_l = (LAS int*)(lds + 8192);
    LAS int* pst_l = (LAS int*)(lds + 8192 + 32);
    LAS int* base_l = (LAS int*)(lds + 8192 + 64);
    LAS int* slot_l = (LAS int*)(lds + 8192 + 128);
    if (tid < 256) { const i32x4 a = *((const i32x4*)tilecnt + 2 * tid), b = *((const i32x4*)tilecnt + 2 * tid + 1); *((LAS i32x4*)lc + 2 * tid) = a; *((LAS i32x4*)lc + 2 * tid + 1) = b; }
    __syncthreads();
    if (tid < 8) { int t = 0; for (int i = 0; i < 256; ++i) t += lc[i * 8 + tid]; tot_l[tid] = t; }
    __syncthreads();
    if (tid == 0) { int ps = 0; for (int e = 0; e < 8; ++e) { const int padded = (tot_l[e] + 255) & ~255; pst_l[e] = ps; ps += padded; pend[e] = ps >> 8; } }
    __syncthreads();
    if (FP8 && blockIdx.x < 8) { const int e = blockIdx.x, t0 = pst_l[e] + tot_l[e], npad = ((tot_l[e] + 255) & ~255) - tot_l[e];
        for (int i = tid; i < npad; i += NTHREADS) ((int*)XS)[t0 + i] = 0; }
    for (int tile = blockIdx.x; tile < M / 256; tile += G) {
        const int r0 = tile * 256;
        if (tid < 8) { int pre = 0; for (int i = 0; i < tile; ++i) pre += lc[i * 8 + tid]; base_l[tid] = pst_l[tid] + pre; }
        __syncthreads();
        if (wave == 0) {
            int run[8];
#pragma unroll
            for (int e = 0; e < 8; ++e) run[e] = 0;
            for (int ch = 0; ch < 8; ++ch) {
                const int i = ch * 64 + lane, tok = r0 + (i >> 1), k = i & 1;
                const int ew = __hip_atomic_load(route_e + tok, RLX_AGENT); const int e = (ew >> (8 * k)) & 0xff;
                int slot = 0;
#pragma unroll
                for (int ee = 0; ee < 8; ++ee) { const unsigned long long mask = __ballot(e == ee);
                    if (e == ee) slot = base_l[ee] + run[ee] + __popcll(mask & ((1ull << lane) - 1ull));
                    run[ee] += __popcll(mask); }
                slot_l[i] = slot; slot_of[2 * tok + k] = slot; gate_slot[slot] = __hip_atomic_load(route_g + 2 * tok + k, RLX_AGENT); if (FP8) ((int*)XS)[slot] = tok;
            }
        }
        __syncthreads();
        if constexpr (!FP8) {
        for (int ii = 0; ii < 64; ii += 4) {
            u32x4 a[4][2];
#pragma unroll
            for (int q = 0; q < 4; ++q) { const int i = wave * 64 + ii + q; const GAS u32x4* src = (const GAS u32x4*)(XN + (size_t)(r0 + (i >> 1)) * D) + lane; a[q][0] = src[0]; a[q][1] = src[64]; }
#pragma unroll
            for (int q = 0; q < 4; ++q) { const int i = wave * 64 + ii + q; GAS u32x4* dst = (GAS u32x4*)(XS + (size_t)slot_l[i] * D) + lane; dst[0] = a[q][0]; dst[64] = a[q][1]; }
        }
        }
        __syncthreads();
    }
}

#define ATT_LOAD(KF, VF, kt_) do { const int k0_ = (kt_) * 32; \
        const GAS u32x4* kp_ = (const GAS u32x4*)(Kb + (rowbase + k0_ + n) * D + h * 64 + 8 * hh); \
        _Pragma("unroll") for (int s_ = 0; s_ < 4; ++s_) KF[s_] = __builtin_bit_cast(bf16x8, kp_[2 * s_]); \
        _Pragma("unroll") for (int dt_ = 0; dt_ < 2; ++dt_) { const GAS u32x4* vp_ = (const GAS u32x4*)(Vt + (size_t)(h * 64 + dt_ * 32 + n) * M + rowbase + k0_ + 8 * hh); \
            _Pragma("unroll") for (int s_ = 0; s_ < 2; ++s_) VF[dt_][s_] = __builtin_bit_cast(bf16x8, vp_[2 * s_]); } } while (0)
constexpr float ATT_STOP = 9.0e-14f;
template <bool DIAG>
__device__ __forceinline__ void att_tile(const bf16x8 (&kf)[4], const bf16x8 (&vf)[2][2], const bf16x8 (&qf)[4], f32x16& o0, f32x16& o1, float& carry, int n, int hh) {
    f32x16 sc = __builtin_amdgcn_mfma_f32_32x32x16_bf16(kf[0], qf[0], (f32x16){0.f, 0.f, 0.f, 0.f, 0.f, 0.f, 0.f, 0.f, 0.f, 0.f, 0.f, 0.f, 0.f, 0.f, 0.f, 0.f}, 0, 0, 0);
#pragma unroll
    for (int s = 1; s < 4; ++s) sc = __builtin_amdgcn_mfma_f32_32x32x16_bf16(kf[s], qf[s], sc, 0, 0, 0);
    float be[16], kp[16];
#pragma unroll
    for (int r = 0; r < 16; r += 2) { f32x2 e; e.x = __builtin_amdgcn_exp2f(-__builtin_amdgcn_fmed3f(sc[r], -64.f, 3.0e38f)); e.y = __builtin_amdgcn_exp2f(-__builtin_amdgcn_fmed3f(sc[r + 1], -64.f, 3.0e38f));
        const f32x2 d = e + 1.0f; f32x2 b2; b2.x = __builtin_amdgcn_rcpf(d.x); b2.y = __builtin_amdgcn_rcpf(d.y); const f32x2 k2 = e * b2;
        be[r] = b2.x; be[r + 1] = b2.y; kp[r] = k2.x; kp[r + 1] = k2.y; }
    if constexpr (DIAG) {
#pragma unroll
        for (int r = 0; r < 16; ++r) { const int key = (r & 3) + 8 * (r >> 2) + 4 * hh; if (key >= n) { be[r] = 0.f; kp[r] = 1.f; } } }
    float T[4], Pp[4], p2[4], p1[4], p0[4];
#pragma unroll
    for (int g = 0; g < 4; ++g) { p2[g] = kp[4 * g + 3]; p1[g] = p2[g] * kp[4 * g + 2]; p0[g] = p1[g] * kp[4 * g + 1]; T[g] = p0[g] * kp[4 * g]; }
#pragma unroll
    for (int g = 0; g < 4; ++g) Pp[g] = __shfl_xor(T[g], 32);
    float off[4];
    { const float own2 = T[3], own1 = T[3] * T[2], own0 = own1 * T[1];
      const float pe2 = Pp[3], pe1 = Pp[3] * Pp[2], pe0 = pe1 * Pp[1];
      if (hh == 0) { off[0] = own0 * pe0 * Pp[0]; off[1] = own1 * pe1 * Pp[1]; off[2] = own2 * pe2 * Pp[2]; off[3] = Pp[3]; }
      else         { off[0] = own0 * pe0;         off[1] = own1 * pe1;         off[2] = own2 * pe2;         off[3] = 1.f; } }
    float a[16];
#pragma unroll
    for (int g = 0; g < 4; ++g) { const float base = carry * off[g];
        a[4 * g + 0] = be[4 * g + 0] * (base * p0[g]); a[4 * g + 1] = be[4 * g + 1] * (base * p1[g]); a[4 * g + 2] = be[4 * g + 2] * (base * p2[g]); a[4 * g + 3] = be[4 * g + 3] * base; }
    carry *= ((T[0] * T[1]) * (T[2] * T[3])) * ((Pp[0] * Pp[1]) * (Pp[2] * Pp[3]));
    bf16x8 pb[2];
#pragma unroll
    for (int s = 0; s < 2; ++s) { u32x4 w; w.x = cvtpk(a[8 * s + 0], a[8 * s + 1]); w.y = cvtpk(a[8 * s + 2], a[8 * s + 3]); w.z = cvtpk(a[8 * s + 4], a[8 * s + 5]); w.w = cvtpk(a[8 * s + 6], a[8 * s + 7]); pb[s] = __builtin_bit_cast(bf16x8, w); }
#pragma unroll
    for (int s = 0; s < 2; ++s) { o0 = __builtin_amdgcn_mfma_f32_32x32x16_bf16(vf[0][s], pb[s], o0, 0, 0, 0); o1 = __builtin_amdgcn_mfma_f32_32x32x16_bf16(vf[1][s], pb[s], o1, 0, 0, 0); }
}
constexpr int ATT_KROW = 144, ATT_VROW = 784, ATT_V_OFF = 384 * ATT_KROW;
static_assert(ATT_V_OFF + 64 * ATT_VROW <= STAGE_BYTES_LDS, "attention LDS image");
__device__ __forceinline__ void attn_phase(const bf16_t* Q, const bf16_t* Kb, const bf16_t* Vt, bf16_t* O, LAS unsigned char* lds, int vcu, int G, int wave_s) {
    const int tid = fresh_tid(wave_s); const int lane = tid & 63, wave = __builtin_amdgcn_readfirstlane(tid >> 6);
    const int n = lane & 31, hh = lane >> 5;
    const int NU = BATCH * NH * (SEQ / 256), per = (NU + G - 1) / G;
    const int u_lo = vcu * per, u_hi = (u_lo + per < NU) ? u_lo + per : NU;
    u32x4 pk[6], pv[6];
#define ATT_FETCH(uu) do { const int bh_ = (uu) >> 3, qb_ = (uu) & 7, h_ = bh_ & 15, b_ = bh_ >> 4; const int kw0_ = qb_ > 0 ? qb_ * 256 - 128 : 0, nk_ = qb_ * 256 + 256 - kw0_; \
        const size_t rb_ = (size_t)b_ * SEQ; \
        _Pragma("unroll") for (int i_ = 0; i_ < 6; ++i_) { const int p_ = tid + i_ * NTHREADS; const int kr_ = p_ >> 3, kc_ = p_ & 7; \
            if (kr_ < nk_) pk[i_] = *(const GAS u32x4*)(Kb + (rb_ + kw0_ + kr_) * D + h_ * 64 + kc_ * 8); \
            const int vd_ = p_ / 48, vc_ = p_ - vd_ * 48; \
            if (vc_ * 8 < nk_) pv[i_] = *(const GAS u32x4*)(Vt + (size_t)(h_ * 64 + vd_) * M + rb_ + kw0_ + vc_ * 8); } } while (0)
#define ATT_PUT(uu) do { const int qb_ = (uu) & 7; const int kw0_ = qb_ > 0 ? qb_ * 256 - 128 : 0, nk_ = qb_ * 256 + 256 - kw0_; \
        _Pragma("unroll") for (int i_ = 0; i_ < 6; ++i_) { const int p_ = tid + i_ * NTHREADS; const int kr_ = p_ >> 3, kc_ = p_ & 7; \
            if (kr_ < nk_) *(LAS u32x4*)(lds + kr_ * ATT_KROW + kc_ * 16) = pk[i_]; \
            const int vd_ = p_ / 48, vc_ = p_ - vd_ * 48; \
            if (vc_ * 8 < nk_) *(LAS u32x4*)(lds + ATT_V_OFF + vd_ * ATT_VROW + vc_ * 16) = pv[i_]; } } while (0)
#define ATT_TILE_LD(KF, VF, kt_) do { const int k0_ = (kt_) * 32; if (k0_ >= kw0) { const int ko_ = k0_ - kw0; \
            _Pragma("unroll") for (int s_ = 0; s_ < 4; ++s_) KF[s_] = *(const LAS bf16x8*)(lds + (ko_ + n) * ATT_KROW + 32 * s_ + 16 * hh); \
            _Pragma("unroll") for (int dt_ = 0; dt_ < 2; ++dt_) _Pragma("unroll") for (int s_ = 0; s_ < 2; ++s_) VF[dt_][s_] = *(const LAS bf16x8*)(lds + ATT_V_OFF + (dt_ * 32 + n) * ATT_VROW + (ko_ + 16 * s_ + 8 * hh) * 2); } \
        else { ATT_LOAD(KF, VF, kt_); } } while (0)
    if (u_lo < u_hi) ATT_FETCH(u_lo);
    for (int u = u_lo; u < u_hi; ++u) {
        const int bh = u >> 3, qb = u & 7, h = bh & 15, b = bh >> 4;
        const size_t rowbase = (size_t)b * SEQ; const int kw0 = qb > 0 ? qb * 256 - 128 : 0;
        const int qt = qb * 8 + wave, q0 = qt * 32;
        bf16x8 qf[4];
        { const GAS u32x4* qp = (const GAS u32x4*)(Q + (rowbase + q0 + n) * D + h * 64 + 8 * hh);
#pragma unroll
          for (int s = 0; s < 4; ++s) qf[s] = __builtin_bit_cast(bf16x8, qp[2 * s]); }
        ATT_PUT(u);
        __syncthreads();
        if (u + 1 < u_hi) ATT_FETCH(u + 1);
        f32x16 o0, o1;
#pragma unroll
        for (int r = 0; r < 16; ++r) { o0[r] = 0.f; o1[r] = 0.f; }
        float carry = 1.f;
        bf16x8 kf[4], vf[2][2];
        ATT_TILE_LD(kf, vf, qt);
        att_tile<true>(kf, vf, qf, o0, o1, carry, n, hh);
        if (!__all(carry < ATT_STOP)) for (int kt = qt - 1; kt >= 0; --kt) {
            ATT_TILE_LD(kf, vf, kt);
            att_tile<false>(kf, vf, qf, o0, o1, carry, n, hh);
            if (__all(carry < ATT_STOP)) break;
        }
        bf16_t* op = O + (rowbase + q0 + n) * D + h * 64 + 4 * hh;
#pragma unroll
        for (int g = 0; g < 4; ++g) { u32x2 w0, w1; w0.x = cvtpk(o0[4 * g], o0[4 * g + 1]); w0.y = cvtpk(o0[4 * g + 2], o0[4 * g + 3]); w1.x = cvtpk(o1[4 * g], o1[4 * g + 1]); w1.y = cvtpk(o1[4 * g + 2], o1[4 * g + 3]);
            *(u32x2*)(op + 8 * g) = w0; *(u32x2*)(op + 32 + 8 * g) = w1; }
        __syncthreads();
    }
#undef ATT_FETCH
#undef ATT_PUT
#undef ATT_TILE_LD
}

#define WSP(T, off) ((T*)(ws + (off)))
#ifndef STAG_POOL
#define STAG_POOL 0
#define STAG_PROJ 0
#define STAG_OPROJ 0
#define STAG_DUP 0
#define STAG_MUP 0
#endif
#ifndef PROBE_DUP
#define PROBE_DUP 0
#endif
#define DUP(k) ((PROBE_DUP >> (k)) & 1)
template <int l>
__device__ __forceinline__ void layer_body(LAS unsigned char* lds, const XcdBarrier& bar, LAS int* pend, LAS int* cnt_l, int G, int bx, int vcu, int NGW, int wave_s, int tix  , bool xl  ) {
#define SEAM_L() { if (xl) xcd_local_barrier(bar, wave_s); else xcd_barrier(bar, wave_s); }
#define SITE_POOLPREP(GRIDBAR) { { unsigned char* ws = ARG_WS(); pool_prep_phase<l == 0>(ARG_IN(0), WSP(bf16_t, WS_XB), WSP(bf16_t, WS_P), lds, G, wave_s, tix); \
              if constexpr (l == 0 && (INT8_UP0 != 0 || INT8_PROJ != 0)) {     \
                  const int t_ = fresh_tid(wave_s); const int wv_ = __builtin_amdgcn_readfirstlane(t_ >> 6); LAS float* sc_ = (LAS float*)(lds + wv_ * 16384); const int g_ = vcu * NWAVES + wv_; int base_ = 0; \
                  for (int j_ = 0; j_ < 5; ++j_) { if ((j_ == 0 && !I8) || (j_ > 0 && !INT8_PROJ)) continue; \
                      const float* W_; const float* gn_; int ldw_, N_; float mul_ = 1.0f; bool gu_ = false; size_t dst_; const unsigned* cm_; float* wsc_; \
                      if (j_ == 0) { W_ = ARG_IN(9); gn_ = ARG_IN(2); ldw_ = 2 * DFF; N_ = 2 * DFF; gu_ = true; dst_ = WS_WFI; cm_ = WSP(unsigned, WS_COLMAX); wsc_ = WSP(float, WS_WSCALE); } \
                      else if (j_ < 3) { W_ = ARG_IN(6) + (j_ - 1) * 1024; gn_ = ARG_IN(5); ldw_ = 2048; N_ = 1024; dst_ = (j_ == 1) ? WS_WK : WS_WV; cm_ = WSP(unsigned, WS_COLMAX2) + (j_ - 1) * 1024; wsc_ = WSP(float, WS_WSCALE2) + (j_ - 1) * 1024; } \
                      else { const int b_ = j_ - 3; W_ = ARG_IN(7) + (size_t)b_ * D * D; gn_ = ARG_IN(1) + (2 + b_) * D; ldw_ = 1024; N_ = 1024; mul_ = 0.125f * 1.4426950408889634f; dst_ = WS_WQ + (size_t)b_ * D * D * 2; cm_ = WSP(unsigned, WS_COLMAX2) + (2 + b_) * 1024; wsc_ = WSP(float, WS_WSCALE2) + (2 + b_) * 1024; } \
                      int first_ = (g_ - base_) % NGW; if (first_ < 0) first_ += NGW; \
                      tr_mat(W_, ldw_, D, N_, gn_, mul_, 2, gu_, ws + dst_, sc_, first_, NGW, t_ & 63, cm_, wsc_); base_ = (base_ + (D / 64) * (N_ / 32)) % NGW; } } } \
          if (GRIDBAR) xcd_barrier(bar, wave_s); \
          else {   \
              __syncthreads(); \
              if constexpr (l == 1) { if (fresh_tid(wave_s) == 0) { unsigned* fl_ = (unsigned*)(ARG_WS() + WS_HALO_FLAGS); __hip_atomic_store(fl_ + tix, 1u, __ATOMIC_RELEASE, __HIP_MEMORY_SCOPE_AGENT); \
                      const int nb_ = tix + 1; if (nb_ < M / 256 && (nb_ % (SEQ / 256)) != 0) { unsigned sp_ = 0; while (__hip_atomic_load(fl_ + nb_, __ATOMIC_ACQUIRE, __HIP_MEMORY_SCOPE_AGENT) == 0u) { __builtin_amdgcn_s_sleep(1); if (++sp_ > (1u << 24)) break; } } } \
                  __syncthreads(); } } }
#define SITE_POOLGEMM(MUL, GRIDBAR) { { unsigned char* ws = ARG_WS(); \
              pg8::GemmK g{256, 1024, 256}; pg8::PoolOrder S{G, tix, (const char*)WSP(bf16_t, WS_P), (const char*)(WSP(bf16_t, WS_WPOOL) + (size_t)l * 4 * 65536)}; \
              pg8::EpiResidB E{WSP(bf16_t, WS_XB), ARG_IN(4) + l * D, MUL}; \
              pg8::gemm_phase<pg8::EpiResidB, pg8::PoolOrder, true>(lds, g, S, E, wave_s, STAG_POOL); } if (GRIDBAR) xcd_barrier(bar, wave_s); else __syncthreads(); }
#define SITE_PROJ() { { unsigned char* ws = ARG_WS(); \
              if constexpr (INT8_PROJ != 0) { pg8::GemmK g{512, 512, 512}; pg8::ProjOrder S{(l == 2) ? 3 : 1, G, bx, (const char*)ws, (size_t)(l - 2) * D * D * 2, (size_t)256 * 1024}; \
                pg8::EpiProjI8 E{WSP(bf16_t, WS_K), WSP(bf16_t, WS_R), WSP(bf16_t, WS_VT), WSP(float, WS_ASCALE), WSP(float, WS_WSCALE2), l - 2}; \
                pg8::gemm_phase<pg8::EpiProjI8, pg8::ProjOrder, true, 2>(lds, g, S, E, wave_s, STAG_PROJ); } \
              else { pg8::GemmK g{1024, 1024, 1024}; pg8::ProjOrder S{(l == 2) ? 3 : 1, G, bx, (const char*)ws, (size_t)(l - 2) * D * D * 2, (size_t)256 * 1024 * 2}; \
                pg8::EpiProj E{WSP(bf16_t, WS_K), WSP(bf16_t, WS_R), WSP(bf16_t, WS_VT)}; \
                pg8::gemm_phase<pg8::EpiProj, pg8::ProjOrder, true>(lds, g, S, E, wave_s); } } SEAM_L() }
#define SITE_ATTN() { { unsigned char* ws = ARG_WS(); attn_phase(WSP(bf16_t, WS_R), WSP(bf16_t, WS_K), WSP(bf16_t, WS_VT), WSP(bf16_t, WS_R) + (size_t)M * D, lds, vcu, G, wave_s); } SEAM_L() }
#define SITE_OPROJ(MUL) { { unsigned char* ws = ARG_WS(); \
              pg8::GemmK g{1024, 1024, 1024}; pg8::DenseOrder S{M / 256, 4, G, bx, (const char*)(WSP(bf16_t, WS_R) + (size_t)M * D), (const char*)(WSP(bf16_t, WS_WO) + (size_t)(l - 2) * D * D), (size_t)256 * 1024 * 2, (size_t)256 * 1024 * 2}; \
              pg8::EpiResidB E{WSP(bf16_t, WS_XB), nullptr, MUL}; \
              pg8::gemm_phase<pg8::EpiResidB, pg8::DenseOrder, true>(lds, g, S, E, wave_s, STAG_OPROJ); } SEAM_L() }
#define SITE_NORMX(OUTK_, DELTA_) { { unsigned char* ws = ARG_WS(); \
              norm_phase<false, false, false, OUTK_, false, bf16_t>(nullptr, WSP(bf16_t, WS_XN), nullptr, nullptr, nullptr, nullptr, nullptr, nullptr, nullptr, lds, cnt_l, G, wave_s, WSP(float, WS_ASCALE), nullptr, (const bf16_t*)WSP(bf16_t, WS_XB), nullptr, tix); } if (l == 0) xcd_barrier(bar, wave_s); else SEAM_L() }
#define SITE_NORMI8() { { unsigned char* ws = ARG_WS(); norm_phase<false, false, false, 2, false, bf16_t>(nullptr, WSP(bf16_t, WS_XN), nullptr, nullptr, nullptr, nullptr, nullptr, nullptr, nullptr, lds, cnt_l, G, wave_s, WSP(float, WS_ASCALE), nullptr, (const bf16_t*)WSP(bf16_t, WS_XB), nullptr, tix); } SEAM_L() }
#define SITE_NORM8() { { unsigned char* ws = ARG_WS(); norm_phase<false, false, false, 1, false, bf16_t>(nullptr, WSP(bf16_t, WS_XN), nullptr, nullptr, nullptr, nullptr, nullptr, nullptr, nullptr, lds, cnt_l, G, wave_s, nullptr, nullptr, (const bf16_t*)WSP(bf16_t, WS_XB), nullptr, tix); } xcd_barrier(bar, wave_s); }
#define SITE_NORM() { { unsigned char* ws = ARG_WS(); norm_phase<false, false, false, 0, false, bf16_t>(nullptr, WSP(bf16_t, WS_XN), nullptr, nullptr, nullptr, nullptr, nullptr, nullptr, nullptr, lds, cnt_l, G, wave_s, nullptr, nullptr, (const bf16_t*)WSP(bf16_t, WS_XB), nullptr, tix); } xcd_barrier(bar, wave_s); }
#define SITE_DUP() { { unsigned char* ws = ARG_WS(); \
              if constexpr (I8) { pg8::GemmK g{512, 512, 512}; pg8::DenseOrder S{M / 256, DFF / 128, G, bx, (const char*)WSP(unsigned char, WS_XN), (const char*)WSP(unsigned char, WS_WFI), (size_t)256 * 1024, (size_t)256 * 1024}; \
                pg8::EpiSwigluI8<L0_DOWN_FP8 != 0> E{WSP(bf16_t, WS_HD), DFF, WSP(float, WS_ASCALE), WSP(float, WS_WSCALE)}; \
                pg8::gemm_phase<pg8::EpiSwigluI8<L0_DOWN_FP8 != 0>, pg8::DenseOrder, true, 2>(lds, g, S, E, wave_s, STAG_DUP); } \
              else if constexpr (F8) { pg8::GemmK g{512, 512, 512}; pg8::DenseOrder S{M / 256, DFF / 128, G, bx, (const char*)WSP(unsigned char, WS_XN), (const char*)(WSP(unsigned char, WS_WFI) + (size_t)(l >> 1) * 2 * DFF * D * 2), (size_t)256 * 1024, (size_t)256 * 1024}; \
                pg8::EpiSwiglu8 E{WSP(unsigned char, WS_HD), DFF, 1.0f / W8_UP}; \
                pg8::gemm_phase<pg8::EpiSwiglu8, pg8::DenseOrder, true, 1>(lds, g, S, E, wave_s, STAG_DUP); } \
              else { pg8::GemmK g{1024, 1024, 1024}; pg8::DenseOrder S{M / 256, DFF / 128, G, bx, (const char*)WSP(bf16_t, WS_XN), (const char*)(WSP(bf16_t, WS_WFI) + (size_t)(l >> 1) * 2 * DFF * D), (size_t)256 * 1024 * 2, (size_t)256 * 1024 * 2}; \
                pg8::EpiSwiglu E{WSP(bf16_t, WS_HD), DFF}; \
                pg8::gemm_phase<pg8::EpiSwiglu, pg8::DenseOrder, true>(lds, g, S, E, wave_s); } } SEAM_L() }
#define SITE_DDOWN(MUL) { { unsigned char* ws = ARG_WS(); \
              if constexpr (F8 || (l == 0 && L0_DOWN_FP8 != 0)) { pg8::GemmK g{DFF / 2, DFF / 2, DFF / 2}; pg8::DenseOrder S{M / 256, 4, G, bx, (const char*)WSP(unsigned char, WS_HD), (const char*)(WSP(unsigned char, WS_WFO) + (size_t)(l >> 1) * D * DFF * 2), (size_t)256 * DFF, (size_t)256 * DFF}; \
                pg8::EpiResidB E{WSP(bf16_t, WS_XB), nullptr, MUL / (W8_DN * H8_SC)}; \
                pg8::gemm_phase<pg8::EpiResidB, pg8::DenseOrder, true, 1>(lds, g, S, E, wave_s); } \
              else { pg8::GemmK g{DFF, DFF, DFF}; pg8::DenseOrder S{M / 256, 4, G, bx, (const char*)WSP(bf16_t, WS_HD), (const char*)(WSP(bf16_t, WS_WFO) + (size_t)(l >> 1) * D * DFF), (size_t)256 * DFF * 2, (size_t)256 * DFF * 2}; \
                pg8::EpiResidB E{WSP(bf16_t, WS_XB), nullptr, MUL}; \
                pg8::gemm_phase<pg8::EpiResidB, pg8::DenseOrder, true>(lds, g, S, E, wave_s); } } SEAM_L() }
#define SITE_ROUTER() { { unsigned char* ws = ARG_WS(); \
              norm_phase<false, true, false, F8 ? 1 : 0, false, bf16_t>(nullptr, WSP(bf16_t, WS_XN), nullptr, nullptr, ARG_IN(2) + l * D, ARG_IN(11) + (size_t)(l >> 1) * D * NE, WSP(int, WS_ROUTE_E), WSP(float, WS_ROUTE_G), WSP(int, WS_TILECNT), lds, cnt_l, G, wave_s, nullptr, WSP(bf16_t, WS_DELTA), (const bf16_t*)WSP(bf16_t, WS_XB), nullptr, tix); } xcd_barrier(bar, wave_s); }
#define SITE_DISPATCH() { { unsigned char* ws = ARG_WS(); \
              dispatch_phase<F8>(WSP(int, WS_TILECNT), WSP(int, WS_ROUTE_E), WSP(float, WS_ROUTE_G), WSP(int, WS_SLOT_OF), WSP(float, WS_GATE_SLOT), WSP(bf16_t, WS_XN), F8 ? WSP(bf16_t, WS_TOS) : WSP(bf16_t, WS_XS), lds, pend, G, wave_s); } xcd_barrier(bar, wave_s); }
#define SITE_MUP() { { unsigned char* ws = ARG_WS(); \
              if constexpr (F8) { pg8::GemmK g{512, 512, 512}; \
                pg8::MoeGatherOrder S{nb, DFFE / 128, G, bx, blk0, (const char*)WSP(unsigned char, WS_XN), (const char*)(WSP(unsigned char, WS_WMI) + (size_t)(l >> 1) * 8 * 2 * DFFE * D * 2), (size_t)256 * 1024, (size_t)2 * DFFE * D, pend, WSP(int, WS_TOS), (LAS int*)(lds + LCTL_OFF + 2048)}; \
                pg8::EpiSwiglu8 E{WSP(unsigned char, WS_R), DFFE, 1.0f / W8_UP}; \
                pg8::gemm_phase<pg8::EpiSwiglu8, pg8::MoeGatherOrder, true, 1, true>(lds, g, S, E, wave_s, STAG_MUP); } \
              else { pg8::GemmK g{1024, 1024, 1024}; \
                pg8::MoeOrder S{nb, DFFE / 128, G, bx, blk0, 0, (const char*)WSP(bf16_t, WS_XS), (const char*)(WSP(bf16_t, WS_WMI) + (size_t)(l >> 1) * 8 * 2 * DFFE * D), (size_t)256 * 1024 * 2, (size_t)256 * 1024 * 2, (size_t)2 * DFFE * D * 2, pend}; \
                pg8::EpiSwiglu E{WSP(bf16_t, WS_R), DFFE}; \
                pg8::gemm_phase<pg8::EpiSwiglu, pg8::MoeOrder, true>(lds, g, S, E, wave_s); } } xcd_barrier(bar, wave_s); }
#define SITE_MDOWN() { { unsigned char* ws = ARG_WS(); \
              if constexpr (F8) { pg8::GemmK g{DFFE / 2, DFFE / 2, DFFE / 2}; \
                const int nbm = nb < pg8::TAIL_B0 ? nb : pg8::TAIL_B0;     \
                pg8::MoeOrder S{nbm, 4, G, bx, blk0, 1, (const char*)WSP(unsigned char, WS_R), (const char*)(WSP(unsigned char, WS_WMO) + (size_t)(l >> 1) * 8 * D * DFFE * 2), (size_t)256 * DFFE, (size_t)256 * DFFE, (size_t)D * DFFE, pend}; \
                pg8::EpiMoeDown E{WSP(bf16_t, WS_XS), WSP(float, WS_GATE_SLOT), 1.0f / (W8_DN * H8_SC)}; \
                pg8::gemm_phase<pg8::EpiMoeDown, pg8::MoeOrder, true, 1>(lds, g, S, E, wave_s); \
                if (nb > pg8::TAIL_B0) { pg8::GemmK g2{DFFE / (2 * pg8::TAIL_KS), DFFE / 2, DFFE / 2}; \
                  pg8::MoeTailOrder S2{nb - pg8::TAIL_B0, G, bx, (const char*)WSP(unsigned char, WS_R), (const char*)(WSP(unsigned char, WS_WMO) + (size_t)(l >> 1) * 8 * D * DFFE * 2), (size_t)256 * DFFE, (size_t)256 * DFFE, (size_t)D * DFFE, (size_t)(DFFE / pg8::TAIL_KS), pend}; \
                  pg8::EpiMoeDownT E2{WSP(bf16_t, WS_YT), WSP(float, WS_GATE_SLOT), 1.0f / (W8_DN * H8_SC)}; \
                  pg8::gemm_phase<pg8::EpiMoeDownT, pg8::MoeTailOrder, true, 1>(lds, g2, S2, E2, wave_s); } } \
              else { pg8::GemmK g{DFFE, DFFE, DFFE}; \
                pg8::MoeOrder S{nb, 4, G, bx, blk0, 1, (const char*)WSP(bf16_t, WS_R), (const char*)(WSP(bf16_t, WS_WMO) + (size_t)(l >> 1) * 8 * D * DFFE), (size_t)256 * DFFE * 2, (size_t)256 * DFFE * 2, (size_t)D * DFFE * 2, pend}; \
                pg8::EpiMoeDown E{WSP(bf16_t, WS_XS), WSP(float, WS_GATE_SLOT), 1.0f}; \
                pg8::gemm_phase<pg8::EpiMoeDown, pg8::MoeOrder, true>(lds, g, S, E, wave_s); } } xcd_barrier(bar, wave_s); }
    constexpr bool F8 = ((FP8_MASK >> l) & 1) != 0;
    constexpr bool I8 = (INT8_UP0 != 0) && l == 0 && !F8;
    if constexpr (l < 2) {
        const bool chain = (G == M / 256);
        if (DUP(5) || (DUP(7) && l == 1) || (DUP(11) && l == 0)) SITE_POOLPREP(true)
        SITE_POOLPREP(!chain)
        if (DUP(2) || DUP(12)) SITE_POOLGEMM(0.f, true)
        SITE_POOLGEMM(1.f, !chain)
    } else {
        if (DUP(2) || DUP(13)) SITE_PROJ()
        SITE_PROJ()
        if (DUP(3)) SITE_ATTN()
        SITE_ATTN()
        if (DUP(2) || DUP(14)) SITE_OPROJ(0.f)
        SITE_OPROJ(1.f)
    }
    if constexpr ((l & 1) == 0) {
        if constexpr (I8) { if (DUP(5) || DUP(8)) SITE_NORMX(2, true) SITE_NORMX(2, true) } else if constexpr (F8) { if (DUP(5) || DUP(8)) SITE_NORMX(1, true) SITE_NORMX(1, true) } else { if (DUP(5)) SITE_NORMX(0, true) SITE_NORMX(0, true) }
        if (DUP(1)) SITE_DUP()
        SITE_DUP()
        if (DUP(1)) SITE_DDOWN(0.f)
        SITE_DDOWN(1.f)
        if constexpr (l == 2) { if constexpr (INT8_PROJ != 0) { if (DUP(5) || DUP(8)) SITE_NORMI8() SITE_NORMI8() } else { if (DUP(5)) SITE_NORM() SITE_NORM() } }
    } else {
        if (DUP(5) || DUP(9)) SITE_ROUTER()
        SITE_ROUTER()
        if (DUP(5) || DUP(10)) SITE_DISPATCH()
        SITE_DISPATCH()
        constexpr int CB = F8 ? CAP / 256 : CHUNK_BLKS;
        for (int ch = 0; ch < (F8 ? 1 : 2); ++ch) {
            const int nblk = pend[7];
            const int blk0 = ch * CB; int nb = nblk - blk0; nb = nb < 0 ? 0 : (nb > CB ? CB : nb); nb = __builtin_amdgcn_readfirstlane(nb);
            if (DUP(0)) SITE_MUP()
            SITE_MUP()
            if (DUP(0)) SITE_MDOWN()
            SITE_MDOWN()
        }
        if constexpr (l == 1) { { unsigned char* ws = ARG_WS(); norm_phase<true, false, false, INT8_PROJ ? 2 : 0, false, bf16_t>(nullptr, WSP(bf16_t, WS_XN), WSP(bf16_t, WS_XS), WSP(int, WS_SLOT_OF), nullptr, nullptr, nullptr, nullptr, nullptr, lds, cnt_l, G, wave_s, WSP(float, WS_ASCALE), WSP(bf16_t, WS_DELTA), (const bf16_t*)WSP(bf16_t, WS_XB), WSP(bf16_t, WS_XB), tix); } SEAM_L() }
        else for (int rep_ = 0; rep_ < 1 + DUP(6); ++rep_) { unsigned char* ws = ARG_WS(); if (rep_) xcd_barrier(bar, wave_s); norm_phase<true, false, true, 0, false, bf16_t>(ARG_OUT(), WSP(bf16_t, WS_XN), WSP(bf16_t, WS_XS), WSP(int, WS_SLOT_OF), ARG_IN(14), nullptr, nullptr, nullptr, nullptr, lds, cnt_l, G, wave_s, nullptr, WSP(bf16_t, WS_DELTA), (const bf16_t*)WSP(bf16_t, WS_XB), nullptr, tix); }
    }
}

__global__ void __launch_bounds__(NTHREADS, 2) yoco_fwd(Args args_unused) {
    extern __shared__ __attribute__((aligned(16))) unsigned char lds_raw[];
    LAS unsigned char* lds = (LAS unsigned char*)lds_raw;
    __builtin_amdgcn_s_setreg((0 << 11) | (23 << 6) | 1, 1u);
    const int G = gridDim.x; const int bx = blockIdx.x; const int wave_s = __builtin_amdgcn_readfirstlane(threadIdx.x >> 6);
    const int vcu = (G % 8 == 0) ? (bx % 8) * (G / 8) + bx / 8 : bx;
    const int NGW = G * NWAVES;
    LAS unsigned* lctl = (LAS unsigned*)(lds + LCTL_OFF);
    for (int u = threadIdx.x; u < (LDS_BYTES - LCTL_OFF) / 4; u += NTHREADS) lctl[u] = 0u;
    __syncthreads();
    volatile LAS unsigned* bar_st = (volatile LAS unsigned*)lctl;
    LAS int* pend = (LAS int*)(lctl + 16);
    LAS int* cnt_l = (LAS int*)(lctl + 32);
    XcdBarrier bar = xcd_barrier_post((unsigned*)(ARG_WS() + WS_CTL) + 1024, bar_st);

    for (int rep = 0; rep < 1 + DUP(4); ++rep) {
        unsigned char* ws = ARG_WS();
        const int tid = fresh_tid(wave_s); const int lane = tid & 63, wave = __builtin_amdgcn_readfirstlane(tid >> 6), gw = vcu * NWAVES + wave;
        LAS float* scr = (LAS float*)(lds + wave * 16384);
        int base = 0;
        for (int j = 0; j < 50; ++j) {
            const float* W; const float* gain = nullptr; int ldw, K, N; float mul = 1.0f; bool f8 = false, gu = false; size_t dst;
            if (j < 8) { W = ARG_IN(3) + (size_t)j * 65536; ldw = 256; K = 256; N = 256; gain = ARG_IN(1) + (j >> 2) * D + (j & 3) * 256; dst = WS_WPOOL + (size_t)j * 65536 * 2; }
            else if (j < 10) { W = ARG_IN(6) + (j - 8) * 1024; ldw = 2048; K = 1024; N = 1024; gain = ARG_IN(5); dst = (j == 8) ? WS_WK : WS_WV; }
            else if (j < 12) { const int b = j - 10; W = ARG_IN(7) + (size_t)b * D * D; ldw = 1024; K = 1024; N = 1024; gain = ARG_IN(1) + (2 + b) * D; mul = 0.125f * 1.4426950408889634f; dst = WS_WQ + (size_t)b * D * D * 2; }
            else if (j < 14) { const int b = j - 12; W = ARG_IN(8) + (size_t)b * D * D; ldw = 1024; K = 1024; N = 1024; dst = WS_WO + (size_t)b * D * D * 2; }
            else if (j < 16) { const int i = j - 14; f8 = ((FP8_MASK >> (2 * i)) & 1) != 0; gu = true; W = ARG_IN(9) + (size_t)i * D * 2 * DFF; ldw = 2 * DFF; K = 1024; N = 2 * DFF; gain = ARG_IN(2) + (2 * i) * D; mul = f8 ? W8_UP : 1.0f; dst = WS_WFI + (size_t)i * 2 * DFF * D * 2; }
            else if (j < 18) { const int i = j - 16; f8 = ((FP8_MASK >> (2 * i)) & 1) != 0 || (i == 0 && L0_DOWN_FP8 != 0); W = ARG_IN(10) + (size_t)i * DFF * D; ldw = 1024; K = DFF; N = 1024; mul = f8 ? W8_DN : 1.0f; dst = WS_WFO + (size_t)i * D * DFF * 2; }
            else if (j < 34) { const int ie = j - 18, li = 2 * (ie >> 3) + 1, e = ie & 7; f8 = ((FP8_MASK >> li) & 1) != 0; gu = true; W = ARG_IN(12) + (size_t)ie * D * 2 * DFFE; ldw = 2 * DFFE; K = 1024; N = 2 * DFFE; gain = ARG_IN(2) + li * D; mul = f8 ? W8_UP : 1.0f;
                               dst = WS_WMI + (size_t)(ie >> 3) * 8 * 2 * DFFE * D * 2 + (size_t)e * 2 * DFFE * D * (f8 ? 1 : 2); }
            else { const int ie = j - 34, li = 2 * (ie >> 3) + 1, e = ie & 7; f8 = ((FP8_MASK >> li) & 1) != 0; W = ARG_IN(13) + (size_t)ie * DFFE * D; ldw = 1024; K = DFFE; N = 1024; mul = f8 ? W8_DN : 1.0f;
                   dst = WS_WMO + (size_t)(ie >> 3) * 8 * D * DFFE * 2 + (size_t)e * D * DFFE * (f8 ? 1 : 2); }
            const int nitems = (K / 64) * (N / 32);
            int first = (gw - base) % NGW; if (first < 0) first += NGW;
            if ((INT8_UP0 && j == 14) || (INT8_PROJ && j >= 8 && j < 12)) continue;
            tr_mat(W, ldw, K, N, gain, mul, f8 ? 1 : 0, gu, ws + dst, scr, first, NGW, lane, nullptr, nullptr, (gu && f8) ? W8_GATE : 0.f);
            base = (base + nitems) % NGW;
        }
    }
    if (INT8_UP0 || INT8_PROJ) {
        unsigned char* ws = ARG_WS(); const int tid = fresh_tid(wave_s); const int lane = tid & 63, gw = vcu * NWAVES + __builtin_amdgcn_readfirstlane(tid >> 6);
        int base = 0;
        for (int j = 0; j < 5; ++j) {
            if ((j == 0 && !INT8_UP0) || (j > 0 && !INT8_PROJ)) continue;
            const GAS float* W; const GAS float* gn; int ldw, ncols; float mul = 1.0f; unsigned* cm;
            if (j == 0) { W = (const GAS float*)ARG_IN(9); gn = (const GAS float*)ARG_IN(2); ldw = 2 * DFF; ncols = 2 * DFF; cm = WSP(unsigned, WS_COLMAX); }
            else if (j < 3) { W = (const GAS float*)ARG_IN(6) + (j - 1) * 1024; gn = (const GAS float*)ARG_IN(5); ldw = 2048; ncols = 1024; cm = WSP(unsigned, WS_COLMAX2) + (j - 1) * 1024; }
            else { W = (const GAS float*)ARG_IN(7) + (size_t)(j - 3) * D * D; gn = (const GAS float*)ARG_IN(1) + (2 + (j - 3)) * D; ldw = 1024; ncols = 1024; mul = 0.125f * 1.4426950408889634f; cm = WSP(unsigned, WS_COLMAX2) + (2 + (j - 3)) * 1024; }
            const int nstrip = ncols / 64, ntask = nstrip * (D / 64);
            int first = (gw - base) % NGW; if (first < 0) first += NGW;
            for (int task = first; task < ntask; task += NGW) { const int strip = task % nstrip, kc = task / nstrip; const int n = strip * 64 + lane; unsigned mxb = 0u;
                const GAS float* wp = W + (size_t)(kc * 64) * ldw + n;
                for (int kb = 0; kb < 64; kb += 16) { float wv[16];
#pragma unroll
                    for (int i = 0; i < 16; ++i) wv[i] = wp[(size_t)(kb + i) * ldw];
#pragma unroll
                    for (int i = 0; i < 16; ++i) { const unsigned b = __builtin_bit_cast(unsigned, wv[i] * gn[kc * 64 + kb + i]) & 0x7fffffffu; mxb = b > mxb ? b : mxb; } }
                const float mx = __builtin_bit_cast(float, mxb);
                const unsigned old = __hip_atomic_fetch_max(cm + n, __builtin_bit_cast(unsigned, mx * mul), __ATOMIC_RELAXED, __HIP_MEMORY_SCOPE_AGENT); asm volatile("" :: "v"(old)); }
            base = (base + ntask) % NGW;
        }
    }
    xcd_barrier(bar, wave_s);

    const bool xl = (bar_st[2] != 0u) && (G == M / 256);
    const int rank = (int)bar_st[3];
    const int vbx = xl ? rank * 8 + (int)bar.x : bx;
    const int vcu2 = xl ? (int)bar.x * (G / 8) + rank : vcu;
    const int tix = xl ? vcu2 : bx;
    layer_body<0>(lds, bar, pend, cnt_l, G, vbx, vcu2, NGW, wave_s, tix, xl);
    layer_body<1>(lds, bar, pend, cnt_l, G, vbx, vcu2, NGW, wave_s, tix, xl);
    layer_body<2>(lds, bar, pend, cnt_l, G, vbx, vcu2, NGW, wave_s, tix, xl);
    layer_body<3>(lds, bar, pend, cnt_l, G, vbx, vcu2, NGW, wave_s, tix, xl);
}

extern "C" void kernel_launch(void* const* d_in, const int* in_sizes, int n_in, void* d_out, int out_size, void* d_ws, size_t ws_size, hipStream_t stream) {
    static int grid = 0;
    if (grid == 0) {
        if (n_in != 15 || out_size != M * D || ws_size < WS_END) { fprintf(stderr, "kernel_launch: unexpected shapes (n_in %d out %d ws %zu)\n", n_in, out_size, ws_size); grid = -1; return; }
        int dev = 0, cus = 0, per_cu = 0;
        if (hipGetDevice(&dev) != hipSuccess || hipDeviceGetAttribute(&cus, hipDeviceAttributeMultiprocessorCount, dev) != hipSuccess) { grid = -1; return; }
        if (hipFuncSetAttribute((const void*)yoco_fwd, hipFuncAttributeMaxDynamicSharedMemorySize, LDS_BYTES) != hipSuccess) { fprintf(stderr, "kernel_launch: hipFuncSetAttribute failed\n"); grid = -1; return; }
        if (hipOccupancyMaxActiveBlocksPerMultiprocessor(&per_cu, (const void*)yoco_fwd, NTHREADS, LDS_BYTES) != hipSuccess || per_cu < 1) { fprintf(stderr, "kernel_launch: occupancy query says %d\n", per_cu); }
        (void)hipGetLastError();
        grid = cus;
    }
    if (grid < 0) return;
    (void)hipMemsetAsync((char*)d_ws + WS_CTL, 0, CTL_ZERO_BYTES, stream);
    Args a{};
    for (int i = 0; i < 15; ++i) a.in[i] = (const float*)d_in[i];
    a.out = (float*)d_out; a.ws = (unsigned char*)d_ws;
    hipLaunchKernelGGL(yoco_fwd, dim3(grid), dim3(NTHREADS), LDS_BYTES, stream, a);
}
```
